# Optimizing an MI355X kernel written in HIP

```python
import math
import jax
import jax.numpy as jnp
from jax import lax
import numpy as np

D_MODEL = 1024
BATCH = 8
SEQ = 4096
DEPTH = 1

GRID_W = 64
CTX_LEN = 256
EPS = 1e-6

RET_HEADS = 4
RET_QK_DIM = 128
RET_V_DIM = 256
RET_QK_WIDTH = RET_HEADS * RET_QK_DIM
RET_V_WIDTH = RET_HEADS * RET_V_DIM
RET_CHUNK = 128
ROPE_BASE = 10000.0

HY_WIDTH = 512
HY_SHORT = 3
HY_POS_DIM = 33
HY_BANDS = (HY_POS_DIM - 1) // 2
HY_FFN = 64
HY_DECAY_TARGET = 1e-2
HY_FAST_PCT = 0.3
HY_SLOW_PCT = 1.5

N_GROUPS = 4
EXPERTS_PER_GROUP = 8
N_EXPERTS = N_GROUPS * EXPERTS_PER_GROUP
TOP_K = 2
EXPERT_HIDDEN = 512
MOE_BLOCK = 128

IN_WIDTH = 2 * RET_QK_WIDTH + 2 * RET_V_WIDTH + 3 * HY_WIDTH + 2 * D_MODEL
IN_SPLITS = (RET_QK_WIDTH, 2 * RET_QK_WIDTH, 2 * RET_QK_WIDTH + RET_V_WIDTH, 2 * RET_QK_WIDTH + 2 * RET_V_WIDTH, 2 * RET_QK_WIDTH + 2 * RET_V_WIDTH + 3 * HY_WIDTH, 2 * RET_QK_WIDTH + 2 * RET_V_WIDTH + 3 * HY_WIDTH + D_MODEL)

kernel_name = 'hybrid_retention_hyena_hmoe_dit'


def rms_norm(x, gain=None):
    x32 = x.astype(jnp.float32)
    y = x32 * lax.rsqrt(jnp.mean(jnp.square(x32), axis=-1, keepdims=True) + EPS)
    if gain is not None:
        y = y * gain.astype(jnp.float32)
    return y.astype(x.dtype)


def modulate(h, shift, scale):
    return h * (1.0 + scale) + shift


def grid_rope_angles(n_tokens):
    rows = n_tokens // GRID_W
    r, col = jnp.meshgrid(jnp.arange(rows, dtype=jnp.float32), jnp.arange(GRID_W, dtype=jnp.float32), indexing='ij')
    n_freq = RET_QK_DIM // 4
    inv_freq = ROPE_BASE ** (-jnp.arange(n_freq, dtype=jnp.float32) / n_freq)
    return r.reshape(-1)[:, None] * inv_freq, col.reshape(-1)[:, None] * inv_freq


def rope_1d(x, ang):
    n_freq = ang.shape[-1]
    x1, x2 = x[..., :n_freq], x[..., n_freq:]
    cos, sin = jnp.cos(ang), jnp.sin(ang)
    return jnp.concatenate([x1 * cos - x2 * sin, x1 * sin + x2 * cos], axis=-1)


def rope_grid(x, ang_row, ang_col):
    half = RET_QK_DIM // 2
    return jnp.concatenate([rope_1d(x[..., :half], ang_row), rope_1d(x[..., half:], ang_col)], axis=-1)


def split_heads(t, n_heads):
    b, n, _ = t.shape
    return t.reshape(b, n, n_heads, -1).transpose(0, 2, 1, 3)


def retention_scan(q, k, v, log_g, s0, strict):
    b, h, n, _ = q.shape
    dv = v.shape[-1]
    n_chunks = n // RET_CHUNK
    pos = jnp.arange(RET_CHUNK, dtype=jnp.float32)
    diff = pos[:, None] - pos[None, :]
    mask = (diff > 0) if strict else (diff >= 0)
    lg = log_g[:, None, None]
    decay_in = jnp.where(mask[None], jnp.exp(lg * jnp.maximum(diff, 0.0)[None]), 0.0)
    decay_q = jnp.exp(lg * (pos + 1.0)[None, :, None])
    decay_k = jnp.exp(lg * (RET_CHUNK - 1.0 - pos)[None, :, None])
    decay_chunk = jnp.exp(lg * RET_CHUNK)

    def chunks(t):
        return t.reshape(b, h, n_chunks, RET_CHUNK, t.shape[-1]).transpose(2, 0, 1, 3, 4)

    def step(state, qkv):
        qc, kc, vc = qkv
        scores = jnp.einsum('bhid,bhjd->bhij', qc, kc) * decay_in
        out = jnp.einsum('bhij,bhjv->bhiv', scores, vc) + jnp.einsum('bhid,bhdv->bhiv', qc, state) * decay_q
        state = state * decay_chunk + jnp.einsum('bhjd,bhjv->bhdv', kc * decay_k, vc)
        return state, out

    s_final, o = lax.scan(step, s0, (chunks(q), chunks(k), chunks(v)))
    return o.transpose(1, 2, 0, 3, 4).reshape(b, h, n, dv), s_final


def retention_bidir(q, k, v, log_g, s0_fwd, s0_bwd):
    o_f, s_f = retention_scan(q, k, v, log_g[0], s0_fwd, False)
    o_b, s_b = retention_scan(jnp.flip(q, 2), jnp.flip(k, 2), jnp.flip(v, 2), log_g[1], s0_bwd, True)
    return o_f + jnp.flip(o_b, 2), s_f, s_b


def retention_readout(o, g):
    b, h, n, dv = o.shape
    o = rms_norm(o).transpose(0, 2, 1, 3).reshape(b, n, h * dv)
    return jax.nn.silu(g) * o.astype(g.dtype)


def short_conv(u, w, bias):
    n = u.shape[1]
    pad = HY_SHORT // 2
    up = jnp.pad(u, ((0, 0), (pad, pad), (0, 0)))
    return sum(up[:, j:j + n] * w[j] for j in range(HY_SHORT)) + bias


def hyena_filters(n, w1, b1, freq, w2, b2, w3):
    f32 = jnp.float32
    t = jnp.arange(n, dtype=f32) / n
    bands = jnp.linspace(1e-4, HY_BANDS - 1, HY_BANDS, dtype=f32)
    phase = 2.0 * math.pi * t[:, None] * bands[None, :]
    feats = jnp.concatenate([t[:, None], jnp.cos(phase), -jnp.sin(phase)], axis=-1)
    freq = freq.astype(f32)
    hid = jnp.sin(freq * (feats @ w1.astype(f32) + b1.astype(f32)))
    hid = jnp.sin(freq * (hid @ w2.astype(f32) + b2.astype(f32)))
    filt = hid @ w3.astype(f32)
    slow = abs(math.log(HY_DECAY_TARGET)) / HY_SLOW_PCT
    fast = abs(math.log(HY_DECAY_TARGET)) / HY_FAST_PCT
    deltas = jnp.tile(jnp.linspace(slow, fast, HY_WIDTH, dtype=f32), 2)
    filt = filt * jnp.exp(-t[:, None] * deltas[None, :])
    filt = filt / jnp.sum(jnp.abs(filt), axis=0, keepdims=True)
    return filt[:, :HY_WIDTH], filt[:, HY_WIDTH:]


def long_conv_bidir(z, h_fwd, h_bwd):
    n = z.shape[1]
    nfft = 2 * n
    zf = jnp.fft.rfft(z.astype(jnp.float32), n=nfft, axis=1)
    hf = jnp.fft.rfft(h_fwd, n=nfft, axis=0) + jnp.conj(jnp.fft.rfft(h_bwd, n=nfft, axis=0))
    return jnp.fft.irfft(zf * hf[None], n=nfft, axis=1)[:, :n]


def hyena_branch(u, conv_w, conv_b, ffn_w1, ffn_b1, ffn_freq, ffn_w2, ffn_b2, ffn_w3, skip):
    x0, x1, v = jnp.split(short_conv(u, conv_w, conv_b), 3, axis=-1)
    z = x1 * v
    h_fwd, h_bwd = hyena_filters(u.shape[1], ffn_w1, ffn_b1, ffn_freq, ffn_w2, ffn_b2, ffn_w3)
    y = long_conv_bidir(z, h_fwd, h_bwd).astype(u.dtype) + z * skip
    return x0 * y


def merge_branches(ret_gated, hy_out, gate_ret, gate_hy, ret_w_o, hy_w_o, w_out):
    mixed = jax.nn.sigmoid(gate_ret) * (ret_gated @ ret_w_o) + jax.nn.sigmoid(gate_hy) * (hy_out @ hy_w_o)
    return mixed @ w_out


def moe_ffn(u, rg_w, rg_b, re_w, re_b, w1, w3, w2):
    n_tok = u.shape[0]
    f32 = jnp.float32
    group_p = jax.nn.softmax((u @ rg_w).astype(f32) + rg_b.astype(f32), axis=-1)
    p_star, g_star = lax.top_k(group_p, 1)
    expert_logits = ((u @ re_w).astype(f32) + re_b.astype(f32)).reshape(n_tok, N_GROUPS, EXPERTS_PER_GROUP)
    in_group = jnp.take_along_axis(expert_logits, g_star[:, :, None], axis=1)[:, 0]
    w_top, e_top = lax.top_k(jax.nn.softmax(in_group, axis=-1), TOP_K)
    weights = p_star * w_top / jnp.sum(w_top, axis=-1, keepdims=True)
    expert_id = g_star * EXPERTS_PER_GROUP + e_top
    n_assign = n_tok * TOP_K
    flat_e = expert_id.reshape(n_assign)
    flat_tok = jnp.arange(n_assign, dtype=jnp.int32) // TOP_K
    flat_w = weights.reshape(n_assign)
    order = jnp.argsort(flat_e)
    se, stok, sw = flat_e[order], flat_tok[order], flat_w[order]
    counts = jnp.bincount(flat_e, length=N_EXPERTS)
    starts = jnp.cumsum(counts) - counts
    padded = (counts + MOE_BLOCK - 1) // MOE_BLOCK * MOE_BLOCK
    padded_end = jnp.cumsum(padded)
    padded_start = padded_end - padded
    dest = padded_start[se] + jnp.arange(n_assign, dtype=jnp.int32) - starts[se]
    n_blocks = -(-(n_assign + N_EXPERTS * (MOE_BLOCK - 1)) // MOE_BLOCK)
    n_rows = n_blocks * MOE_BLOCK
    row_tok = jnp.zeros((n_rows,), jnp.int32).at[dest].set(stok)
    block_expert = jnp.minimum(jnp.searchsorted(padded_end, jnp.arange(n_blocks, dtype=jnp.int32) * MOE_BLOCK, side='right'), N_EXPERTS - 1)
    xb = u[row_tok].reshape(n_blocks, MOE_BLOCK, u.shape[1])

    def expert_block(args):
        xblk, e = args
        return (jax.nn.silu(xblk @ w1[e]) * (xblk @ w3[e])) @ w2[e]

    yb = lax.map(expert_block, (xb, block_expert)).reshape(n_rows, u.shape[1])
    y = yb[dest] * sw[:, None].astype(u.dtype)
    return jax.ops.segment_sum(y, stok, num_segments=n_tok)


def setup_inputs(seed: int = 0) -> dict:
    key = jax.random.key(seed)
    ks = jax.random.split(key, 32)
    f32 = jnp.float32

    def nrm(k, shape, scale):
        return scale * jax.random.normal(k, shape, f32)

    base_logit = np.log(2.0 ** (5 + np.arange(RET_HEADS)) - 1.0).astype(np.float32)
    return {
        'x': nrm(ks[0], (BATCH, SEQ, D_MODEL), 1.0),
        'c': nrm(ks[1], (BATCH, D_MODEL), 1.0),
        'ctx': nrm(ks[2], (BATCH, CTX_LEN, D_MODEL), 1.0),
        'c_ctx': nrm(ks[3], (D_MODEL,), 1.0),
        'ada_w': nrm(ks[4], (DEPTH, D_MODEL, 6 * D_MODEL), 0.5 * D_MODEL ** -0.5),
        'ada_b': nrm(ks[5], (DEPTH, 6 * D_MODEL), 0.02),
        'norm1_g': 1.0 + nrm(ks[6], (DEPTH, D_MODEL), 0.05),
        'norm2_g': 1.0 + nrm(ks[7], (DEPTH, D_MODEL), 0.05),
        'w_in': nrm(ks[8], (DEPTH, D_MODEL, IN_WIDTH), D_MODEL ** -0.5),
        'b_in': nrm(ks[9], (DEPTH, IN_WIDTH), 0.02),
        'ret_decay_logit': jnp.asarray(base_logit)[None, None, :] + nrm(ks[10], (DEPTH, 2, RET_HEADS), 0.1),
        'ret_w_o': nrm(ks[11], (DEPTH, RET_V_WIDTH, D_MODEL), RET_V_WIDTH ** -0.5),
        'hy_conv_w': nrm(ks[12], (DEPTH, HY_SHORT, 3 * HY_WIDTH), HY_SHORT ** -0.5),
        'hy_conv_b': nrm(ks[13], (DEPTH, 3 * HY_WIDTH), 0.02),
        'hy_ffn_w1': nrm(ks[14], (DEPTH, HY_POS_DIM, HY_FFN), HY_POS_DIM ** -0.5),
        'hy_ffn_b1': nrm(ks[15], (DEPTH, HY_FFN), 0.02),
        'hy_ffn_freq': 1.0 + nrm(ks[16], (DEPTH, HY_FFN), 0.05),
        'hy_ffn_w2': nrm(ks[17], (DEPTH, HY_FFN, HY_FFN), HY_FFN ** -0.5),
        'hy_ffn_b2': nrm(ks[18], (DEPTH, HY_FFN), 0.02),
        'hy_ffn_w3': nrm(ks[19], (DEPTH, HY_FFN, 2 * HY_WIDTH), HY_FFN ** -0.5),
        'hy_skip': nrm(ks[20], (DEPTH, HY_WIDTH), 0.5),
        'hy_w_o': nrm(ks[21], (DEPTH, HY_WIDTH, D_MODEL), HY_WIDTH ** -0.5),
        'w_out': nrm(ks[22], (DEPTH, D_MODEL, D_MODEL), D_MODEL ** -0.5),
        'router_group_w': nrm(ks[23], (DEPTH, D_MODEL, N_GROUPS), D_MODEL ** -0.5),
        'router_group_b': nrm(ks[24], (DEPTH, N_GROUPS), 0.01),
        'router_expert_w': nrm(ks[25], (DEPTH, D_MODEL, N_EXPERTS), D_MODEL ** -0.5),
        'router_expert_b': nrm(ks[26], (DEPTH, N_EXPERTS), 0.01),
        'expert_w1': nrm(ks[27], (DEPTH, N_EXPERTS, D_MODEL, EXPERT_HIDDEN), D_MODEL ** -0.5),
        'expert_w3': nrm(ks[28], (DEPTH, N_EXPERTS, D_MODEL, EXPERT_HIDDEN), D_MODEL ** -0.5),
        'expert_w2': nrm(ks[29], (DEPTH, N_EXPERTS, EXPERT_HIDDEN, D_MODEL), EXPERT_HIDDEN ** -0.5),
        'final_norm_g': 1.0 + nrm(ks[30], (D_MODEL,), 0.05),
    }


def reference(x, c, ctx, c_ctx, ada_w, ada_b, norm1_g, norm2_g, w_in, b_in, ret_decay_logit, ret_w_o, hy_conv_w, hy_conv_b, hy_ffn_w1, hy_ffn_b1, hy_ffn_freq, hy_ffn_w2, hy_ffn_b2, hy_ffn_w3, hy_skip, hy_w_o, w_out, router_group_w, router_group_b, router_expert_w, router_expert_b, expert_w1, expert_w3, expert_w2, final_norm_g):
    f32 = jnp.float32
    batch, n_tokens = x.shape[0], x.shape[1]
    ang_row, ang_col = grid_rope_angles(n_tokens)
    silu_c = jax.nn.silu(c)
    silu_cc = jax.nn.silu(c_ctx)
    k_scale = RET_QK_DIM ** -0.5
    for layer in range(DEPTH):
        last = layer == DEPTH - 1
        sh1, sc1, gt1, sh2, sc2, gt2 = jnp.split((silu_c @ ada_w[layer] + ada_b[layer])[:, None, :], 6, axis=-1)
        csh1, csc1, cgt1, csh2, csc2, cgt2 = jnp.split(silu_cc @ ada_w[layer] + ada_b[layer], 6, axis=-1)
        h = modulate(rms_norm(x, norm1_g[layer]), sh1, sc1)
        hc = modulate(rms_norm(ctx, norm1_g[layer]), csh1, csc1)
        q, k, v, g, hy_u, gate_ret, gate_hy = jnp.split(h @ w_in[layer] + b_in[layer], IN_SPLITS, axis=-1)
        qc, kc, vc, gc, hyc_u, gate_ret_c, gate_hy_c = jnp.split(hc @ w_in[layer] + b_in[layer], IN_SPLITS, axis=-1)
        log_g = jax.nn.log_sigmoid(ret_decay_logit[layer].astype(f32))
        zero_state = jnp.zeros((batch, RET_HEADS, RET_QK_DIM, RET_V_DIM), f32)
        o_ctx, s_fwd, s_bwd = retention_bidir(split_heads(qc, RET_HEADS).astype(f32), split_heads(kc, RET_HEADS).astype(f32) * k_scale, split_heads(vc, RET_HEADS).astype(f32), log_g, zero_state, zero_state)
        q_h = rope_grid(split_heads(q, RET_HEADS).astype(f32), ang_row, ang_col)
        k_h = rope_grid(split_heads(k, RET_HEADS).astype(f32), ang_row, ang_col) * k_scale
        o_lat, _, _ = retention_bidir(q_h, k_h, split_heads(v, RET_HEADS).astype(f32), log_g, s_fwd, s_bwd)
        hy_args = (hy_conv_w[layer], hy_conv_b[layer], hy_ffn_w1[layer], hy_ffn_b1[layer], hy_ffn_freq[layer], hy_ffn_w2[layer], hy_ffn_b2[layer], hy_ffn_w3[layer], hy_skip[layer])
        out_args = (ret_w_o[layer], hy_w_o[layer], w_out[layer])
        moe_args = (router_group_w[layer], router_group_b[layer], router_expert_w[layer], router_expert_b[layer], expert_w1[layer], expert_w3[layer], expert_w2[layer])
        mix = merge_branches(retention_readout(o_lat, g), hyena_branch(hy_u, *hy_args), gate_ret, gate_hy, *out_args)
        x = x + gt1 * mix
        h2 = modulate(rms_norm(x, norm2_g[layer]), sh2, sc2)
        if last:
            x = x + gt2 * moe_ffn(h2.reshape(-1, D_MODEL), *moe_args).reshape(x.shape)
        else:
            mix_c = merge_branches(retention_readout(o_ctx, gc), hyena_branch(hyc_u, *hy_args), gate_ret_c, gate_hy_c, *out_args)
            ctx = ctx + cgt1 * mix_c
            h2c = modulate(rms_norm(ctx, norm2_g[layer]), csh2, csc2)
            y = moe_ffn(jnp.concatenate([h2.reshape(-1, D_MODEL), h2c.reshape(-1, D_MODEL)], axis=0), *moe_args)
            n_lat = batch * n_tokens
            x = x + gt2 * y[:n_lat].reshape(x.shape)
            ctx = ctx + cgt2 * y[n_lat:].reshape(ctx.shape)
    return rms_norm(x, final_norm_g)
```

```cpp
#include <hip/hip_runtime.h>
#include <hip/hip_cooperative_groups.h>
#include <cstdio>
#include <cstdint>
namespace cg = cooperative_groups;

#define LAS __attribute__((address_space(3)))
typedef unsigned short bf16_t;
typedef short bf16x8 __attribute__((ext_vector_type(8)));
typedef float f32x4 __attribute__((ext_vector_type(4)));
typedef unsigned u32x4 __attribute__((ext_vector_type(4)));
typedef unsigned u32x2 __attribute__((ext_vector_type(2)));

constexpr int BATCH = 8, SEQ = 4096, D = 1024, T = BATCH * SEQ, CTXL = 256, TC = BATCH * CTXL, MT = T + TC;
constexpr int NH = 4, DK = 128, DV = 256, TOKP = SEQ + CTXL;
constexpr int NINA = 4608;
constexpr int NE = 32, EH = 512;
constexpr float EPS = 1e-6f;
constexpr int LDS_BYTES = 163840;
constexpr int MISC_OFF = 131072;

constexpr size_t MiB = 1u << 20;
constexpr size_t WS_CTL = 0, CTL_BYTES = 65536;
constexpr size_t WS_MOD = 65536;
constexpr size_t WS_ROPE = 327680;
constexpr size_t WS_BINP = 344064;
constexpr size_t WS_FPART = 524288;
constexpr size_t WS_TOKINFO = 2 * MiB;
constexpr size_t WS_LISTS = 3 * MiB;
constexpr size_t WS_TR = 8 * MiB;
constexpr size_t WS_WT_IN = 16 * MiB;
constexpr size_t WS_WT_RETO = 29 * MiB, WS_WT_HYO = 31 * MiB, WS_WT_OUT = 32 * MiB;
constexpr size_t WS_R1 = 34 * MiB;
constexpr size_t WS_Q = WS_R1, WS_K = WS_R1 + 32 * MiB, WS_KT = WS_R1 + 66 * MiB, WS_VT = WS_R1 + 100 * MiB;
constexpr size_t WS_FILT = WS_R1;
constexpr size_t WS_SGR = WS_R1, WS_SGH = WS_R1 + 64 * MiB;
constexpr size_t WS_XB = WS_R1;
constexpr size_t WS_SG = 202 * MiB;
constexpr size_t WS_HU = 266 * MiB;
constexpr size_t WS_KV = 362 * MiB;
constexpr size_t WS_WE13 = 362 * MiB, WS_WE2 = 426 * MiB;
constexpr size_t WS_END = 494 * MiB;
constexpr size_t DO_XN = 0, DO_ZT = 68 * MiB;

__device__ __forceinline__ unsigned f2bf(float f) { unsigned u = __float_as_uint(f); return (u + 0x7fffu + ((u >> 16) & 1u)) >> 16; }
__device__ __forceinline__ unsigned pk2(float lo, float hi) { return f2bf(lo) | (f2bf(hi) << 16); }
__device__ __forceinline__ float bflo(unsigned w) { return __uint_as_float(w << 16); }
__device__ __forceinline__ float bfhi(unsigned w) { return __uint_as_float(w & 0xffff0000u); }
__device__ __forceinline__ float bf2f(bf16_t h) { return __uint_as_float((unsigned)h << 16); }
__device__ __forceinline__ float silu_f(float v) { return v / (1.f + __expf(-v)); }
__device__ __forceinline__ float sigm_f(float v) { return 1.f / (1.f + __expf(-v)); }
__device__ __forceinline__ float wave_sum(float v) {
#pragma unroll
    for (int o = 1; o < 64; o <<= 1) v += __shfl_xor(v, o);
    return v;
}
__host__ __device__ __forceinline__ int dimperm(int p) { const int wc = p >> 5, n = (p >> 4) & 1, i16 = p & 15; return 64 * (wc >> 1) + 32 * n + 16 * (wc & 1) + i16; }
__host__ __device__ __forceinline__ int inv_dimperm(int d) { const int half = d >> 6, n = (d >> 5) & 1, idx = d & 31; return 32 * (2 * half + (idx >> 4)) + 16 * n + (idx & 15); }
__host__ __device__ __forceinline__ int win_destrow(int n) { return n < 1024 ? (n & ~127) + inv_dimperm(n & 127) : n; }

namespace pg8 {
constexpr int BM = 256, BK = 64, HALF = 128, HTB = HALF * BK * 2, STAGE_BYTES = 8 * HTB, NXCD = 8, WGM = 8;
__host__ __device__ __forceinline__ int lds_byte(int r, int c) { const int st = (r >> 4) * 2 + (c >> 5), rr = r & 15, cc = c & 31, ob = rr * 64 + cc * 2; return st * 1024 + (ob ^ (((ob >> 9) & 1) << 5)); }
__host__ __device__ __forceinline__ void stage_rc(int b, int& R, int& C) { const int st = b / 1024, sb = b % 1024, swz = sb ^ (((sb >> 9) & 1) << 5); R = (st >> 1) * 16 + swz / 64; C = (st & 1) * 32 + (swz % 64) / 2; }
__host__ __device__ __forceinline__ int perm32(int rho) { const int n = rho >> 4, i = rho & 15; return 8 * (i >> 2) + 4 * n + (i & 3); }

struct Unit { int pm, pn, pc; };
struct Gemm { const bf16_t* A; const bf16_t* Bt; int K, lda, ldb; };

struct StaticOrder {
    int nM, nN, nwg, G, c;
    __device__ void init(int M, int N, int G_, int c_) { nM = M / BM; nN = N / BM; nwg = nM * nN; G = G_; c = c_; }
    __device__ bool next(int i, Unit& u) const {
        const long L = (long)i * G + c; if (L >= nwg) return false;
        int wgid = (int)L; { const int q = nwg / NXCD, r = nwg % NXCD, xcd = wgid % NXCD, off = wgid / NXCD; wgid = (xcd < r ? xcd * (q + 1) : r * (q + 1) + (xcd - r) * q) + off; }
        const int nig = WGM * nN, gid = wgid / nig, fm = gid * WGM, gsz = (nM - fm) < WGM ? (nM - fm) : WGM;
        u.pm = fm + ((wgid % nig) % gsz); u.pn = (wgid % nig) / gsz; u.pc = u.pn; return true;
    }
};
struct InProjOrder {
    StaticOrder so; int G, c;
    __device__ void init(int G_, int c_) { so.init(T, NINA, G_, c_); G = G_; c = c_; }
    __device__ bool next(int i, Unit& u) const {
        const long L = (long)i * G + c;
        if (L < so.nwg) return so.next(i, u);
        const int l = (int)(L - so.nwg); if (l >= 48) return false;
        u.pm = 128 + (l & 7); u.pn = 2 + (l >> 3); u.pc = u.pn; return true;
    }
};
struct MoeOrder {
    int ntile4, G, c; const LAS int* texp;
    __device__ bool next(int i, Unit& u) const {
        const long L = (long)i * G + c; if (L >= ntile4) return false;
        u.pm = (int)(L >> 2); u.pc = (int)(L & 3); u.pn = texp[u.pm] * 4 + u.pc; return true;
    }
};

__device__ __forceinline__ unsigned cvt_pk_bf16(float lo, float hi) { unsigned r; asm volatile("v_cvt_pk_bf16_f32 %0, %1, %2" : "=v"(r) : "v"(lo), "v"(hi)); return r; }

template <class Epi, class Sched>
__device__ __forceinline__ void gemm_phase(LAS unsigned char* lds, const Gemm g, const Sched& S, const Epi& E) {
    const int tid = threadIdx.x, wid = __builtin_amdgcn_readfirstlane(tid >> 6), lane = tid & 63, wr = wid >> 2, wc = wid & 3, fr = lane & 15, fq = lane >> 4;
    const int K = g.K, nt = K / BK;
    unsigned voffA[2], voffB[2];
#pragma unroll
    for (int i = 0; i < 2; ++i) { int R, C; stage_rc(tid * 16 + i * 8192, R, C); const int Rb = Epi::PERM ? ((R & ~31) + perm32(R & 31)) : R;
        voffA[i] = (unsigned)(R * g.lda + C) * 2u; voffB[i] = (unsigned)(Rb * g.ldb + C) * 2u; }
    const size_t kstep = (size_t)(BK * 2);
    const size_t hstepA = (size_t)HALF * g.lda * 2, tstepA = 2 * hstepA;
    const size_t hstepB = (size_t)HALF * g.ldb * 2, tstepB = 2 * hstepB;
    const unsigned ldsw = (unsigned)wid * 1024u;
    const int aoff = lds_byte(wr * 64 + fr, fq * 8), boff = lds_byte(wc * 32 + fr, fq * 8);
#define PG8_SA(b, h) (((b) * 2 + (h)) * HTB)
#define PG8_SB(b, h) ((4 + (b) * 2 + (h)) * HTB)
#define PG8_STAGE(bufoff, gbase, voff) do { _Pragma("unroll") for (int _i = 0; _i < 2; ++_i) \
        __builtin_amdgcn_global_load_lds((const unsigned*)((const char*)(gbase) + (voff)[_i]), (LAS unsigned*)(lds + (bufoff) + ldsw + _i * 8192), 16, 0, 0); } while (0)
#define PG8_LDA(dst, b, h) do { _Pragma("unroll") for (int m = 0; m < 4; ++m) _Pragma("unroll") for (int k = 0; k < 2; ++k) dst[m][k] = *(const LAS bf16x8*)(lds + PG8_SA(b, h) + aoff + m * 2048 + k * 1024); } while (0)
#define PG8_LDB(dst, b, h) do { _Pragma("unroll") for (int n = 0; n < 2; ++n) _Pragma("unroll") for (int k = 0; k < 2; ++k) dst[n][k] = *(const LAS bf16x8*)(lds + PG8_SB(b, h) + boff + n * 2048 + k * 1024); } while (0)
#define PG8_MMA(ai, bj, At, Bt) do { __builtin_amdgcn_s_setprio(1); _Pragma("unroll") for (int m = 0; m < 4; ++m) _Pragma("unroll") for (int n = 0; n < 2; ++n) _Pragma("unroll") for (int k = 0; k < 2; ++k) \
        acc[ai][bj][m][n] = __builtin_amdgcn_mfma_f32_16x16x32_bf16(Bt[n][k], At[m][k], acc[ai][bj][m][n], 0, 0, 0); __builtin_amdgcn_s_setprio(0); } while (0)
#define PG8_WAIT_V(n) asm volatile("s_waitcnt vmcnt(" #n ")" ::: "memory")
#define PG8_WAIT_L(n) asm volatile("s_waitcnt lgkmcnt(" #n ")" ::: "memory")
#define PG8_BAR __builtin_amdgcn_s_barrier()
#define PG8_SCHED __builtin_amdgcn_sched_barrier(0)
    Unit cur, nxt; int ui = 0;
    if (!S.next(0, cur)) return;
    f32x4 acc[2][2][4][2];
#pragma unroll
    for (int a = 0; a < 2; ++a)
#pragma unroll
        for (int b = 0; b < 2; ++b)
#pragma unroll
            for (int m = 0; m < 4; ++m)
#pragma unroll
                for (int n = 0; n < 2; ++n) acc[a][b][m][n] = (f32x4){0.f, 0.f, 0.f, 0.f};
    bf16x8 At[4][2], B0[2][2], B1[2][2];
    const char* cA = (const char*)g.A + (size_t)cur.pm * tstepA; const char* cB = (const char*)g.Bt + (size_t)cur.pn * tstepB;
    PG8_STAGE(PG8_SB(0, 0), cB, voffB); PG8_STAGE(PG8_SB(0, 1), cB + hstepB, voffB); PG8_STAGE(PG8_SA(0, 0), cA, voffA); PG8_STAGE(PG8_SA(0, 1), cA + hstepA, voffA);
    if (wr == 1) PG8_BAR;
    PG8_WAIT_V(2); PG8_BAR;
    PG8_STAGE(PG8_SB(1, 0), cB + kstep, voffB); PG8_STAGE(PG8_SA(1, 0), cA + kstep, voffA); PG8_STAGE(PG8_SB(1, 1), cB + hstepB + kstep, voffB);
    PG8_WAIT_V(6); PG8_BAR;
    for (;;) {
        const bool has_next = S.next(ui + 1, nxt);
        const char* nA = has_next ? (const char*)g.A + (size_t)nxt.pm * tstepA : cA; const char* nB = has_next ? (const char*)g.Bt + (size_t)nxt.pn * tstepB : cB;
        for (int t = 0; t < nt; t += 2) {
            const bool last = (t == nt - 2);
            const char* a1 = cA + (size_t)(t + 1) * kstep;
            const char* a2 = last ? nA : cA + (size_t)(t + 2) * kstep; const char* b2 = last ? nB : cB + (size_t)(t + 2) * kstep;
            const char* a3 = a2 + kstep; const char* b3 = b2 + kstep;
            PG8_LDB(B0, 0, 0); PG8_LDB(B1, 0, 1); PG8_SCHED; PG8_LDA(At, 0, 0); PG8_STAGE(PG8_SA(1, 1), a1 + hstepA, voffA);
            PG8_WAIT_V(8); PG8_WAIT_L(0); PG8_BAR; PG8_MMA(0, 0, At, B0); PG8_MMA(0, 1, At, B1); PG8_BAR; PG8_SCHED;
            PG8_LDA(At, 0, 1); PG8_STAGE(PG8_SB(0, 0), b2, voffB); PG8_STAGE(PG8_SB(0, 1), b2 + hstepB, voffB); PG8_STAGE(PG8_SA(0, 0), a2, voffA);
            PG8_WAIT_V(8); PG8_WAIT_L(0); PG8_BAR; PG8_MMA(1, 0, At, B0); PG8_MMA(1, 1, At, B1); PG8_BAR; PG8_SCHED;
            PG8_LDB(B0, 1, 0); PG8_LDB(B1, 1, 1); PG8_SCHED; PG8_LDA(At, 1, 0); PG8_STAGE(PG8_SA(0, 1), a2 + hstepA, voffA);
            PG8_WAIT_V(8); PG8_WAIT_L(0); PG8_BAR; PG8_MMA(0, 0, At, B0); PG8_MMA(0, 1, At, B1); PG8_BAR; PG8_SCHED;
            PG8_LDA(At, 1, 1); PG8_STAGE(PG8_SB(1, 0), b3, voffB); PG8_STAGE(PG8_SB(1, 1), b3 + hstepB, voffB); PG8_STAGE(PG8_SA(1, 0), a3, voffA);
            PG8_WAIT_V(8); PG8_WAIT_L(0); PG8_BAR; PG8_MMA(1, 0, At, B0); PG8_MMA(1, 1, At, B1); PG8_BAR; PG8_SCHED;
        }
        if (wr == 0) PG8_BAR;
        E(acc, cur, wr, wc, fr, fq);
        if (!has_next) break;
#pragma unroll
        for (int a = 0; a < 2; ++a)
#pragma unroll
            for (int b = 0; b < 2; ++b)
#pragma unroll
                for (int m = 0; m < 4; ++m)
#pragma unroll
                    for (int n = 0; n < 2; ++n) acc[a][b][m][n] = (f32x4){0.f, 0.f, 0.f, 0.f};
        cur = nxt; cA = nA; cB = nB; ++ui;
        if (wr == 1) PG8_BAR;
    }
    PG8_WAIT_V(0);
    PG8_BAR;
#undef PG8_SA
#undef PG8_SB
#undef PG8_STAGE
#undef PG8_LDA
#undef PG8_LDB
#undef PG8_MMA
#undef PG8_WAIT_V
#undef PG8_WAIT_L
#undef PG8_BAR
#undef PG8_SCHED
}

__device__ __forceinline__ void st_bf4(bf16_t* p, f32x4 v) { u32x2 w; w.x = cvt_pk_bf16(v[0], v[1]); w.y = cvt_pk_bf16(v[2], v[3]); *(u32x2*)p = w; }
__device__ __forceinline__ void st_bf8(bf16_t* p, f32x4 v0, f32x4 v1) { u32x4 w; w.x = cvt_pk_bf16(v0[0], v0[1]); w.y = cvt_pk_bf16(v0[2], v0[3]); w.z = cvt_pk_bf16(v1[0], v1[1]); w.w = cvt_pk_bf16(v1[2], v1[3]); *(u32x4*)p = w; }

struct EpiInA {
    static constexpr bool PERM = false;
    bf16_t *Q, *Kn, *KT, *VT, *SG, *HU; const float* binp; const float* rope;
    __device__ __forceinline__ void operator()(const f32x4 (&acc)[2][2][4][2], const Unit& u, int wr, int wc, int fr, int fq) const {
        const int pc = u.pc, rbase = u.pm * BM + wr * 64 + fr, cbase = pc * BM + wc * 32 + 4 * fq;
        f32x4 bv[2][2];
#pragma unroll
        for (int bj = 0; bj < 2; ++bj)
#pragma unroll
            for (int n = 0; n < 2; ++n) bv[bj][n] = *(const f32x4*)(binp + cbase + bj * HALF + n * 16);
        const bool lat = u.pm < 128;
        const int bidx = lat ? (u.pm >> 4) : (u.pm - 128);
        if (pc < 4) {
            const bool isk = pc >= 2; const float ks = isk ? 0.08838834764831845f : 1.f;
            const int h0 = (pc & 1) * 2;
#pragma unroll
            for (int ai = 0; ai < 2; ++ai)
#pragma unroll
                for (int m = 0; m < 4; ++m) {
                    const int r = rbase + ai * HALF + m * 16, t = r & 4095;
                    const int tok = lat ? t : 4096 + ((r - T) & 255);
                    f32x4 cs = (f32x4){1.f, 1.f, 1.f, 1.f}, sn = (f32x4){0.f, 0.f, 0.f, 0.f};
                    if (lat) { const int pos = (wc >> 1) ? (t & 63) : (t >> 6); const float* rp = rope + pos * 32 + 16 * (wc & 1) + 4 * fq; cs = *(const f32x4*)rp; sn = *(const f32x4*)(rp + 2048); }
#pragma unroll
                    for (int bj = 0; bj < 2; ++bj) {
                        const f32x4 x1 = acc[ai][bj][m][0] + bv[bj][0], x2 = acc[ai][bj][m][1] + bv[bj][1];
                        const f32x4 o1 = (x1 * cs - x2 * sn) * ks, o2 = (x1 * sn + x2 * cs) * ks;
                        const int col = (pc & 1) * BM + bj * HALF + wc * 32 + 4 * fq;
                        if (!isk) { st_bf4(Q + (size_t)r * 512 + col, o1); st_bf4(Q + (size_t)r * 512 + col + 16, o2); }
                        else {
                            st_bf4(Kn + (size_t)r * 512 + col, o1); st_bf4(Kn + (size_t)r * 512 + col + 16, o2);
                            bf16_t* kt = KT + ((size_t)((bidx * 4 + h0 + bj) * 128 + wc * 32 + 4 * fq)) * TOKP + tok;
#pragma unroll
                            for (int e = 0; e < 4; ++e) { kt[(size_t)e * TOKP] = (bf16_t)f2bf(o1[e]); kt[(size_t)(16 + e) * TOKP] = (bf16_t)f2bf(o2[e]); }
                        }
                    }
                }
        } else if (pc < 8) {
            const int h = pc - 4;
#pragma unroll
            for (int ai = 0; ai < 2; ++ai)
#pragma unroll
                for (int m = 0; m < 4; ++m) {
                    const int r = rbase + ai * HALF + m * 16;
                    const int tok = lat ? (r & 4095) : 4096 + ((r - T) & 255);
#pragma unroll
                    for (int bj = 0; bj < 2; ++bj)
#pragma unroll
                        for (int n = 0; n < 2; ++n) {
                            const f32x4 v = acc[ai][bj][m][n] + bv[bj][n];
                            bf16_t* vt = VT + ((size_t)((bidx * 4 + h) * 256 + bj * HALF + wc * 32 + n * 16 + 4 * fq)) * TOKP + tok;
#pragma unroll
                            for (int e = 0; e < 4; ++e) vt[(size_t)e * TOKP] = (bf16_t)f2bf(v[e]);
                        }
                }
        } else {
            const bool isg = pc < 12;
            bf16_t* O = isg ? SG : HU; const int ldo = isg ? 1024 : 1536; const int c0 = (isg ? pc - 8 : pc - 12) * BM + wc * 32 + 4 * fq;
#pragma unroll
            for (int ai = 0; ai < 2; ++ai)
#pragma unroll
                for (int m = 0; m < 4; ++m) {
                    const int r = rbase + ai * HALF + m * 16;
#pragma unroll
                    for (int bj = 0; bj < 2; ++bj)
#pragma unroll
                        for (int n = 0; n < 2; ++n) {
                            f32x4 v = acc[ai][bj][m][n] + bv[bj][n];
                            if (isg) { v[0] = silu_f(v[0]); v[1] = silu_f(v[1]); v[2] = silu_f(v[2]); v[3] = silu_f(v[3]); }
                            st_bf4(O + (size_t)r * ldo + c0 + bj * HALF + n * 16, v);
                        }
                }
        }
    }
};
struct EpiGate {
    static constexpr bool PERM = true;
    bf16_t *SGR, *SGH; const float* bias;
    __device__ __forceinline__ void operator()(const f32x4 (&acc)[2][2][4][2], const Unit& u, int wr, int wc, int fr, int fq) const {
        const int pc = u.pc, rbase = u.pm * BM + wr * 64 + fr; bf16_t* O = pc < 4 ? SGR : SGH;
        const int col0 = (pc & 3) * BM + wc * 32 + 8 * fq, bcol0 = pc * BM + wc * 32 + 8 * fq;
        f32x4 bv[2][2];
#pragma unroll
        for (int bj = 0; bj < 2; ++bj)
#pragma unroll
            for (int n = 0; n < 2; ++n) bv[bj][n] = *(const f32x4*)(bias + bcol0 + bj * HALF + 4 * n);
#pragma unroll
        for (int ai = 0; ai < 2; ++ai)
#pragma unroll
            for (int m = 0; m < 4; ++m) { bf16_t* rowp = O + (size_t)(rbase + ai * HALF + m * 16) * 1024 + col0;
#pragma unroll
                for (int bj = 0; bj < 2; ++bj) { f32x4 v0 = acc[ai][bj][m][0] + bv[bj][0], v1 = acc[ai][bj][m][1] + bv[bj][1];
#pragma unroll
                    for (int e = 0; e < 4; ++e) { v0[e] = sigm_f(v0[e]); v1[e] = sigm_f(v1[e]); }
                    st_bf8(rowp + bj * HALF, v0, v1); } }
    }
};
template <int MODE> struct EpiMerge {
    static constexpr bool PERM = true;
    bf16_t* O; const bf16_t* P;
    __device__ __forceinline__ void operator()(const f32x4 (&acc)[2][2][4][2], const Unit& u, int wr, int wc, int fr, int fq) const {
        const int rbase = u.pm * BM + wr * 64 + fr, col0 = u.pc * BM + wc * 32 + 8 * fq;
#pragma unroll
        for (int ai = 0; ai < 2; ++ai)
#pragma unroll
            for (int m = 0; m < 4; ++m) { const size_t off = (size_t)(rbase + ai * HALF + m * 16) * 1024 + col0;
#pragma unroll
                for (int bj = 0; bj < 2; ++bj) {
                    const u32x4 gw = *(const u32x4*)(O + off + bj * HALF);
                    f32x4 v0 = acc[ai][bj][m][0], v1 = acc[ai][bj][m][1];
                    v0[0] *= bflo(gw.x); v0[1] *= bfhi(gw.x); v0[2] *= bflo(gw.y); v0[3] *= bfhi(gw.y);
                    v1[0] *= bflo(gw.z); v1[1] *= bfhi(gw.z); v1[2] *= bflo(gw.w); v1[3] *= bfhi(gw.w);
                    if (MODE == 1) { const u32x4 pw = *(const u32x4*)(P + off + bj * HALF);
                        v0[0] += bflo(pw.x); v0[1] += bfhi(pw.x); v0[2] += bflo(pw.y); v0[3] += bfhi(pw.y);
                        v1[0] += bflo(pw.z); v1[1] += bfhi(pw.z); v1[2] += bflo(pw.w); v1[3] += bfhi(pw.w); }
                    st_bf8(O + off + bj * HALF, v0, v1); } }
    }
};
struct EpiX1 {
    static constexpr bool PERM = false;
    const float* x; const float* mod; float* out;
    __device__ __forceinline__ void operator()(const f32x4 (&acc)[2][2][4][2], const Unit& u, int wr, int wc, int fr, int fq) const {
        const int rbase = u.pm * BM + wr * 64 + fr, col0 = u.pc * BM + wc * 32 + 4 * fq;
        const float* gt = mod + (size_t)(u.pm >> 4) * 6144 + 2048 + col0;
        f32x4 gv[2][2];
#pragma unroll
        for (int bj = 0; bj < 2; ++bj)
#pragma unroll
            for (int n = 0; n < 2; ++n) gv[bj][n] = *(const f32x4*)(gt + bj * HALF + n * 16);
#pragma unroll
        for (int ai = 0; ai < 2; ++ai)
#pragma unroll
            for (int m = 0; m < 4; ++m) { const size_t off = (size_t)(rbase + ai * HALF + m * 16) * 1024 + col0;
#pragma unroll
                for (int bj = 0; bj < 2; ++bj)
#pragma unroll
                    for (int n = 0; n < 2; ++n) { const f32x4 xv = *(const f32x4*)(x + off + bj * HALF + n * 16); *(f32x4*)(out + off + bj * HALF + n * 16) = xv + gv[bj][n] * acc[ai][bj][m][n]; } }
    }
};
struct EpiMoe1 {
    static constexpr bool PERM = true;
    bf16_t* HM;
    __device__ __forceinline__ void operator()(const f32x4 (&acc)[2][2][4][2], const Unit& u, int wr, int wc, int fr, int fq) const {
        const int rbase = u.pm * BM + wr * 64 + fr, col0 = u.pc * HALF + wc * 32 + 8 * fq;
#pragma unroll
        for (int ai = 0; ai < 2; ++ai)
#pragma unroll
            for (int m = 0; m < 4; ++m) {
                f32x4 v0, v1;
#pragma unroll
                for (int e = 0; e < 4; ++e) { v0[e] = silu_f(acc[ai][0][m][0][e]) * acc[ai][1][m][0][e]; v1[e] = silu_f(acc[ai][0][m][1][e]) * acc[ai][1][m][1][e]; }
                st_bf8(HM + (size_t)(rbase + ai * HALF + m * 16) * EH + col0, v0, v1); }
    }
};
struct EpiBf {
    static constexpr bool PERM = true;
    bf16_t* O; int ldo;
    __device__ __forceinline__ void operator()(const f32x4 (&acc)[2][2][4][2], const Unit& u, int wr, int wc, int fr, int fq) const {
        const int rbase = u.pm * BM + wr * 64 + fr, col0 = u.pc * BM + wc * 32 + 8 * fq;
#pragma unroll
        for (int ai = 0; ai < 2; ++ai)
#pragma unroll
            for (int m = 0; m < 4; ++m)
#pragma unroll
                for (int bj = 0; bj < 2; ++bj) st_bf8(O + (size_t)(rbase + ai * HALF + m * 16) * ldo + col0 + bj * HALF, acc[ai][bj][m][0], acc[ai][bj][m][1]);
    }
};
}

namespace gt {
constexpr int AST = 144;
constexpr int STAGE_BYTES = 128 * AST + 256 * AST;
template <int NT, class AL, class BL>
__device__ __forceinline__ void gemm_tile(f32x4 (&acc)[4][NT], const AL& al, const BL& bl, int nk, LAS unsigned char* st, int tid) {
    const int lane = tid & 63, wid = tid >> 6, wr = wid >> 2, wc = wid & 3, fr = lane & 15, fq = lane >> 4;
    LAS unsigned char* sa = st; LAS unsigned char* sb = st + 128 * AST;
    u32x4 ra[2], rb[NT];
#pragma unroll
    for (int i = 0; i < 2; ++i) { const int p = tid + i * 512; ra[i] = al(p >> 3, (p & 7) * 8); }
#pragma unroll
    for (int i = 0; i < NT; ++i) { const int p = tid + i * 512; rb[i] = bl(p >> 3, (p & 7) * 8); }
    for (int kt = 0; kt < nk; ++kt) {
        __syncthreads();
#pragma unroll
        for (int i = 0; i < 2; ++i) { const int p = tid + i * 512; *(LAS u32x4*)(sa + (p >> 3) * AST + (p & 7) * 16) = ra[i]; }
#pragma unroll
        for (int i = 0; i < NT; ++i) { const int p = tid + i * 512; *(LAS u32x4*)(sb + (p >> 3) * AST + (p & 7) * 16) = rb[i]; }
        __syncthreads();
        if (kt + 1 < nk) {
#pragma unroll
            for (int i = 0; i < 2; ++i) { const int p = tid + i * 512; ra[i] = al(p >> 3, (kt + 1) * 64 + (p & 7) * 8); }
#pragma unroll
            for (int i = 0; i < NT; ++i) { const int p = tid + i * 512; rb[i] = bl(p >> 3, (kt + 1) * 64 + (p & 7) * 8); }
        }
#pragma unroll
        for (int kk = 0; kk < 2; ++kk) {
            bf16x8 a[4], b[NT];
#pragma unroll
            for (int m = 0; m < 4; ++m) a[m] = *(const LAS bf16x8*)(sa + (wr * 64 + m * 16 + fr) * AST + kk * 64 + fq * 16);
#pragma unroll
            for (int n = 0; n < NT; ++n) b[n] = *(const LAS bf16x8*)(sb + (wc * 16 * NT + n * 16 + fr) * AST + kk * 64 + fq * 16);
#pragma unroll
            for (int m = 0; m < 4; ++m)
#pragma unroll
                for (int n = 0; n < NT; ++n) acc[m][n] = __builtin_amdgcn_mfma_f32_16x16x32_bf16(a[m], b[n], acc[m][n], 0, 0, 0);
        }
    }
    __syncthreads();
}
struct LdRows {
    const bf16_t* base; int ld;
    __device__ __forceinline__ u32x4 operator()(int row, int k) const { return *(const u32x4*)(base + (size_t)row * ld + k); }
};
__device__ __forceinline__ u32x4 scale8(u32x4 v, float s0, float s1, float s2, float s3, float s4, float s5, float s6, float s7) {
    u32x4 o; o.x = pk2(bflo(v.x) * s0, bfhi(v.x) * s1); o.y = pk2(bflo(v.y) * s2, bfhi(v.y) * s3); o.z = pk2(bflo(v.z) * s4, bfhi(v.z) * s5); o.w = pk2(bflo(v.w) * s6, bfhi(v.w) * s7); return o;
}
}

struct Args { const float* in[31]; float* out; unsigned char* ws; };
enum { I_X = 0, I_C, I_CTX, I_CCTX, I_ADAW, I_ADAB, I_N1G, I_N2G, I_WIN, I_BIN, I_DECAY, I_RETWO, I_HCW, I_HCB, I_HW1, I_HB1, I_HFREQ, I_HW2, I_HB2, I_HW3, I_HSKIP, I_HYWO, I_WOUT,
       I_RGW, I_RGB, I_REW, I_REB, I_EW1, I_EW3, I_EW2, I_FNG };

template <class RowMap>
__device__ __forceinline__ void transpose_item(const float* W, int N, int k0, int n0, bf16_t* WT, int ldt, const RowMap& rm, LAS float* scr, int lane) {
#pragma unroll 8
    for (int i = 0; i < 32; ++i) { const int kk = 2 * i + (lane >> 5); scr[kk * 33 + (lane & 31)] = W[(size_t)(k0 + kk) * N + n0 + (lane & 31)]; }
    asm volatile("s_waitcnt lgkmcnt(0)" ::: "memory");
    const int c = lane & 7;
#pragma unroll
    for (int j = 0; j < 4; ++j) { const int n = (lane >> 3) + 8 * j; const LAS float* s = scr + (8 * c) * 33 + n;
        u32x4 o; o.x = pk2(s[0 * 33], s[1 * 33]); o.y = pk2(s[2 * 33], s[3 * 33]); o.z = pk2(s[4 * 33], s[5 * 33]); o.w = pk2(s[6 * 33], s[7 * 33]);
        *(u32x4*)(WT + (size_t)rm(n0 + n) * ldt + k0 + 8 * c) = o; }
    asm volatile("s_waitcnt lgkmcnt(0)" ::: "memory");
}
struct RmId { __device__ __forceinline__ int operator()(int n) const { return n; } };
struct RmWin { __device__ __forceinline__ int operator()(int n) const { return win_destrow(n); } };
struct RmE13 { int add; __device__ __forceinline__ int operator()(int n) const { return 256 * (n >> 7) + (n & 127) + add; } };

__device__ __forceinline__ float lg2_decay(float logit) { return -log1pf(expf(-logit)) * 1.4426950408889634f; }

__device__ __forceinline__ void short_conv8(const bf16_t* HU, int row, int t, int ch, const float* cw, const float* cb, float (&o)[8]) {
    const f32x4 b0 = *(const f32x4*)(cb + ch), b1 = *(const f32x4*)(cb + ch + 4);
#pragma unroll
    for (int e = 0; e < 4; ++e) { o[e] = b0[e]; o[4 + e] = b1[e]; }
#pragma unroll
    for (int j = 0; j < 3; ++j) {
        const int tt = t + j - 1;
        if (tt >= 0 && tt < SEQ) {
            const u32x4 v = *(const u32x4*)(HU + (size_t)(row + j - 1) * 1536 + ch);
            const f32x4 w0 = *(const f32x4*)(cw + j * 1536 + ch), w1 = *(const f32x4*)(cw + j * 1536 + ch + 4);
            o[0] += bflo(v.x) * w0[0]; o[1] += bfhi(v.x) * w0[1]; o[2] += bflo(v.y) * w0[2]; o[3] += bfhi(v.y) * w0[3];
            o[4] += bflo(v.z) * w1[0]; o[5] += bfhi(v.z) * w1[1]; o[6] += bflo(v.w) * w1[2]; o[7] += bfhi(v.w) * w1[3];
        }
    }
}

__global__ void __launch_bounds__(512, 2) fwd_kernel(Args a) {
    extern __shared__ __attribute__((aligned(16))) unsigned char lds_raw[];
    LAS unsigned char* lds = (LAS unsigned char*)lds_raw;
    cg::grid_group grid = cg::this_grid();
    const int tid = threadIdx.x, lane = tid & 63, wave = tid >> 6, G = gridDim.x, bid = blockIdx.x;
    const int gw = bid * 8 + wave, NGW = G * 8;
    unsigned char* ws = a.ws; unsigned char* dob = (unsigned char*)a.out;
    int* cnt = (int*)(ws + WS_CTL);
    float* MOD = (float*)(ws + WS_MOD); float* ROPE = (float*)(ws + WS_ROPE); float* BINP = (float*)(ws + WS_BINP); float* FPART = (float*)(ws + WS_FPART);
    int* TOKINFO = (int*)(ws + WS_TOKINFO); int* LISTS = (int*)(ws + WS_LISTS);
    bf16_t* TR = (bf16_t*)(ws + WS_TR);
    bf16_t* WT_IN = (bf16_t*)(ws + WS_WT_IN); bf16_t* WT_RETO = (bf16_t*)(ws + WS_WT_RETO); bf16_t* WT_HYO = (bf16_t*)(ws + WS_WT_HYO); bf16_t* WT_OUT = (bf16_t*)(ws + WS_WT_OUT);
    bf16_t* Qb = (bf16_t*)(ws + WS_Q); bf16_t* Kb = (bf16_t*)(ws + WS_K); bf16_t* KT = (bf16_t*)(ws + WS_KT); bf16_t* VT = (bf16_t*)(ws + WS_VT);
    float* FILT = (float*)(ws + WS_FILT);
    bf16_t* SGR = (bf16_t*)(ws + WS_SGR); bf16_t* SGH = (bf16_t*)(ws + WS_SGH); bf16_t* XB = (bf16_t*)(ws + WS_XB);
    bf16_t* SG = (bf16_t*)(ws + WS_SG); bf16_t* HU = (bf16_t*)(ws + WS_HU); bf16_t* HM = (bf16_t*)(ws + WS_HU);
    bf16_t* KV = (bf16_t*)(ws + WS_KV); bf16_t* WE13 = (bf16_t*)(ws + WS_WE13); bf16_t* WE2 = (bf16_t*)(ws + WS_WE2);
    bf16_t* XN = (bf16_t*)(dob + DO_XN); bf16_t* ZT = (bf16_t*)(dob + DO_ZT);
    float* X1 = a.out;

    for (int it = bid; it < 192 + 256 + 1; it += G) {
        if (it < 192) {
            const int col0 = it * 32, kq = tid >> 5, cl = tid & 31;
            float acc9[9];
#pragma unroll
            for (int r = 0; r < 9; ++r) acc9[r] = 0.f;
            for (int kk = 0; kk < 64; ++kk) { const int k = kq * 64 + kk; const float w = a.in[I_ADAW][(size_t)k * 6144 + col0 + cl];
#pragma unroll
                for (int r = 0; r < 8; ++r) acc9[r] += silu_f(a.in[I_C][r * 1024 + k]) * w;
                acc9[8] += silu_f(a.in[I_CCTX][k]) * w; }
            LAS float* red = (LAS float*)lds;
#pragma unroll
            for (int r = 0; r < 9; ++r) red[(kq * 9 + r) * 32 + cl] = acc9[r];
            __syncthreads();
            if (tid < 288) { const int r = tid >> 5, c2 = tid & 31; float s = 0.f; for (int q = 0; q < 16; ++q) s += red[(q * 9 + r) * 32 + c2]; MOD[r * 6144 + col0 + c2] = s + a.in[I_ADAB][col0 + c2]; }
            __syncthreads();
        } else if (it < 448) {
            const int fi = it - 192, t0 = fi * 16;
            LAS float* feats = (LAS float*)lds; LAS float* hid1 = feats + 544; LAS float* hid2 = hid1 + 1024;
            for (int idx = tid; idx < 16 * 33; idx += 512) { const int row = idx / 33, f = idx % 33; const float t = (float)(t0 + row) * (1.f / 4096.f); float v;
                if (f == 0) v = t; else { const int mb = (f - 1) & 15; const float band = 1e-4f + (float)mb * ((15.f - 1e-4f) / 15.f); const float ph = (6.283185307179586f * t) * band; v = f <= 16 ? cosf(ph) : -sinf(ph); }
                feats[idx] = v; }
            __syncthreads();
            for (int idx = tid; idx < 1024; idx += 512) { const int row = idx >> 6, j = idx & 63; float s = a.in[I_HB1][j]; for (int f = 0; f < 33; ++f) s += feats[row * 33 + f] * a.in[I_HW1][f * 64 + j]; hid1[idx] = sinf(a.in[I_HFREQ][j] * s); }
            __syncthreads();
            for (int idx = tid; idx < 1024; idx += 512) { const int row = idx >> 6, j = idx & 63; float s = a.in[I_HB2][j]; for (int k = 0; k < 64; ++k) s += hid1[row * 64 + k] * a.in[I_HW2][k * 64 + j]; hid2[idx] = sinf(a.in[I_HFREQ][j] * s); }
            __syncthreads();
            const float slow = 4.605170185988091f / 1.5f, fast = 4.605170185988091f / 0.3f;
            for (int col = tid; col < 1024; col += 512) {
                float ac[16];
#pragma unroll
                for (int r = 0; r < 16; ++r) ac[r] = 0.f;
                for (int k = 0; k < 64; ++k) { const float w = a.in[I_HW3][k * 1024 + col];
#pragma unroll
                    for (int r = 0; r < 16; ++r) ac[r] += hid2[r * 64 + k] * w; }
                const float delta = slow + (float)(col & 511) * ((fast - slow) / 511.f); float ps = 0.f;
#pragma unroll
                for (int r = 0; r < 16; ++r) { const float t = (float)(t0 + r) * (1.f / 4096.f); const float v = ac[r] * expf(-t * delta); FILT[(size_t)(t0 + r) * 1024 + col] = v; ps += fabsf(v); }
                FPART[fi * 1024 + col] = ps;
            }
            __syncthreads();
        } else {
            for (int idx = tid; idx < 2048; idx += 512) { const int pos = idx >> 5, i = idx & 31; const float inv = powf(10000.f, -(float)i / 32.f); const float ang = (float)pos * inv; ROPE[idx] = cosf(ang); ROPE[2048 + idx] = sinf(ang); }
            for (int n = tid; n < 6656; n += 512) BINP[win_destrow(n)] = a.in[I_BIN][n];
        }
    }
    __syncthreads();
    {
        LAS float* scr = (LAS float*)(lds + wave * 8448);
        constexpr int I_IN = 16 * 208, I_RO = 16 * 32, I_HO = 8 * 32, I_OU = 16 * 32;
        for (int it = gw; it < I_IN + I_RO + I_HO + I_OU; it += NGW) {
            int r = it;
            if (r < I_IN) { transpose_item(a.in[I_WIN], 6656, 64 * (r / 208), 32 * (r % 208), WT_IN, 1024, RmWin{}, scr, lane); continue; } r -= I_IN;
            if (r < I_RO) { transpose_item(a.in[I_RETWO], 1024, 64 * (r / 32), 32 * (r % 32), WT_RETO, 1024, RmId{}, scr, lane); continue; } r -= I_RO;
            if (r < I_HO) { transpose_item(a.in[I_HYWO], 1024, 64 * (r / 32), 32 * (r % 32), WT_HYO, 512, RmId{}, scr, lane); continue; } r -= I_HO;
            transpose_item(a.in[I_WOUT], 1024, 64 * (r / 32), 32 * (r % 32), WT_OUT, 1024, RmId{}, scr, lane);
        }
    }
    grid.sync();

    for (int m = gw; m < MT; m += NGW) {
        const bool lat = m < T; const float* xr = lat ? a.in[I_X] + (size_t)m * D : a.in[I_CTX] + (size_t)(m - T) * D;
        const float* md = MOD + (size_t)(lat ? (m >> 12) : 8) * 6144;
        f32x4 v[4]; float s = 0.f;
#pragma unroll
        for (int j = 0; j < 4; ++j) { v[j] = *(const f32x4*)(xr + 4 * lane + 256 * j); s += (v[j][0] * v[j][0] + v[j][1] * v[j][1]) + (v[j][2] * v[j][2] + v[j][3] * v[j][3]); }
        const float rstd = rsqrtf(wave_sum(s) * (1.f / D) + EPS);
#pragma unroll
        for (int j = 0; j < 4; ++j) { const int c0 = 4 * lane + 256 * j; const f32x4 g = *(const f32x4*)(a.in[I_N1G] + c0), sh = *(const f32x4*)(md + c0), sc = *(const f32x4*)(md + 1024 + c0);
            const f32x4 o = (v[j] * rstd * g) * (sc + 1.f) + sh; u32x2 w; w.x = pk2(o[0], o[1]); w.y = pk2(o[2], o[3]); *(u32x2*)(XN + (size_t)m * D + c0) = w; }
    }
    for (int c = bid; c < 512; c += G) {
        LAS float* red = (LAS float*)lds;
        float p = 0.f; if (tid < 256) p = FPART[tid * 1024 + c]; else p = FPART[(tid - 256) * 1024 + 512 + c];
        p = wave_sum(p); if (lane == 0) red[wave] = p;
        __syncthreads();
        const float nf = 1.f / ((red[0] + red[1]) + (red[2] + red[3])), nb = 1.f / ((red[4] + red[5]) + (red[6] + red[7]));
        for (int i = tid; i < 8192; i += 512) { const int x = 4096 - i; float v = 0.f;
            if (x >= 0 && x < 4096) v += FILT[(size_t)x * 1024 + c] * nf;
            if (x <= 0 && x > -4096) v += FILT[(size_t)(-x) * 1024 + 512 + c] * nb;
            TR[(size_t)c * 8192 + i] = (bf16_t)f2bf(v); }
        __syncthreads();
    }
    grid.sync();

    {
        pg8::Gemm g{XN, WT_IN, 1024, 1024, 1024}; pg8::InProjOrder S; S.init(G, bid);
        pg8::EpiInA E{Qb, Kb, KT, VT, SG, HU, BINP, ROPE};
        pg8::gemm_phase(lds, g, S, E);
    }
    grid.sync();

    for (int it = bid; it < 4096; it += G) {
        const int b = it >> 9, tt = (it >> 3) & 63, cc = it & 7;
        LAS bf16_t* zt = (LAS bf16_t*)lds;
        { const int tl = tid >> 3, c0 = cc * 64 + (tid & 7) * 8, t = tt * 64 + tl, row = b * SEQ + t;
          float x1[8], vv[8]; short_conv8(HU, row, t, 512 + c0, a.in[I_HCW], a.in[I_HCB], x1); short_conv8(HU, row, t, 1024 + c0, a.in[I_HCW], a.in[I_HCB], vv);
#pragma unroll
          for (int e = 0; e < 8; ++e) zt[((tid & 7) * 8 + e) * 72 + tl] = (bf16_t)f2bf(x1[e] * vv[e]); }
        __syncthreads();
        { const int cl = tid >> 3, seg = tid & 7; const u32x4 v = *(const LAS u32x4*)(zt + cl * 72 + seg * 8);
          *(u32x4*)(ZT + ((size_t)(cc * 64 + cl) * 8 + b) * SEQ + tt * 64 + seg * 8) = v; }
        __syncthreads();
    }
    {
        LAS float* wtab = (LAS float*)(lds + gt::STAGE_BYTES);
        for (int u = bid; u < 32 * 66; u += G) {
            const int bh = u / 66, rem = u % 66, dir = rem / 33, s = rem % 33, h = bh & 3;
            const float lg = lg2_decay(a.in[I_DECAY][dir * 4 + h]);
            const int tok0 = dir == 0 ? (s == 0 ? 4096 : s == 1 ? 4224 : (s - 2) * 128) : (s == 0 ? 4224 : s == 1 ? 4096 : (33 - s) * 128);
            if (tid < 128) wtab[tid] = exp2f((float)(dir == 0 ? 127 - tid : tid) * lg);
            __syncthreads();
            struct LdKTw { const bf16_t* base; const LAS float* w;
                __device__ __forceinline__ u32x4 operator()(int row, int k) const { const u32x4 v = *(const u32x4*)(base + (size_t)row * TOKP + k); const f32x4 w0 = *(const LAS f32x4*)(w + k), w1 = *(const LAS f32x4*)(w + k + 4);
                    return gt::scale8(v, w0[0], w0[1], w0[2], w0[3], w1[0], w1[1], w1[2], w1[3]); } };
            const LdKTw bl{KT + (size_t)bh * 128 * TOKP + tok0, wtab};
            int tl = tid; asm volatile("" : "+v"(tl));
            const int wr = tl >> 8, wc = (tl >> 6) & 3, fr = tl & 15, fq = (tl >> 4) & 3;
            for (int mt = 0; mt < 2; ++mt) {
                f32x4 acc[4][2];
#pragma unroll
                for (int m = 0; m < 4; ++m)
#pragma unroll
                    for (int n = 0; n < 2; ++n) acc[m][n] = (f32x4){0.f, 0.f, 0.f, 0.f};
                const gt::LdRows al{VT + ((size_t)bh * 256 + mt * 128) * TOKP + tok0, TOKP};
                gt::gemm_tile<2>(acc, al, bl, 2, lds, tl);
                bf16_t* o = KV + (((size_t)(bh * 2 + dir) * 33 + s) * 256 + mt * 128) * 128;
#pragma unroll
                for (int m = 0; m < 4; ++m)
#pragma unroll
                    for (int n = 0; n < 2; ++n)
#pragma unroll
                        for (int j = 0; j < 4; ++j) o[(size_t)(wr * 64 + m * 16 + 4 * fq + j) * 128 + wc * 32 + n * 16 + fr] = (bf16_t)f2bf(acc[m][n][j]);
            }
            __syncthreads();
        }
    }
    grid.sync();

    for (int idx = bid * 512 + tid; idx < 64 * 4096; idx += G * 512) {
        const int chain = idx >> 12, eg = idx & 4095, dir = chain & 1, h = (chain >> 1) & 3;
        const float g128 = exp2f(128.f * lg2_decay(a.in[I_DECAY][dir * 4 + h]));
        float run[8];
#pragma unroll
        for (int e = 0; e < 8; ++e) run[e] = 0.f;
        bf16_t* p = KV + (size_t)chain * 33 * 32768 + eg * 8;
        for (int s = 0; s < 33; ++s) {
            const u32x4 v = *(const u32x4*)(p + (size_t)s * 32768);
            run[0] = run[0] * g128 + bflo(v.x); run[1] = run[1] * g128 + bfhi(v.x); run[2] = run[2] * g128 + bflo(v.y); run[3] = run[3] * g128 + bfhi(v.y);
            run[4] = run[4] * g128 + bflo(v.z); run[5] = run[5] * g128 + bfhi(v.z); run[6] = run[6] * g128 + bflo(v.w); run[7] = run[7] * g128 + bfhi(v.w);
            u32x4 o; o.x = pk2(run[0], run[1]); o.y = pk2(run[2], run[3]); o.z = pk2(run[4], run[5]); o.w = pk2(run[6], run[7]);
            *(u32x4*)(p + (size_t)s * 32768) = o;
        }
    }
    for (int c = bid; c < 512; c += G) {
        struct LdToep { const bf16_t* tr; int dlo;
            __device__ __forceinline__ u32x4 operator()(int r, int k) const { const int d = dlo + (k >> 7), q = k & 127; const bf16_t* p = tr + (4096 - 128 * d - r + q);
                u32x4 o; o.x = (unsigned)p[0] | ((unsigned)p[1] << 16); o.y = (unsigned)p[2] | ((unsigned)p[3] << 16); o.z = (unsigned)p[4] | ((unsigned)p[5] << 16); o.w = (unsigned)p[6] | ((unsigned)p[7] << 16); return o; } };
        struct LdZ { const bf16_t* z; int dlo, a0;
            __device__ __forceinline__ u32x4 operator()(int n, int k) const { const int d = dlo + (k >> 7), q = k & 127, s = a0 + (n >> 3) - d;
                if (s < 0 || s > 31) return (u32x4){0u, 0u, 0u, 0u};
                return *(const u32x4*)(z + (size_t)(n & 7) * SEQ + 128 * s + q); } };
        bf16_t* zc = ZT + (size_t)c * 8 * SEQ;
        f32x4 acc0[4][2], acc1[4][2];
#pragma unroll
        for (int m = 0; m < 4; ++m)
#pragma unroll
            for (int n = 0; n < 2; ++n) { acc0[m][n] = (f32x4){0.f, 0.f, 0.f, 0.f}; acc1[m][n] = (f32x4){0.f, 0.f, 0.f, 0.f}; }
        int tl = tid; asm volatile("" : "+v"(tl));
        gt::gemm_tile<2>(acc0, LdToep{TR + (size_t)c * 8192, -31}, LdZ{zc, -31, 0}, 94, lds, tl);
        gt::gemm_tile<2>(acc1, LdToep{TR + (size_t)c * 8192, -15}, LdZ{zc, -15, 16}, 94, lds, tl);
        const float skip = a.in[I_HSKIP][c];
        const int wr = tl >> 8, wc = (tl >> 6) & 3, fr = tl & 15, fq = (tl >> 4) & 3;
#pragma unroll
        for (int m = 0; m < 4; ++m)
#pragma unroll
            for (int n = 0; n < 2; ++n)
#pragma unroll
                for (int j = 0; j < 4; ++j) { const int r = wr * 64 + m * 16 + 4 * fq + j, col = wc * 32 + n * 16 + fr, al = col >> 3, nb = col & 7;
                    bf16_t* p0 = zc + (size_t)nb * SEQ + al * 128 + r; bf16_t* p1 = p0 + 2048;
                    *p0 = (bf16_t)f2bf(acc0[m][n][j] + skip * bf2f(*p0)); *p1 = (bf16_t)f2bf(acc1[m][n][j] + skip * bf2f(*p1)); }
        __syncthreads();
    }
    grid.sync();

    {
        LAS unsigned char* Pl = lds + gt::STAGE_BYTES;
        LAS float* sfb = (LAS float*)(lds + gt::STAGE_BYTES + 128 * 272);
        LAS float* rsum = sfb + 256;
        for (int u = bid; u < 1024; u += G) {
            int tl = tid; asm volatile("" : "+v"(tl));
            const int wr = tl >> 8, wc = (tl >> 6) & 3, fr = tl & 15, fq = (tl >> 4) & 3;
            const int bh = u >> 5, c = u & 31, b = bh >> 2, h = bh & 3, row0 = b * SEQ + c * 128;
            const float lgf = lg2_decay(a.in[I_DECAY][h]), lgb = lg2_decay(a.in[I_DECAY][4 + h]);
            if (tl < 128) sfb[tl] = exp2f((float)(tl + 1) * lgf); else if (tl < 256) sfb[tl] = exp2f((float)(128 - (tl - 128)) * lgb);
            {
                f32x4 sacc[4][2];
#pragma unroll
                for (int m = 0; m < 4; ++m)
#pragma unroll
                    for (int n = 0; n < 2; ++n) sacc[m][n] = (f32x4){0.f, 0.f, 0.f, 0.f};
                gt::gemm_tile<2>(sacc, gt::LdRows{Qb + (size_t)row0 * 512 + h * 128, 512}, gt::LdRows{Kb + (size_t)row0 * 512 + h * 128, 512}, 2, lds, tl);
#pragma unroll
                for (int m = 0; m < 4; ++m)
#pragma unroll
                    for (int n = 0; n < 2; ++n)
#pragma unroll
                        for (int j = 0; j < 4; ++j) { const int i = wr * 64 + m * 16 + 4 * fq + j, jj = wc * 32 + n * 16 + fr, df = i - jj;
                            const float dcy = df >= 0 ? exp2f((float)df * lgf) : exp2f((float)(-df) * lgb);
                            *(LAS bf16_t*)(Pl + i * 272 + jj * 2) = (bf16_t)f2bf(sacc[m][n][j] * dcy); }
                asm volatile("" ::: "memory");
            }
            __syncthreads();
            struct LdA2 { LAS unsigned char* P; const bf16_t* q; const LAS float* sc;
                __device__ __forceinline__ u32x4 operator()(int row, int k) const {
                    if (k < 128) return *(const LAS u32x4*)(P + row * 272 + k * 2);
                    const bool fw = k < 256; const u32x4 v = *(const u32x4*)(q + (size_t)row * 512 + (fw ? k - 128 : k - 256)); const float s = sc[fw ? row : 128 + row];
                    return gt::scale8(v, s, s, s, s, s, s, s, s); } };
            struct LdB2 { const bf16_t* vt; const bf16_t* sf; const bf16_t* sb;
                __device__ __forceinline__ u32x4 operator()(int dv, int k) const {
                    if (k < 128) return *(const u32x4*)(vt + (size_t)dv * TOKP + k);
                    if (k < 256) return *(const u32x4*)(sf + (size_t)dv * 128 + (k - 128));
                    return *(const u32x4*)(sb + (size_t)dv * 128 + (k - 256)); } };
            f32x4 acc[4][4];
#pragma unroll
            for (int m = 0; m < 4; ++m)
#pragma unroll
                for (int n = 0; n < 4; ++n) acc[m][n] = (f32x4){0.f, 0.f, 0.f, 0.f};
            const LdA2 al{Pl, Qb + (size_t)row0 * 512 + h * 128, sfb};
            const LdB2 bl{VT + (size_t)bh * 256 * TOKP + c * 128, KV + ((size_t)(bh * 2 + 0) * 33 + (c + 1)) * 32768, KV + ((size_t)(bh * 2 + 1) * 33 + (32 - c)) * 32768};
            gt::gemm_tile<4>(acc, al, bl, 6, lds, tl);
#pragma unroll
            for (int m = 0; m < 4; ++m)
#pragma unroll
                for (int j = 0; j < 4; ++j) { float s = 0.f;
#pragma unroll
                    for (int n = 0; n < 4; ++n) s += acc[m][n][j] * acc[m][n][j];
                    s += __shfl_xor(s, 1); s += __shfl_xor(s, 2); s += __shfl_xor(s, 4); s += __shfl_xor(s, 8);
                    if (fr == 0) rsum[(wr * 64 + m * 16 + 4 * fq + j) * 4 + wc] = s; }
            __syncthreads();
#pragma unroll
            for (int m = 0; m < 4; ++m)
#pragma unroll
                for (int j = 0; j < 4; ++j) { const int i = wr * 64 + m * 16 + 4 * fq + j; const f32x4 rs = *(const LAS f32x4*)(rsum + i * 4);
                    const float rstd = rsqrtf(((rs[0] + rs[1]) + (rs[2] + rs[3])) * (1.f / 256.f) + EPS);
                    bf16_t* gp = SG + (size_t)(row0 + i) * 1024 + h * 256 + wc * 64 + fr;
#pragma unroll
                    for (int n = 0; n < 4; ++n) gp[n * 16] = (bf16_t)f2bf(acc[m][n][j] * rstd * bf2f(gp[n * 16]));
                    asm volatile("" ::: "memory"); }
            __syncthreads();
        }
    }
    for (int it = bid; it < 4096; it += G) {
        const int b = it >> 9, tt = (it >> 3) & 63, cc = it & 7;
        LAS bf16_t* yt = (LAS bf16_t*)lds;
        { const int cl = tid >> 3, seg = tid & 7; *(LAS u32x4*)(yt + cl * 72 + seg * 8) = *(const u32x4*)(ZT + ((size_t)(cc * 64 + cl) * 8 + b) * SEQ + tt * 64 + seg * 8); }
        __syncthreads();
        { const int tl = tid >> 3, c0 = cc * 64 + (tid & 7) * 8, t = tt * 64 + tl, row = b * SEQ + t;
          float x0[8]; short_conv8(HU, row, t, c0, a.in[I_HCW], a.in[I_HCB], x0);
          float o[8];
#pragma unroll
          for (int e = 0; e < 8; ++e) o[e] = x0[e] * bf2f(yt[((tid & 7) * 8 + e) * 72 + tl]);
          u32x4 w; w.x = pk2(o[0], o[1]); w.y = pk2(o[2], o[3]); w.z = pk2(o[4], o[5]); w.w = pk2(o[6], o[7]);
          *(u32x4*)(HU + (size_t)row * 1536 + 512 + c0) = w; }
        __syncthreads();
    }
    grid.sync();

    {
        pg8::Gemm g{XN, WT_IN + (size_t)NINA * 1024, 1024, 1024, 1024}; pg8::StaticOrder S; S.init(T, 2048, G, bid);
        pg8::EpiGate E{SGR, SGH, a.in[I_BIN] + NINA};
        pg8::gemm_phase(lds, g, S, E);
    }
    {
        LAS float* scr = (LAS float*)(lds + wave * 8448);
        constexpr int PER = 16 * 16;
        for (int it = gw; it < NE * 3 * PER; it += NGW) {
            const int e = it / (3 * PER), r3 = it % (3 * PER), which = r3 / PER, r = r3 % PER;
            if (which == 0) transpose_item(a.in[I_EW1] + (size_t)e * 1024 * 512, 512, 64 * (r / 16), 32 * (r % 16), WE13 + (size_t)e * 1024 * 1024, 1024, RmE13{0}, scr, lane);
            else if (which == 1) transpose_item(a.in[I_EW3] + (size_t)e * 1024 * 512, 512, 64 * (r / 16), 32 * (r % 16), WE13 + (size_t)e * 1024 * 1024, 1024, RmE13{128}, scr, lane);
            else transpose_item(a.in[I_EW2] + (size_t)e * 512 * 1024, 1024, 64 * (r / 32), 32 * (r % 32), WE2 + (size_t)e * 1024 * 512, 512, RmId{}, scr, lane);
        }
    }
    grid.sync();

    {
        pg8::Gemm g{HU + 512, WT_HYO, 512, 1536, 512}; pg8::StaticOrder S; S.init(T, 1024, G, bid);
        pg8::EpiMerge<0> E{SGH, nullptr};
        pg8::gemm_phase(lds, g, S, E);
    }
    grid.sync();
    {
        pg8::Gemm g{SG, WT_RETO, 1024, 1024, 1024}; pg8::StaticOrder S; S.init(T, 1024, G, bid);
        pg8::EpiMerge<1> E{SGR, SGH};
        pg8::gemm_phase(lds, g, S, E);
    }
    grid.sync();
    {
        pg8::Gemm g{SGR, WT_OUT, 1024, 1024, 1024}; pg8::StaticOrder S; S.init(T, 1024, G, bid);
        pg8::EpiX1 E{a.in[I_X], MOD, X1};
        pg8::gemm_phase(lds, g, S, E);
    }
    grid.sync();

    {
        LAS float* Wl = (LAS float*)lds;
        for (int idx = tid; idx < 1024 * 36; idx += 512) { const int k = idx / 36, j = idx % 36; Wl[idx] = j < 4 ? a.in[I_RGW][k * 4 + j] : a.in[I_REW][k * 32 + j - 4]; }
        __syncthreads();
        bf16_t* H2 = SG;
        for (int row = gw; row < T; row += NGW) {
            const int b = row >> 12; const float* md = MOD + (size_t)b * 6144;
            int ll = lane; asm volatile("" : "+v"(ll));
            const float* xr = X1 + (size_t)row * D + ll;
            float s = 0.f;
#pragma unroll
            for (int jj = 0; jj < 16; ++jj) { const float xx = xr[64 * jj]; s += xx * xx; }
            const float rstd = rsqrtf(wave_sum(s) * (1.f / D) + EPS);
            float lg[36];
#pragma unroll
            for (int j = 0; j < 36; ++j) lg[j] = 0.f;
#pragma unroll 1
            for (int jj = 0; jj < 16; ++jj) { const int k = ll + 64 * jj;
                const float hv = (xr[64 * jj] * rstd * a.in[I_N2G][k]) * (1.f + md[4096 + k]) + md[3072 + k];
                H2[(size_t)row * D + k] = (bf16_t)f2bf(hv);
#pragma unroll
                for (int q = 0; q < 9; ++q) { const f32x4 w = *(const LAS f32x4*)(Wl + k * 36 + 4 * q); lg[4 * q] += hv * w[0]; lg[4 * q + 1] += hv * w[1]; lg[4 * q + 2] += hv * w[2]; lg[4 * q + 3] += hv * w[3]; } }
#pragma unroll
            for (int j = 0; j < 36; ++j) lg[j] = wave_sum(lg[j]);
            float gl[4];
#pragma unroll
            for (int j = 0; j < 4; ++j) gl[j] = lg[j] + a.in[I_RGB][j];
            int gs = 0; float gm = gl[0];
#pragma unroll
            for (int j = 1; j < 4; ++j) if (gl[j] > gm) { gm = gl[j]; gs = j; }
            float den = 0.f;
#pragma unroll
            for (int j = 0; j < 4; ++j) den += expf(gl[j] - gm);
            const float pstar = 1.f / den;
            float el[8];
#pragma unroll
            for (int e = 0; e < 8; ++e) { const float v0 = lg[4 + e], v1 = lg[12 + e], v2 = lg[20 + e], v3 = lg[28 + e]; el[e] = (gs == 0 ? v0 : gs == 1 ? v1 : gs == 2 ? v2 : v3) + a.in[I_REB][gs * 8 + e]; }
            int e0 = 0; float m0 = el[0];
#pragma unroll
            for (int e = 1; e < 8; ++e) if (el[e] > m0) { m0 = el[e]; e0 = e; }
            int e1 = -1; float m1 = -3.0e38f;
#pragma unroll
            for (int e = 0; e < 8; ++e) if (e != e0 && el[e] > m1) { m1 = el[e]; e1 = e; }
            const float ex = expf(m1 - m0); const float w0 = pstar / (1.f + ex), w1 = pstar * ex / (1.f + ex);
            if (lane == 0) {
                const int E0 = gs * 8 + e0, E1 = gs * 8 + e1;
                const int s0 = atomicAdd(&cnt[E0], 1), s1 = atomicAdd(&cnt[E1], 1);
                LISTS[E0 * 32768 + s0] = row; LISTS[E1 * 32768 + s1] = row;
                int4 ti; ti.x = (E0 << 16) | s0; ti.y = (E1 << 16) | s1; ti.z = __float_as_int(w0); ti.w = __float_as_int(w1);
                *(int4*)(TOKINFO + (size_t)row * 4) = ti;
            }
        }
    }
    grid.sync();

    LAS int* tbase = (LAS int*)(lds + MISC_OFF);
    LAS int* texp = tbase + 64;
    if (tid == 0) { int acc = 0; for (int e = 0; e < NE; ++e) { tbase[e] = acc; const int nt = (cnt[e] + 255) >> 8; for (int q = 0; q < nt; ++q) texp[acc + q] = e; acc += nt; } tbase[NE] = acc; }
    __syncthreads();
    const int ntiles = tbase[NE];
    {
        const bf16_t* H2 = SG;
        for (int r = gw; r < ntiles * 256; r += NGW) {
            const int e = texp[r >> 8], slot = r - tbase[e] * 256;
            const int src = slot < cnt[e] ? LISTS[e * 32768 + slot] : -1;
#pragma unroll
            for (int i = 0; i < 2; ++i) { u32x4 v = (u32x4){0u, 0u, 0u, 0u}; if (src >= 0) v = *(const u32x4*)(H2 + (size_t)src * D + lane * 8 + 512 * i); *(u32x4*)(XB + (size_t)r * D + lane * 8 + 512 * i) = v; }
        }
    }
    grid.sync();

    {
        pg8::Gemm g{XB, WE13, 1024, 1024, 1024}; pg8::MoeOrder S{ntiles * 4, G, bid, texp};
        pg8::EpiMoe1 E{HM};
        pg8::gemm_phase(lds, g, S, E);
    }
    grid.sync();
    {
        pg8::Gemm g{HM, WE2, 512, 512, 512}; pg8::MoeOrder S{ntiles * 4, G, bid, texp};
        pg8::EpiBf E{XB, 1024};
        pg8::gemm_phase(lds, g, S, E);
    }
    grid.sync();

    {
        const bf16_t* YB = XB;
        for (int row = gw; row < T; row += NGW) {
            const int b = row >> 12; const float* gt2 = MOD + (size_t)b * 6144 + 5120;
            const int4 ti = *(const int4*)(TOKINFO + (size_t)row * 4);
            const size_t r0 = (size_t)tbase[ti.x >> 16] * 256 + (ti.x & 0xffff), r1 = (size_t)tbase[ti.y >> 16] * 256 + (ti.y & 0xffff);
            const float w0 = __int_as_float(ti.z), w1 = __int_as_float(ti.w);
            f32x4 v[4]; float s = 0.f;
#pragma unroll
            for (int j = 0; j < 4; ++j) { const int c0 = 4 * lane + 256 * j;
                const f32x4 xv = *(const f32x4*)(X1 + (size_t)row * D + c0), gv = *(const f32x4*)(gt2 + c0);
                const u32x2 y0 = *(const u32x2*)(YB + r0 * D + c0), y1 = *(const u32x2*)(YB + r1 * D + c0);
                f32x4 mo; mo[0] = w0 * bflo(y0.x) + w1 * bflo(y1.x); mo[1] = w0 * bfhi(y0.x) + w1 * bfhi(y1.x); mo[2] = w0 * bflo(y0.y) + w1 * bflo(y1.y); mo[3] = w0 * bfhi(y0.y) + w1 * bfhi(y1.y);
                v[j] = xv + gv * mo; s += (v[j][0] * v[j][0] + v[j][1] * v[j][1]) + (v[j][2] * v[j][2] + v[j][3] * v[j][3]); }
            const float rstd = rsqrtf(wave_sum(s) * (1.f / D) + EPS);
#pragma unroll
            for (int j = 0; j < 4; ++j) { const int c0 = 4 * lane + 256 * j; const f32x4 fg = *(const f32x4*)(a.in[I_FNG] + c0); *(f32x4*)(X1 + (size_t)row * D + c0) = v[j] * rstd * fg; }
        }
    }
}

extern "C" void kernel_launch(void* const* d_in, const int* in_sizes, int n_in, void* d_out, int out_size, void* d_ws, size_t ws_size, hipStream_t stream) {
    static int grid = 0;
    if (grid == 0) {
        if (n_in != 31 || out_size != T * D || ws_size < WS_END) { fprintf(stderr, "kernel_launch: unexpected shapes: n_in %d out %d ws %zu (need %zu)\n", n_in, out_size, ws_size, (size_t)WS_END); grid = -1; return; }
        int dev = 0, cus = 0, per_cu = 0;
        if (hipGetDevice(&dev) != hipSuccess || hipDeviceGetAttribute(&cus, hipDeviceAttributeMultiprocessorCount, dev) != hipSuccess) { grid = -1; return; }
        if (hipFuncSetAttribute((const void*)fwd_kernel, hipFuncAttributeMaxDynamicSharedMemorySize, LDS_BYTES) != hipSuccess) { fprintf(stderr, "kernel_launch: hipFuncSetAttribute failed\n"); grid = -1; return; }
        if (hipOccupancyMaxActiveBlocksPerMultiprocessor(&per_cu, (const void*)fwd_kernel, 512, LDS_BYTES) != hipSuccess || per_cu < 1) { fprintf(stderr, "kernel_launch: occupancy query says %d blocks per CU\n", per_cu); grid = -1; return; }
        grid = cus;
        fprintf(stderr, "kernel_launch: cus %d per_cu %d grid %d ws %zu\n", cus, per_cu, grid, ws_size);
    }
    if (grid < 0) return;
    if (hipMemsetAsync((char*)d_ws + WS_CTL, 0, CTL_BYTES, stream) != hipSuccess) return;
    Args a{};
    for (int i = 0; i < 31; ++i) a.in[i] = (const float*)d_in[i];
    a.out = (float*)d_out; a.ws = (unsigned char*)d_ws;
    void* args[] = {&a};
    const hipError_t e = hipLaunchCooperativeKernel((const void*)fwd_kernel, dim3(grid), dim3(512), args, LDS_BYTES, stream);
    if (e != hipSuccess) fprintf(stderr, "kernel_launch: cooperative launch failed: %s (grid %d)\n", hipGetErrorString(e), grid);
}
```

```cpp
#ifndef PROBE_PHASE
#define PROBE_PHASE -1
#endif
#ifndef REPMASK
#define REPMASK 0
#endif
#include <hip/hip_runtime.h>
#include <hip/hip_cooperative_groups.h>
#include <cstdio>
#include <cstdint>
namespace cg = cooperative_groups;

#define LAS __attribute__((address_space(3)))
typedef unsigned short bf16_t;
typedef short bf16x8 __attribute__((ext_vector_type(8)));
typedef float f32x4 __attribute__((ext_vector_type(4)));
typedef unsigned u32x4 __attribute__((ext_vector_type(4)));
typedef unsigned u32x2 __attribute__((ext_vector_type(2)));

constexpr int BATCH = 8, SEQ = 4096, D = 1024, T = BATCH * SEQ, CTXL = 256, TC = BATCH * CTXL, MT = T + TC;
constexpr int NH = 4, DK = 128, DV = 256, TOKP = SEQ + CTXL;
constexpr int NINA = 4608;
constexpr int NE = 32, EH = 512;
constexpr float EPS = 1e-6f;
constexpr int LDS_BYTES = 163840;
constexpr int MISC_OFF = 131072;

constexpr size_t MiB = 1u << 20;
constexpr size_t WS_CTL = 0, CTL_BYTES = 65536;
constexpr size_t WS_MOD = 65536;
constexpr size_t WS_ROPE = 327680;
constexpr size_t WS_BINP = 344064;
constexpr size_t WS_FPART = 524288;
constexpr size_t WS_TOKINFO = 2 * MiB;
constexpr size_t WS_LISTS = 3 * MiB;
constexpr size_t WS_TR = 8 * MiB;
constexpr size_t WS_WT_IN = 16 * MiB;
constexpr size_t WS_WT_RETO = 29 * MiB, WS_WT_HYO = 31 * MiB, WS_WT_OUT = 32 * MiB;
constexpr size_t WS_R1 = 34 * MiB;
constexpr size_t WS_Q = WS_R1, WS_K = WS_R1 + 32 * MiB, WS_KT = WS_R1 + 66 * MiB, WS_VT = WS_R1 + 100 * MiB;
constexpr size_t WS_FILT = WS_R1;
constexpr size_t WS_SGR = WS_R1, WS_SGH = WS_R1 + 64 * MiB;
constexpr size_t WS_XB = WS_R1;
constexpr size_t WS_SG = 202 * MiB;
constexpr size_t WS_HU = 266 * MiB;
constexpr size_t WS_KV = 362 * MiB;
constexpr size_t WS_WE13 = 362 * MiB, WS_WE2 = 426 * MiB;
constexpr size_t WS_END = 494 * MiB;
constexpr size_t DO_XN = 0, DO_ZT = 68 * MiB;

__device__ __forceinline__ unsigned f2bf(float f) { unsigned u = __float_as_uint(f); return (u + 0x7fffu + ((u >> 16) & 1u)) >> 16; }
__device__ __forceinline__ unsigned pk2(float lo, float hi) { return f2bf(lo) | (f2bf(hi) << 16); }
__device__ __forceinline__ float bflo(unsigned w) { return __uint_as_float(w << 16); }
__device__ __forceinline__ float bfhi(unsigned w) { return __uint_as_float(w & 0xffff0000u); }
__device__ __forceinline__ float bf2f(bf16_t h) { return __uint_as_float((unsigned)h << 16); }
__device__ __forceinline__ float silu_f(float v) { return v / (1.f + __expf(-v)); }
__device__ __forceinline__ float sigm_f(float v) { return 1.f / (1.f + __expf(-v)); }
__device__ __forceinline__ float wave_sum(float v) {
#pragma unroll
    for (int o = 1; o < 64; o <<= 1) v += __shfl_xor(v, o);
    return v;
}
__host__ __device__ __forceinline__ int dimperm(int p) { const int wc = p >> 5, n = (p >> 4) & 1, i16 = p & 15; return 64 * (wc >> 1) + 32 * n + 16 * (wc & 1) + i16; }
__host__ __device__ __forceinline__ int inv_dimperm(int d) { const int half = d >> 6, n = (d >> 5) & 1, idx = d & 31; return 32 * (2 * half + (idx >> 4)) + 16 * n + (idx & 15); }
__host__ __device__ __forceinline__ int win_destrow(int n) { return n < 1024 ? (n & ~127) + inv_dimperm(n & 127) : n; }

namespace pg8 {
constexpr int BM = 256, BK = 64, HALF = 128, HTB = HALF * BK * 2, STAGE_BYTES = 8 * HTB, NXCD = 8, WGM = 8;
__host__ __device__ __forceinline__ int lds_byte(int r, int c) { const int st = (r >> 4) * 2 + (c >> 5), rr = r & 15, cc = c & 31, ob = rr * 64 + cc * 2; return st * 1024 + (ob ^ (((ob >> 9) & 1) << 5)); }
__host__ __device__ __forceinline__ void stage_rc(int b, int& R, int& C) { const int st = b / 1024, sb = b % 1024, swz = sb ^ (((sb >> 9) & 1) << 5); R = (st >> 1) * 16 + swz / 64; C = (st & 1) * 32 + (swz % 64) / 2; }
__host__ __device__ __forceinline__ int perm32(int rho) { const int n = rho >> 4, i = rho & 15; return 8 * (i >> 2) + 4 * n + (i & 3); }

struct Unit { int pm, pn, pc; };
struct Gemm { const bf16_t* A; const bf16_t* Bt; int K, lda, ldb; };

struct StaticOrder {
    int nM, nN, nwg, G, c;
    __device__ void init(int M, int N, int G_, int c_) { nM = M / BM; nN = N / BM; nwg = nM * nN; G = G_; c = c_; }
    __device__ bool next(int i, Unit& u) const {
        const long L = (long)i * G + c; if (L >= nwg) return false;
        int wgid = (int)L; { const int q = nwg / NXCD, r = nwg % NXCD, xcd = wgid % NXCD, off = wgid / NXCD; wgid = (xcd < r ? xcd * (q + 1) : r * (q + 1) + (xcd - r) * q) + off; }
        const int nig = WGM * nN, gid = wgid / nig, fm = gid * WGM, gsz = (nM - fm) < WGM ? (nM - fm) : WGM;
        u.pm = fm + ((wgid % nig) % gsz); u.pn = (wgid % nig) / gsz; u.pc = u.pn; return true;
    }
};
struct InProjOrder {
    StaticOrder so; int G, c;
    __device__ void init(int G_, int c_) { so.init(T, NINA, G_, c_); G = G_; c = c_; }
    __device__ bool next(int i, Unit& u) const {
        const long L = (long)i * G + c;
        if (L < so.nwg) return so.next(i, u);
        const int l = (int)(L - so.nwg); if (l >= 48) return false;
        u.pm = 128 + (l & 7); u.pn = 2 + (l >> 3); u.pc = u.pn; return true;
    }
};
struct MoeOrder {
    int ntile4, G, c; const LAS int* texp;
    __device__ bool next(int i, Unit& u) const {
        const long L = (long)i * G + c; if (L >= ntile4) return false;
        u.pm = (int)(L >> 2); u.pc = (int)(L & 3); u.pn = texp[u.pm] * 4 + u.pc; return true;
    }
};

__device__ __forceinline__ unsigned cvt_pk_bf16(float lo, float hi) { unsigned r; asm volatile("v_cvt_pk_bf16_f32 %0, %1, %2" : "=v"(r) : "v"(lo), "v"(hi)); return r; }

template <class Epi, class Sched>
__device__ __forceinline__ void gemm_phase(LAS unsigned char* lds, const Gemm g, const Sched& S, const Epi& E) {
    int tid = threadIdx.x; asm volatile("" : "+v"(tid));
    const int wid = __builtin_amdgcn_readfirstlane(tid >> 6), lane = tid & 63, wr = wid >> 2, wc = wid & 3, fr = lane & 15, fq = lane >> 4;
    const int K = g.K, nt = K / BK;
    unsigned voffA[2], voffB[2];
#pragma unroll
    for (int i = 0; i < 2; ++i) { int R, C; stage_rc(tid * 16 + i * 8192, R, C); const int Rb = Epi::PERM ? ((R & ~31) + perm32(R & 31)) : R;
        voffA[i] = (unsigned)(R * g.lda + C) * 2u; voffB[i] = (unsigned)(Rb * g.ldb + C) * 2u; }
    const size_t kstep = (size_t)(BK * 2);
    const size_t hstepA = (size_t)HALF * g.lda * 2, tstepA = 2 * hstepA;
    const size_t hstepB = (size_t)HALF * g.ldb * 2, tstepB = 2 * hstepB;
    const unsigned ldsw = (unsigned)wid * 1024u;
    const int aoff = lds_byte(wr * 64 + fr, fq * 8), boff = lds_byte(wc * 32 + fr, fq * 8);
#define PG8_SA(b, h) (((b) * 2 + (h)) * HTB)
#define PG8_SB(b, h) ((4 + (b) * 2 + (h)) * HTB)
#define PG8_STAGE(bufoff, gbase, voff) do { _Pragma("unroll") for (int _i = 0; _i < 2; ++_i) \
        __builtin_amdgcn_global_load_lds((const unsigned*)((const char*)(gbase) + (voff)[_i]), (LAS unsigned*)(lds + (bufoff) + ldsw + _i * 8192), 16, 0, 0); } while (0)
#define PG8_LDA(dst, b, h) do { _Pragma("unroll") for (int m = 0; m < 4; ++m) _Pragma("unroll") for (int k = 0; k < 2; ++k) dst[m][k] = *(const LAS bf16x8*)(lds + PG8_SA(b, h) + aoff + m * 2048 + k * 1024); } while (0)
#define PG8_LDB(dst, b, h) do { _Pragma("unroll") for (int n = 0; n < 2; ++n) _Pragma("unroll") for (int k = 0; k < 2; ++k) dst[n][k] = *(const LAS bf16x8*)(lds + PG8_SB(b, h) + boff + n * 2048 + k * 1024); } while (0)
#define PG8_MMA(ai, bj, At, Bt) do { __builtin_amdgcn_s_setprio(1); _Pragma("unroll") for (int m = 0; m < 4; ++m) _Pragma("unroll") for (int n = 0; n < 2; ++n) _Pragma("unroll") for (int k = 0; k < 2; ++k) \
        acc[ai][bj][m][n] = __builtin_amdgcn_mfma_f32_16x16x32_bf16(Bt[n][k], At[m][k], acc[ai][bj][m][n], 0, 0, 0); __builtin_amdgcn_s_setprio(0); } while (0)
#define PG8_WAIT_V(n) asm volatile("s_waitcnt vmcnt(" #n ")" ::: "memory")
#define PG8_WAIT_L(n) asm volatile("s_waitcnt lgkmcnt(" #n ")" ::: "memory")
#define PG8_BAR __builtin_amdgcn_s_barrier()
#define PG8_SCHED __builtin_amdgcn_sched_barrier(0)
    Unit cur, nxt; int ui = 0;
    if (!S.next(0, cur)) return;
    f32x4 acc[2][2][4][2];
#pragma unroll
    for (int a = 0; a < 2; ++a)
#pragma unroll
        for (int b = 0; b < 2; ++b)
#pragma unroll
            for (int m = 0; m < 4; ++m)
#pragma unroll
                for (int n = 0; n < 2; ++n) acc[a][b][m][n] = (f32x4){0.f, 0.f, 0.f, 0.f};
    bf16x8 At[4][2], B0[2][2], B1[2][2];
    const char* cA = (const char*)g.A + (size_t)cur.pm * tstepA; const char* cB = (const char*)g.Bt + (size_t)cur.pn * tstepB;
    PG8_STAGE(PG8_SB(0, 0), cB, voffB); PG8_STAGE(PG8_SB(0, 1), cB + hstepB, voffB); PG8_STAGE(PG8_SA(0, 0), cA, voffA); PG8_STAGE(PG8_SA(0, 1), cA + hstepA, voffA);
    if (wr == 1) PG8_BAR;
    PG8_WAIT_V(2); PG8_BAR;
    PG8_STAGE(PG8_SB(1, 0), cB + kstep, voffB); PG8_STAGE(PG8_SA(1, 0), cA + kstep, voffA); PG8_STAGE(PG8_SB(1, 1), cB + hstepB + kstep, voffB);
    PG8_WAIT_V(6); PG8_BAR;
    for (;;) {
        const bool has_next = S.next(ui + 1, nxt);
        const char* nA = has_next ? (const char*)g.A + (size_t)nxt.pm * tstepA : cA; const char* nB = has_next ? (const char*)g.Bt + (size_t)nxt.pn * tstepB : cB;
        for (int t = 0; t < nt; t += 2) {
            const bool last = (t == nt - 2);
            const char* a1 = cA + (size_t)(t + 1) * kstep;
            const char* a2 = last ? nA : cA + (size_t)(t + 2) * kstep; const char* b2 = last ? nB : cB + (size_t)(t + 2) * kstep;
            const char* a3 = a2 + kstep; const char* b3 = b2 + kstep;
            PG8_LDB(B0, 0, 0); PG8_LDB(B1, 0, 1); PG8_SCHED; PG8_LDA(At, 0, 0); PG8_STAGE(PG8_SA(1, 1), a1 + hstepA, voffA);
            PG8_WAIT_V(8); PG8_WAIT_L(0); PG8_BAR; PG8_MMA(0, 0, At, B0); PG8_MMA(0, 1, At, B1); PG8_BAR; PG8_SCHED;
            PG8_LDA(At, 0, 1); PG8_STAGE(PG8_SB(0, 0), b2, voffB); PG8_STAGE(PG8_SB(0, 1), b2 + hstepB, voffB); PG8_STAGE(PG8_SA(0, 0), a2, voffA);
            PG8_WAIT_V(8); PG8_WAIT_L(0); PG8_BAR; PG8_MMA(1, 0, At, B0); PG8_MMA(1, 1, At, B1); PG8_BAR; PG8_SCHED;
            PG8_LDB(B0, 1, 0); PG8_LDB(B1, 1, 1); PG8_SCHED; PG8_LDA(At, 1, 0); PG8_STAGE(PG8_SA(0, 1), a2 + hstepA, voffA);
            PG8_WAIT_V(8); PG8_WAIT_L(0); PG8_BAR; PG8_MMA(0, 0, At, B0); PG8_MMA(0, 1, At, B1); PG8_BAR; PG8_SCHED;
            PG8_LDA(At, 1, 1); PG8_STAGE(PG8_SB(1, 0), b3, voffB); PG8_STAGE(PG8_SB(1, 1), b3 + hstepB, voffB); PG8_STAGE(PG8_SA(1, 0), a3, voffA);
            PG8_WAIT_V(8); PG8_WAIT_L(0); PG8_BAR; PG8_MMA(1, 0, At, B0); PG8_MMA(1, 1, At, B1); PG8_BAR; PG8_SCHED;
        }
        if (wr == 0) PG8_BAR;
        E(acc, cur, wr, wc, fr, fq);
        if (!has_next) break;
#pragma unroll
        for (int a = 0; a < 2; ++a)
#pragma unroll
            for (int b = 0; b < 2; ++b)
#pragma unroll
                for (int m = 0; m < 4; ++m)
#pragma unroll
                    for (int n = 0; n < 2; ++n) acc[a][b][m][n] = (f32x4){0.f, 0.f, 0.f, 0.f};
        cur = nxt; cA = nA; cB = nB; ++ui;
        if (wr == 1) PG8_BAR;
    }
    PG8_WAIT_V(0);
    PG8_BAR;
#undef PG8_SA
#undef PG8_SB
#undef PG8_STAGE
#undef PG8_LDA
#undef PG8_LDB
#undef PG8_MMA
#undef PG8_WAIT_V
#undef PG8_WAIT_L
#undef PG8_BAR
#undef PG8_SCHED
}

__device__ __forceinline__ void st_bf4(bf16_t* p, f32x4 v) { u32x2 w; w.x = cvt_pk_bf16(v[0], v[1]); w.y = cvt_pk_bf16(v[2], v[3]); *(u32x2*)p = w; }
__device__ __forceinline__ void st_bf8(bf16_t* p, f32x4 v0, f32x4 v1) { u32x4 w; w.x = cvt_pk_bf16(v0[0], v0[1]); w.y = cvt_pk_bf16(v0[2], v0[3]); w.z = cvt_pk_bf16(v1[0], v1[1]); w.w = cvt_pk_bf16(v1[2], v1[3]); *(u32x4*)p = w; }

struct EpiInA {
    static constexpr bool PERM = false;
    bf16_t *Q, *Kn, *KT, *VT, *SG, *HU; const float* binp; const float* rope;
    __device__ __forceinline__ void operator()(const f32x4 (&acc)[2][2][4][2], const Unit& u, int wr, int wc, int fr, int fq) const {
        const int pc = u.pc, rbase = u.pm * BM + wr * 64 + fr, cbase = pc * BM + wc * 32 + 4 * fq;
        f32x4 bv[2][2];
#pragma unroll
        for (int bj = 0; bj < 2; ++bj)
#pragma unroll
            for (int n = 0; n < 2; ++n) bv[bj][n] = *(const f32x4*)(binp + cbase + bj * HALF + n * 16);
        const bool lat = u.pm < 128;
        const int bidx = lat ? (u.pm >> 4) : (u.pm - 128);
        if (pc < 4) {
            const bool isk = pc >= 2; const float ks = isk ? 0.08838834764831845f : 1.f;
            const int h0 = (pc & 1) * 2;
#pragma unroll
            for (int ai = 0; ai < 2; ++ai)
#pragma unroll
                for (int m = 0; m < 4; ++m) {
                    const int r = rbase + ai * HALF + m * 16, t = r & 4095;
                    const int tok = lat ? t : 4096 + ((r - T) & 255);
                    f32x4 cs = (f32x4){1.f, 1.f, 1.f, 1.f}, sn = (f32x4){0.f, 0.f, 0.f, 0.f};
                    if (lat) { const int pos = (wc >> 1) ? (t & 63) : (t >> 6); const float* rp = rope + pos * 32 + 16 * (wc & 1) + 4 * fq; cs = *(const f32x4*)rp; sn = *(const f32x4*)(rp + 2048); }
#pragma unroll
                    for (int bj = 0; bj < 2; ++bj) {
                        const f32x4 x1 = acc[ai][bj][m][0] + bv[bj][0], x2 = acc[ai][bj][m][1] + bv[bj][1];
                        const f32x4 o1 = (x1 * cs - x2 * sn) * ks, o2 = (x1 * sn + x2 * cs) * ks;
                        const int col = (pc & 1) * BM + bj * HALF + wc * 32 + 4 * fq;
                        if (!isk) { st_bf4(Q + (size_t)r * 512 + col, o1); st_bf4(Q + (size_t)r * 512 + col + 16, o2); }
                        else {
                            st_bf4(Kn + (size_t)r * 512 + col, o1); st_bf4(Kn + (size_t)r * 512 + col + 16, o2);
                            bf16_t* kt = KT + ((size_t)((bidx * 4 + h0 + bj) * 128 + wc * 32 + 4 * fq)) * TOKP + tok;
#pragma unroll
                            for (int e = 0; e < 4; ++e) { kt[(size_t)e * TOKP] = (bf16_t)f2bf(o1[e]); kt[(size_t)(16 + e) * TOKP] = (bf16_t)f2bf(o2[e]); }
                        }
                    }
                }
        } else if (pc < 8) {
            const int h = pc - 4;
#pragma unroll
            for (int ai = 0; ai < 2; ++ai)
#pragma unroll
                for (int m = 0; m < 4; ++m) {
                    const int r = rbase + ai * HALF + m * 16;
                    const int tok = lat ? (r & 4095) : 4096 + ((r - T) & 255);
#pragma unroll
                    for (int bj = 0; bj < 2; ++bj)
#pragma unroll
                        for (int n = 0; n < 2; ++n) {
                            const f32x4 v = acc[ai][bj][m][n] + bv[bj][n];
                            bf16_t* vt = VT + ((size_t)((bidx * 4 + h) * 256 + bj * HALF + wc * 32 + n * 16 + 4 * fq)) * TOKP + tok;
#pragma unroll
                            for (int e = 0; e < 4; ++e) vt[(size_t)e * TOKP] = (bf16_t)f2bf(v[e]);
                        }
                }
        } else {
            const bool isg = pc < 12;
            bf16_t* O = isg ? SG : HU; const int ldo = isg ? 1024 : 1536; const int c0 = (isg ? pc - 8 : pc - 12) * BM + wc * 32 + 4 * fq;
#pragma unroll
            for (int ai = 0; ai < 2; ++ai)
#pragma unroll
                for (int m = 0; m < 4; ++m) {
                    const int r = rbase + ai * HALF + m * 16;
#pragma unroll
                    for (int bj = 0; bj < 2; ++bj)
#pragma unroll
                        for (int n = 0; n < 2; ++n) {
                            f32x4 v = acc[ai][bj][m][n] + bv[bj][n];
                            if (isg) { v[0] = silu_f(v[0]); v[1] = silu_f(v[1]); v[2] = silu_f(v[2]); v[3] = silu_f(v[3]); }
                            st_bf4(O + (size_t)r * ldo + c0 + bj * HALF + n * 16, v);
                        }
                }
        }
    }
};
struct EpiGate {
    static constexpr bool PERM = true;
    bf16_t *SGR, *SGH; const float* bias;
    __device__ __forceinline__ void operator()(const f32x4 (&acc)[2][2][4][2], const Unit& u, int wr, int wc, int fr, int fq) const {
        const int pc = u.pc, rbase = u.pm * BM + wr * 64 + fr; bf16_t* O = pc < 4 ? SGR : SGH;
        const int col0 = (pc & 3) * BM + wc * 32 + 8 * fq, bcol0 = pc * BM + wc * 32 + 8 * fq;
        f32x4 bv[2][2];
#pragma unroll
        for (int bj = 0; bj < 2; ++bj)
#pragma unroll
            for (int n = 0; n < 2; ++n) bv[bj][n] = *(const f32x4*)(bias + bcol0 + bj * HALF + 4 * n);
#pragma unroll
        for (int ai = 0; ai < 2; ++ai)
#pragma unroll
            for (int m = 0; m < 4; ++m) { bf16_t* rowp = O + (size_t)(rbase + ai * HALF + m * 16) * 1024 + col0;
#pragma unroll
                for (int bj = 0; bj < 2; ++bj) { f32x4 v0 = acc[ai][bj][m][0] + bv[bj][0], v1 = acc[ai][bj][m][1] + bv[bj][1];
#pragma unroll
                    for (int e = 0; e < 4; ++e) { v0[e] = sigm_f(v0[e]); v1[e] = sigm_f(v1[e]); }
                    st_bf8(rowp + bj * HALF, v0, v1); } }
    }
};
template <int MODE> struct EpiMerge {
    static constexpr bool PERM = true;
    bf16_t* O; const bf16_t* P;
    __device__ __forceinline__ void operator()(const f32x4 (&acc)[2][2][4][2], const Unit& u, int wr, int wc, int fr, int fq) const {
        const int rbase = u.pm * BM + wr * 64 + fr, col0 = u.pc * BM + wc * 32 + 8 * fq;
#pragma unroll
        for (int ai = 0; ai < 2; ++ai)
#pragma unroll
            for (int m = 0; m < 4; ++m) { const size_t off = (size_t)(rbase + ai * HALF + m * 16) * 1024 + col0;
#pragma unroll
                for (int bj = 0; bj < 2; ++bj) {
                    const u32x4 gw = *(const u32x4*)(O + off + bj * HALF);
                    f32x4 v0 = acc[ai][bj][m][0], v1 = acc[ai][bj][m][1];
                    v0[0] *= bflo(gw.x); v0[1] *= bfhi(gw.x); v0[2] *= bflo(gw.y); v0[3] *= bfhi(gw.y);
                    v1[0] *= bflo(gw.z); v1[1] *= bfhi(gw.z); v1[2] *= bflo(gw.w); v1[3] *= bfhi(gw.w);
                    if (MODE == 1) { const u32x4 pw = *(const u32x4*)(P + off + bj * HALF);
                        v0[0] += bflo(pw.x); v0[1] += bfhi(pw.x); v0[2] += bflo(pw.y); v0[3] += bfhi(pw.y);
                        v1[0] += bflo(pw.z); v1[1] += bfhi(pw.z); v1[2] += bflo(pw.w); v1[3] += bfhi(pw.w); }
                    st_bf8(O + off + bj * HALF, v0, v1); } }
    }
};
struct EpiX1 {
    static constexpr bool PERM = false;
    const float* x; const float* mod; float* out;
    __device__ __forceinline__ void operator()(const f32x4 (&acc)[2][2][4][2], const Unit& u, int wr, int wc, int fr, int fq) const {
        const int rbase = u.pm * BM + wr * 64 + fr, col0 = u.pc * BM + wc * 32 + 4 * fq;
        const float* gt = mod + (size_t)(u.pm >> 4) * 6144 + 2048 + col0;
        f32x4 gv[2][2];
#pragma unroll
        for (int bj = 0; bj < 2; ++bj)
#pragma unroll
            for (int n = 0; n < 2; ++n) gv[bj][n] = *(const f32x4*)(gt + bj * HALF + n * 16);
#pragma unroll
        for (int ai = 0; ai < 2; ++ai)
#pragma unroll
            for (int m = 0; m < 4; ++m) { const size_t off = (size_t)(rbase + ai * HALF + m * 16) * 1024 + col0;
#pragma unroll
                for (int bj = 0; bj < 2; ++bj)
#pragma unroll
                    for (int n = 0; n < 2; ++n) { const f32x4 xv = *(const f32x4*)(x + off + bj * HALF + n * 16); *(f32x4*)(out + off + bj * HALF + n * 16) = xv + gv[bj][n] * acc[ai][bj][m][n]; } }
    }
};
struct EpiMoe1 {
    static constexpr bool PERM = true;
    bf16_t* HM;
    __device__ __forceinline__ void operator()(const f32x4 (&acc)[2][2][4][2], const Unit& u, int wr, int wc, int fr, int fq) const {
        const int rbase = u.pm * BM + wr * 64 + fr, col0 = u.pc * HALF + wc * 32 + 8 * fq;
#pragma unroll
        for (int ai = 0; ai < 2; ++ai)
#pragma unroll
            for (int m = 0; m < 4; ++m) {
                f32x4 v0, v1;
#pragma unroll
                for (int e = 0; e < 4; ++e) { v0[e] = silu_f(acc[ai][0][m][0][e]) * acc[ai][1][m][0][e]; v1[e] = silu_f(acc[ai][0][m][1][e]) * acc[ai][1][m][1][e]; }
                st_bf8(HM + (size_t)(rbase + ai * HALF + m * 16) * EH + col0, v0, v1); }
    }
};
struct EpiBf {
    static constexpr bool PERM = true;
    bf16_t* O; int ldo;
    __device__ __forceinline__ void operator()(const f32x4 (&acc)[2][2][4][2], const Unit& u, int wr, int wc, int fr, int fq) const {
        const int rbase = u.pm * BM + wr * 64 + fr, col0 = u.pc * BM + wc * 32 + 8 * fq;
#pragma unroll
        for (int ai = 0; ai < 2; ++ai)
#pragma unroll
            for (int m = 0; m < 4; ++m)
#pragma unroll
                for (int bj = 0; bj < 2; ++bj) st_bf8(O + (size_t)(rbase + ai * HALF + m * 16) * ldo + col0 + bj * HALF, acc[ai][bj][m][0], acc[ai][bj][m][1]);
    }
};
}

namespace gt {
constexpr int AST = 144;
constexpr int STAGE_BYTES = 128 * AST + 256 * AST;
template <int NT, class AL, class BL>
__device__ __forceinline__ void gemm_tile(f32x4 (&acc)[4][NT], const AL& al, const BL& bl, int nk, LAS unsigned char* st, int tid) {
    const int lane = tid & 63, wid = tid >> 6, wr = wid >> 2, wc = wid & 3, fr = lane & 15, fq = lane >> 4;
    LAS unsigned char* sa = st; LAS unsigned char* sb = st + 128 * AST;
    u32x4 ra[2], rb[NT];
#pragma unroll
    for (int i = 0; i < 2; ++i) { const int p = tid + i * 512; ra[i] = al(p >> 3, (p & 7) * 8); }
#pragma unroll
    for (int i = 0; i < NT; ++i) { const int p = tid + i * 512; rb[i] = bl(p >> 3, (p & 7) * 8); }
    for (int kt = 0; kt < nk; ++kt) {
        __syncthreads();
#pragma unroll
        for (int i = 0; i < 2; ++i) { const int p = tid + i * 512; *(LAS u32x4*)(sa + (p >> 3) * AST + (p & 7) * 16) = ra[i]; }
#pragma unroll
        for (int i = 0; i < NT; ++i) { const int p = tid + i * 512; *(LAS u32x4*)(sb + (p >> 3) * AST + (p & 7) * 16) = rb[i]; }
        __syncthreads();
        if (kt + 1 < nk) {
#pragma unroll
            for (int i = 0; i < 2; ++i) { const int p = tid + i * 512; ra[i] = al(p >> 3, (kt + 1) * 64 + (p & 7) * 8); }
#pragma unroll
            for (int i = 0; i < NT; ++i) { const int p = tid + i * 512; rb[i] = bl(p >> 3, (kt + 1) * 64 + (p & 7) * 8); }
        }
#pragma unroll
        for (int kk = 0; kk < 2; ++kk) {
            bf16x8 a[4], b[NT];
#pragma unroll
            for (int m = 0; m < 4; ++m) a[m] = *(const LAS bf16x8*)(sa + (wr * 64 + m * 16 + fr) * AST + kk * 64 + fq * 16);
#pragma unroll
            for (int n = 0; n < NT; ++n) b[n] = *(const LAS bf16x8*)(sb + (wc * 16 * NT + n * 16 + fr) * AST + kk * 64 + fq * 16);
#pragma unroll
            for (int m = 0; m < 4; ++m)
#pragma unroll
                for (int n = 0; n < NT; ++n) acc[m][n] = __builtin_amdgcn_mfma_f32_16x16x32_bf16(a[m], b[n], acc[m][n], 0, 0, 0);
        }
    }
    __syncthreads();
}
struct LdRows {
    const bf16_t* base; int ld;
    __device__ __forceinline__ u32x4 operator()(int row, int k) const { return *(const u32x4*)(base + (size_t)row * ld + k); }
};
__device__ __forceinline__ u32x4 scale8(u32x4 v, float s0, float s1, float s2, float s3, float s4, float s5, float s6, float s7) {
    u32x4 o; o.x = pk2(bflo(v.x) * s0, bfhi(v.x) * s1); o.y = pk2(bflo(v.y) * s2, bfhi(v.y) * s3); o.z = pk2(bflo(v.z) * s4, bfhi(v.z) * s5); o.w = pk2(bflo(v.w) * s6, bfhi(v.w) * s7); return o;
}
}


#define XB_TMO      128
#define XB_XCNT(j)  (256  + 64 * (j))
#define XB_XSUB(j)  (1280 + 64 * (j))
#define XB_XGEN(j)  (2304 + 64 * (j))
#define XB_TOP      3328
#define XB_TOPGEN   3392
#define XCD_BAR_WORDS 3456
#define XB_SPIN_CAP (1u << 18)
__device__ __forceinline__ unsigned xb_ld(unsigned* p)              { return __hip_atomic_load(p, __ATOMIC_RELAXED, __HIP_MEMORY_SCOPE_AGENT); }
__device__ __forceinline__ unsigned xb_add(unsigned* p, unsigned v) { return __hip_atomic_fetch_add(p, v, __ATOMIC_RELAXED, __HIP_MEMORY_SCOPE_AGENT); }
__device__ __forceinline__ unsigned xb_xcc_id() { return (unsigned)__builtin_amdgcn_s_getreg((3 << 11) | 20) & 0xFu; }
#define XB_SPIN(cond, bar) do { unsigned _sp = 0; while (cond) { __builtin_amdgcn_s_sleep(1); \
    if ((++_sp & 255u) == 0u) { if (xb_ld(&(bar)[XB_TMO])) break; if (_sp > XB_SPIN_CAP) { atomicAdd(&(bar)[XB_TMO], 1u); break; } } } } while (0)
struct XcdBarrier { unsigned* bar; unsigned x; volatile LAS unsigned* st; };
__device__ __forceinline__ XcdBarrier xcd_barrier_post(unsigned* bar, volatile LAS unsigned* st) {
    XcdBarrier b; b.bar = bar; b.x = xb_xcc_id(); b.st = st;
    if (threadIdx.x == 0) (void)xb_add(&bar[XB_XCNT(b.x)], 1u);
    return b;
}
__device__ __forceinline__ void xcd_barrier_complete(unsigned* bar, unsigned x, unsigned& nloc, unsigned& nx) {
    const unsigned G = gridDim.x * gridDim.y * gridDim.z;
    unsigned sum, cnt, mine, sp = 0u;
    for (;;) {
        sum = 0u; cnt = 0u; mine = 0u;
#pragma unroll
        for (unsigned j = 0; j < 16; ++j) { const unsigned c = xb_ld(&bar[XB_XCNT(j)]); sum += c; cnt += (c > 0u) ? 1u : 0u; mine = (j == x) ? c : mine; }
        if (sum == G) break;
        __builtin_amdgcn_s_sleep(1);
        if ((++sp & 255u) == 0u) { if (xb_ld(&bar[XB_TMO])) break; if (sp > XB_SPIN_CAP) { atomicAdd(&bar[XB_TMO], 1u); break; } }
    }
    nloc = mine > 0u ? mine : 1u; nx = cnt > 0u ? cnt : 1u;
}
__device__ __forceinline__ void xcd_barrier(const XcdBarrier& b) {
    asm volatile("s_waitcnt vmcnt(0)" ::: "memory");
    __syncthreads();
    if (threadIdx.x == 0) {
        unsigned* bar = b.bar;
        __builtin_amdgcn_s_waitcnt(0);
        unsigned nloc = b.st[0], nx = b.st[1];
        if (nloc == 0u) { xcd_barrier_complete(bar, b.x, nloc, nx); b.st[0] = nloc; b.st[1] = nx; }
        const unsigned old = xb_add(&bar[XB_XSUB(b.x)], 1u);
        const unsigned gen = old / nloc;
        if (old + 1u == (gen + 1u) * nloc) {
            __builtin_amdgcn_fence(__ATOMIC_RELEASE, "agent");
            asm volatile("s_waitcnt vmcnt(0)" ::: "memory");
            const unsigned og = xb_add(&bar[XB_TOP], 1u);
            const unsigned tg = og / nx;
            if (og + 1u == (tg + 1u) * nx) xb_add(&bar[XB_TOPGEN], 1u);
            else XB_SPIN(xb_ld(&bar[XB_TOPGEN]) == tg, bar);
            __builtin_amdgcn_fence(__ATOMIC_ACQUIRE, "agent");
            xb_add(&bar[XB_XGEN(b.x)], 1u);
            asm volatile("s_waitcnt vmcnt(0)" ::: "memory");
        } else {
            XB_SPIN(xb_ld(&bar[XB_XGEN(b.x)]) == gen, bar);
            __builtin_amdgcn_fence(__ATOMIC_ACQUIRE, "agent");
            asm volatile("s_waitcnt vmcnt(0)" ::: "memory");
        }
    }
    __syncthreads();
}

struct Args { const float* in[31]; float* out; unsigned char* ws; };
enum { I_X = 0, I_C, I_CTX, I_CCTX, I_ADAW, I_ADAB, I_N1G, I_N2G, I_WIN, I_BIN, I_DECAY, I_RETWO, I_HCW, I_HCB, I_HW1, I_HB1, I_HFREQ, I_HW2, I_HB2, I_HW3, I_HSKIP, I_HYWO, I_WOUT,
       I_RGW, I_RGB, I_REW, I_REB, I_EW1, I_EW3, I_EW2, I_FNG };

template <class RowMap>
__device__ __forceinline__ void transpose_item(const float* W, int N, int k0, int n0, bf16_t* WT, int ldt, const RowMap& rm, LAS float* scr, int lane) {
    const int lr = lane >> 4, lc = (lane & 15) * 4;
#pragma unroll
    for (int i = 0; i < 16; ++i) { const int kk = 4 * i + lr; const f32x4 v = *(const f32x4*)(W + (size_t)(k0 + kk) * N + n0 + lc); LAS float* s = scr + kk * 69 + lc; s[0] = v[0]; s[1] = v[1]; s[2] = v[2]; s[3] = v[3]; }
    asm volatile("s_waitcnt lgkmcnt(0)" ::: "memory");
    const int c = lane & 7;
#pragma unroll
    for (int j = 0; j < 8; ++j) { const int n = (lane >> 3) + 8 * j; const LAS float* s = scr + (8 * c) * 69 + n;
        u32x4 o; o.x = pk2(s[0 * 69], s[1 * 69]); o.y = pk2(s[2 * 69], s[3 * 69]); o.z = pk2(s[4 * 69], s[5 * 69]); o.w = pk2(s[6 * 69], s[7 * 69]);
        *(u32x4*)(WT + (size_t)rm(n0 + n) * ldt + k0 + 8 * c) = o; }
    asm volatile("s_waitcnt lgkmcnt(0)" ::: "memory");
}
struct RmId { __device__ __forceinline__ int operator()(int n) const { return n; } };
struct RmWin { __device__ __forceinline__ int operator()(int n) const { return win_destrow(n); } };
struct RmE13 { int add; __device__ __forceinline__ int operator()(int n) const { return 256 * (n >> 7) + (n & 127) + add; } };

__device__ __forceinline__ float lg2_decay(float logit) { return -log1pf(expf(-logit)) * 1.4426950408889634f; }

__device__ __forceinline__ void short_conv8(const bf16_t* HU, int row, int t, int ch, const float* cw, const float* cb, float (&o)[8]) {
    const f32x4 b0 = *(const f32x4*)(cb + ch), b1 = *(const f32x4*)(cb + ch + 4);
#pragma unroll
    for (int e = 0; e < 4; ++e) { o[e] = b0[e]; o[4 + e] = b1[e]; }
#pragma unroll
    for (int j = 0; j < 3; ++j) {
        const int tt = t + j - 1;
        if (tt >= 0 && tt < SEQ) {
            const u32x4 v = *(const u32x4*)(HU + (size_t)(row + j - 1) * 1536 + ch);
            const f32x4 w0 = *(const f32x4*)(cw + j * 1536 + ch), w1 = *(const f32x4*)(cw + j * 1536 + ch + 4);
            o[0] += bflo(v.x) * w0[0]; o[1] += bfhi(v.x) * w0[1]; o[2] += bflo(v.y) * w0[2]; o[3] += bfhi(v.y) * w0[3];
            o[4] += bflo(v.z) * w1[0]; o[5] += bfhi(v.z) * w1[1]; o[6] += bflo(v.w) * w1[2]; o[7] += bfhi(v.w) * w1[3];
        }
    }
}

typedef const __attribute__((address_space(4))) Args CArgs;
__device__ __forceinline__ CArgs* args_ptr() { CArgs* p = (CArgs*)__builtin_amdgcn_kernarg_segment_ptr(); asm volatile("" : "+s"(p)); return p; }
#define DECL_PTRS \
    CArgs& a = *args_ptr(); unsigned char* ws = a.ws; unsigned char* dob = (unsigned char*)a.out; \
    int tid = threadIdx.x; asm volatile("" : "+v"(tid)); const int lane = tid & 63, wave = tid >> 6, gw = bid * 8 + wave; (void)lane; (void)gw; \
    int* cnt = (int*)(ws + WS_CTL); \
    float* MOD = (float*)(ws + WS_MOD); float* ROPE = (float*)(ws + WS_ROPE); float* BINP = (float*)(ws + WS_BINP); float* FPART = (float*)(ws + WS_FPART); \
    int* TOKINFO = (int*)(ws + WS_TOKINFO); int* LISTS = (int*)(ws + WS_LISTS); \
    bf16_t* TR = (bf16_t*)(ws + WS_TR); \
    bf16_t* WT_IN = (bf16_t*)(ws + WS_WT_IN); bf16_t* WT_RETO = (bf16_t*)(ws + WS_WT_RETO); bf16_t* WT_HYO = (bf16_t*)(ws + WS_WT_HYO); bf16_t* WT_OUT = (bf16_t*)(ws + WS_WT_OUT); \
    bf16_t* Qb = (bf16_t*)(ws + WS_Q); bf16_t* Kb = (bf16_t*)(ws + WS_K); bf16_t* KT = (bf16_t*)(ws + WS_KT); bf16_t* VT = (bf16_t*)(ws + WS_VT); \
    float* FILT = (float*)(ws + WS_FILT); \
    bf16_t* SGR = (bf16_t*)(ws + WS_SGR); bf16_t* SGH = (bf16_t*)(ws + WS_SGH); bf16_t* XB = (bf16_t*)(ws + WS_XB); \
    bf16_t* SG = (bf16_t*)(ws + WS_SG); bf16_t* HU = (bf16_t*)(ws + WS_HU); bf16_t* HM = (bf16_t*)(ws + WS_HU); \
    bf16_t* KV = (bf16_t*)(ws + WS_KV); bf16_t* WE13 = (bf16_t*)(ws + WS_WE13); bf16_t* WE2 = (bf16_t*)(ws + WS_WE2); \
    bf16_t* XN = (bf16_t*)(dob + DO_XN); bf16_t* ZT = (bf16_t*)(dob + DO_ZT); \
    float* X1 = a.out; \
    (void)cnt; (void)MOD; (void)ROPE; (void)BINP; (void)FPART; (void)TOKINFO; (void)LISTS; (void)TR; (void)WT_IN; (void)WT_RETO; (void)WT_HYO; (void)WT_OUT; (void)Qb; (void)Kb; (void)KT; (void)VT; (void)FILT; \
    (void)SGR; (void)SGH; (void)XB; (void)SG; (void)HU; (void)HM; (void)KV; (void)WE13; (void)WE2; (void)XN; (void)ZT; (void)X1;

__global__ void __launch_bounds__(512, 2) fwd_kernel(Args a_) {
    extern __shared__ __attribute__((aligned(16))) unsigned char lds_raw[];
    LAS unsigned char* lds = (LAS unsigned char*)lds_raw;
    cg::grid_group grid = cg::this_grid();
    const int G = gridDim.x, bid = blockIdx.x, NGW = G * 8;
    volatile LAS unsigned* bst = (volatile LAS unsigned*)(lds + LDS_BYTES - 16);
    if (threadIdx.x == 0) { bst[0] = 0u; bst[1] = 0u; }
    __syncthreads();
    const XcdBarrier xbar = xcd_barrier_post((unsigned*)(args_ptr()->ws + WS_CTL) + 1024, bst);
#define GRID_BAR() xcd_barrier(xbar)
    unsigned long long tprev_ = 0, spin_ = 0;
    if (PROBE_PHASE >= 0) tprev_ = __builtin_amdgcn_s_memrealtime();
#define STAMP(k) do { if (PROBE_PHASE >= 0 && blockIdx.x == 0 && threadIdx.x == 0) { const unsigned long long now_ = __builtin_amdgcn_s_memrealtime(); if ((k) == PROBE_PHASE) spin_ = now_ - tprev_; tprev_ = now_; } } while (0)

    for (int rp_ = 0; rp_ <= ((REPMASK >> 0) & 1); ++rp_) { if (rp_) GRID_BAR();
    { DECL_PTRS
    for (int it = bid; it < 192 + 256 + 1; it += G) {
        if (it < 192) {
            const int col0 = it * 32, kq = tid >> 5, cl = tid & 31;
            LAS float* sl = (LAS float*)(lds + 32768);
            for (int idx = tid; idx < 9 * 1024; idx += 512) { const int r = idx >> 10, k = idx & 1023; sl[k * 12 + r] = silu_f(r < 8 ? a.in[I_C][r * 1024 + k] : a.in[I_CCTX][k]); }
            __syncthreads();
            float acc9[9];
#pragma unroll
            for (int r = 0; r < 9; ++r) acc9[r] = 0.f;
#pragma unroll 8
            for (int kk = 0; kk < 64; ++kk) { const int k = kq * 64 + kk; const float w = a.in[I_ADAW][(size_t)k * 6144 + col0 + cl];
                const f32x4 s0 = *(const LAS f32x4*)(sl + k * 12), s1 = *(const LAS f32x4*)(sl + k * 12 + 4); const float s8 = sl[k * 12 + 8];
                acc9[0] += s0[0] * w; acc9[1] += s0[1] * w; acc9[2] += s0[2] * w; acc9[3] += s0[3] * w; acc9[4] += s1[0] * w; acc9[5] += s1[1] * w; acc9[6] += s1[2] * w; acc9[7] += s1[3] * w; acc9[8] += s8 * w; }
            LAS float* red = (LAS float*)lds;
#pragma unroll
            for (int r = 0; r < 9; ++r) red[(kq * 9 + r) * 32 + cl] = acc9[r];
            __syncthreads();
            if (tid < 288) { const int r = tid >> 5, c2 = tid & 31; float s = 0.f; for (int q = 0; q < 16; ++q) s += red[(q * 9 + r) * 32 + c2]; MOD[r * 6144 + col0 + c2] = s + a.in[I_ADAB][col0 + c2]; }
            __syncthreads();
        } else if (it < 448) {
            const int fi = it - 192, t0 = fi * 16;
            LAS float* feats = (LAS float*)lds; LAS float* hid1 = feats + 544; LAS float* hid2 = hid1 + 1024;
            for (int idx = tid; idx < 16 * 33; idx += 512) { const int row = idx / 33, f = idx % 33; const float t = (float)(t0 + row) * (1.f / 4096.f); float v;
                if (f == 0) v = t; else { const int mb = (f - 1) & 15; const float band = 1e-4f + (float)mb * ((15.f - 1e-4f) / 15.f); const float ph = (6.283185307179586f * t) * band; v = f <= 16 ? cosf(ph) : -sinf(ph); }
                feats[idx] = v; }
            __syncthreads();
            for (int idx = tid; idx < 1024; idx += 512) { const int row = idx >> 6, j = idx & 63; float s = a.in[I_HB1][j]; for (int f = 0; f < 33; ++f) s += feats[row * 33 + f] * a.in[I_HW1][f * 64 + j]; hid1[idx] = sinf(a.in[I_HFREQ][j] * s); }
            __syncthreads();
            for (int idx = tid; idx < 1024; idx += 512) { const int row = idx >> 6, j = idx & 63; float s = a.in[I_HB2][j]; for (int k = 0; k < 64; ++k) s += hid1[row * 64 + k] * a.in[I_HW2][k * 64 + j]; hid2[j * 16 + row] = sinf(a.in[I_HFREQ][j] * s); }
            __syncthreads();
            const float slow = 4.605170185988091f / 1.5f, fast = 4.605170185988091f / 0.3f;
            for (int col = tid; col < 1024; col += 512) {
                float ac[16];
#pragma unroll
                for (int r = 0; r < 16; ++r) ac[r] = 0.f;
#pragma unroll 4
                for (int k = 0; k < 64; ++k) { const float w = a.in[I_HW3][k * 1024 + col];
#pragma unroll
                    for (int r4 = 0; r4 < 4; ++r4) { const f32x4 hv = *(const LAS f32x4*)(hid2 + k * 16 + 4 * r4); ac[4 * r4] += hv[0] * w; ac[4 * r4 + 1] += hv[1] * w; ac[4 * r4 + 2] += hv[2] * w; ac[4 * r4 + 3] += hv[3] * w; } }
                const float delta = slow + (float)(col & 511) * ((fast - slow) / 511.f); float ps = 0.f;
#pragma unroll
                for (int r = 0; r < 16; ++r) { const float t = (float)(t0 + r) * (1.f / 4096.f); ac[r] *= expf(-t * delta); ps += fabsf(ac[r]); }
#pragma unroll
                for (int r = 0; r < 4; ++r) *(f32x4*)(FILT + (size_t)col * 4096 + t0 + 4 * r) = (f32x4){ac[4 * r], ac[4 * r + 1], ac[4 * r + 2], ac[4 * r + 3]};
                FPART[fi * 1024 + col] = ps;
            }
            __syncthreads();
        } else {
            for (int idx = tid; idx < 2048; idx += 512) { const int pos = idx >> 5, i = idx & 31; const float inv = powf(10000.f, -(float)i / 32.f); const float ang = (float)pos * inv; ROPE[idx] = cosf(ang); ROPE[2048 + idx] = sinf(ang); }
            for (int n = tid; n < 6656; n += 512) BINP[win_destrow(n)] = a.in[I_BIN][n];
        }
    }
    __syncthreads();
    {
        LAS float* scr = (LAS float*)(lds + wave * 17664);
        constexpr int I_IN = 16 * 104, I_RO = 16 * 16, I_HO = 8 * 16, I_OU = 16 * 16;
        for (int it = gw; it < I_IN + I_RO + I_HO + I_OU; it += NGW) {
            int r = it;
            if (r < I_IN) { transpose_item(a.in[I_WIN], 6656, 64 * (r / 104), 64 * (r % 104), WT_IN, 1024, RmWin{}, scr, lane); continue; } r -= I_IN;
            if (r < I_RO) { transpose_item(a.in[I_RETWO], 1024, 64 * (r / 16), 64 * (r % 16), WT_RETO, 1024, RmId{}, scr, lane); continue; } r -= I_RO;
            if (r < I_HO) { transpose_item(a.in[I_HYWO], 1024, 64 * (r / 16), 64 * (r % 16), WT_HYO, 512, RmId{}, scr, lane); continue; } r -= I_HO;
            transpose_item(a.in[I_WOUT], 1024, 64 * (r / 16), 64 * (r % 16), WT_OUT, 1024, RmId{}, scr, lane);
        }
    }
    }
    }
    grid.sync();
    STAMP(0);

    for (int rp_ = 0; rp_ <= ((REPMASK >> 1) & 1); ++rp_) { if (rp_) GRID_BAR();
    { DECL_PTRS
    for (int m = gw; m < MT; m += NGW) {
        const bool lat = m < T; const float* xr = lat ? a.in[I_X] + (size_t)m * D : a.in[I_CTX] + (size_t)(m - T) * D;
        const float* md = MOD + (size_t)(lat ? (m >> 12) : 8) * 6144;
        f32x4 v[4]; float s = 0.f;
#pragma unroll
        for (int j = 0; j < 4; ++j) { v[j] = *(const f32x4*)(xr + 4 * lane + 256 * j); s += (v[j][0] * v[j][0] + v[j][1] * v[j][1]) + (v[j][2] * v[j][2] + v[j][3] * v[j][3]); }
        const float rstd = rsqrtf(wave_sum(s) * (1.f / D) + EPS);
#pragma unroll
        for (int j = 0; j < 4; ++j) { const int c0 = 4 * lane + 256 * j; const f32x4 g = *(const f32x4*)(a.in[I_N1G] + c0), sh = *(const f32x4*)(md + c0), sc = *(const f32x4*)(md + 1024 + c0);
            const f32x4 o = (v[j] * rstd * g) * (sc + 1.f) + sh; u32x2 w; w.x = pk2(o[0], o[1]); w.y = pk2(o[2], o[3]); *(u32x2*)(XN + (size_t)m * D + c0) = w; }
    }
    for (int c = bid; c < 512; c += G) {
        LAS float* red = (LAS float*)lds;
        float p = 0.f; if (tid < 256) p = FPART[tid * 1024 + c]; else p = FPART[(tid - 256) * 1024 + 512 + c];
        p = wave_sum(p); if (lane == 0) red[wave] = p;
        __syncthreads();
        const float nf = 1.f / ((red[0] + red[1]) + (red[2] + red[3])), nb = 1.f / ((red[4] + red[5]) + (red[6] + red[7]));
        for (int i = tid; i < 8192; i += 512) { const int x = 4096 - i; float v = 0.f;
            if (x >= 0 && x < 4096) v += FILT[(size_t)c * 4096 + x] * nf;
            if (x <= 0 && x > -4096) v += FILT[(size_t)(512 + c) * 4096 - x] * nb;
            TR[(size_t)c * 8192 + i] = (bf16_t)f2bf(v); }
        __syncthreads();
    }
    }
    }
    GRID_BAR();
    STAMP(1);

    for (int rp_ = 0; rp_ <= ((REPMASK >> 2) & 1); ++rp_) { if (rp_) GRID_BAR();
    { DECL_PTRS
    {
        pg8::Gemm g{XN, WT_IN, 1024, 1024, 1024}; pg8::InProjOrder S; S.init(G, bid);
        pg8::EpiInA E{Qb, Kb, KT, VT, SG, HU, BINP, ROPE};
        pg8::gemm_phase(lds, g, S, E);
    }
    }
    }
    GRID_BAR();
    STAMP(2);

    for (int rp_ = 0; rp_ <= ((REPMASK >> 3) & 1); ++rp_) { if (rp_) GRID_BAR();
    { DECL_PTRS
    for (int it = bid; it < 4096; it += G) {
        const int b = it >> 9, tt = (it >> 3) & 63, cc = it & 7;
        LAS bf16_t* zt = (LAS bf16_t*)lds;
        { const int tl = tid >> 3, c0 = cc * 64 + (tid & 7) * 8, t = tt * 64 + tl, row = b * SEQ + t;
          float x1[8], vv[8]; short_conv8(HU, row, t, 512 + c0, a.in[I_HCW], a.in[I_HCB], x1); short_conv8(HU, row, t, 1024 + c0, a.in[I_HCW], a.in[I_HCB], vv);
#pragma unroll
          for (int e = 0; e < 8; ++e) zt[((tid & 7) * 8 + e) * 72 + tl] = (bf16_t)f2bf(x1[e] * vv[e]); }
        __syncthreads();
        { const int cl = tid >> 3, seg = tid & 7; const u32x4 v = *(const LAS u32x4*)(zt + cl * 72 + seg * 8);
          *(u32x4*)(ZT + ((size_t)(cc * 64 + cl) * 8 + b) * SEQ + tt * 64 + seg * 8) = v; }
        __syncthreads();
    }
    {
        LAS float* wtab = (LAS float*)(lds + gt::STAGE_BYTES);
        for (int u = bid; u < 32 * 66; u += G) {
            const int bh = u / 66, rem = u % 66, dir = rem / 33, s = rem % 33, h = bh & 3;
            const float lg = lg2_decay(a.in[I_DECAY][dir * 4 + h]);
            const int tok0 = dir == 0 ? (s == 0 ? 4096 : s == 1 ? 4224 : (s - 2) * 128) : (s == 0 ? 4224 : s == 1 ? 4096 : (33 - s) * 128);
            if (tid < 128) wtab[tid] = exp2f((float)(dir == 0 ? 127 - tid : tid) * lg);
            __syncthreads();
            struct LdKTw { const bf16_t* base; const LAS float* w;
                __device__ __forceinline__ u32x4 operator()(int row, int k) const { const u32x4 v = *(const u32x4*)(base + (size_t)row * TOKP + k); const f32x4 w0 = *(const LAS f32x4*)(w + k), w1 = *(const LAS f32x4*)(w + k + 4);
                    return gt::scale8(v, w0[0], w0[1], w0[2], w0[3], w1[0], w1[1], w1[2], w1[3]); } };
            const LdKTw bl{KT + (size_t)bh * 128 * TOKP + tok0, wtab};
            int tl = tid; asm volatile("" : "+v"(tl));
            const int wr = tl >> 8, wc = (tl >> 6) & 3, fr = tl & 15, fq = (tl >> 4) & 3;
            for (int mt = 0; mt < 2; ++mt) {
                f32x4 acc[4][2];
#pragma unroll
                for (int m = 0; m < 4; ++m)
#pragma unroll
                    for (int n = 0; n < 2; ++n) acc[m][n] = (f32x4){0.f, 0.f, 0.f, 0.f};
                const gt::LdRows al{VT + ((size_t)bh * 256 + mt * 128) * TOKP + tok0, TOKP};
                gt::gemm_tile<2>(acc, al, bl, 2, lds, tl);
                bf16_t* o = KV + (((size_t)(bh * 2 + dir) * 33 + s) * 256 + mt * 128) * 128;
#pragma unroll
                for (int m = 0; m < 4; ++m)
#pragma unroll
                    for (int n = 0; n < 2; ++n)
#pragma unroll
                        for (int j = 0; j < 4; ++j) o[(size_t)(wr * 64 + m * 16 + 4 * fq + j) * 128 + wc * 32 + n * 16 + fr] = (bf16_t)f2bf(acc[m][n][j]);
            }
            __syncthreads();
        }
    }
    }
    }
    GRID_BAR();
    STAMP(3);

    for (int rp_ = 0; rp_ <= ((REPMASK >> 4) & 1); ++rp_) { if (rp_) GRID_BAR();
    { DECL_PTRS
    for (int idx = bid * 512 + tid; idx < 64 * 4096; idx += G * 512) {
        const int chain = idx >> 12, eg = idx & 4095, dir = chain & 1, h = (chain >> 1) & 3;
        const float g128 = exp2f(128.f * lg2_decay(a.in[I_DECAY][dir * 4 + h]));
        float run[8];
#pragma unroll
        for (int e = 0; e < 8; ++e) run[e] = 0.f;
        bf16_t* p = KV + (size_t)chain * 33 * 32768 + eg * 8;
        for (int s = 0; s < 33; ++s) {
            const u32x4 v = *(const u32x4*)(p + (size_t)s * 32768);
            run[0] = run[0] * g128 + bflo(v.x); run[1] = run[1] * g128 + bfhi(v.x); run[2] = run[2] * g128 + bflo(v.y); run[3] = run[3] * g128 + bfhi(v.y);
            run[4] = run[4] * g128 + bflo(v.z); run[5] = run[5] * g128 + bfhi(v.z); run[6] = run[6] * g128 + bflo(v.w); run[7] = run[7] * g128 + bfhi(v.w);
            u32x4 o; o.x = pk2(run[0], run[1]); o.y = pk2(run[2], run[3]); o.z = pk2(run[4], run[5]); o.w = pk2(run[6], run[7]);
            *(u32x4*)(p + (size_t)s * 32768) = o;
        }
    }
    {
        typedef float f32x16 __attribute__((ext_vector_type(16)));
        constexpr int CPB = 16448, ZOFF = 4 * CPB, ROWB = 10256, PADB = 992;
        for (int i = tid; i < (8 * ROWB) / 16; i += 512) *(LAS u32x4*)(lds + ZOFF + i * 16) = (u32x4){0u, 0u, 0u, 0u};
        __syncthreads();
        for (int c = bid; c < 512; c += G) {
            int tl = tid; asm volatile("" : "+v"(tl));
            const int w = tl >> 6, l = tl & 63, col = l & 31, hh = l >> 5, Rl = col >> 3, nn = col & 7;
            bf16_t* zc = ZT + (size_t)c * 8 * SEQ; const bf16_t* trg = TR + (size_t)c * 8192;
#pragma unroll
            for (int i = 0; i < 8; ++i) { const int q = tl + 512 * i, n = q >> 9, off = (q & 511) * 8; *(LAS u32x4*)(lds + ZOFF + n * ROWB + PADB + off * 2) = *(const u32x4*)(zc + (size_t)n * SEQ + off); }
#pragma unroll
            for (int i = 0; i < 2; ++i) { const int u = tl + 512 * i; const u32x4 v0 = *(const u32x4*)(trg + 8 * u); u32x4 v1 = (u32x4){0u, 0u, 0u, 0u}; if (u < 1023) v1 = *(const u32x4*)(trg + 8 * u + 8);
                const unsigned W0 = v0.x, W1 = v0.y, W2 = v0.z, W3 = v0.w, W4 = v1.x, W5 = v1.y;
                *(LAS u32x4*)(lds + 0 * CPB + 16 * u) = v0;
                *(LAS u32x4*)(lds + 1 * CPB + 16 * u) = (u32x4){(W0 >> 16) | (W1 << 16), (W1 >> 16) | (W2 << 16), (W2 >> 16) | (W3 << 16), (W3 >> 16) | (W4 << 16)};
                *(LAS u32x4*)(lds + 2 * CPB + 16 * u) = (u32x4){W1, W2, W3, W4};
                *(LAS u32x4*)(lds + 3 * CPB + 16 * u) = (u32x4){(W1 >> 16) | (W2 << 16), (W2 >> 16) | (W3 << 16), (W3 >> 16) | (W4 << 16), (W4 >> 16) | (W5 << 16)}; }
            __syncthreads();
            const int dlo = 32 * w - 255;
            const int e0 = 4096 - 16 * dlo - col + 8 * hh;
            int aaddr = (e0 & 3) * CPB + 2 * (e0 & ~3);
            int baddr = ZOFF + nn * ROWB + PADB + 2 * (512 * w + 64 * Rl + 8 * hh - 16 * dlo);
            f32x16 acc[4];
#pragma unroll
            for (int q = 0; q < 4; ++q)
#pragma unroll
                for (int i = 0; i < 16; ++i) acc[q][i] = 0.f;
            u32x2 alo = *(const LAS u32x2*)(lds + aaddr), ahi = *(const LAS u32x2*)(lds + aaddr + 8);
            u32x4 bq[4];
#pragma unroll
            for (int q = 0; q < 4; ++q) bq[q] = *(const LAS u32x4*)(lds + baddr + 512 * (q >> 1) + 64 * (q & 1));
            for (int it = 0; it < 285; ++it) {
                aaddr -= 32; baddr -= 32;
                const u32x2 nlo = *(const LAS u32x2*)(lds + aaddr), nhi = *(const LAS u32x2*)(lds + aaddr + 8);
                u32x4 nb[4];
#pragma unroll
                for (int q = 0; q < 4; ++q) nb[q] = *(const LAS u32x4*)(lds + baddr + 512 * (q >> 1) + 64 * (q & 1));
                const bf16x8 af = __builtin_bit_cast(bf16x8, (u32x4){alo.x, alo.y, ahi.x, ahi.y});
#pragma unroll
                for (int q = 0; q < 4; ++q) acc[q] = __builtin_amdgcn_mfma_f32_32x32x16_bf16(af, __builtin_bit_cast(bf16x8, bq[q]), acc[q], 0, 0, 0);
                alo = nlo; ahi = nhi;
#pragma unroll
                for (int q = 0; q < 4; ++q) bq[q] = nb[q];
            }
            {
                const bf16x8 af = __builtin_bit_cast(bf16x8, (u32x4){alo.x, alo.y, ahi.x, ahi.y});
#pragma unroll
                for (int q = 0; q < 4; ++q) acc[q] = __builtin_amdgcn_mfma_f32_32x32x16_bf16(af, __builtin_bit_cast(bf16x8, bq[q]), acc[q], 0, 0, 0);
            }
            const float skip = a.in[I_HSKIP][c];
#pragma unroll
            for (int q = 0; q < 4; ++q)
#pragma unroll
                for (int gq = 0; gq < 4; ++gq) {
                    const int t0 = 512 * w + 256 * (q >> 1) + 32 * (q & 1) + 64 * Rl + 8 * gq + 4 * hh;
                    const u32x2 zz = *(const LAS u32x2*)(lds + ZOFF + nn * ROWB + PADB + 2 * t0);
                    u32x2 o; o.x = pk2(acc[q][4 * gq] + skip * bflo(zz.x), acc[q][4 * gq + 1] + skip * bfhi(zz.x)); o.y = pk2(acc[q][4 * gq + 2] + skip * bflo(zz.y), acc[q][4 * gq + 3] + skip * bfhi(zz.y));
                    *(u32x2*)(zc + (size_t)nn * SEQ + t0) = o;
                }
            __syncthreads();
        }
    }
    }
    }
    GRID_BAR();
    STAMP(4);

    for (int rp_ = 0; rp_ <= ((REPMASK >> 5) & 1); ++rp_) { if (rp_) GRID_BAR();
    { DECL_PTRS
    {
        LAS unsigned char* Pl = lds + gt::STAGE_BYTES;
        LAS float* sfb = (LAS float*)(lds + gt::STAGE_BYTES + 128 * 272);
        LAS float* rsum = sfb + 256;
        for (int u = bid; u < 1024; u += G) {
            int tl = tid; asm volatile("" : "+v"(tl));
            const int wr = tl >> 8, wc = (tl >> 6) & 3, fr = tl & 15, fq = (tl >> 4) & 3;
            const int bh = u >> 5, c = u & 31, b = bh >> 2, h = bh & 3, row0 = b * SEQ + c * 128;
            const float lgf = lg2_decay(a.in[I_DECAY][h]), lgb = lg2_decay(a.in[I_DECAY][4 + h]);
            if (tl < 128) sfb[tl] = exp2f((float)(tl + 1) * lgf); else if (tl < 256) sfb[tl] = exp2f((float)(128 - (tl - 128)) * lgb);
            {
                f32x4 sacc[4][2];
#pragma unroll
                for (int m = 0; m < 4; ++m)
#pragma unroll
                    for (int n = 0; n < 2; ++n) sacc[m][n] = (f32x4){0.f, 0.f, 0.f, 0.f};
                gt::gemm_tile<2>(sacc, gt::LdRows{Qb + (size_t)row0 * 512 + h * 128, 512}, gt::LdRows{Kb + (size_t)row0 * 512 + h * 128, 512}, 2, lds, tl);
#pragma unroll
                for (int m = 0; m < 4; ++m)
#pragma unroll
                    for (int n = 0; n < 2; ++n)
#pragma unroll
                        for (int j = 0; j < 4; ++j) { const int i = wr * 64 + m * 16 + 4 * fq + j, jj = wc * 32 + n * 16 + fr, df = i - jj;
                            const float dcy = df >= 0 ? exp2f((float)df * lgf) : exp2f((float)(-df) * lgb);
                            *(LAS bf16_t*)(Pl + i * 272 + jj * 2) = (bf16_t)f2bf(sacc[m][n][j] * dcy); }
                asm volatile("" ::: "memory");
            }
            __syncthreads();
            struct LdA2 { LAS unsigned char* P; const bf16_t* q; const LAS float* sc;
                __device__ __forceinline__ u32x4 operator()(int row, int k) const {
                    if (k < 128) return *(const LAS u32x4*)(P + row * 272 + k * 2);
                    const bool fw = k < 256; const u32x4 v = *(const u32x4*)(q + (size_t)row * 512 + (fw ? k - 128 : k - 256)); const float s = sc[fw ? row : 128 + row];
                    return gt::scale8(v, s, s, s, s, s, s, s, s); } };
            struct LdB2 { const bf16_t* vt; const bf16_t* sf; const bf16_t* sb;
                __device__ __forceinline__ u32x4 operator()(int dv, int k) const {
                    if (k < 128) return *(const u32x4*)(vt + (size_t)dv * TOKP + k);
                    if (k < 256) return *(const u32x4*)(sf + (size_t)dv * 128 + (k - 128));
                    return *(const u32x4*)(sb + (size_t)dv * 128 + (k - 256)); } };
            f32x4 acc[4][4];
#pragma unroll
            for (int m = 0; m < 4; ++m)
#pragma unroll
                for (int n = 0; n < 4; ++n) acc[m][n] = (f32x4){0.f, 0.f, 0.f, 0.f};
            const LdA2 al{Pl, Qb + (size_t)row0 * 512 + h * 128, sfb};
            const LdB2 bl{VT + (size_t)bh * 256 * TOKP + c * 128, KV + ((size_t)(bh * 2 + 0) * 33 + (c + 1)) * 32768, KV + ((size_t)(bh * 2 + 1) * 33 + (32 - c)) * 32768};
            gt::gemm_tile<4>(acc, al, bl, 6, lds, tl);
#pragma unroll
            for (int m = 0; m < 4; ++m)
#pragma unroll
                for (int j = 0; j < 4; ++j) { float s = 0.f;
#pragma unroll
                    for (int n = 0; n < 4; ++n) s += acc[m][n][j] * acc[m][n][j];
                    s += __shfl_xor(s, 1); s += __shfl_xor(s, 2); s += __shfl_xor(s, 4); s += __shfl_xor(s, 8);
                    if (fr == 0) rsum[(wr * 64 + m * 16 + 4 * fq + j) * 4 + wc] = s; }
            __syncthreads();
#pragma unroll
            for (int m = 0; m < 4; ++m)
#pragma unroll
                for (int j = 0; j < 4; ++j) { const int i = wr * 64 + m * 16 + 4 * fq + j; const f32x4 rs = *(const LAS f32x4*)(rsum + i * 4);
                    const float rstd = rsqrtf(((rs[0] + rs[1]) + (rs[2] + rs[3])) * (1.f / 256.f) + EPS);
                    bf16_t* gp = SG + (size_t)(row0 + i) * 1024 + h * 256 + wc * 64 + fr;
#pragma unroll
                    for (int n = 0; n < 4; ++n) gp[n * 16] = (bf16_t)f2bf(acc[m][n][j] * rstd * bf2f(gp[n * 16]));
                    asm volatile("" ::: "memory"); }
            __syncthreads();
        }
    }
    for (int it = bid; it < 4096; it += G) {
        const int b = it >> 9, tt = (it >> 3) & 63, cc = it & 7;
        LAS bf16_t* yt = (LAS bf16_t*)lds;
        { const int cl = tid >> 3, seg = tid & 7; *(LAS u32x4*)(yt + cl * 72 + seg * 8) = *(const u32x4*)(ZT + ((size_t)(cc * 64 + cl) * 8 + b) * SEQ + tt * 64 + seg * 8); }
        __syncthreads();
        { const int tl = tid >> 3, c0 = cc * 64 + (tid & 7) * 8, t = tt * 64 + tl, row = b * SEQ + t;
          float x0[8]; short_conv8(HU, row, t, c0, a.in[I_HCW], a.in[I_HCB], x0);
          float o[8];
#pragma unroll
          for (int e = 0; e < 8; ++e) o[e] = x0[e] * bf2f(yt[((tid & 7) * 8 + e) * 72 + tl]);
          u32x4 w; w.x = pk2(o[0], o[1]); w.y = pk2(o[2], o[3]); w.z = pk2(o[4], o[5]); w.w = pk2(o[6], o[7]);
          *(u32x4*)(HU + (size_t)row * 1536 + 512 + c0) = w; }
        __syncthreads();
    }
    }
    }
    GRID_BAR();
    STAMP(5);

    for (int rp_ = 0; rp_ <= ((REPMASK >> 6) & 1); ++rp_) { if (rp_) GRID_BAR();
    { DECL_PTRS
    {
        pg8::Gemm g{XN, WT_IN + (size_t)NINA * 1024, 1024, 1024, 1024}; pg8::StaticOrder S; S.init(T, 2048, G, bid);
        pg8::EpiGate E{SGR, SGH, a.in[I_BIN] + NINA};
        pg8::gemm_phase(lds, g, S, E);
    }
    {
        LAS float* scr = (LAS float*)(lds + wave * 17664);
        constexpr int PER = 16 * 8;
        for (int it = gw; it < NE * 3 * PER; it += NGW) {
            const int e = it / (3 * PER), r3 = it % (3 * PER), which = r3 / PER, r = r3 % PER;
            if (which == 0) transpose_item(a.in[I_EW1] + (size_t)e * 1024 * 512, 512, 64 * (r / 8), 64 * (r % 8), WE13 + (size_t)e * 1024 * 1024, 1024, RmE13{0}, scr, lane);
            else if (which == 1) transpose_item(a.in[I_EW3] + (size_t)e * 1024 * 512, 512, 64 * (r / 8), 64 * (r % 8), WE13 + (size_t)e * 1024 * 1024, 1024, RmE13{128}, scr, lane);
            else transpose_item(a.in[I_EW2] + (size_t)e * 512 * 1024, 1024, 64 * (r / 16), 64 * (r % 16), WE2 + (size_t)e * 1024 * 512, 512, RmId{}, scr, lane);
        }
    }
    }
    }
    GRID_BAR();
    STAMP(6);

    for (int rp_ = 0; rp_ <= ((REPMASK >> 7) & 1); ++rp_) { if (rp_) GRID_BAR();
    { DECL_PTRS
    {
        pg8::Gemm g{HU + 512, WT_HYO, 512, 1536, 512}; pg8::StaticOrder S; S.init(T, 1024, G, bid);
        pg8::EpiMerge<0> E{SGH, nullptr};
        pg8::gemm_phase(lds, g, S, E);
    }
    }
    }
    GRID_BAR();
    STAMP(7);
    for (int rp_ = 0; rp_ <= ((REPMASK >> 8) & 1); ++rp_) { if (rp_) GRID_BAR();
    { DECL_PTRS
    {
        pg8::Gemm g{SG, WT_RETO, 1024, 1024, 1024}; pg8::StaticOrder S; S.init(T, 1024, G, bid);
        pg8::EpiMerge<1> E{SGR, SGH};
        pg8::gemm_phase(lds, g, S, E);
    }
    }
    }
    GRID_BAR();
    STAMP(8);
    for (int rp_ = 0; rp_ <= ((REPMASK >> 9) & 1); ++rp_) { if (rp_) GRID_BAR();
    { DECL_PTRS
    {
        pg8::Gemm g{SGR, WT_OUT, 1024, 1024, 1024}; pg8::StaticOrder S; S.init(T, 1024, G, bid);
        pg8::EpiX1 E{a.in[I_X], MOD, X1};
        pg8::gemm_phase(lds, g, S, E);
    }
    }
    }
    GRID_BAR();
    STAMP(9);

    for (int rp_ = 0; rp_ <= ((REPMASK >> 10) & 1); ++rp_) { if (rp_) GRID_BAR();
    { DECL_PTRS
    {
        LAS float* Wl = (LAS float*)lds;
#pragma unroll
        for (int i = 0; i < 18; ++i) { const int q = tid + 512 * i, k = q / 9, p4 = q % 9;
            const f32x4 v = p4 == 0 ? *(const f32x4*)(a.in[I_RGW] + k * 4) : *(const f32x4*)(a.in[I_REW] + k * 32 + (p4 - 1) * 4);
            *(LAS f32x4*)(Wl + k * 36 + p4 * 4) = v; }
        __syncthreads();
        bf16_t* H2 = SG;
        LAS float* Sw = (LAS float*)(lds + 147456 + wave * 1152);
        LAS int* lcnt = (LAS int*)(lds + 147456 + 9216);
        if (tid < NE) lcnt[tid] = 0;
        __syncthreads();
        for (int rb = gw; rb < T / 16; rb += NGW) {
            int ll = lane; asm volatile("" : "+v"(ll));
            const int r = ll & 15, kq = ll >> 4, row = rb * 16 + r, b = (rb * 16) >> 12;
            const float* md = MOD + (size_t)b * 6144; const float* xr = X1 + (size_t)row * D + 4 * kq;
            float s = 0.f;
#pragma unroll 16
            for (int i = 0; i < 64; ++i) { const f32x4 xv = *(const f32x4*)(xr + 16 * i); s += (xv[0] * xv[0] + xv[1] * xv[1]) + (xv[2] * xv[2] + xv[3] * xv[3]); }
            s += __shfl_xor(s, 16); s += __shfl_xor(s, 32);
            const float rstd = rsqrtf(s * (1.f / D) + EPS);
            f32x4 lacc[3];
#pragma unroll
            for (int ct = 0; ct < 3; ++ct) lacc[ct] = (f32x4){0.f, 0.f, 0.f, 0.f};
            const int c0 = ll & 15, c2 = (32 + c0) < 36 ? 32 + c0 : 35;
#pragma unroll 4
            for (int i = 0; i < 64; ++i) {
                const int k0 = 16 * i + 4 * kq;
                const f32x4 xv = *(const f32x4*)(xr + 16 * i), gv = *(const f32x4*)(a.in[I_N2G] + k0), sc = *(const f32x4*)(md + 4096 + k0), sh = *(const f32x4*)(md + 3072 + k0);
                const f32x4 hv = (xv * rstd * gv) * (sc + 1.f) + sh;
                u32x2 hw; hw.x = pk2(hv[0], hv[1]); hw.y = pk2(hv[2], hv[3]); *(u32x2*)(H2 + (size_t)row * D + k0) = hw;
#pragma unroll
                for (int e = 0; e < 4; ++e) { const LAS float* wr_ = Wl + (k0 + e) * 36;
                    lacc[0] = __builtin_amdgcn_mfma_f32_16x16x4f32(hv[e], wr_[c0], lacc[0], 0, 0, 0);
                    lacc[1] = __builtin_amdgcn_mfma_f32_16x16x4f32(hv[e], wr_[16 + c0], lacc[1], 0, 0, 0);
                    lacc[2] = __builtin_amdgcn_mfma_f32_16x16x4f32(hv[e], wr_[c2], lacc[2], 0, 0, 0); }
            }
#pragma unroll
            for (int hf = 0; hf < 2; ++hf) {
                if ((kq >> 1) == hf) {
#pragma unroll
                    for (int j = 0; j < 4; ++j) { LAS float* sp = Sw + (4 * (kq & 1) + j) * 36 + c0; sp[0] = lacc[0][j]; sp[16] = lacc[1][j]; if (c0 < 4) sp[32] = lacc[2][j]; }
                }
                asm volatile("s_waitcnt lgkmcnt(0)" ::: "memory");
                if (ll < 8) {
                    const int rrow = rb * 16 + 8 * hf + ll;
                    float lg[36];
#pragma unroll
                    for (int q = 0; q < 9; ++q) { const f32x4 v = *(const LAS f32x4*)(Sw + ll * 36 + 4 * q); lg[4 * q] = v[0]; lg[4 * q + 1] = v[1]; lg[4 * q + 2] = v[2]; lg[4 * q + 3] = v[3]; }
                    float gl[4];
#pragma unroll
                    for (int j = 0; j < 4; ++j) gl[j] = lg[j] + a.in[I_RGB][j];
                    int gs = 0; float gm = gl[0];
#pragma unroll
                    for (int j = 1; j < 4; ++j) if (gl[j] > gm) { gm = gl[j]; gs = j; }
                    float den = 0.f;
#pragma unroll
                    for (int j = 0; j < 4; ++j) den += expf(gl[j] - gm);
                    const float pstar = 1.f / den;
                    float el[8];
#pragma unroll
                    for (int e = 0; e < 8; ++e) { const float v0 = lg[4 + e], v1 = lg[12 + e], v2 = lg[20 + e], v3 = lg[28 + e]; el[e] = (gs == 0 ? v0 : gs == 1 ? v1 : gs == 2 ? v2 : v3) + a.in[I_REB][gs * 8 + e]; }
                    int e0 = 0; float m0 = el[0];
#pragma unroll
                    for (int e = 1; e < 8; ++e) if (el[e] > m0) { m0 = el[e]; e0 = e; }
                    int e1 = -1; float m1 = -3.0e38f;
#pragma unroll
                    for (int e = 0; e < 8; ++e) if (e != e0 && el[e] > m1) { m1 = el[e]; e1 = e; }
                    const float ex = expf(m1 - m0); const float w0 = pstar / (1.f + ex), w1 = pstar * ex / (1.f + ex);
                    const int E0 = gs * 8 + e0, E1 = gs * 8 + e1;
                    const int s0 = __hip_atomic_fetch_add(lcnt + E0, 1, __ATOMIC_RELAXED, __HIP_MEMORY_SCOPE_WORKGROUP), s1 = __hip_atomic_fetch_add(lcnt + E1, 1, __ATOMIC_RELAXED, __HIP_MEMORY_SCOPE_WORKGROUP);
                    int4 ti; ti.x = (E0 << 16) | s0; ti.y = (E1 << 16) | s1; ti.z = __float_as_int(w0); ti.w = __float_as_int(w1);
                    *(int4*)(TOKINFO + (size_t)rrow * 4) = ti;
                }
                asm volatile("s_waitcnt lgkmcnt(0)" ::: "memory");
            }
        }
        __syncthreads();
        if (tid < NE) LISTS[bid * NE + tid] = lcnt[tid];
    }
    }
    }
    GRID_BAR();
    STAMP(10);

    LAS int* tbase = (LAS int*)(lds + MISC_OFF);
    LAS int* texp = tbase + 64;
    int ntiles = 0;
    for (int rp_ = 0; rp_ <= ((REPMASK >> 11) & 1); ++rp_) { if (rp_) GRID_BAR();
    { DECL_PTRS
    {
        LAS int* ptot = texp + 320;
        LAS int* pbas = ptot + 512; LAS int* total = pbas + 512; LAS int* mybase = total + 32;
        { const int e = tid & 31, part = tid >> 5, per = (G + 15) >> 4; int s = 0, sb = 0;
          for (int b = part * per; b < (part + 1) * per && b < G; ++b) { const int v = LISTS[b * NE + e]; s += v; if (b < bid) sb += v; }
          ptot[part * 32 + e] = s; pbas[part * 32 + e] = sb; }
        __syncthreads();
        if (tid < NE) { int s = 0, sb = 0; for (int q = 0; q < 16; ++q) { s += ptot[q * 32 + tid]; sb += pbas[q * 32 + tid]; } total[tid] = s; mybase[tid] = sb; }
        __syncthreads();
        if (tid == 0) { int acc = 0; for (int e = 0; e < NE; ++e) { tbase[e] = acc; const int nt = (total[e] + 255) >> 8; for (int q = 0; q < nt; ++q) texp[acc + q] = e; acc += nt; } tbase[NE] = acc; }
        __syncthreads();
        ntiles = tbase[NE];
        const bf16_t* H2 = SG;
        for (int rb = gw; rb < T / 16; rb += NGW) {
#pragma unroll 4
            for (int i = 0; i < 16; ++i) { const int row = rb * 16 + i;
                const int4 ti = *(const int4*)(TOKINFO + (size_t)row * 4);
                const int e0 = ti.x >> 16, e1 = ti.y >> 16;
                const int r0 = tbase[e0] * 256 + mybase[e0] + (ti.x & 0xffff), r1 = tbase[e1] * 256 + mybase[e1] + (ti.y & 0xffff);
                const u32x4 v0 = *(const u32x4*)(H2 + (size_t)row * D + lane * 8), v1 = *(const u32x4*)(H2 + (size_t)row * D + 512 + lane * 8);
                *(u32x4*)(XB + (size_t)r0 * D + lane * 8) = v0; *(u32x4*)(XB + (size_t)r0 * D + 512 + lane * 8) = v1;
                *(u32x4*)(XB + (size_t)r1 * D + lane * 8) = v0; *(u32x4*)(XB + (size_t)r1 * D + 512 + lane * 8) = v1;
                if (lane == 0) { int4 to = ti; to.x = r0; to.y = r1; *(int4*)(TOKINFO + (size_t)row * 4) = to; } }
        }
        if (bid < NE) { const int rlo = tbase[bid] * 256 + total[bid], rhi = tbase[bid + 1] * 256;
            for (int r = rlo + wave; r < rhi; r += 8) { *(u32x4*)(XB + (size_t)r * D + lane * 8) = (u32x4){0u, 0u, 0u, 0u}; *(u32x4*)(XB + (size_t)r * D + 512 + lane * 8) = (u32x4){0u, 0u, 0u, 0u}; } }
    }
    }
    }
    GRID_BAR();
    STAMP(11);

    for (int rp_ = 0; rp_ <= ((REPMASK >> 12) & 1); ++rp_) { if (rp_) GRID_BAR();
    { DECL_PTRS
    {
        pg8::Gemm g{XB, WE13, 1024, 1024, 1024}; pg8::MoeOrder S{ntiles * 4, G, bid, texp};
        pg8::EpiMoe1 E{HM};
        pg8::gemm_phase(lds, g, S, E);
    }
    }
    }
    GRID_BAR();
    STAMP(12);
    for (int rp_ = 0; rp_ <= ((REPMASK >> 13) & 1); ++rp_) { if (rp_) GRID_BAR();
    { DECL_PTRS
    {
        pg8::Gemm g{HM, WE2, 512, 512, 512}; pg8::MoeOrder S{ntiles * 4, G, bid, texp};
        pg8::EpiBf E{XB, 1024};
        pg8::gemm_phase(lds, g, S, E);
    }
    }
    }
    GRID_BAR();
    STAMP(13);

    for (int rp_ = 0; rp_ <= ((REPMASK >> 14) & 1); ++rp_) { if (rp_) GRID_BAR();
    { DECL_PTRS
    {
        const bf16_t* YB = XB;
        for (int row = gw; row < T; row += NGW) {
            const int b = row >> 12; const float* gt2 = MOD + (size_t)b * 6144 + 5120;
            const int4 ti = *(const int4*)(TOKINFO + (size_t)row * 4);
            const size_t r0 = (size_t)ti.x, r1 = (size_t)ti.y;
            const float w0 = __int_as_float(ti.z), w1 = __int_as_float(ti.w);
            f32x4 v[4]; float s = 0.f;
#pragma unroll
            for (int j = 0; j < 4; ++j) { const int c0 = 4 * lane + 256 * j;
                const f32x4 xv = *(const f32x4*)(X1 + (size_t)row * D + c0), gv = *(const f32x4*)(gt2 + c0);
                const u32x2 y0 = *(const u32x2*)(YB + r0 * D + c0), y1 = *(const u32x2*)(YB + r1 * D + c0);
                f32x4 mo; mo[0] = w0 * bflo(y0.x) + w1 * bflo(y1.x); mo[1] = w0 * bfhi(y0.x) + w1 * bfhi(y1.x); mo[2] = w0 * bflo(y0.y) + w1 * bflo(y1.y); mo[3] = w0 * bfhi(y0.y) + w1 * bfhi(y1.y);
                v[j] = xv + gv * mo; s += (v[j][0] * v[j][0] + v[j][1] * v[j][1]) + (v[j][2] * v[j][2] + v[j][3] * v[j][3]); }
            const float rstd = rsqrtf(wave_sum(s) * (1.f / D) + EPS);
#pragma unroll
            for (int j = 0; j < 4; ++j) { const int c0 = 4 * lane + 256 * j; const f32x4 fg = *(const f32x4*)(a.in[I_FNG] + c0); *(f32x4*)(X1 + (size_t)row * D + c0) = v[j] * rstd * fg; }
        }
    }
    }
    }
    STAMP(14);
    if (PROBE_PHASE >= 0 && blockIdx.x == 0 && threadIdx.x == 0) { const unsigned long long t0_ = __builtin_amdgcn_s_memrealtime(); while (__builtin_amdgcn_s_memrealtime() - t0_ < spin_) __builtin_amdgcn_s_sleep(8); }
}

extern "C" void kernel_launch(void* const* d_in, const int* in_sizes, int n_in, void* d_out, int out_size, void* d_ws, size_t ws_size, hipStream_t stream) {
    static int grid = 0;
    if (grid == 0) {
        if (n_in != 31 || out_size != T * D || ws_size < WS_END) { fprintf(stderr, "kernel_launch: unexpected shapes: n_in %d out %d ws %zu (need %zu)\n", n_in, out_size, ws_size, (size_t)WS_END); grid = -1; return; }
        int dev = 0, cus = 0, per_cu = 0;
        if (hipGetDevice(&dev) != hipSuccess || hipDeviceGetAttribute(&cus, hipDeviceAttributeMultiprocessorCount, dev) != hipSuccess) { grid = -1; return; }
        if (hipFuncSetAttribute((const void*)fwd_kernel, hipFuncAttributeMaxDynamicSharedMemorySize, LDS_BYTES) != hipSuccess) { fprintf(stderr, "kernel_launch: hipFuncSetAttribute failed\n"); grid = -1; return; }
        if (hipOccupancyMaxActiveBlocksPerMultiprocessor(&per_cu, (const void*)fwd_kernel, 512, LDS_BYTES) != hipSuccess || per_cu < 1) { fprintf(stderr, "kernel_launch: occupancy query says %d blocks per CU\n", per_cu); grid = -1; return; }
        grid = cus;
        fprintf(stderr, "kernel_launch: cus %d per_cu %d grid %d ws %zu\n", cus, per_cu, grid, ws_size);
    }
    if (grid < 0) return;
    if (hipMemsetAsync((char*)d_ws + WS_CTL, 0, CTL_BYTES, stream) != hipSuccess) return;
    Args a{};
    for (int i = 0; i < 31; ++i) a.in[i] = (const float*)d_in[i];
    a.out = (float*)d_out; a.ws = (unsigned char*)d_ws;
    void* args[] = {&a};
    const hipError_t e = hipLaunchCooperativeKernel((const void*)fwd_kernel, dim3(grid), dim3(512), args, LDS_BYTES, stream);
    if (e != hipSuccess) fprintf(stderr, "kernel_launch: cooperative launch failed: %s (grid %d)\n", hipGetErrorString(e), grid);
}
```

```cpp
#ifndef PROBE_PHASE
#define PROBE_PHASE -1
#endif
#ifndef REPMASK
#define REPMASK 0
#endif
#include <hip/hip_runtime.h>
#include <hip/hip_cooperative_groups.h>
#include <cstdio>
#include <cstdint>
namespace cg = cooperative_groups;

#define LAS __attribute__((address_space(3)))
typedef unsigned short bf16_t;
typedef short bf16x8 __attribute__((ext_vector_type(8)));
typedef float f32x4 __attribute__((ext_vector_type(4)));
typedef unsigned u32x4 __attribute__((ext_vector_type(4)));
typedef unsigned u32x2 __attribute__((ext_vector_type(2)));

constexpr int BATCH = 8, SEQ = 4096, D = 1024, T = BATCH * SEQ, CTXL = 256, TC = BATCH * CTXL, MT = T + TC;
constexpr int NH = 4, DK = 128, DV = 256, TOKP = SEQ + CTXL;
constexpr int NINA = 4608;
constexpr int NE = 32, EH = 512;
constexpr float EPS = 1e-6f;
constexpr int LDS_BYTES = 163840;
constexpr int MISC_OFF = 131072;

constexpr size_t MiB = 1u << 20;
constexpr size_t WS_CTL = 0, CTL_BYTES = 65536;
constexpr size_t WS_MOD = 65536;
constexpr size_t WS_ROPE = 327680;
constexpr size_t WS_BINP = 344064;
constexpr size_t WS_FPART = 524288;
constexpr size_t WS_TOKINFO = 2 * MiB;
constexpr size_t WS_LISTS = 3 * MiB;
constexpr size_t WS_TR = 8 * MiB;
constexpr size_t WS_WT_IN = 16 * MiB;
constexpr size_t WS_WT_RETO = 29 * MiB, WS_WT_HYO = 31 * MiB, WS_WT_OUT = 32 * MiB;
constexpr size_t WS_R1 = 34 * MiB;
constexpr size_t WS_Q = WS_R1, WS_K = WS_R1 + 32 * MiB, WS_KT = WS_R1 + 66 * MiB, WS_VT = WS_R1 + 100 * MiB;
constexpr size_t WS_FILT = WS_R1;
constexpr size_t WS_SGR = WS_R1, WS_SGH = WS_R1 + 64 * MiB;
constexpr size_t WS_XB = WS_R1;
constexpr size_t WS_SG = 202 * MiB;
constexpr size_t WS_HU = 266 * MiB;
constexpr size_t WS_KV = 362 * MiB;
constexpr size_t WS_WE13 = 362 * MiB, WS_WE2 = 426 * MiB;
constexpr size_t WS_END = 494 * MiB;
constexpr size_t DO_XN = 0, DO_ZT = 68 * MiB, DO_FILT = 100 * MiB;

__device__ __forceinline__ unsigned f2bf(float f) { unsigned u = __float_as_uint(f); return (u + 0x7fffu + ((u >> 16) & 1u)) >> 16; }
__device__ __forceinline__ unsigned pk2(float lo, float hi) { return f2bf(lo) | (f2bf(hi) << 16); }
__device__ __forceinline__ float bflo(unsigned w) { return __uint_as_float(w << 16); }
__device__ __forceinline__ float bfhi(unsigned w) { return __uint_as_float(w & 0xffff0000u); }
__device__ __forceinline__ float bf2f(bf16_t h) { return __uint_as_float((unsigned)h << 16); }
__device__ __forceinline__ float silu_f(float v) { return v / (1.f + __expf(-v)); }
__device__ __forceinline__ float sigm_f(float v) { return 1.f / (1.f + __expf(-v)); }
__device__ __forceinline__ float wave_sum(float v) {
#pragma unroll
    for (int o = 1; o < 64; o <<= 1) v += __shfl_xor(v, o);
    return v;
}
__host__ __device__ __forceinline__ int dimperm(int p) { const int wc = p >> 5, n = (p >> 4) & 1, i16 = p & 15; return 64 * (wc >> 1) + 32 * n + 16 * (wc & 1) + i16; }
__host__ __device__ __forceinline__ int inv_dimperm(int d) { const int half = d >> 6, n = (d >> 5) & 1, idx = d & 31; return 32 * (2 * half + (idx >> 4)) + 16 * n + (idx & 15); }
__host__ __device__ __forceinline__ int win_destrow(int n) { return n < 1024 ? (n & ~127) + inv_dimperm(n & 127) : n; }

namespace pg8 {
constexpr int BM = 256, BK = 64, HALF = 128, HTB = HALF * BK * 2, STAGE_BYTES = 8 * HTB, NXCD = 8, WGM = 8;
__host__ __device__ __forceinline__ int lds_byte(int r, int c) { const int st = (r >> 4) * 2 + (c >> 5), rr = r & 15, cc = c & 31, ob = rr * 64 + cc * 2; return st * 1024 + (ob ^ (((ob >> 9) & 1) << 5)); }
__host__ __device__ __forceinline__ void stage_rc(int b, int& R, int& C) { const int st = b / 1024, sb = b % 1024, swz = sb ^ (((sb >> 9) & 1) << 5); R = (st >> 1) * 16 + swz / 64; C = (st & 1) * 32 + (swz % 64) / 2; }
__host__ __device__ __forceinline__ int perm32(int rho) { const int n = rho >> 4, i = rho & 15; return 8 * (i >> 2) + 4 * n + (i & 3); }

struct Unit { int pm, pn, pc; };
struct Gemm { const bf16_t* A; const bf16_t* Bt; int K, lda, ldb; };

struct StaticOrder {
    int nM, nN, nwg, G, c;
    __device__ void init(int M, int N, int G_, int c_) { nM = M / BM; nN = N / BM; nwg = nM * nN; G = G_; c = c_; }
    __device__ bool next(int i, Unit& u) const {
        const long L = (long)i * G + c; if (L >= nwg) return false;
        int wgid = (int)L; { const int q = nwg / NXCD, r = nwg % NXCD, xcd = wgid % NXCD, off = wgid / NXCD; wgid = (xcd < r ? xcd * (q + 1) : r * (q + 1) + (xcd - r) * q) + off; }
        const int nig = WGM * nN, gid = wgid / nig, fm = gid * WGM, gsz = (nM - fm) < WGM ? (nM - fm) : WGM;
        u.pm = fm + ((wgid % nig) % gsz); u.pn = (wgid % nig) / gsz; u.pc = u.pn; return true;
    }
};
struct InProjOrder {
    StaticOrder so; int G, c;
    __device__ void init(int G_, int c_) { so.init(T, NINA, G_, c_); G = G_; c = c_; }
    __device__ bool next(int i, Unit& u) const {
        const long L = (long)i * G + c;
        if (L < so.nwg) return so.next(i, u);
        const int l = (int)(L - so.nwg); if (l >= 48) return false;
        u.pm = 128 + (l & 7); u.pn = 2 + (l >> 3); u.pc = u.pn; return true;
    }
};
struct MoeOrder {
    int ntiles, G, c; const LAS int* texp;
    __device__ bool next(int i, Unit& u) const {
        const long L = (long)i * G + c; if (L >= (long)ntiles * 4) return false;
        const int full = (ntiles >> 3) * 32, l = (int)L;
        if (l < full) { u.pm = (l >> 5) * 8 + (l & 7); u.pc = (l & 31) >> 3; } else { u.pm = (ntiles & ~7) + ((l - full) >> 2); u.pc = (l - full) & 3; }
        u.pn = texp[u.pm] * 4 + u.pc; return true;
    }
};

__device__ __forceinline__ unsigned cvt_pk_bf16(float lo, float hi) { unsigned r; asm volatile("v_cvt_pk_bf16_f32 %0, %1, %2" : "=v"(r) : "v"(lo), "v"(hi)); return r; }

typedef int v8i __attribute__((ext_vector_type(8)));
__device__ __forceinline__ unsigned pk_fp8x4(float a, float b, float c, float d) { int w = 0; w = __builtin_amdgcn_cvt_pk_fp8_f32(a, b, w, false); w = __builtin_amdgcn_cvt_pk_fp8_f32(c, d, w, true); return (unsigned)w; }
template <class Epi, class Sched, bool GATHER = false, bool FP8 = false>
__device__ __forceinline__ void gemm_phase(LAS unsigned char* lds, const Gemm g, const Sched& S, const Epi& E, const int* rowidx = nullptr) {
    int tid = threadIdx.x; asm volatile("" : "+v"(tid));
    const int wid = __builtin_amdgcn_readfirstlane(tid >> 6), lane = tid & 63, wr = wid >> 2, wc = wid & 3, fr = lane & 15, fq = lane >> 4;
    const int K = g.K; int nt = K / BK; asm volatile("" : "+s"(nt));
    int Ra[2], Ca[2]; unsigned voffA[2], voffB[2];
#pragma unroll
    for (int i = 0; i < 2; ++i) { int R, C; stage_rc(tid * 16 + i * 8192, R, C); const int Rb = Epi::PERM ? ((R & ~31) + perm32(R & 31)) : R;
        Ra[i] = R; Ca[i] = C; voffA[i] = (unsigned)(R * g.lda + C) * 2u; voffB[i] = (unsigned)(Rb * g.ldb + C) * 2u; }
    const size_t hstepA = (size_t)HALF * g.lda * 2, tstepA = 2 * hstepA;
    const size_t kstep = (size_t)(BK * 2);
    const size_t hstepB = (size_t)HALF * g.ldb * 2, tstepB = 2 * hstepB;
    const unsigned ldsw = (unsigned)wid * 1024u;
    const int aoff = lds_byte(wr * 64 + fr, fq * 8), boff = lds_byte(wc * 32 + fr, fq * 8);
#define PG8_AOFF(dst, u) do { _Pragma("unroll") for (int _h = 0; _h < 2; ++_h) _Pragma("unroll") for (int _i = 0; _i < 2; ++_i) { int _row = (u).pm * BM + _h * HALF + Ra[_i]; if (GATHER) _row = rowidx[_row]; \
        dst[_h][_i] = (unsigned)(_row * g.lda + Ca[_i]) * 2u; } } while (0)
#define PG8_SA(b, h) (((b) * 2 + (h)) * HTB)
#define PG8_SB(b, h) ((4 + (b) * 2 + (h)) * HTB)
#define PG8_STAGE(bufoff, gbase, voff) do { _Pragma("unroll") for (int _i = 0; _i < 2; ++_i) \
        __builtin_amdgcn_global_load_lds((const unsigned*)((const char*)(gbase) + (voff)[_i]), (LAS unsigned*)(lds + (bufoff) + ldsw + _i * 8192), 16, 0, 0); } while (0)
#define PG8_STAGE_A(bufoff, ubase, vsel, h, kb) do { if constexpr (GATHER) { PG8_STAGE(bufoff, gA + (kb), (vsel)[h]); } else { PG8_STAGE(bufoff, (ubase) + (size_t)(h) * hstepA + (kb), voffA); } } while (0)
#define PG8_LD8(p) ({ const u32x4 _lo = *(const LAS u32x4*)(p), _hi = *(const LAS u32x4*)((p) + 1024); v8i _r; _r[0] = (int)_lo.x; _r[1] = (int)_lo.y; _r[2] = (int)_lo.z; _r[3] = (int)_lo.w; _r[4] = (int)_hi.x; _r[5] = (int)_hi.y; _r[6] = (int)_hi.z; _r[7] = (int)_hi.w; _r; })
#define PG8_LDA(dst, b, h) do { _Pragma("unroll") for (int m = 0; m < 4; ++m) dst[m] = PG8_LD8(lds + PG8_SA(b, h) + aoff + m * 2048); } while (0)
#define PG8_LDB(dst, b, h) do { _Pragma("unroll") for (int n = 0; n < 2; ++n) dst[n] = PG8_LD8(lds + PG8_SB(b, h) + boff + n * 2048); } while (0)
#define PG8_LO(v) __builtin_bit_cast(bf16x8, __builtin_shufflevector(v, v, 0, 1, 2, 3))
#define PG8_HI(v) __builtin_bit_cast(bf16x8, __builtin_shufflevector(v, v, 4, 5, 6, 7))
#define PG8_MMA(ai, bj, At, Bt) do { __builtin_amdgcn_s_setprio(1); _Pragma("unroll") for (int m = 0; m < 4; ++m) _Pragma("unroll") for (int n = 0; n < 2; ++n) { \
        if constexpr (FP8) { asm volatile("v_mfma_scale_f32_16x16x128_f8f6f4 %0, %1, %2, %0, %3, %3 op_sel_hi:[0,0,0]" : "+v"(acc[ai][bj][m][n]) : "v"(Bt[n]), "v"(At[m]), "v"(one_scale)); } \
        else { acc[ai][bj][m][n] = __builtin_amdgcn_mfma_f32_16x16x32_bf16(PG8_LO(Bt[n]), PG8_LO(At[m]), acc[ai][bj][m][n], 0, 0, 0); \
               acc[ai][bj][m][n] = __builtin_amdgcn_mfma_f32_16x16x32_bf16(PG8_HI(Bt[n]), PG8_HI(At[m]), acc[ai][bj][m][n], 0, 0, 0); } } __builtin_amdgcn_s_setprio(0); } while (0)
#define PG8_WAIT_V(n) asm volatile("s_waitcnt vmcnt(" #n ")" ::: "memory")
#define PG8_WAIT_L(n) asm volatile("s_waitcnt lgkmcnt(" #n ")" ::: "memory")
#define PG8_BAR __builtin_amdgcn_s_barrier()
#define PG8_SCHED __builtin_amdgcn_sched_barrier(0)
    Unit cur, nxt; int ui = 0;
    if (!S.next(0, cur)) return;
    f32x4 acc[2][2][4][2];
#pragma unroll
    for (int a = 0; a < 2; ++a)
#pragma unroll
        for (int b = 0; b < 2; ++b)
#pragma unroll
            for (int m = 0; m < 4; ++m)
#pragma unroll
                for (int n = 0; n < 2; ++n) { acc[a][b][m][n] = (f32x4){0.f, 0.f, 0.f, 0.f}; }
    v8i At[4], B0[2], B1[2];
    int one_scale = 0x7f7f7f7f; asm volatile("" : "+v"(one_scale)); (void)one_scale;
    unsigned vA[2][2], nvA[2][2];
    if constexpr (GATHER) PG8_AOFF(vA, cur);
    const char* gA = (const char*)g.A;
    const char* cA = gA + (size_t)cur.pm * tstepA;
    const char* cB = (const char*)g.Bt + (size_t)cur.pn * tstepB;
    PG8_STAGE(PG8_SB(0, 0), cB, voffB); PG8_STAGE(PG8_SB(0, 1), cB + hstepB, voffB); PG8_STAGE_A(PG8_SA(0, 0), cA, vA, 0, 0); PG8_STAGE_A(PG8_SA(0, 1), cA, vA, 1, 0);
    if (wr == 1) PG8_BAR;
    PG8_WAIT_V(2); PG8_BAR;
    PG8_STAGE(PG8_SB(1, 0), cB + kstep, voffB); PG8_STAGE_A(PG8_SA(1, 0), cA, vA, 0, kstep); PG8_STAGE(PG8_SB(1, 1), cB + hstepB + kstep, voffB);
    PG8_WAIT_V(6); PG8_BAR;
    for (;;) {
        const bool has_next = S.next(ui + 1, nxt);
        if constexpr (GATHER) { if (has_next) { PG8_AOFF(nvA, nxt); } else {
#pragma unroll
            for (int h = 0; h < 2; ++h)
#pragma unroll
                for (int i = 0; i < 2; ++i) nvA[h][i] = vA[h][i]; } }
        const char* nA = has_next ? gA + (size_t)nxt.pm * tstepA : cA;
        const char* nB = has_next ? (const char*)g.Bt + (size_t)nxt.pn * tstepB : cB;
#pragma unroll 1
        for (int t = 0; t < nt; t += 2) {
            const bool last = (t == nt - 2);
            const size_t k1 = (size_t)(t + 1) * kstep, k2 = last ? 0 : (size_t)(t + 2) * kstep, k3 = k2 + kstep;
            const char* u2 = last ? nA : cA; const char* b2 = last ? nB : cB + (size_t)(t + 2) * kstep; const char* b3 = b2 + kstep;
            unsigned v2[2][2];
            if constexpr (GATHER) {
#pragma unroll
                for (int h = 0; h < 2; ++h)
#pragma unroll
                    for (int i = 0; i < 2; ++i) v2[h][i] = last ? nvA[h][i] : vA[h][i]; }
            PG8_LDB(B0, 0, 0); PG8_LDB(B1, 0, 1); PG8_SCHED; PG8_LDA(At, 0, 0); PG8_STAGE_A(PG8_SA(1, 1), cA, vA, 1, k1);
            PG8_WAIT_V(8); PG8_WAIT_L(0); PG8_BAR; PG8_MMA(0, 0, At, B0); PG8_MMA(0, 1, At, B1); PG8_BAR; PG8_SCHED;
            PG8_LDA(At, 0, 1); PG8_STAGE(PG8_SB(0, 0), b2, voffB); PG8_STAGE(PG8_SB(0, 1), b2 + hstepB, voffB); PG8_STAGE_A(PG8_SA(0, 0), u2, v2, 0, k2);
            PG8_WAIT_V(8); PG8_WAIT_L(0); PG8_BAR; PG8_MMA(1, 0, At, B0); PG8_MMA(1, 1, At, B1); PG8_BAR; PG8_SCHED;
            PG8_LDB(B0, 1, 0); PG8_LDB(B1, 1, 1); PG8_SCHED; PG8_LDA(At, 1, 0); PG8_STAGE_A(PG8_SA(0, 1), u2, v2, 1, k2);
            PG8_WAIT_V(8); PG8_WAIT_L(0); PG8_BAR; PG8_MMA(0, 0, At, B0); PG8_MMA(0, 1, At, B1); PG8_BAR; PG8_SCHED;
            PG8_LDA(At, 1, 1); PG8_STAGE(PG8_SB(1, 0), b3, voffB); PG8_STAGE(PG8_SB(1, 1), b3 + hstepB, voffB); PG8_STAGE_A(PG8_SA(1, 0), u2, v2, 0, k3);
            PG8_WAIT_V(8); PG8_WAIT_L(0); PG8_BAR; PG8_MMA(1, 0, At, B0); PG8_MMA(1, 1, At, B1); PG8_BAR; PG8_SCHED;
        }
        if (wr == 0) PG8_BAR;
        if constexpr (FP8) asm volatile("s_nop 15\n\ts_nop 15" ::: "memory");
        E(acc, cur, wr, wc, fr, fq);
        if (!has_next) break;
#pragma unroll
        for (int a = 0; a < 2; ++a)
#pragma unroll
            for (int b = 0; b < 2; ++b)
#pragma unroll
                for (int m = 0; m < 4; ++m)
#pragma unroll
                    for (int n = 0; n < 2; ++n) { acc[a][b][m][n] = (f32x4){0.f, 0.f, 0.f, 0.f}; }
        cur = nxt; cA = nA; cB = nB; ++ui;
        if constexpr (GATHER) {
#pragma unroll
            for (int h = 0; h < 2; ++h)
#pragma unroll
                for (int i = 0; i < 2; ++i) vA[h][i] = nvA[h][i]; }
        if (wr == 1) PG8_BAR;
    }
    PG8_WAIT_V(0);
    PG8_BAR;
#undef PG8_AOFF
#undef PG8_SA
#undef PG8_SB
#undef PG8_STAGE
#undef PG8_LDA
#undef PG8_LDB
#undef PG8_STAGE_A
#undef PG8_LD8
#undef PG8_LO
#undef PG8_HI
#undef PG8_MMA
#undef PG8_WAIT_V
#undef PG8_WAIT_L
#undef PG8_BAR
#undef PG8_SCHED
}

__device__ __forceinline__ void st_bf4(bf16_t* p, f32x4 v) { u32x2 w; w.x = cvt_pk_bf16(v[0], v[1]); w.y = cvt_pk_bf16(v[2], v[3]); *(u32x2*)p = w; }
__device__ __forceinline__ void st_bf8(bf16_t* p, f32x4 v0, f32x4 v1) { u32x4 w; w.x = cvt_pk_bf16(v0[0], v0[1]); w.y = cvt_pk_bf16(v0[2], v0[3]); w.z = cvt_pk_bf16(v1[0], v1[1]); w.w = cvt_pk_bf16(v1[2], v1[3]); *(u32x4*)p = w; }

struct EpiInA {
    static constexpr bool PERM = false;
    bf16_t *Q, *Kn, *KT, *VT, *SG, *HU; const float* binp; const float* rope;
    __device__ __forceinline__ void operator()(const f32x4 (&acc)[2][2][4][2], const Unit& u, int wr, int wc, int fr, int fq) const {
        const int pc = u.pc, rbase = u.pm * BM + wr * 64 + fr, cbase = pc * BM + wc * 32 + 4 * fq;
        f32x4 bv[2][2];
#pragma unroll
        for (int bj = 0; bj < 2; ++bj)
#pragma unroll
            for (int n = 0; n < 2; ++n) bv[bj][n] = *(const f32x4*)(binp + cbase + bj * HALF + n * 16);
        const bool lat = u.pm < 128;
        const int bidx = lat ? (u.pm >> 4) : (u.pm - 128);
        if (pc < 4) {
            const bool isk = pc >= 2; const float ks = isk ? 0.08838834764831845f : 1.f;
            const int h0 = (pc & 1) * 2;
#pragma unroll
            for (int ai = 0; ai < 2; ++ai)
#pragma unroll
                for (int m = 0; m < 4; ++m) {
                    const int r = rbase + ai * HALF + m * 16, t = r & 4095;
                    const int tok = lat ? t : 4096 + ((r - T) & 255);
                    f32x4 cs = (f32x4){1.f, 1.f, 1.f, 1.f}, sn = (f32x4){0.f, 0.f, 0.f, 0.f};
                    if (lat) { const int pos = (wc >> 1) ? (t & 63) : (t >> 6); const float* rp = rope + pos * 32 + 16 * (wc & 1) + 4 * fq; cs = *(const f32x4*)rp; sn = *(const f32x4*)(rp + 2048); }
#pragma unroll
                    for (int bj = 0; bj < 2; ++bj) {
                        const f32x4 x1 = acc[ai][bj][m][0] + bv[bj][0], x2 = acc[ai][bj][m][1] + bv[bj][1];
                        const f32x4 o1 = (x1 * cs - x2 * sn) * ks, o2 = (x1 * sn + x2 * cs) * ks;
                        const int col = (pc & 1) * BM + bj * HALF + wc * 32 + 4 * fq;
                        if (!isk) { st_bf4(Q + (size_t)r * 512 + col, o1); st_bf4(Q + (size_t)r * 512 + col + 16, o2); }
                        else {
                            st_bf4(Kn + (size_t)r * 512 + col, o1); st_bf4(Kn + (size_t)r * 512 + col + 16, o2);
                            bf16_t* kt = KT + ((size_t)((bidx * 4 + h0 + bj) * 128 + wc * 32 + 4 * fq)) * TOKP + tok;
#pragma unroll
                            for (int e = 0; e < 4; ++e) { kt[(size_t)e * TOKP] = (bf16_t)f2bf(o1[e]); kt[(size_t)(16 + e) * TOKP] = (bf16_t)f2bf(o2[e]); }
                        }
                    }
                }
        } else if (pc < 8) {
            const int h = pc - 4;
#pragma unroll
            for (int ai = 0; ai < 2; ++ai)
#pragma unroll
                for (int m = 0; m < 4; ++m) {
                    const int r = rbase + ai * HALF + m * 16;
                    const int tok = lat ? (r & 4095) : 4096 + ((r - T) & 255);
#pragma unroll
                    for (int bj = 0; bj < 2; ++bj)
#pragma unroll
                        for (int n = 0; n < 2; ++n) {
                            const f32x4 v = acc[ai][bj][m][n] + bv[bj][n];
                            bf16_t* vt = VT + ((size_t)((bidx * 4 + h) * 256 + bj * HALF + wc * 32 + n * 16 + 4 * fq)) * TOKP + tok;
#pragma unroll
                            for (int e = 0; e < 4; ++e) vt[(size_t)e * TOKP] = (bf16_t)f2bf(v[e]);
                        }
                }
        } else {
            const bool isg = pc < 12;
            bf16_t* O = isg ? SG : HU; const int ldo = isg ? 1024 : 1536; const int c0 = (isg ? pc - 8 : pc - 12) * BM + wc * 32 + 4 * fq;
#pragma unroll
            for (int ai = 0; ai < 2; ++ai)
#pragma unroll
                for (int m = 0; m < 4; ++m) {
                    const int r = rbase + ai * HALF + m * 16;
#pragma unroll
                    for (int bj = 0; bj < 2; ++bj)
#pragma unroll
                        for (int n = 0; n < 2; ++n) {
                            f32x4 v = acc[ai][bj][m][n] + bv[bj][n];
                            if (isg) { v[0] = silu_f(v[0]); v[1] = silu_f(v[1]); v[2] = silu_f(v[2]); v[3] = silu_f(v[3]); }
                            st_bf4(O + (size_t)r * ldo + c0 + bj * HALF + n * 16, v);
                        }
                }
        }
    }
};
struct EpiGate {
    static constexpr bool PERM = true;
    bf16_t* O; const float* bias;
    __device__ __forceinline__ void operator()(const f32x4 (&acc)[2][2][4][2], const Unit& u, int wr, int wc, int fr, int fq) const {
        const int rbase = u.pm * BM + wr * 64 + fr, col0 = u.pc * BM + wc * 32 + 8 * fq;
        f32x4 bv[2][2];
#pragma unroll
        for (int bj = 0; bj < 2; ++bj)
#pragma unroll
            for (int n = 0; n < 2; ++n) bv[bj][n] = *(const f32x4*)(bias + col0 + bj * HALF + 4 * n);
#pragma unroll
        for (int ai = 0; ai < 2; ++ai)
#pragma unroll
            for (int m = 0; m < 4; ++m) { bf16_t* rowp = O + (size_t)(rbase + ai * HALF + m * 16) * 1024 + col0;
#pragma unroll
                for (int bj = 0; bj < 2; ++bj) { f32x4 v0 = acc[ai][bj][m][0] + bv[bj][0], v1 = acc[ai][bj][m][1] + bv[bj][1];
#pragma unroll
                    for (int e = 0; e < 4; ++e) { v0[e] = sigm_f(v0[e]); v1[e] = sigm_f(v1[e]); }
                    st_bf8(rowp + bj * HALF, v0, v1); } }
    }
};
template <int MODE> struct EpiMerge {
    static constexpr bool PERM = true;
    bf16_t* O; const bf16_t* P;
    __device__ __forceinline__ void operator()(const f32x4 (&acc)[2][2][4][2], const Unit& u, int wr, int wc, int fr, int fq) const {
        const int rbase = u.pm * BM + wr * 64 + fr, col0 = u.pc * BM + wc * 32 + 8 * fq;
#pragma unroll
        for (int ai = 0; ai < 2; ++ai)
#pragma unroll
            for (int m = 0; m < 4; ++m) { const size_t off = (size_t)(rbase + ai * HALF + m * 16) * 1024 + col0;
#pragma unroll
                for (int bj = 0; bj < 2; ++bj) {
                    const u32x4 gw = *(const u32x4*)(O + off + bj * HALF);
                    f32x4 v0 = acc[ai][bj][m][0], v1 = acc[ai][bj][m][1];
                    v0[0] *= bflo(gw.x); v0[1] *= bfhi(gw.x); v0[2] *= bflo(gw.y); v0[3] *= bfhi(gw.y);
                    v1[0] *= bflo(gw.z); v1[1] *= bfhi(gw.z); v1[2] *= bflo(gw.w); v1[3] *= bfhi(gw.w);
                    if (MODE == 1) { const u32x4 pw = *(const u32x4*)(P + off + bj * HALF);
                        v0[0] += bflo(pw.x); v0[1] += bfhi(pw.x); v0[2] += bflo(pw.y); v0[3] += bfhi(pw.y);
                        v1[0] += bflo(pw.z); v1[1] += bfhi(pw.z); v1[2] += bflo(pw.w); v1[3] += bfhi(pw.w); }
                    st_bf8(O + off + bj * HALF, v0, v1); } }
    }
};
struct EpiX1 {
    static constexpr bool PERM = false;
    const float* x; const float* mod; float* out;
    __device__ __forceinline__ void operator()(const f32x4 (&acc)[2][2][4][2], const Unit& u, int wr, int wc, int fr, int fq) const {
        const int rbase = u.pm * BM + wr * 64 + fr, col0 = u.pc * BM + wc * 32 + 4 * fq;
        const float* gt = mod + (size_t)(u.pm >> 4) * 6144 + 2048 + col0;
        f32x4 gv[2][2];
#pragma unroll
        for (int bj = 0; bj < 2; ++bj)
#pragma unroll
            for (int n = 0; n < 2; ++n) gv[bj][n] = *(const f32x4*)(gt + bj * HALF + n * 16);
#pragma unroll
        for (int ai = 0; ai < 2; ++ai)
#pragma unroll
            for (int m = 0; m < 4; ++m) { const size_t off = (size_t)(rbase + ai * HALF + m * 16) * 1024 + col0;
#pragma unroll
                for (int bj = 0; bj < 2; ++bj)
#pragma unroll
                    for (int n = 0; n < 2; ++n) { const f32x4 xv = *(const f32x4*)(x + off + bj * HALF + n * 16); *(f32x4*)(out + off + bj * HALF + n * 16) = xv + gv[bj][n] * acc[ai][bj][m][n]; } }
    }
};
struct EpiMoe1 {
    static constexpr bool PERM = true;
    unsigned char* HM;
    __device__ __forceinline__ void operator()(const f32x4 (&acc)[2][2][4][2], const Unit& u, int wr, int wc, int fr, int fq) const {
        const int rbase = u.pm * BM + wr * 64 + fr, col0 = u.pc * HALF + wc * 32 + 8 * fq;
#pragma unroll
        for (int ai = 0; ai < 2; ++ai)
#pragma unroll
            for (int m = 0; m < 4; ++m) {
                f32x4 v0, v1;
#pragma unroll
                for (int e = 0; e < 4; ++e) { v0[e] = silu_f(acc[ai][0][m][0][e] * 0.03125f) * (acc[ai][1][m][0][e] * 0.03125f); v1[e] = silu_f(acc[ai][0][m][1][e] * 0.03125f) * (acc[ai][1][m][1][e] * 0.03125f); }
                u32x2 w; w.x = pk_fp8x4(v0[0], v0[1], v0[2], v0[3]); w.y = pk_fp8x4(v1[0], v1[1], v1[2], v1[3]);
                *(u32x2*)(HM + (size_t)(rbase + ai * HALF + m * 16) * EH + col0) = w; }
    }
};
struct EpiBf {
    static constexpr bool PERM = true;
    bf16_t* O; int ldo; float scale;
    __device__ __forceinline__ void operator()(const f32x4 (&acc)[2][2][4][2], const Unit& u, int wr, int wc, int fr, int fq) const {
        const int rbase = u.pm * BM + wr * 64 + fr, col0 = u.pc * BM + wc * 32 + 8 * fq;
#pragma unroll
        for (int ai = 0; ai < 2; ++ai)
#pragma unroll
            for (int m = 0; m < 4; ++m)
#pragma unroll
                for (int bj = 0; bj < 2; ++bj) st_bf8(O + (size_t)(rbase + ai * HALF + m * 16) * ldo + col0 + bj * HALF, acc[ai][bj][m][0] * scale, acc[ai][bj][m][1] * scale);
    }
};
}

namespace gt {
constexpr int STAGE_BYTES = 128 * 144 + 256 * 144;
template <int NT, int BKT, class AL, class BL>
__device__ __forceinline__ void gemm_tile(f32x4 (&acc)[4][NT], const AL& al, const BL& bl, int nk, LAS unsigned char* st, int tid) {
    constexpr int AST = (BKT + 8) * 2, PPR = BKT / 8, NA = 128 * PPR / 512, NB = 64 * NT * PPR / 512;
    const int lane = tid & 63, wid = tid >> 6, wr = wid >> 2, wc = wid & 3, fr = lane & 15, fq = lane >> 4;
    LAS unsigned char* sa = st; LAS unsigned char* sb = st + 128 * AST;
    u32x4 ra[NA], rb[NB];
#pragma unroll
    for (int i = 0; i < NA; ++i) { const int p = tid + i * 512; ra[i] = al(p / PPR, (p % PPR) * 8); }
#pragma unroll
    for (int i = 0; i < NB; ++i) { const int p = tid + i * 512; rb[i] = bl(p / PPR, (p % PPR) * 8); }
    for (int kt = 0; kt < nk; ++kt) {
        __syncthreads();
#pragma unroll
        for (int i = 0; i < NA; ++i) { const int p = tid + i * 512; *(LAS u32x4*)(sa + (p / PPR) * AST + (p % PPR) * 16) = ra[i]; }
#pragma unroll
        for (int i = 0; i < NB; ++i) { const int p = tid + i * 512; *(LAS u32x4*)(sb + (p / PPR) * AST + (p % PPR) * 16) = rb[i]; }
        __syncthreads();
        if (kt + 1 < nk) {
            int t2 = tid; asm volatile("" : "+v"(t2));
#pragma unroll
            for (int i = 0; i < NA; ++i) { const int p = t2 + i * 512; ra[i] = al(p / PPR, (kt + 1) * BKT + (p % PPR) * 8); }
#pragma unroll
            for (int i = 0; i < NB; ++i) { const int p = t2 + i * 512; rb[i] = bl(p / PPR, (kt + 1) * BKT + (p % PPR) * 8); }
        }
#pragma unroll
        for (int kk = 0; kk < BKT / 32; ++kk) {
            bf16x8 a[4], b[NT];
#pragma unroll
            for (int m = 0; m < 4; ++m) a[m] = *(const LAS bf16x8*)(sa + (wr * 64 + m * 16 + fr) * AST + kk * 64 + fq * 16);
#pragma unroll
            for (int n = 0; n < NT; ++n) b[n] = *(const LAS bf16x8*)(sb + (wc * 16 * NT + n * 16 + fr) * AST + kk * 64 + fq * 16);
#pragma unroll
            for (int m = 0; m < 4; ++m)
#pragma unroll
                for (int n = 0; n < NT; ++n) acc[m][n] = __builtin_amdgcn_mfma_f32_16x16x32_bf16(a[m], b[n], acc[m][n], 0, 0, 0);
        }
    }
    __syncthreads();
}
struct LdRows {
    const bf16_t* base; int ld;
    __device__ __forceinline__ u32x4 operator()(int row, int k) const { return *(const u32x4*)(base + (size_t)row * ld + k); }
};
__device__ __forceinline__ u32x4 scale8(u32x4 v, float s0, float s1, float s2, float s3, float s4, float s5, float s6, float s7) {
    u32x4 o; o.x = pk2(bflo(v.x) * s0, bfhi(v.x) * s1); o.y = pk2(bflo(v.y) * s2, bfhi(v.y) * s3); o.z = pk2(bflo(v.z) * s4, bfhi(v.z) * s5); o.w = pk2(bflo(v.w) * s6, bfhi(v.w) * s7); return o;
}
}


#define XB_TMO      128
#define XB_XCNT(j)  (256  + 64 * (j))
#define XB_XSUB(j)  (1280 + 64 * (j))
#define XB_XGEN(j)  (2304 + 64 * (j))
#define XB_TOP      3328
#define XB_TOPGEN   3392
#define XCD_BAR_WORDS 3456
#define XB_SPIN_CAP (1u << 18)
__device__ __forceinline__ unsigned xb_ld(unsigned* p)              { return __hip_atomic_load(p, __ATOMIC_RELAXED, __HIP_MEMORY_SCOPE_AGENT); }
__device__ __forceinline__ unsigned xb_add(unsigned* p, unsigned v) { return __hip_atomic_fetch_add(p, v, __ATOMIC_RELAXED, __HIP_MEMORY_SCOPE_AGENT); }
__device__ __forceinline__ unsigned xb_xcc_id() { return (unsigned)__builtin_amdgcn_s_getreg((3 << 11) | 20) & 0xFu; }
#define XB_SPIN(cond, bar) do { unsigned _sp = 0; while (cond) { __builtin_amdgcn_s_sleep(1); \
    if ((++_sp & 255u) == 0u) { if (xb_ld(&(bar)[XB_TMO])) break; if (_sp > XB_SPIN_CAP) { atomicAdd(&(bar)[XB_TMO], 1u); break; } } } } while (0)
struct XcdBarrier { unsigned* bar; unsigned x; volatile LAS unsigned* st; };
__device__ __forceinline__ XcdBarrier xcd_barrier_post(unsigned* bar, volatile LAS unsigned* st) {
    XcdBarrier b; b.bar = bar; b.x = xb_xcc_id(); b.st = st;
    if (threadIdx.x == 0) (void)xb_add(&bar[XB_XCNT(b.x)], 1u);
    return b;
}
__device__ __forceinline__ void xcd_barrier_complete(unsigned* bar, unsigned x, unsigned& nloc, unsigned& nx) {
    const unsigned G = gridDim.x * gridDim.y * gridDim.z;
    unsigned sum, cnt, mine, sp = 0u;
    for (;;) {
        sum = 0u; cnt = 0u; mine = 0u;
#pragma unroll
        for (unsigned j = 0; j < 16; ++j) { const unsigned c = xb_ld(&bar[XB_XCNT(j)]); sum += c; cnt += (c > 0u) ? 1u : 0u; mine = (j == x) ? c : mine; }
        if (sum == G) break;
        __builtin_amdgcn_s_sleep(1);
        if ((++sp & 255u) == 0u) { if (xb_ld(&bar[XB_TMO])) break; if (sp > XB_SPIN_CAP) { atomicAdd(&bar[XB_TMO], 1u); break; } }
    }
    nloc = mine > 0u ? mine : 1u; nx = cnt > 0u ? cnt : 1u;
}
__device__ __forceinline__ void xcd_barrier(const XcdBarrier& b) {
    asm volatile("s_waitcnt vmcnt(0)" ::: "memory");
    __syncthreads();
    if (threadIdx.x == 0) {
        unsigned* bar = b.bar;
        __builtin_amdgcn_s_waitcnt(0);
        unsigned nloc = b.st[0], nx = b.st[1];
        if (nloc == 0u) { xcd_barrier_complete(bar, b.x, nloc, nx); b.st[0] = nloc; b.st[1] = nx; }
        const unsigned old = xb_add(&bar[XB_XSUB(b.x)], 1u);
        const unsigned gen = old / nloc;
        if (old + 1u == (gen + 1u) * nloc) {
            __builtin_amdgcn_fence(__ATOMIC_RELEASE, "agent");
            asm volatile("s_waitcnt vmcnt(0)" ::: "memory");
            const unsigned og = xb_add(&bar[XB_TOP], 1u);
            const unsigned tg = og / nx;
            if (og + 1u == (tg + 1u) * nx) xb_add(&bar[XB_TOPGEN], 1u);
            else XB_SPIN(xb_ld(&bar[XB_TOPGEN]) == tg, bar);
            __builtin_amdgcn_fence(__ATOMIC_ACQUIRE, "agent");
            xb_add(&bar[XB_XGEN(b.x)], 1u);
            asm volatile("s_waitcnt vmcnt(0)" ::: "memory");
        } else {
            XB_SPIN(xb_ld(&bar[XB_XGEN(b.x)]) == gen, bar);
            __builtin_amdgcn_fence(__ATOMIC_ACQUIRE, "agent");
            asm volatile("s_waitcnt vmcnt(0)" ::: "memory");
        }
    }
    __syncthreads();
}

struct Args { const float* in[31]; float* out; unsigned char* ws; };
enum { I_X = 0, I_C, I_CTX, I_CCTX, I_ADAW, I_ADAB, I_N1G, I_N2G, I_WIN, I_BIN, I_DECAY, I_RETWO, I_HCW, I_HCB, I_HW1, I_HB1, I_HFREQ, I_HW2, I_HB2, I_HW3, I_HSKIP, I_HYWO, I_WOUT,
       I_RGW, I_RGB, I_REW, I_REB, I_EW1, I_EW3, I_EW2, I_FNG };

template <class RowMap>
__device__ __forceinline__ void transpose_item(const float* W, int N, int k0, int n0, bf16_t* WT, int ldt, const RowMap& rm, LAS float* scr, int lane) {
    const int lr = lane >> 4, lc = (lane & 15) * 4;
#pragma unroll
    for (int i = 0; i < 16; ++i) { const int kk = 4 * i + lr; const f32x4 v = *(const f32x4*)(W + (size_t)(k0 + kk) * N + n0 + lc); LAS float* s = scr + kk * 69 + lc; s[0] = v[0]; s[1] = v[1]; s[2] = v[2]; s[3] = v[3]; }
    asm volatile("s_waitcnt lgkmcnt(0)" ::: "memory");
    const int c = lane & 7;
#pragma unroll
    for (int j = 0; j < 8; ++j) { const int n = (lane >> 3) + 8 * j; const LAS float* s = scr + (8 * c) * 69 + n;
        u32x4 o; o.x = pk2(s[0 * 69], s[1 * 69]); o.y = pk2(s[2 * 69], s[3 * 69]); o.z = pk2(s[4 * 69], s[5 * 69]); o.w = pk2(s[6 * 69], s[7 * 69]);
        *(u32x4*)(WT + (size_t)rm(n0 + n) * ldt + k0 + 8 * c) = o; }
    asm volatile("s_waitcnt lgkmcnt(0)" ::: "memory");
}
using pg8::pk_fp8x4;
template <class RowMap>
__device__ __forceinline__ void transpose_item_f8(const float* W, int N, int k0, int n0, unsigned char* WT, int ldt, const RowMap& rm, float scale, LAS float* scr, int lane) {
    const int lr = lane >> 4, lc = (lane & 15) * 4;
#pragma unroll
    for (int i = 0; i < 16; ++i) { const int kk = 4 * i + lr; const f32x4 v = *(const f32x4*)(W + (size_t)(k0 + kk) * N + n0 + lc); LAS float* s = scr + kk * 69 + lc; s[0] = v[0]; s[1] = v[1]; s[2] = v[2]; s[3] = v[3]; }
    asm volatile("s_waitcnt lgkmcnt(0)" ::: "memory");
    const int c = lane & 7;
#pragma unroll
    for (int j = 0; j < 8; ++j) { const int n = (lane >> 3) + 8 * j; const LAS float* s = scr + (8 * c) * 69 + n;
        u32x2 o; o.x = pk_fp8x4(s[0 * 69] * scale, s[1 * 69] * scale, s[2 * 69] * scale, s[3 * 69] * scale); o.y = pk_fp8x4(s[4 * 69] * scale, s[5 * 69] * scale, s[6 * 69] * scale, s[7 * 69] * scale);
        *(u32x2*)(WT + (size_t)rm(n0 + n) * ldt + k0 + 8 * c) = o; }
    asm volatile("s_waitcnt lgkmcnt(0)" ::: "memory");
}
struct RmId { __device__ __forceinline__ int operator()(int n) const { return n; } };
struct RmWin { __device__ __forceinline__ int operator()(int n) const { return win_destrow(n); } };
struct RmE13 { int add; __device__ __forceinline__ int operator()(int n) const { return 256 * (n >> 7) + (n & 127) + add; } };

__device__ __forceinline__ float lg2_decay(float logit) { return -log1pf(expf(-logit)) * 1.4426950408889634f; }

__device__ __forceinline__ void short_conv8(const bf16_t* HU, int row, int t, int ch, const float* cw, const float* cb, float (&o)[8]) {
    const f32x4 b0 = *(const f32x4*)(cb + ch), b1 = *(const f32x4*)(cb + ch + 4);
#pragma unroll
    for (int e = 0; e < 4; ++e) { o[e] = b0[e]; o[4 + e] = b1[e]; }
#pragma unroll
    for (int j = 0; j < 3; ++j) {
        const int tt = t + j - 1;
        if (tt >= 0 && tt < SEQ) {
            const u32x4 v = *(const u32x4*)(HU + (size_t)(row + j - 1) * 1536 + ch);
            const f32x4 w0 = *(const f32x4*)(cw + j * 1536 + ch), w1 = *(const f32x4*)(cw + j * 1536 + ch + 4);
            o[0] += bflo(v.x) * w0[0]; o[1] += bfhi(v.x) * w0[1]; o[2] += bflo(v.y) * w0[2]; o[3] += bfhi(v.y) * w0[3];
            o[4] += bflo(v.z) * w1[0]; o[5] += bfhi(v.z) * w1[1]; o[6] += bflo(v.w) * w1[2]; o[7] += bfhi(v.w) * w1[3];
        }
    }
}


__device__ __forceinline__ void short_conv8x8(const bf16_t* HU, int row0, int t0, int ch, const float* cw, const float* cb, float (&o)[8][8]) {
    u32x4 rw[10];
#pragma unroll
    for (int r = 0; r < 10; ++r) { const int tt = t0 + r - 1; rw[r] = (u32x4){0u, 0u, 0u, 0u}; if (tt >= 0 && tt < SEQ) rw[r] = *(const u32x4*)(HU + (size_t)(row0 + r - 1) * 1536 + ch); }
    float w[3][8], bb[8];
#pragma unroll
    for (int j = 0; j < 3; ++j) { const f32x4 w0 = *(const f32x4*)(cw + j * 1536 + ch), w1 = *(const f32x4*)(cw + j * 1536 + ch + 4);
#pragma unroll
        for (int e = 0; e < 4; ++e) { w[j][e] = w0[e]; w[j][4 + e] = w1[e]; } }
    { const f32x4 b0 = *(const f32x4*)(cb + ch), b1 = *(const f32x4*)(cb + ch + 4);
#pragma unroll
      for (int e = 0; e < 4; ++e) { bb[e] = b0[e]; bb[4 + e] = b1[e]; } }
#pragma unroll
    for (int t = 0; t < 8; ++t)
#pragma unroll
        for (int e = 0; e < 8; ++e) o[t][e] = bb[e];
#pragma unroll
    for (int r = 0; r < 10; ++r) {
        float u[8]; u[0] = bflo(rw[r].x); u[1] = bfhi(rw[r].x); u[2] = bflo(rw[r].y); u[3] = bfhi(rw[r].y); u[4] = bflo(rw[r].z); u[5] = bfhi(rw[r].z); u[6] = bflo(rw[r].w); u[7] = bfhi(rw[r].w);
#pragma unroll
        for (int j = 0; j < 3; ++j) { const int t = r - j;
            if (t >= 0 && t < 8) {
#pragma unroll
                for (int e = 0; e < 8; ++e) o[t][e] += u[e] * w[j][e]; } }
    }
}

typedef const __attribute__((address_space(4))) Args CArgs;
__device__ __forceinline__ CArgs* args_ptr() { CArgs* p = (CArgs*)__builtin_amdgcn_kernarg_segment_ptr(); asm volatile("" : "+s"(p)); return p; }
#define DECL_PTRS \
    CArgs& a = *args_ptr(); unsigned char* ws = a.ws; unsigned char* dob = (unsigned char*)a.out; \
    int tid = threadIdx.x; asm volatile("" : "+v"(tid)); const int lane = tid & 63, wave = tid >> 6, gw = bid * 8 + wave; (void)lane; (void)gw; \
    int* cnt = (int*)(ws + WS_CTL); \
    float* MOD = (float*)(ws + WS_MOD); float* ROPE = (float*)(ws + WS_ROPE); float* BINP = (float*)(ws + WS_BINP); float* FPART = (float*)(ws + WS_FPART); \
    int* TOKINFO = (int*)(ws + WS_TOKINFO); int* LISTS = (int*)(ws + WS_LISTS); \
    bf16_t* TR = (bf16_t*)(ws + WS_TR); \
    bf16_t* WT_IN = (bf16_t*)(ws + WS_WT_IN); bf16_t* WT_RETO = (bf16_t*)(ws + WS_WT_RETO); bf16_t* WT_HYO = (bf16_t*)(ws + WS_WT_HYO); bf16_t* WT_OUT = (bf16_t*)(ws + WS_WT_OUT); \
    bf16_t* Qb = (bf16_t*)(ws + WS_Q); bf16_t* Kb = (bf16_t*)(ws + WS_K); bf16_t* KT = (bf16_t*)(ws + WS_KT); bf16_t* VT = (bf16_t*)(ws + WS_VT); \
    float* FILT = (float*)(dob + DO_FILT); \
    bf16_t* SGR = (bf16_t*)(ws + WS_SGR); bf16_t* SGH = (bf16_t*)(ws + WS_SGH); bf16_t* XB = (bf16_t*)(ws + WS_XB); \
    bf16_t* SG = (bf16_t*)(ws + WS_SG); bf16_t* HU = (bf16_t*)(ws + WS_HU); bf16_t* HM = (bf16_t*)(ws + WS_HU); \
    bf16_t* KV = (bf16_t*)(ws + WS_KV); bf16_t* WE13 = (bf16_t*)(ws + WS_WE13); bf16_t* WE2 = (bf16_t*)(ws + WS_WE2); \
    bf16_t* XN = (bf16_t*)(dob + DO_XN); bf16_t* ZT = (bf16_t*)(dob + DO_ZT); \
    float* X1 = a.out; \
    (void)cnt; (void)MOD; (void)ROPE; (void)BINP; (void)FPART; (void)TOKINFO; (void)LISTS; (void)TR; (void)WT_IN; (void)WT_RETO; (void)WT_HYO; (void)WT_OUT; (void)Qb; (void)Kb; (void)KT; (void)VT; (void)FILT; \
    (void)SGR; (void)SGH; (void)XB; (void)SG; (void)HU; (void)HM; (void)KV; (void)WE13; (void)WE2; (void)XN; (void)ZT; (void)X1;

__global__ void __launch_bounds__(512, 2) fwd_kernel(Args a_) {
    extern __shared__ __attribute__((aligned(16))) unsigned char lds_raw[];
    LAS unsigned char* lds = (LAS unsigned char*)lds_raw;
    cg::grid_group grid = cg::this_grid();
    const int G = gridDim.x, bid = blockIdx.x, NGW = G * 8;
    volatile LAS unsigned* bst = (volatile LAS unsigned*)(lds + LDS_BYTES - 16);
    if (threadIdx.x == 0) { bst[0] = 0u; bst[1] = 0u; }
    __syncthreads();
    if (blockIdx.x == 0) { unsigned* bw = (unsigned*)(args_ptr()->ws + WS_CTL) + 1024; for (int i = threadIdx.x; i < XCD_BAR_WORDS; i += 512) bw[i] = 0u; }
#define GRID_BAR() xcd_barrier(xbar)
    unsigned long long tprev_ = 0, spin_ = 0;
    if (PROBE_PHASE >= 0) tprev_ = __builtin_amdgcn_s_memrealtime();
#define STAMP(k) do { if (PROBE_PHASE >= 0 && blockIdx.x == 0 && threadIdx.x == 0) { const unsigned long long now_ = __builtin_amdgcn_s_memrealtime(); if ((k) == PROBE_PHASE) spin_ = now_ - tprev_; tprev_ = now_; } } while (0)

    { DECL_PTRS
    for (int it = bid; it < 193; it += G) {
        if (it < 192) {
            const int col0 = it * 32, kq = tid >> 5, cl = tid & 31;
            LAS float* sl = (LAS float*)(lds + 32768);
            for (int idx = tid; idx < 9 * 1024; idx += 512) { const int r = idx >> 10, k = idx & 1023; sl[k * 12 + r] = silu_f(r < 8 ? a.in[I_C][r * 1024 + k] : a.in[I_CCTX][k]); }
            __syncthreads();
            float acc9[9];
#pragma unroll
            for (int r = 0; r < 9; ++r) acc9[r] = 0.f;
#pragma unroll 8
            for (int kk = 0; kk < 64; ++kk) { const int k = kq * 64 + kk; const float w = a.in[I_ADAW][(size_t)k * 6144 + col0 + cl];
                const f32x4 s0 = *(const LAS f32x4*)(sl + k * 12), s1 = *(const LAS f32x4*)(sl + k * 12 + 4); const float s8 = sl[k * 12 + 8];
                acc9[0] += s0[0] * w; acc9[1] += s0[1] * w; acc9[2] += s0[2] * w; acc9[3] += s0[3] * w; acc9[4] += s1[0] * w; acc9[5] += s1[1] * w; acc9[6] += s1[2] * w; acc9[7] += s1[3] * w; acc9[8] += s8 * w; }
            LAS float* red = (LAS float*)lds;
#pragma unroll
            for (int r = 0; r < 9; ++r) red[(kq * 9 + r) * 32 + cl] = acc9[r];
            __syncthreads();
            if (tid < 288) { const int r = tid >> 5, c2 = tid & 31; float s = 0.f; for (int q = 0; q < 16; ++q) s += red[(q * 9 + r) * 32 + c2]; MOD[r * 6144 + col0 + c2] = s + a.in[I_ADAB][col0 + c2]; }
            __syncthreads();
        } else {
            for (int idx = tid; idx < 2048; idx += 512) { const int pos = idx >> 5, i = idx & 31; const float inv = powf(10000.f, -(float)i / 32.f); const float ang = (float)pos * inv; ROPE[idx] = cosf(ang); ROPE[2048 + idx] = sinf(ang); }
            for (int n = tid; n < 6656; n += 512) BINP[win_destrow(n)] = a.in[I_BIN][n];
        }
    }
    __syncthreads();
    {
        LAS float* scr = (LAS float*)(lds + wave * 17664);
        constexpr int I_IN = 16 * 104, I_RO = 16 * 16, I_HO = 8 * 16, I_OU = 16 * 16;
        for (int it = gw; it < I_IN + I_RO + I_HO + I_OU; it += NGW) {
            int r = it;
            if (r < I_IN) { transpose_item(a.in[I_WIN], 6656, 64 * (r / 104), 64 * (r % 104), WT_IN, 1024, RmWin{}, scr, lane); continue; } r -= I_IN;
            if (r < I_RO) { transpose_item(a.in[I_RETWO], 1024, 64 * (r / 16), 64 * (r % 16), WT_RETO, 1024, RmId{}, scr, lane); continue; } r -= I_RO;
            if (r < I_HO) { transpose_item(a.in[I_HYWO], 1024, 64 * (r / 16), 64 * (r % 16), WT_HYO, 512, RmId{}, scr, lane); continue; } r -= I_HO;
            transpose_item(a.in[I_WOUT], 1024, 64 * (r / 16), 64 * (r % 16), WT_OUT, 1024, RmId{}, scr, lane);
        }
    }
    }
    grid.sync();
    const XcdBarrier xbar = xcd_barrier_post((unsigned*)(args_ptr()->ws + WS_CTL) + 1024, bst);
    STAMP(0);

    { DECL_PTRS
    for (int fi = bid; fi < 256; fi += G) {
        {
            const int t0 = fi * 16;
            LAS float* feats = (LAS float*)lds; LAS float* hid1 = feats + 544; LAS float* hid2 = hid1 + 1024;
            for (int idx = tid; idx < 16 * 33; idx += 512) { const int row = idx / 33, f = idx % 33; const float t = (float)(t0 + row) * (1.f / 4096.f); float v;
                if (f == 0) v = t; else { const int mb = (f - 1) & 15; const float band = 1e-4f + (float)mb * ((15.f - 1e-4f) / 15.f); const float ph = (6.283185307179586f * t) * band; v = f <= 16 ? cosf(ph) : -sinf(ph); }
                feats[idx] = v; }
            __syncthreads();
            for (int idx = tid; idx < 1024; idx += 512) { const int row = idx >> 6, j = idx & 63; float s = a.in[I_HB1][j]; for (int f = 0; f < 33; ++f) s += feats[row * 33 + f] * a.in[I_HW1][f * 64 + j]; hid1[idx] = sinf(a.in[I_HFREQ][j] * s); }
            __syncthreads();
            for (int idx = tid; idx < 1024; idx += 512) { const int row = idx >> 6, j = idx & 63; float s = a.in[I_HB2][j]; for (int k = 0; k < 64; ++k) s += hid1[row * 64 + k] * a.in[I_HW2][k * 64 + j]; hid2[j * 16 + row] = sinf(a.in[I_HFREQ][j] * s); }
            __syncthreads();
            const float slow = 4.605170185988091f / 1.5f, fast = 4.605170185988091f / 0.3f;
            for (int col = tid; col < 1024; col += 512) {
                float ac[16];
#pragma unroll
                for (int r = 0; r < 16; ++r) ac[r] = 0.f;
#pragma unroll 4
                for (int k = 0; k < 64; ++k) { const float w = a.in[I_HW3][k * 1024 + col];
#pragma unroll
                    for (int r4 = 0; r4 < 4; ++r4) { const f32x4 hv = *(const LAS f32x4*)(hid2 + k * 16 + 4 * r4); ac[4 * r4] += hv[0] * w; ac[4 * r4 + 1] += hv[1] * w; ac[4 * r4 + 2] += hv[2] * w; ac[4 * r4 + 3] += hv[3] * w; } }
                const float delta = slow + (float)(col & 511) * ((fast - slow) / 511.f); float ps = 0.f;
#pragma unroll
                for (int r = 0; r < 16; ++r) { const float t = (float)(t0 + r) * (1.f / 4096.f); ac[r] *= expf(-t * delta); ps += fabsf(ac[r]); }
#pragma unroll
                for (int r = 0; r < 4; ++r) *(f32x4*)(FILT + (size_t)col * 4096 + t0 + 4 * r) = (f32x4){ac[4 * r], ac[4 * r + 1], ac[4 * r + 2], ac[4 * r + 3]};
                FPART[fi * 1024 + col] = ps;
            }
            __syncthreads();
        }
    }
    for (int m = gw; m < MT; m += NGW) {
        const bool lat = m < T; const float* xr = lat ? a.in[I_X] + (size_t)m * D : a.in[I_CTX] + (size_t)(m - T) * D;
        const float* md = MOD + (size_t)(lat ? (m >> 12) : 8) * 6144;
        f32x4 v[4]; float s = 0.f;
#pragma unroll
        for (int j = 0; j < 4; ++j) { v[j] = *(const f32x4*)(xr + 4 * lane + 256 * j); s += (v[j][0] * v[j][0] + v[j][1] * v[j][1]) + (v[j][2] * v[j][2] + v[j][3] * v[j][3]); }
        const float rstd = rsqrtf(wave_sum(s) * (1.f / D) + EPS);
#pragma unroll
        for (int j = 0; j < 4; ++j) { const int c0 = 4 * lane + 256 * j; const f32x4 g = *(const f32x4*)(a.in[I_N1G] + c0), sh = *(const f32x4*)(md + c0), sc = *(const f32x4*)(md + 1024 + c0);
            const f32x4 o = (v[j] * rstd * g) * (sc + 1.f) + sh; u32x2 w; w.x = pk2(o[0], o[1]); w.y = pk2(o[2], o[3]); *(u32x2*)(XN + (size_t)m * D + c0) = w; }
    }
    }
    GRID_BAR();
    STAMP(1);

    { DECL_PTRS
    {
        pg8::Gemm g{XN, WT_IN, 1024, 1024, 1024}; pg8::InProjOrder S; S.init(G, bid);
        pg8::EpiInA E{Qb, Kb, KT, VT, SG, HU, BINP, ROPE};
        pg8::gemm_phase(lds, g, S, E);
    }
    }
    GRID_BAR();
    STAMP(2);

    { DECL_PTRS
    for (int c = bid; c < 512; c += G) {
        LAS float* red = (LAS float*)lds;
        float p = 0.f; if (tid < 256) p = FPART[tid * 1024 + c]; else p = FPART[(tid - 256) * 1024 + 512 + c];
        p = wave_sum(p); if (lane == 0) red[wave] = p;
        __syncthreads();
        const float nf = 1.f / ((red[0] + red[1]) + (red[2] + red[3])), nb = 1.f / ((red[4] + red[5]) + (red[6] + red[7]));
        for (int i = tid; i < 8192; i += 512) { const int x = 4096 - i; float v = 0.f;
            if (x >= 0 && x < 4096) v += FILT[(size_t)c * 4096 + x] * nf;
            if (x <= 0 && x > -4096) v += FILT[(size_t)(512 + c) * 4096 - x] * nb;
            TR[(size_t)c * 8192 + i] = (bf16_t)f2bf(v); }
        __syncthreads();
    }
    for (int it = bid; it < 512; it += G) {
        const int b = it >> 6, tt = (it >> 3) & 7, cc = it & 7;
        LAS bf16_t* zt = (LAS bf16_t*)lds;
        { int tl = tid; asm volatile("" : "+v"(tl));
          const int tq = tl >> 3, cg = tl & 7, c0 = cc * 64 + cg * 8, t0 = tt * 512 + tq * 8, row0 = b * SEQ + t0;
          float x1[8][8], vv[8][8];
          short_conv8x8(HU, row0, t0, 512 + c0, a.in[I_HCW], a.in[I_HCB], x1);
          short_conv8x8(HU, row0, t0, 1024 + c0, a.in[I_HCW], a.in[I_HCB], vv);
#pragma unroll
          for (int e = 0; e < 8; ++e) { u32x4 w; w.x = pk2(x1[0][e] * vv[0][e], x1[1][e] * vv[1][e]); w.y = pk2(x1[2][e] * vv[2][e], x1[3][e] * vv[3][e]); w.z = pk2(x1[4][e] * vv[4][e], x1[5][e] * vv[5][e]); w.w = pk2(x1[6][e] * vv[6][e], x1[7][e] * vv[7][e]);
              *(LAS u32x4*)(zt + (cg * 8 + e) * 520 + tq * 8) = w; } }
        __syncthreads();
#pragma unroll
        for (int i = 0; i < 8; ++i) { const int ch = wave * 8 + i; *(u32x4*)(ZT + ((size_t)(cc * 64 + ch) * 8 + b) * SEQ + tt * 512 + lane * 8) = *(const LAS u32x4*)(zt + ch * 520 + lane * 8); }
        __syncthreads();
    }
    {
        LAS float* wtab = (LAS float*)(lds + 104448);
        LAS bf16_t* ot = (LAS bf16_t*)lds;
        for (int u = bid; u < 32 * 34; u += G) {
            int tl = tid; asm volatile("" : "+v"(tl));
            const int bh = u / 34, ch = u % 34, h = bh & 3;
            const int tok0 = ch == 0 ? 4096 : ch == 1 ? 4224 : (ch - 2) * 128;
            const int slf = ch, slb = ch == 0 ? 1 : ch == 1 ? 0 : 35 - ch;
            if (tl < 256) { const int dir = tl >> 7, j = tl & 127; wtab[tl] = exp2f((float)(dir == 0 ? 127 - j : j) * lg2_decay(a.in[I_DECAY][dir * 4 + h])); }
            __syncthreads();
            struct LdKTw { const bf16_t* base; const LAS float* w;
                __device__ __forceinline__ u32x4 operator()(int row, int k) const { const u32x4 v = *(const u32x4*)(base + (size_t)(row & 127) * TOKP + k); const LAS float* wp = w + (row >> 7) * 128 + k;
                    const f32x4 w0 = *(const LAS f32x4*)wp, w1 = *(const LAS f32x4*)(wp + 4);
                    return gt::scale8(v, w0[0], w0[1], w0[2], w0[3], w1[0], w1[1], w1[2], w1[3]); } };
            const LdKTw bl{KT + (size_t)bh * 128 * TOKP + tok0, wtab};
            const int wr = tl >> 8, wc = (tl >> 6) & 3, fr = tl & 15, fq = (tl >> 4) & 3;
            for (int mt = 0; mt < 2; ++mt) {
                f32x4 acc[4][4];
#pragma unroll
                for (int m = 0; m < 4; ++m)
#pragma unroll
                    for (int n = 0; n < 4; ++n) acc[m][n] = (f32x4){0.f, 0.f, 0.f, 0.f};
                const gt::LdRows al{VT + ((size_t)bh * 256 + mt * 128) * TOKP + tok0, TOKP};
                gt::gemm_tile<4, 128>(acc, al, bl, 1, lds, tl);
#pragma unroll
                for (int m = 0; m < 4; ++m)
#pragma unroll
                    for (int n = 0; n < 4; ++n)
#pragma unroll
                        for (int j = 0; j < 4; ++j) ot[(wr * 64 + m * 16 + 4 * fq + j) * 264 + wc * 64 + n * 16 + fr] = (bf16_t)f2bf(acc[m][n][j]);
                __syncthreads();
#pragma unroll
                for (int i = 0; i < 8; ++i) { const int pz = tl + 512 * i, row = pz >> 5, c8 = pz & 31, dir = c8 >> 4;
                    const bool ok = dir ? (ch != 2) : (ch != 33);
                    if (ok) *(u32x4*)(KV + (((size_t)(bh * 2 + dir) * 33 + (dir ? slb : slf)) * 256 + mt * 128 + row) * 128 + (c8 & 15) * 8) = *(const LAS u32x4*)(ot + row * 264 + c8 * 8); }
                __syncthreads();
            }
        }
    }
    }
    GRID_BAR();
    STAMP(3);

    { DECL_PTRS
    for (int idx = bid * 512 + tid; idx < 64 * 4096; idx += G * 512) {
        const int chain = idx >> 12, eg = idx & 4095, dir = chain & 1, h = (chain >> 1) & 3;
        const float g128 = exp2f(128.f * lg2_decay(a.in[I_DECAY][dir * 4 + h]));
        float run[8];
#pragma unroll
        for (int e = 0; e < 8; ++e) run[e] = 0.f;
        bf16_t* p = KV + (size_t)chain * 33 * 32768 + eg * 8;
        for (int s = 0; s < 33; ++s) {
            const u32x4 v = *(const u32x4*)(p + (size_t)s * 32768);
            run[0] = run[0] * g128 + bflo(v.x); run[1] = run[1] * g128 + bfhi(v.x); run[2] = run[2] * g128 + bflo(v.y); run[3] = run[3] * g128 + bfhi(v.y);
            run[4] = run[4] * g128 + bflo(v.z); run[5] = run[5] * g128 + bfhi(v.z); run[6] = run[6] * g128 + bflo(v.w); run[7] = run[7] * g128 + bfhi(v.w);
            u32x4 o; o.x = pk2(run[0], run[1]); o.y = pk2(run[2], run[3]); o.z = pk2(run[4], run[5]); o.w = pk2(run[6], run[7]);
            *(u32x4*)(p + (size_t)s * 32768) = o;
        }
    }
    {
        typedef float f32x16 __attribute__((ext_vector_type(16)));
        constexpr int CPB = 16448, ZOFF = 4 * CPB, ROWB = 10256, PADB = 992;
        for (int i = tid; i < (8 * ROWB) / 16; i += 512) *(LAS u32x4*)(lds + ZOFF + i * 16) = (u32x4){0u, 0u, 0u, 0u};
        __syncthreads();
        for (int c = bid; c < 512; c += G) {
            int tl = tid; asm volatile("" : "+v"(tl));
            const int w = tl >> 6, l = tl & 63, col = l & 31, hh = l >> 5, Rl = col >> 3, nn = col & 7;
            bf16_t* zc = ZT + (size_t)c * 8 * SEQ; const bf16_t* trg = TR + (size_t)c * 8192;
#pragma unroll
            for (int i = 0; i < 8; ++i) { const int q = tl + 512 * i, n = q >> 9, off = (q & 511) * 8; *(LAS u32x4*)(lds + ZOFF + n * ROWB + PADB + off * 2) = *(const u32x4*)(zc + (size_t)n * SEQ + off); }
#pragma unroll
            for (int i = 0; i < 2; ++i) { const int u = tl + 512 * i; const u32x4 v0 = *(const u32x4*)(trg + 8 * u); u32x4 v1 = (u32x4){0u, 0u, 0u, 0u}; if (u < 1023) v1 = *(const u32x4*)(trg + 8 * u + 8);
                const unsigned W0 = v0.x, W1 = v0.y, W2 = v0.z, W3 = v0.w, W4 = v1.x, W5 = v1.y;
                *(LAS u32x4*)(lds + 0 * CPB + 16 * u) = v0;
                *(LAS u32x4*)(lds + 1 * CPB + 16 * u) = (u32x4){(W0 >> 16) | (W1 << 16), (W1 >> 16) | (W2 << 16), (W2 >> 16) | (W3 << 16), (W3 >> 16) | (W4 << 16)};
                *(LAS u32x4*)(lds + 2 * CPB + 16 * u) = (u32x4){W1, W2, W3, W4};
                *(LAS u32x4*)(lds + 3 * CPB + 16 * u) = (u32x4){(W1 >> 16) | (W2 << 16), (W2 >> 16) | (W3 << 16), (W3 >> 16) | (W4 << 16), (W4 >> 16) | (W5 << 16)}; }
            __syncthreads();
            const int dlo = 32 * w - 255;
            const int e0 = 4096 - 16 * dlo - col + 8 * hh;
            int aaddr = (e0 & 3) * CPB + 2 * (e0 & ~3);
            int baddr = ZOFF + nn * ROWB + PADB + 2 * (512 * w + 64 * Rl + 8 * hh - 16 * dlo);
            f32x16 acc[4];
#pragma unroll
            for (int q = 0; q < 4; ++q)
#pragma unroll
                for (int i = 0; i < 16; ++i) acc[q][i] = 0.f;
            u32x2 alo = *(const LAS u32x2*)(lds + aaddr), ahi = *(const LAS u32x2*)(lds + aaddr + 8);
            u32x4 bq[4];
#pragma unroll
            for (int q = 0; q < 4; ++q) bq[q] = *(const LAS u32x4*)(lds + baddr + 512 * (q >> 1) + 64 * (q & 1));
            for (int it = 0; it < 285; ++it) {
                aaddr -= 32; baddr -= 32;
                const u32x2 nlo = *(const LAS u32x2*)(lds + aaddr), nhi = *(const LAS u32x2*)(lds + aaddr + 8);
                u32x4 nb[4];
#pragma unroll
                for (int q = 0; q < 4; ++q) nb[q] = *(const LAS u32x4*)(lds + baddr + 512 * (q >> 1) + 64 * (q & 1));
                const bf16x8 af = __builtin_bit_cast(bf16x8, (u32x4){alo.x, alo.y, ahi.x, ahi.y});
#pragma unroll
                for (int q = 0; q < 4; ++q) acc[q] = __builtin_amdgcn_mfma_f32_32x32x16_bf16(af, __builtin_bit_cast(bf16x8, bq[q]), acc[q], 0, 0, 0);
                alo = nlo; ahi = nhi;
#pragma unroll
                for (int q = 0; q < 4; ++q) bq[q] = nb[q];
            }
            {
                const bf16x8 af = __builtin_bit_cast(bf16x8, (u32x4){alo.x, alo.y, ahi.x, ahi.y});
#pragma unroll
                for (int q = 0; q < 4; ++q) acc[q] = __builtin_amdgcn_mfma_f32_32x32x16_bf16(af, __builtin_bit_cast(bf16x8, bq[q]), acc[q], 0, 0, 0);
            }
            const float skip = a.in[I_HSKIP][c];
#pragma unroll
            for (int q = 0; q < 4; ++q)
#pragma unroll
                for (int gq = 0; gq < 4; ++gq) {
                    const int t0 = 512 * w + 256 * (q >> 1) + 32 * (q & 1) + 64 * Rl + 8 * gq + 4 * hh;
                    const u32x2 zz = *(const LAS u32x2*)(lds + ZOFF + nn * ROWB + PADB + 2 * t0);
                    u32x2 o; o.x = pk2(acc[q][4 * gq] + skip * bflo(zz.x), acc[q][4 * gq + 1] + skip * bfhi(zz.x)); o.y = pk2(acc[q][4 * gq + 2] + skip * bflo(zz.y), acc[q][4 * gq + 3] + skip * bfhi(zz.y));
                    *(u32x2*)(zc + (size_t)nn * SEQ + t0) = o;
                }
            __syncthreads();
        }
    }
    }
    GRID_BAR();
    STAMP(4);

    { DECL_PTRS
    {
        LAS unsigned char* Pl = lds + 104448;
        LAS float* sfb = (LAS float*)(lds + 104448 + 128 * 272);
        LAS float* rsum = sfb + 256;
        LAS bf16_t* ot = (LAS bf16_t*)lds;
        for (int u = bid; u < 1024; u += G) {
            int tl = tid; asm volatile("" : "+v"(tl));
            const int wr = tl >> 8, wc = (tl >> 6) & 3, fr = tl & 15, fq = (tl >> 4) & 3;
            const int bh = u >> 5, c = u & 31, b = bh >> 2, h = bh & 3, row0 = b * SEQ + c * 128;
            const float lgf = lg2_decay(a.in[I_DECAY][h]), lgb = lg2_decay(a.in[I_DECAY][4 + h]);
            if (tl < 128) sfb[tl] = exp2f((float)(tl + 1) * lgf); else if (tl < 256) sfb[tl] = exp2f((float)(128 - (tl - 128)) * lgb);
            {
                f32x4 sacc[4][2];
#pragma unroll
                for (int m = 0; m < 4; ++m)
#pragma unroll
                    for (int n = 0; n < 2; ++n) sacc[m][n] = (f32x4){0.f, 0.f, 0.f, 0.f};
                gt::gemm_tile<2, 128>(sacc, gt::LdRows{Qb + (size_t)row0 * 512 + h * 128, 512}, gt::LdRows{Kb + (size_t)row0 * 512 + h * 128, 512}, 1, lds, tl);
#pragma unroll
                for (int m = 0; m < 4; ++m)
#pragma unroll
                    for (int n = 0; n < 2; ++n)
#pragma unroll
                        for (int j = 0; j < 4; ++j) { const int i = wr * 64 + m * 16 + 4 * fq + j, jj = wc * 32 + n * 16 + fr, df = i - jj;
                            const float dcy = df >= 0 ? exp2f((float)df * lgf) : exp2f((float)(-df) * lgb);
                            *(LAS bf16_t*)(Pl + i * 272 + jj * 2) = (bf16_t)f2bf(sacc[m][n][j] * dcy); }
                asm volatile("" ::: "memory");
            }
            __syncthreads();
            struct LdA2 { LAS unsigned char* P; const bf16_t* q; const LAS float* sc;
                __device__ __forceinline__ u32x4 operator()(int row, int k) const {
                    if (k < 128) return *(const LAS u32x4*)(P + row * 272 + k * 2);
                    const bool fw = k < 256; const u32x4 v = *(const u32x4*)(q + (size_t)row * 512 + (fw ? k - 128 : k - 256)); const float s = sc[fw ? row : 128 + row];
                    return gt::scale8(v, s, s, s, s, s, s, s, s); } };
            struct LdB2 { const bf16_t* vt; const bf16_t* sf; const bf16_t* sb;
                __device__ __forceinline__ u32x4 operator()(int dv, int k) const {
                    if (k < 128) return *(const u32x4*)(vt + (size_t)dv * TOKP + k);
                    if (k < 256) return *(const u32x4*)(sf + (size_t)dv * 128 + (k - 128));
                    return *(const u32x4*)(sb + (size_t)dv * 128 + (k - 256)); } };
            f32x4 acc[4][4];
#pragma unroll
            for (int m = 0; m < 4; ++m)
#pragma unroll
                for (int n = 0; n < 4; ++n) acc[m][n] = (f32x4){0.f, 0.f, 0.f, 0.f};
            const LdA2 al{Pl, Qb + (size_t)row0 * 512 + h * 128, sfb};
            const LdB2 bl{VT + (size_t)bh * 256 * TOKP + c * 128, KV + ((size_t)(bh * 2 + 0) * 33 + (c + 1)) * 32768, KV + ((size_t)(bh * 2 + 1) * 33 + (32 - c)) * 32768};
            gt::gemm_tile<4, 128>(acc, al, bl, 3, lds, tl);
#pragma unroll
            for (int m = 0; m < 4; ++m)
#pragma unroll
                for (int j = 0; j < 4; ++j) { float s = 0.f;
#pragma unroll
                    for (int n = 0; n < 4; ++n) s += acc[m][n][j] * acc[m][n][j];
                    s += __shfl_xor(s, 1); s += __shfl_xor(s, 2); s += __shfl_xor(s, 4); s += __shfl_xor(s, 8);
                    if (fr == 0) rsum[(wr * 64 + m * 16 + 4 * fq + j) * 4 + wc] = s; }
            __syncthreads();
#pragma unroll
            for (int m = 0; m < 4; ++m)
#pragma unroll
                for (int j = 0; j < 4; ++j) { const int i = wr * 64 + m * 16 + 4 * fq + j; const f32x4 rs = *(const LAS f32x4*)(rsum + i * 4);
                    const float rstd = rsqrtf(((rs[0] + rs[1]) + (rs[2] + rs[3])) * (1.f / 256.f) + EPS);
#pragma unroll
                    for (int n = 0; n < 4; ++n) ot[i * 264 + wc * 64 + n * 16 + fr] = (bf16_t)f2bf(acc[m][n][j] * rstd); }
            __syncthreads();
#pragma unroll
            for (int i = 0; i < 8; ++i) { const int pz = tl + 512 * i, row = pz >> 5, c8 = pz & 31;
                bf16_t* gp = SG + (size_t)(row0 + row) * 1024 + h * 256 + c8 * 8;
                const u32x4 gv = *(const u32x4*)gp, ov = *(const LAS u32x4*)(ot + row * 264 + c8 * 8);
                u32x4 o; o.x = pk2(bflo(gv.x) * bflo(ov.x), bfhi(gv.x) * bfhi(ov.x)); o.y = pk2(bflo(gv.y) * bflo(ov.y), bfhi(gv.y) * bfhi(ov.y)); o.z = pk2(bflo(gv.z) * bflo(ov.z), bfhi(gv.z) * bfhi(ov.z)); o.w = pk2(bflo(gv.w) * bflo(ov.w), bfhi(gv.w) * bfhi(ov.w));
                *(u32x4*)gp = o; }
            __syncthreads();
        }
    }
    for (int it = bid; it < 512; it += G) {
        const int b = it >> 6, tt = (it >> 3) & 7, cc = it & 7;
        LAS bf16_t* yt = (LAS bf16_t*)lds;
#pragma unroll
        for (int i = 0; i < 8; ++i) { const int ch = wave * 8 + i; *(LAS u32x4*)(yt + ch * 520 + lane * 8) = *(const u32x4*)(ZT + ((size_t)(cc * 64 + ch) * 8 + b) * SEQ + tt * 512 + lane * 8); }
        __syncthreads();
        { int tl = tid; asm volatile("" : "+v"(tl));
          const int tq = tl >> 3, cg = tl & 7, c0 = cc * 64 + cg * 8, t0 = tt * 512 + tq * 8, row0 = b * SEQ + t0;
          float x0[8][8];
          short_conv8x8(HU, row0, t0, c0, a.in[I_HCW], a.in[I_HCB], x0);
          u32x4 yv[8];
#pragma unroll
          for (int e = 0; e < 8; ++e) yv[e] = *(const LAS u32x4*)(yt + (cg * 8 + e) * 520 + tq * 8);
#pragma unroll
          for (int t = 0; t < 8; ++t) { float o[8];
#pragma unroll
              for (int e = 0; e < 8; ++e) { const unsigned wd = (t >> 1) == 0 ? yv[e].x : (t >> 1) == 1 ? yv[e].y : (t >> 1) == 2 ? yv[e].z : yv[e].w; o[e] = x0[t][e] * ((t & 1) ? bfhi(wd) : bflo(wd)); }
              u32x4 w; w.x = pk2(o[0], o[1]); w.y = pk2(o[2], o[3]); w.z = pk2(o[4], o[5]); w.w = pk2(o[6], o[7]);
              *(u32x4*)(HU + (size_t)(row0 + t) * 1536 + 512 + c0) = w; } }
        __syncthreads();
    }
    }
    GRID_BAR();
    STAMP(5);

    { DECL_PTRS
    {
        pg8::Gemm g{XN, WT_IN + (size_t)(NINA + 1024) * 1024, 1024, 1024, 1024}; pg8::StaticOrder S; S.init(T, 1024, G, bid);
        pg8::EpiGate E{SGH, a.in[I_BIN] + NINA + 1024};
        pg8::gemm_phase(lds, g, S, E);
    }
    {
        pg8::Gemm g{HU + 512, WT_HYO, 512, 1536, 512}; pg8::StaticOrder S; S.init(T, 1024, G, bid);
        pg8::EpiMerge<0> E{SGH, nullptr};
        pg8::gemm_phase(lds, g, S, E);
    }
    {
        pg8::Gemm g{XN, WT_IN + (size_t)NINA * 1024, 1024, 1024, 1024}; pg8::StaticOrder S; S.init(T, 1024, G, bid);
        pg8::EpiGate E{SGR, a.in[I_BIN] + NINA};
        pg8::gemm_phase(lds, g, S, E);
    }
    {
        pg8::Gemm g{SG, WT_RETO, 1024, 1024, 1024}; pg8::StaticOrder S; S.init(T, 1024, G, bid);
        pg8::EpiMerge<1> E{SGR, SGH};
        pg8::gemm_phase(lds, g, S, E);
    }
    __syncthreads();
    {
        LAS float* scr = (LAS float*)(lds + wave * 17664);
        constexpr int PER = 16 * 8;
        for (int it = gw; it < NE * 3 * PER; it += NGW) {
            const int e = it / (3 * PER), r3 = it % (3 * PER), which = r3 / PER, r = r3 % PER;
            unsigned char* W13 = (unsigned char*)WE13; unsigned char* W2 = (unsigned char*)WE2;
            if (which == 0) transpose_item_f8(a.in[I_EW1] + (size_t)e * 1024 * 512, 512, 64 * (r / 8), 64 * (r % 8), W13 + (size_t)e * 1024 * 1024, 1024, RmE13{0}, 32.f, scr, lane);
            else if (which == 1) transpose_item_f8(a.in[I_EW3] + (size_t)e * 1024 * 512, 512, 64 * (r / 8), 64 * (r % 8), W13 + (size_t)e * 1024 * 1024, 1024, RmE13{128}, 32.f, scr, lane);
            else transpose_item_f8(a.in[I_EW2] + (size_t)e * 512 * 1024, 1024, 64 * (r / 16), 64 * (r % 16), W2 + (size_t)e * 1024 * 512, 512, RmId{}, 32.f, scr, lane);
        }
    }
    }
    GRID_BAR();
    STAMP(6);
    STAMP(7);
    STAMP(8);
    { DECL_PTRS
    {
        pg8::Gemm g{SGR, WT_OUT, 1024, 1024, 1024}; pg8::StaticOrder S; S.init(T, 1024, G, bid);
        pg8::EpiX1 E{a.in[I_X], MOD, X1};
        pg8::gemm_phase(lds, g, S, E);
    }
    }
    GRID_BAR();
    STAMP(9);

    { DECL_PTRS
    {
        LAS float* Wl = (LAS float*)lds;
#pragma unroll
        for (int i = 0; i < 18; ++i) { const int q = tid + 512 * i, k = q / 9, p4 = q % 9;
            const f32x4 v = p4 == 0 ? *(const f32x4*)(a.in[I_RGW] + k * 4) : *(const f32x4*)(a.in[I_REW] + k * 32 + (p4 - 1) * 4);
            *(LAS f32x4*)(Wl + k * 36 + p4 * 4) = v; }
        __syncthreads();
        unsigned char* H2 = (unsigned char*)SG;
        LAS float* Sw = (LAS float*)(lds + 147456 + wave * 1152);
        LAS int* lcnt = (LAS int*)(lds + 147456 + 9216);
        if (tid < NE) lcnt[tid] = 0;
        __syncthreads();
        for (int rb = gw; rb < T / 16; rb += NGW) {
            int ll = lane; asm volatile("" : "+v"(ll));
            const int r = ll & 15, kq = ll >> 4, row = rb * 16 + r, b = (rb * 16) >> 12;
            const float* md = MOD + (size_t)b * 6144; const float* xr = X1 + (size_t)row * D + 4 * kq;
            float s = 0.f;
#pragma unroll 16
            for (int i = 0; i < 64; ++i) { const f32x4 xv = *(const f32x4*)(xr + 16 * i); s += (xv[0] * xv[0] + xv[1] * xv[1]) + (xv[2] * xv[2] + xv[3] * xv[3]); }
            s += __shfl_xor(s, 16); s += __shfl_xor(s, 32);
            const float rstd = rsqrtf(s * (1.f / D) + EPS);
            f32x4 lacc[3];
#pragma unroll
            for (int ct = 0; ct < 3; ++ct) lacc[ct] = (f32x4){0.f, 0.f, 0.f, 0.f};
            const int c0 = ll & 15, c2 = (32 + c0) < 36 ? 32 + c0 : 35;
#pragma unroll 4
            for (int i = 0; i < 64; ++i) {
                const int k0 = 16 * i + 4 * kq;
                const f32x4 xv = *(const f32x4*)(xr + 16 * i), gv = *(const f32x4*)(a.in[I_N2G] + k0), sc = *(const f32x4*)(md + 4096 + k0), sh = *(const f32x4*)(md + 3072 + k0);
                const f32x4 hv = (xv * rstd * gv) * (sc + 1.f) + sh;
                *(unsigned*)(H2 + (size_t)row * D + k0) = pk_fp8x4(hv[0], hv[1], hv[2], hv[3]);
#pragma unroll
                for (int e = 0; e < 4; ++e) { const LAS float* wr_ = Wl + (k0 + e) * 36;
                    lacc[0] = __builtin_amdgcn_mfma_f32_16x16x4f32(hv[e], wr_[c0], lacc[0], 0, 0, 0);
                    lacc[1] = __builtin_amdgcn_mfma_f32_16x16x4f32(hv[e], wr_[16 + c0], lacc[1], 0, 0, 0);
                    lacc[2] = __builtin_amdgcn_mfma_f32_16x16x4f32(hv[e], wr_[c2], lacc[2], 0, 0, 0); }
            }
#pragma unroll
            for (int hf = 0; hf < 2; ++hf) {
                if ((kq >> 1) == hf) {
#pragma unroll
                    for (int j = 0; j < 4; ++j) { LAS float* sp = Sw + (4 * (kq & 1) + j) * 36 + c0; sp[0] = lacc[0][j]; sp[16] = lacc[1][j]; if (c0 < 4) sp[32] = lacc[2][j]; }
                }
                asm volatile("s_waitcnt lgkmcnt(0)" ::: "memory");
                if (ll < 8) {
                    const int rrow = rb * 16 + 8 * hf + ll;
                    float lg[36];
#pragma unroll
                    for (int q = 0; q < 9; ++q) { const f32x4 v = *(const LAS f32x4*)(Sw + ll * 36 + 4 * q); lg[4 * q] = v[0]; lg[4 * q + 1] = v[1]; lg[4 * q + 2] = v[2]; lg[4 * q + 3] = v[3]; }
                    float gl[4];
#pragma unroll
                    for (int j = 0; j < 4; ++j) gl[j] = lg[j] + a.in[I_RGB][j];
                    int gs = 0; float gm = gl[0];
#pragma unroll
                    for (int j = 1; j < 4; ++j) if (gl[j] > gm) { gm = gl[j]; gs = j; }
                    float den = 0.f;
#pragma unroll
                    for (int j = 0; j < 4; ++j) den += expf(gl[j] - gm);
                    const float pstar = 1.f / den;
                    float el[8];
#pragma unroll
                    for (int e = 0; e < 8; ++e) { const float v0 = lg[4 + e], v1 = lg[12 + e], v2 = lg[20 + e], v3 = lg[28 + e]; el[e] = (gs == 0 ? v0 : gs == 1 ? v1 : gs == 2 ? v2 : v3) + a.in[I_REB][gs * 8 + e]; }
                    int e0 = 0; float m0 = el[0];
#pragma unroll
                    for (int e = 1; e < 8; ++e) if (el[e] > m0) { m0 = el[e]; e0 = e; }
                            int e1 = e0 == 0 ? 1 : 0; float m1 = e0 == 0 ? el[1] : el[0];
#pragma unroll
                    for (int e = 1; e < 8; ++e) if (e != e0 && el[e] > m1) { m1 = el[e]; e1 = e; }
                    const float ex = expf(m1 - m0); const float w0 = pstar / (1.f + ex), w1 = pstar * ex / (1.f + ex);
                    const int E0 = gs * 8 + e0, E1 = gs * 8 + e1;
                    const int s0 = __hip_atomic_fetch_add(lcnt + E0, 1, __ATOMIC_RELAXED, __HIP_MEMORY_SCOPE_WORKGROUP), s1 = __hip_atomic_fetch_add(lcnt + E1, 1, __ATOMIC_RELAXED, __HIP_MEMORY_SCOPE_WORKGROUP);
                    int4 ti; ti.x = (E0 << 16) | s0; ti.y = (E1 << 16) | s1; ti.z = __float_as_int(w0); ti.w = __float_as_int(w1);
                    *(int4*)(TOKINFO + (size_t)rrow * 4) = ti;
                }
                asm volatile("s_waitcnt lgkmcnt(0)" ::: "memory");
            }
        }
        __syncthreads();
        if (tid < NE) LISTS[bid * NE + tid] = lcnt[tid];
    }
    }
    GRID_BAR();
    STAMP(10);

    LAS int* tbase = (LAS int*)(lds + MISC_OFF);
    LAS int* texp = tbase + 64;
    int ntiles = 0;
    { DECL_PTRS
    {
        LAS int* ptot = texp + 320;
        LAS int* pbas = ptot + 512; LAS int* total = pbas + 512; LAS int* mybase = total + 32;
        { const int e = tid & 31, part = tid >> 5, per = (G + 15) >> 4; int s = 0, sb = 0;
          for (int b = part * per; b < (part + 1) * per && b < G; ++b) { const int v = LISTS[b * NE + e]; s += v; if (b < bid) sb += v; }
          ptot[part * 32 + e] = s; pbas[part * 32 + e] = sb; }
        __syncthreads();
        if (tid < NE) { int s = 0, sb = 0; for (int q = 0; q < 16; ++q) { s += ptot[q * 32 + tid]; sb += pbas[q * 32 + tid]; } total[tid] = s; mybase[tid] = sb; }
        __syncthreads();
        if (tid == 0) { int acc = 0; for (int e = 0; e < NE; ++e) { tbase[e] = acc; const int nt = (total[e] + 255) >> 8; for (int q = 0; q < nt; ++q) texp[acc + q] = e; acc += nt; } tbase[NE] = acc; }
        __syncthreads();
        ntiles = tbase[NE];
        int* ROWTOK = LISTS + 16384;
        for (int rb = gw; rb < T / 16; rb += NGW) {
            if (lane < 16) { const int row = rb * 16 + lane;
                const int4 ti = *(const int4*)(TOKINFO + (size_t)row * 4);
                const int e0 = ti.x >> 16, e1 = ti.y >> 16;
                const int r0 = tbase[e0] * 256 + mybase[e0] + (ti.x & 0xffff), r1 = tbase[e1] * 256 + mybase[e1] + (ti.y & 0xffff);
                ROWTOK[r0] = row; ROWTOK[r1] = row;
                int4 to = ti; to.x = r0; to.y = r1; *(int4*)(TOKINFO + (size_t)row * 4) = to; }
        }
        if (bid < NE) { const int rlo = tbase[bid] * 256 + total[bid], rhi = tbase[bid + 1] * 256; for (int r = rlo + tid; r < rhi; r += 512) ROWTOK[r] = 0; }
    }
    }
    GRID_BAR();
    STAMP(11);

    { DECL_PTRS
    {
        pg8::Gemm g{SG  , WE13, 512, 512, 512}; pg8::MoeOrder S{ntiles, G, bid, texp};
        pg8::EpiMoe1 E{(unsigned char*)HM};
        pg8::gemm_phase<pg8::EpiMoe1, pg8::MoeOrder, true, true>(lds, g, S, E, LISTS + 16384);
    }
    }
    GRID_BAR();
    STAMP(12);
    { DECL_PTRS
    {
        pg8::Gemm g{HM  , WE2, 256, 256, 256}; pg8::MoeOrder S{ntiles, G, bid, texp};
        pg8::EpiBf E{XB, 1024, 0.03125f};
        pg8::gemm_phase<pg8::EpiBf, pg8::MoeOrder, false, true>(lds, g, S, E);
    }
    }
    GRID_BAR();
    STAMP(13);

    { DECL_PTRS
    {
        const bf16_t* YB = XB;
        for (int row = gw; row < T; row += NGW) {
            const int b = row >> 12; const float* gt2 = MOD + (size_t)b * 6144 + 5120;
            const int4 ti = *(const int4*)(TOKINFO + (size_t)row * 4);
            const size_t r0 = (size_t)ti.x, r1 = (size_t)ti.y;
            const float w0 = __int_as_float(ti.z), w1 = __int_as_float(ti.w);
            f32x4 v[4]; float s = 0.f;
#pragma unroll
            for (int j = 0; j < 4; ++j) { const int c0 = 4 * lane + 256 * j;
                const f32x4 xv = *(const f32x4*)(X1 + (size_t)row * D + c0), gv = *(const f32x4*)(gt2 + c0);
                const u32x2 y0 = *(const u32x2*)(YB + r0 * D + c0), y1 = *(const u32x2*)(YB + r1 * D + c0);
                f32x4 mo; mo[0] = w0 * bflo(y0.x) + w1 * bflo(y1.x); mo[1] = w0 * bfhi(y0.x) + w1 * bfhi(y1.x); mo[2] = w0 * bflo(y0.y) + w1 * bflo(y1.y); mo[3] = w0 * bfhi(y0.y) + w1 * bfhi(y1.y);
                v[j] = xv + gv * mo; s += (v[j][0] * v[j][0] + v[j][1] * v[j][1]) + (v[j][2] * v[j][2] + v[j][3] * v[j][3]); }
            const float rstd = rsqrtf(wave_sum(s) * (1.f / D) + EPS);
#pragma unroll
            for (int j = 0; j < 4; ++j) { const int c0 = 4 * lane + 256 * j; const f32x4 fg = *(const f32x4*)(a.in[I_FNG] + c0); *(f32x4*)(X1 + (size_t)row * D + c0) = v[j] * rstd * fg; }
        }
    }
    }
    STAMP(14);
    if (PROBE_PHASE >= 0 && blockIdx.x == 0 && threadIdx.x == 0) { const unsigned long long t0_ = __builtin_amdgcn_s_memrealtime(); while (__builtin_amdgcn_s_memrealtime() - t0_ < spin_) __builtin_amdgcn_s_sleep(8); }
}

extern "C" void kernel_launch(void* const* d_in, const int* in_sizes, int n_in, void* d_out, int out_size, void* d_ws, size_t ws_size, hipStream_t stream) {
    static int grid = 0;
    if (grid == 0) {
        if (n_in != 31 || out_size != T * D || ws_size < WS_END) { fprintf(stderr, "kernel_launch: unexpected shapes: n_in %d out %d ws %zu (need %zu)\n", n_in, out_size, ws_size, (size_t)WS_END); grid = -1; return; }
        int dev = 0, cus = 0, per_cu = 0;
        if (hipGetDevice(&dev) != hipSuccess || hipDeviceGetAttribute(&cus, hipDeviceAttributeMultiprocessorCount, dev) != hipSuccess) { grid = -1; return; }
        if (hipFuncSetAttribute((const void*)fwd_kernel, hipFuncAttributeMaxDynamicSharedMemorySize, LDS_BYTES) != hipSuccess) { fprintf(stderr, "kernel_launch: hipFuncSetAttribute failed\n"); grid = -1; return; }
        if (hipOccupancyMaxActiveBlocksPerMultiprocessor(&per_cu, (const void*)fwd_kernel, 512, LDS_BYTES) != hipSuccess || per_cu < 1) { fprintf(stderr, "kernel_launch: occupancy query says %d blocks per CU\n", per_cu); grid = -1; return; }
        grid = cus;
        fprintf(stderr, "kernel_launch: cus %d per_cu %d grid %d ws %zu\n", cus, per_cu, grid, ws_size);
    }
    if (grid < 0) return;
    Args a{};
    for (int i = 0; i < 31; ++i) a.in[i] = (const float*)d_in[i];
    a.out = (float*)d_out; a.ws = (unsigned char*)d_ws;
    void* args[] = {&a};
    const hipError_t e = hipLaunchCooperativeKernel((const void*)fwd_kernel, dim3(grid), dim3(512), args, LDS_BYTES, stream);
    if (e != hipSuccess) fprintf(stderr, "kernel_launch: cooperative launch failed: %s (grid %d)\n", hipGetErrorString(e), grid);
}
```

```cpp
#ifndef PROBE_PHASE
#define PROBE_PHASE -1
#endif
#ifndef REPMASK
#define REPMASK 0
#endif
#include <hip/hip_runtime.h>
#include <hip/hip_cooperative_groups.h>
#include <cstdio>
#include <cstdint>
namespace cg = cooperative_groups;

#define LAS __attribute__((address_space(3)))
typedef unsigned short bf16_t;
typedef short bf16x8 __attribute__((ext_vector_type(8)));
typedef float f32x4 __attribute__((ext_vector_type(4)));
typedef unsigned u32x4 __attribute__((ext_vector_type(4)));
typedef unsigned u32x2 __attribute__((ext_vector_type(2)));

constexpr int BATCH = 8, SEQ = 4096, D = 1024, T = BATCH * SEQ, CTXL = 256, TC = BATCH * CTXL, MT = T + TC;
constexpr int NH = 4, DK = 128, DV = 256, TOKP = SEQ + CTXL;
constexpr int NINA = 4608;
constexpr int NE = 32, EH = 512;
constexpr float EPS = 1e-6f;
constexpr int LDS_BYTES = 163840;
constexpr int MISC_OFF = 131072;

constexpr size_t MiB = 1u << 20;
constexpr size_t WS_CTL = 0, CTL_BYTES = 65536;
constexpr size_t WS_MOD = 65536;
constexpr size_t WS_ROPE = 327680;
constexpr size_t WS_BINP = 344064;
constexpr size_t WS_FPART = 524288;
constexpr size_t WS_TOKINFO = 2 * MiB;
constexpr size_t WS_LISTS = 3 * MiB;
constexpr size_t WS_TR = 8 * MiB;
constexpr size_t WS_WT_IN = 16 * MiB;
constexpr size_t WS_WT_RETO = 29 * MiB, WS_WT_HYO = 31 * MiB, WS_WT_OUT = 32 * MiB;
constexpr size_t WS_R1 = 34 * MiB;
constexpr size_t WS_Q = WS_R1, WS_K = WS_R1 + 32 * MiB, WS_KT = WS_R1 + 66 * MiB, WS_VT = WS_R1 + 100 * MiB;
constexpr size_t WS_FILT = WS_R1;
constexpr size_t WS_SGR = WS_R1, WS_SGH = WS_R1 + 64 * MiB;
constexpr size_t WS_XB = WS_R1;
constexpr size_t WS_SG = 202 * MiB;
constexpr size_t WS_HU = 266 * MiB;
constexpr size_t WS_KV = 362 * MiB;
constexpr size_t WS_WE13 = 362 * MiB, WS_WE2 = 426 * MiB;
constexpr size_t WS_END = 494 * MiB;
constexpr size_t DO_XN = 0, DO_ZT = 64 * MiB, DO_XN8 = 96 * MiB;

__device__ __forceinline__ unsigned f2bf(float f) { unsigned u = __float_as_uint(f); return (u + 0x7fffu + ((u >> 16) & 1u)) >> 16; }
__device__ __forceinline__ unsigned pk2(float lo, float hi) { return f2bf(lo) | (f2bf(hi) << 16); }
__device__ __forceinline__ float bflo(unsigned w) { return __uint_as_float(w << 16); }
__device__ __forceinline__ float bfhi(unsigned w) { return __uint_as_float(w & 0xffff0000u); }
__device__ __forceinline__ float bf2f(bf16_t h) { return __uint_as_float((unsigned)h << 16); }
__device__ __forceinline__ float silu_f(float v) { return v / (1.f + __expf(-v)); }
__device__ __forceinline__ float sigm_f(float v) { return 1.f / (1.f + __expf(-v)); }
__device__ __forceinline__ float wave_sum(float v) {
#pragma unroll
    for (int o = 1; o < 64; o <<= 1) v += __shfl_xor(v, o);
    return v;
}
__host__ __device__ __forceinline__ int dimperm(int p) { const int wc = p >> 5, n = (p >> 4) & 1, i16 = p & 15; return 64 * (wc >> 1) + 32 * n + 16 * (wc & 1) + i16; }
__host__ __device__ __forceinline__ int inv_dimperm(int d) { const int half = d >> 6, n = (d >> 5) & 1, idx = d & 31; return 32 * (2 * half + (idx >> 4)) + 16 * n + (idx & 15); }
__host__ __device__ __forceinline__ int win_destrow(int n) { return n < 1024 ? (n & ~127) + inv_dimperm(n & 127) : n; }

namespace pg8 {
constexpr int BM = 256, BK = 64, HALF = 128, HTB = HALF * BK * 2, STAGE_BYTES = 8 * HTB, NXCD = 8, WGM = 8;
__host__ __device__ __forceinline__ int lds_byte(int r, int c) { const int st = (r >> 4) * 2 + (c >> 5), rr = r & 15, cc = c & 31, ob = rr * 64 + cc * 2; return st * 1024 + (ob ^ (((ob >> 9) & 1) << 5)); }
__host__ __device__ __forceinline__ void stage_rc(int b, int& R, int& C) { const int st = b / 1024, sb = b % 1024, swz = sb ^ (((sb >> 9) & 1) << 5); R = (st >> 1) * 16 + swz / 64; C = (st & 1) * 32 + (swz % 64) / 2; }
__host__ __device__ __forceinline__ int perm32(int rho) { const int n = rho >> 4, i = rho & 15; return 8 * (i >> 2) + 4 * n + (i & 3); }

struct Unit { int pm, pn, pc; };
struct Gemm { const bf16_t* A; const bf16_t* Bt; int K, lda, ldb; };

struct StaticOrder {
    int nM, nN, nwg, G, c;
    __device__ void init(int M, int N, int G_, int c_) { nM = M / BM; nN = N / BM; nwg = nM * nN; G = G_; c = c_; }
    __device__ bool next(int i, Unit& u) const {
        const long L = (long)i * G + c; if (L >= nwg) return false;
        int wgid = (int)L; { const int q = nwg / NXCD, r = nwg % NXCD, xcd = wgid % NXCD, off = wgid / NXCD; wgid = (xcd < r ? xcd * (q + 1) : r * (q + 1) + (xcd - r) * q) + off; }
        const int nig = WGM * nN, gid = wgid / nig, fm = gid * WGM, gsz = (nM - fm) < WGM ? (nM - fm) : WGM;
        u.pm = fm + ((wgid % nig) % gsz); u.pn = (wgid % nig) / gsz; u.pc = u.pn; return true;
    }
};
struct InProjOrder {
    StaticOrder so; int G, c;
    __device__ void init(int G_, int c_) { so.init(T, NINA, G_, c_); G = G_; c = c_; }
    __device__ bool next(int i, Unit& u) const {
        const long L = (long)i * G + c;
        if (L < so.nwg) return so.next(i, u);
        const int l = (int)(L - so.nwg); if (l >= 48) return false;
        u.pm = 128 + (l & 7); u.pn = 2 + (l >> 3); u.pc = u.pn; return true;
    }
};
struct MoeOrder {
    int ntiles, G, c; const LAS int* texp;
    __device__ bool next(int i, Unit& u) const {
        const long L = (long)i * G + c; if (L >= (long)ntiles * 4) return false;
        const int full = (ntiles >> 3) * 32, l = (int)L;
        if (l < full) { u.pm = (l >> 5) * 8 + (l & 7); u.pc = (l & 31) >> 3; } else { u.pm = (ntiles & ~7) + ((l - full) >> 2); u.pc = (l - full) & 3; }
        u.pn = texp[u.pm] * 4 + u.pc; return true;
    }
};

__device__ __forceinline__ unsigned cvt_pk_bf16(float lo, float hi) { unsigned r; asm volatile("v_cvt_pk_bf16_f32 %0, %1, %2" : "=v"(r) : "v"(lo), "v"(hi)); return r; }

typedef int v8i __attribute__((ext_vector_type(8)));
__device__ __forceinline__ unsigned pk_fp8x4(float a, float b, float c, float d) { int w = 0; w = __builtin_amdgcn_cvt_pk_fp8_f32(a, b, w, false); w = __builtin_amdgcn_cvt_pk_fp8_f32(c, d, w, true); return (unsigned)w; }
template <class Epi, class Sched, bool GATHER = false, bool FP8 = false>
__device__ __forceinline__ void gemm_phase(LAS unsigned char* lds, const Gemm g, const Sched& S, const Epi& E, const int* rowidx = nullptr) {
    int tid = threadIdx.x; asm volatile("" : "+v"(tid));
    const int wid = __builtin_amdgcn_readfirstlane(tid >> 6), lane = tid & 63, wr = wid >> 2, wc = wid & 3, fr = lane & 15, fq = lane >> 4;
    const int K = g.K; int nt = K / BK; asm volatile("" : "+s"(nt));
    int Ra[2], Ca[2]; unsigned voffA[2], voffB[2];
#pragma unroll
    for (int i = 0; i < 2; ++i) { int R, C; stage_rc(tid * 16 + i * 8192, R, C); const int Rb = Epi::PERM ? ((R & ~31) + perm32(R & 31)) : R;
        Ra[i] = R; Ca[i] = C; voffA[i] = (unsigned)(R * g.lda + C) * 2u; voffB[i] = (unsigned)(Rb * g.ldb + C) * 2u; }
    const size_t hstepA = (size_t)HALF * g.lda * 2, tstepA = 2 * hstepA;
    const size_t kstep = (size_t)(BK * 2);
    const size_t hstepB = (size_t)HALF * g.ldb * 2, tstepB = 2 * hstepB;
    const unsigned ldsw = (unsigned)wid * 1024u;
    const int aoff = lds_byte(wr * 64 + fr, fq * 8), boff = lds_byte(wc * 32 + fr, fq * 8);
#define PG8_AOFF(dst, u) do { _Pragma("unroll") for (int _h = 0; _h < 2; ++_h) _Pragma("unroll") for (int _i = 0; _i < 2; ++_i) { int _row = (u).pm * BM + _h * HALF + Ra[_i]; if (GATHER) _row = rowidx[_row]; \
        dst[_h][_i] = (unsigned)(_row * g.lda + Ca[_i]) * 2u; } } while (0)
#define PG8_SA(b, h) (((b) * 2 + (h)) * HTB)
#define PG8_SB(b, h) ((4 + (b) * 2 + (h)) * HTB)
#define PG8_STAGE(bufoff, gbase, voff) do { _Pragma("unroll") for (int _i = 0; _i < 2; ++_i) \
        __builtin_amdgcn_global_load_lds((const unsigned*)((const char*)(gbase) + (voff)[_i]), (LAS unsigned*)(lds + (bufoff) + ldsw + _i * 8192), 16, 0, 0); } while (0)
#define PG8_STAGE_A(bufoff, ubase, vsel, h, kb) do { if constexpr (GATHER) { PG8_STAGE(bufoff, gA + (kb), (vsel)[h]); } else { PG8_STAGE(bufoff, (ubase) + (size_t)(h) * hstepA + (kb), voffA); } } while (0)
#define PG8_LD8(p) ({ const u32x4 _lo = *(const LAS u32x4*)(p), _hi = *(const LAS u32x4*)((p) + 1024); v8i _r; _r[0] = (int)_lo.x; _r[1] = (int)_lo.y; _r[2] = (int)_lo.z; _r[3] = (int)_lo.w; _r[4] = (int)_hi.x; _r[5] = (int)_hi.y; _r[6] = (int)_hi.z; _r[7] = (int)_hi.w; _r; })
#define PG8_LDA(dst, b, h) do { _Pragma("unroll") for (int m = 0; m < 4; ++m) dst[m] = PG8_LD8(lds + PG8_SA(b, h) + aoff + m * 2048); } while (0)
#define PG8_LDB(dst, b, h) do { _Pragma("unroll") for (int n = 0; n < 2; ++n) dst[n] = PG8_LD8(lds + PG8_SB(b, h) + boff + n * 2048); } while (0)
#define PG8_LO(v) __builtin_bit_cast(bf16x8, __builtin_shufflevector(v, v, 0, 1, 2, 3))
#define PG8_HI(v) __builtin_bit_cast(bf16x8, __builtin_shufflevector(v, v, 4, 5, 6, 7))
#define PG8_MMA(ai, bj, At, Bt) do { __builtin_amdgcn_s_setprio(1); _Pragma("unroll") for (int m = 0; m < 4; ++m) _Pragma("unroll") for (int n = 0; n < 2; ++n) { \
        if constexpr (FP8) { asm volatile("v_mfma_scale_f32_16x16x128_f8f6f4 %0, %1, %2, %0, %3, %3 op_sel_hi:[0,0,0]" : "+v"(acc[ai][bj][m][n]) : "v"(Bt[n]), "v"(At[m]), "v"(one_scale)); } \
        else { acc[ai][bj][m][n] = __builtin_amdgcn_mfma_f32_16x16x32_bf16(PG8_LO(Bt[n]), PG8_LO(At[m]), acc[ai][bj][m][n], 0, 0, 0); \
               acc[ai][bj][m][n] = __builtin_amdgcn_mfma_f32_16x16x32_bf16(PG8_HI(Bt[n]), PG8_HI(At[m]), acc[ai][bj][m][n], 0, 0, 0); } } __builtin_amdgcn_s_setprio(0); } while (0)
#define PG8_WAIT_V(n) asm volatile("s_waitcnt vmcnt(" #n ")" ::: "memory")
#define PG8_WAIT_L(n) asm volatile("s_waitcnt lgkmcnt(" #n ")" ::: "memory")
#define PG8_BAR __builtin_amdgcn_s_barrier()
#define PG8_SCHED __builtin_amdgcn_sched_barrier(0)
    Unit cur, nxt; int ui = 0;
    if (!S.next(0, cur)) return;
    f32x4 acc[2][2][4][2];
#pragma unroll
    for (int a = 0; a < 2; ++a)
#pragma unroll
        for (int b = 0; b < 2; ++b)
#pragma unroll
            for (int m = 0; m < 4; ++m)
#pragma unroll
                for (int n = 0; n < 2; ++n) { acc[a][b][m][n] = (f32x4){0.f, 0.f, 0.f, 0.f}; }
    v8i At[4], B0[2], B1[2];
    int one_scale = 0x7f7f7f7f; asm volatile("" : "+v"(one_scale)); (void)one_scale;
    unsigned vA[2][2], nvA[2][2];
    if constexpr (GATHER) PG8_AOFF(vA, cur);
    const char* gA = (const char*)g.A;
    const char* cA = gA + (size_t)cur.pm * tstepA;
    const char* cB = (const char*)g.Bt + (size_t)cur.pn * tstepB;
    PG8_STAGE(PG8_SB(0, 0), cB, voffB); PG8_STAGE(PG8_SB(0, 1), cB + hstepB, voffB); PG8_STAGE_A(PG8_SA(0, 0), cA, vA, 0, 0); PG8_STAGE_A(PG8_SA(0, 1), cA, vA, 1, 0);
    if (wr == 1) PG8_BAR;
    PG8_WAIT_V(2); PG8_BAR;
    PG8_STAGE(PG8_SB(1, 0), cB + kstep, voffB); PG8_STAGE_A(PG8_SA(1, 0), cA, vA, 0, kstep); PG8_STAGE(PG8_SB(1, 1), cB + hstepB + kstep, voffB);
    PG8_WAIT_V(6); PG8_BAR;
    for (;;) {
        const bool has_next = S.next(ui + 1, nxt);
        if constexpr (GATHER) { if (has_next) { PG8_AOFF(nvA, nxt); } else {
#pragma unroll
            for (int h = 0; h < 2; ++h)
#pragma unroll
                for (int i = 0; i < 2; ++i) nvA[h][i] = vA[h][i]; } }
        const char* nA = has_next ? gA + (size_t)nxt.pm * tstepA : cA;
        const char* nB = has_next ? (const char*)g.Bt + (size_t)nxt.pn * tstepB : cB;
#pragma unroll 1
        for (int t = 0; t < nt; t += 2) {
            const bool last = (t == nt - 2);
            const size_t k1 = (size_t)(t + 1) * kstep, k2 = last ? 0 : (size_t)(t + 2) * kstep, k3 = k2 + kstep;
            const char* u2 = last ? nA : cA; const char* b2 = last ? nB : cB + (size_t)(t + 2) * kstep; const char* b3 = b2 + kstep;
            unsigned v2[2][2];
            if constexpr (GATHER) {
#pragma unroll
                for (int h = 0; h < 2; ++h)
#pragma unroll
                    for (int i = 0; i < 2; ++i) v2[h][i] = last ? nvA[h][i] : vA[h][i]; }
            PG8_LDB(B0, 0, 0); PG8_LDB(B1, 0, 1); PG8_SCHED; PG8_LDA(At, 0, 0); PG8_STAGE_A(PG8_SA(1, 1), cA, vA, 1, k1);
            PG8_WAIT_V(8); PG8_WAIT_L(0); PG8_BAR; PG8_MMA(0, 0, At, B0); PG8_MMA(0, 1, At, B1); PG8_BAR; PG8_SCHED;
            PG8_LDA(At, 0, 1); PG8_STAGE(PG8_SB(0, 0), b2, voffB); PG8_STAGE(PG8_SB(0, 1), b2 + hstepB, voffB); PG8_STAGE_A(PG8_SA(0, 0), u2, v2, 0, k2);
            PG8_WAIT_V(8); PG8_WAIT_L(0); PG8_BAR; PG8_MMA(1, 0, At, B0); PG8_MMA(1, 1, At, B1); PG8_BAR; PG8_SCHED;
            PG8_LDB(B0, 1, 0); PG8_LDB(B1, 1, 1); PG8_SCHED; PG8_LDA(At, 1, 0); PG8_STAGE_A(PG8_SA(0, 1), u2, v2, 1, k2);
            PG8_WAIT_V(8); PG8_WAIT_L(0); PG8_BAR; PG8_MMA(0, 0, At, B0); PG8_MMA(0, 1, At, B1); PG8_BAR; PG8_SCHED;
            PG8_LDA(At, 1, 1); PG8_STAGE(PG8_SB(1, 0), b3, voffB); PG8_STAGE(PG8_SB(1, 1), b3 + hstepB, voffB); PG8_STAGE_A(PG8_SA(1, 0), u2, v2, 0, k3);
            PG8_WAIT_V(8); PG8_WAIT_L(0); PG8_BAR; PG8_MMA(1, 0, At, B0); PG8_MMA(1, 1, At, B1); PG8_BAR; PG8_SCHED;
        }
        if (wr == 0) PG8_BAR;
        if constexpr (FP8) asm volatile("s_nop 15\n\ts_nop 15" ::: "memory");
        E(acc, cur, wr, wc, fr, fq);
        if (!has_next) break;
#pragma unroll
        for (int a = 0; a < 2; ++a)
#pragma unroll
            for (int b = 0; b < 2; ++b)
#pragma unroll
                for (int m = 0; m < 4; ++m)
#pragma unroll
                    for (int n = 0; n < 2; ++n) { acc[a][b][m][n] = (f32x4){0.f, 0.f, 0.f, 0.f}; }
        cur = nxt; cA = nA; cB = nB; ++ui;
        if constexpr (GATHER) {
#pragma unroll
            for (int h = 0; h < 2; ++h)
#pragma unroll
                for (int i = 0; i < 2; ++i) vA[h][i] = nvA[h][i]; }
        if (wr == 1) PG8_BAR;
    }
    PG8_WAIT_V(0);
    PG8_BAR;
#undef PG8_AOFF
#undef PG8_SA
#undef PG8_SB
#undef PG8_STAGE
#undef PG8_LDA
#undef PG8_LDB
#undef PG8_STAGE_A
#undef PG8_LD8
#undef PG8_LO
#undef PG8_HI
#undef PG8_MMA
#undef PG8_WAIT_V
#undef PG8_WAIT_L
#undef PG8_BAR
#undef PG8_SCHED
}

__device__ __forceinline__ void st_bf4(bf16_t* p, f32x4 v) { u32x2 w; w.x = cvt_pk_bf16(v[0], v[1]); w.y = cvt_pk_bf16(v[2], v[3]); *(u32x2*)p = w; }
__device__ __forceinline__ void st_bf8(bf16_t* p, f32x4 v0, f32x4 v1) { u32x4 w; w.x = cvt_pk_bf16(v0[0], v0[1]); w.y = cvt_pk_bf16(v0[2], v0[3]); w.z = cvt_pk_bf16(v1[0], v1[1]); w.w = cvt_pk_bf16(v1[2], v1[3]); *(u32x4*)p = w; }

struct EpiInA {
    static constexpr bool PERM = false;
    bf16_t *Q, *Kn, *KT, *VT, *SG, *HU; const float* binp; const float* rope;
    __device__ __forceinline__ void operator()(const f32x4 (&acc)[2][2][4][2], const Unit& u, int wr, int wc, int fr, int fq) const {
        const int pc = u.pc, rbase = u.pm * BM + wr * 64 + fr, cbase = pc * BM + wc * 32 + 4 * fq;
        f32x4 bv[2][2];
#pragma unroll
        for (int bj = 0; bj < 2; ++bj)
#pragma unroll
            for (int n = 0; n < 2; ++n) bv[bj][n] = *(const f32x4*)(binp + cbase + bj * HALF + n * 16);
        const bool lat = u.pm < 128;
        const int bidx = lat ? (u.pm >> 4) : (u.pm - 128);
        if (pc < 4) {
            const bool isk = pc >= 2; const float ks = isk ? 0.08838834764831845f : 1.f;
            const int h0 = (pc & 1) * 2;
#pragma unroll
            for (int ai = 0; ai < 2; ++ai)
#pragma unroll
                for (int m = 0; m < 4; ++m) {
                    const int r = rbase + ai * HALF + m * 16, t = r & 4095;
                    const int tok = lat ? t : 4096 + ((r - T) & 255);
                    f32x4 cs = (f32x4){1.f, 1.f, 1.f, 1.f}, sn = (f32x4){0.f, 0.f, 0.f, 0.f};
                    if (lat) { const int pos = (wc >> 1) ? (t & 63) : (t >> 6); const float* rp = rope + pos * 32 + 16 * (wc & 1) + 4 * fq; cs = *(const f32x4*)rp; sn = *(const f32x4*)(rp + 2048); }
#pragma unroll
                    for (int bj = 0; bj < 2; ++bj) {
                        const f32x4 x1 = acc[ai][bj][m][0] + bv[bj][0], x2 = acc[ai][bj][m][1] + bv[bj][1];
                        const f32x4 o1 = (x1 * cs - x2 * sn) * ks, o2 = (x1 * sn + x2 * cs) * ks;
                        const int col = (pc & 1) * BM + bj * HALF + wc * 32 + 4 * fq;
                        if (!isk) { st_bf4(Q + (size_t)r * 512 + col, o1); st_bf4(Q + (size_t)r * 512 + col + 16, o2); }
                        else {
                            st_bf4(Kn + (size_t)r * 512 + col, o1); st_bf4(Kn + (size_t)r * 512 + col + 16, o2);
                            bf16_t* kt = KT + ((size_t)((bidx * 4 + h0 + bj) * 128 + wc * 32 + 4 * fq)) * TOKP + tok;
#pragma unroll
                            for (int e = 0; e < 4; ++e) { kt[(size_t)e * TOKP] = (bf16_t)f2bf(o1[e]); kt[(size_t)(16 + e) * TOKP] = (bf16_t)f2bf(o2[e]); }
                        }
                    }
                }
        } else if (pc < 8) {
            const int h = pc - 4;
#pragma unroll
            for (int ai = 0; ai < 2; ++ai)
#pragma unroll
                for (int m = 0; m < 4; ++m) {
                    const int r = rbase + ai * HALF + m * 16;
                    const int tok = lat ? (r & 4095) : 4096 + ((r - T) & 255);
#pragma unroll
                    for (int bj = 0; bj < 2; ++bj)
#pragma unroll
                        for (int n = 0; n < 2; ++n) {
                            const f32x4 v = acc[ai][bj][m][n] + bv[bj][n];
                            bf16_t* vt = VT + ((size_t)((bidx * 4 + h) * 256 + bj * HALF + wc * 32 + n * 16 + 4 * fq)) * TOKP + tok;
#pragma unroll
                            for (int e = 0; e < 4; ++e) vt[(size_t)e * TOKP] = (bf16_t)f2bf(v[e]);
                        }
                }
        } else {
            const bool isg = pc < 12;
            bf16_t* O = isg ? SG : HU; const int ldo = isg ? 1024 : 1536; const int c0 = (isg ? pc - 8 : pc - 12) * BM + wc * 32 + 4 * fq;
#pragma unroll
            for (int ai = 0; ai < 2; ++ai)
#pragma unroll
                for (int m = 0; m < 4; ++m) {
                    const int r = rbase + ai * HALF + m * 16;
#pragma unroll
                    for (int bj = 0; bj < 2; ++bj)
#pragma unroll
                        for (int n = 0; n < 2; ++n) {
                            f32x4 v = acc[ai][bj][m][n] + bv[bj][n];
                            if (isg) { v[0] = silu_f(v[0]); v[1] = silu_f(v[1]); v[2] = silu_f(v[2]); v[3] = silu_f(v[3]); }
                            st_bf4(O + (size_t)r * ldo + c0 + bj * HALF + n * 16, v);
                        }
                }
        }
    }
};
struct EpiGate {
    static constexpr bool PERM = true;
    bf16_t* O; const float* bias; float scale;
    __device__ __forceinline__ void operator()(const f32x4 (&acc)[2][2][4][2], const Unit& u, int wr, int wc, int fr, int fq) const {
        const int rbase = u.pm * BM + wr * 64 + fr, col0 = u.pc * BM + wc * 32 + 8 * fq;
        f32x4 bv[2][2];
#pragma unroll
        for (int bj = 0; bj < 2; ++bj)
#pragma unroll
            for (int n = 0; n < 2; ++n) bv[bj][n] = *(const f32x4*)(bias + col0 + bj * HALF + 4 * n);
#pragma unroll
        for (int ai = 0; ai < 2; ++ai)
#pragma unroll
            for (int m = 0; m < 4; ++m) { bf16_t* rowp = O + (size_t)(rbase + ai * HALF + m * 16) * 1024 + col0;
#pragma unroll
                for (int bj = 0; bj < 2; ++bj) { f32x4 v0 = acc[ai][bj][m][0] * scale + bv[bj][0], v1 = acc[ai][bj][m][1] * scale + bv[bj][1];
#pragma unroll
                    for (int e = 0; e < 4; ++e) { v0[e] = sigm_f(v0[e]); v1[e] = sigm_f(v1[e]); }
                    st_bf8(rowp + bj * HALF, v0, v1); } }
    }
};
template <int MODE> struct EpiMerge {
    static constexpr bool PERM = true;
    bf16_t* O; const bf16_t* P;
    __device__ __forceinline__ void operator()(const f32x4 (&acc)[2][2][4][2], const Unit& u, int wr, int wc, int fr, int fq) const {
        const int rbase = u.pm * BM + wr * 64 + fr, col0 = u.pc * BM + wc * 32 + 8 * fq;
#pragma unroll
        for (int ai = 0; ai < 2; ++ai)
#pragma unroll
            for (int m = 0; m < 4; ++m) { const size_t off = (size_t)(rbase + ai * HALF + m * 16) * 1024 + col0;
#pragma unroll
                for (int bj = 0; bj < 2; ++bj) {
                    const u32x4 gw = *(const u32x4*)(O + off + bj * HALF);
                    f32x4 v0 = acc[ai][bj][m][0], v1 = acc[ai][bj][m][1];
                    v0[0] *= bflo(gw.x); v0[1] *= bfhi(gw.x); v0[2] *= bflo(gw.y); v0[3] *= bfhi(gw.y);
                    v1[0] *= bflo(gw.z); v1[1] *= bfhi(gw.z); v1[2] *= bflo(gw.w); v1[3] *= bfhi(gw.w);
                    if (MODE == 1) { const u32x4 pw = *(const u32x4*)(P + off + bj * HALF);
                        v0[0] += bflo(pw.x); v0[1] += bfhi(pw.x); v0[2] += bflo(pw.y); v0[3] += bfhi(pw.y);
                        v1[0] += bflo(pw.z); v1[1] += bfhi(pw.z); v1[2] += bflo(pw.w); v1[3] += bfhi(pw.w); }
                    st_bf8(O + off + bj * HALF, v0, v1); } }
    }
};
struct EpiX1 {
    static constexpr bool PERM = false;
    const float* x; const float* mod; float* out;
    __device__ __forceinline__ void operator()(const f32x4 (&acc)[2][2][4][2], const Unit& u, int wr, int wc, int fr, int fq) const {
        const int rbase = u.pm * BM + wr * 64 + fr, col0 = u.pc * BM + wc * 32 + 4 * fq;
        const float* gt = mod + (size_t)(u.pm >> 4) * 6144 + 2048 + col0;
        f32x4 gv[2][2];
#pragma unroll
        for (int bj = 0; bj < 2; ++bj)
#pragma unroll
            for (int n = 0; n < 2; ++n) gv[bj][n] = *(const f32x4*)(gt + bj * HALF + n * 16);
#pragma unroll
        for (int ai = 0; ai < 2; ++ai)
#pragma unroll
            for (int m = 0; m < 4; ++m) { const size_t off = (size_t)(rbase + ai * HALF + m * 16) * 1024 + col0;
#pragma unroll
                for (int bj = 0; bj < 2; ++bj)
#pragma unroll
                    for (int n = 0; n < 2; ++n) { const f32x4 xv = *(const f32x4*)(x + off + bj * HALF + n * 16); *(f32x4*)(out + off + bj * HALF + n * 16) = xv + gv[bj][n] * acc[ai][bj][m][n]; } }
    }
};
struct EpiMoe1 {
    static constexpr bool PERM = true;
    unsigned char* HM;
    __device__ __forceinline__ void operator()(const f32x4 (&acc)[2][2][4][2], const Unit& u, int wr, int wc, int fr, int fq) const {
        const int rbase = u.pm * BM + wr * 64 + fr, col0 = u.pc * HALF + wc * 32 + 8 * fq;
#pragma unroll
        for (int ai = 0; ai < 2; ++ai)
#pragma unroll
            for (int m = 0; m < 4; ++m) {
                f32x4 v0, v1;
#pragma unroll
                for (int e = 0; e < 4; ++e) { v0[e] = silu_f(acc[ai][0][m][0][e] * 0.03125f) * (acc[ai][1][m][0][e] * 0.03125f); v1[e] = silu_f(acc[ai][0][m][1][e] * 0.03125f) * (acc[ai][1][m][1][e] * 0.03125f); }
                u32x2 w; w.x = pk_fp8x4(v0[0], v0[1], v0[2], v0[3]); w.y = pk_fp8x4(v1[0], v1[1], v1[2], v1[3]);
                *(u32x2*)(HM + (size_t)(rbase + ai * HALF + m * 16) * EH + col0) = w; }
    }
};
struct EpiBf {
    static constexpr bool PERM = true;
    bf16_t* O; int ldo; float scale;
    __device__ __forceinline__ void operator()(const f32x4 (&acc)[2][2][4][2], const Unit& u, int wr, int wc, int fr, int fq) const {
        const int rbase = u.pm * BM + wr * 64 + fr, col0 = u.pc * BM + wc * 32 + 8 * fq;
#pragma unroll
        for (int ai = 0; ai < 2; ++ai)
#pragma unroll
            for (int m = 0; m < 4; ++m)
#pragma unroll
                for (int bj = 0; bj < 2; ++bj) st_bf8(O + (size_t)(rbase + ai * HALF + m * 16) * ldo + col0 + bj * HALF, acc[ai][bj][m][0] * scale, acc[ai][bj][m][1] * scale);
    }
};
}

namespace gt {
constexpr int STAGE_BYTES = 128 * 144 + 256 * 144;
template <int NT, int BKT, class AL, class BL>
__device__ __forceinline__ void gemm_tile(f32x4 (&acc)[4][NT], const AL& al, const BL& bl, int nk, LAS unsigned char* st, int tid) {
    constexpr int AST = (BKT + 8) * 2, PPR = BKT / 8, NA = 128 * PPR / 512, NB = 64 * NT * PPR / 512;
    const int lane = tid & 63, wid = tid >> 6, wr = wid >> 2, wc = wid & 3, fr = lane & 15, fq = lane >> 4;
    LAS unsigned char* sa = st; LAS unsigned char* sb = st + 128 * AST;
    u32x4 ra[NA], rb[NB];
#pragma unroll
    for (int i = 0; i < NA; ++i) { const int p = tid + i * 512; ra[i] = al(p / PPR, (p % PPR) * 8); }
#pragma unroll
    for (int i = 0; i < NB; ++i) { const int p = tid + i * 512; rb[i] = bl(p / PPR, (p % PPR) * 8); }
    for (int kt = 0; kt < nk; ++kt) {
        __syncthreads();
#pragma unroll
        for (int i = 0; i < NA; ++i) { const int p = tid + i * 512; *(LAS u32x4*)(sa + (p / PPR) * AST + (p % PPR) * 16) = ra[i]; }
#pragma unroll
        for (int i = 0; i < NB; ++i) { const int p = tid + i * 512; *(LAS u32x4*)(sb + (p / PPR) * AST + (p % PPR) * 16) = rb[i]; }
        __syncthreads();
        if (kt + 1 < nk) {
            int t2 = tid; asm volatile("" : "+v"(t2));
#pragma unroll
            for (int i = 0; i < NA; ++i) { const int p = t2 + i * 512; ra[i] = al(p / PPR, (kt + 1) * BKT + (p % PPR) * 8); }
#pragma unroll
            for (int i = 0; i < NB; ++i) { const int p = t2 + i * 512; rb[i] = bl(p / PPR, (kt + 1) * BKT + (p % PPR) * 8); }
        }
#pragma unroll
        for (int kk = 0; kk < BKT / 32; ++kk) {
            bf16x8 a[4], b[NT];
#pragma unroll
            for (int m = 0; m < 4; ++m) a[m] = *(const LAS bf16x8*)(sa + (wr * 64 + m * 16 + fr) * AST + kk * 64 + fq * 16);
#pragma unroll
            for (int n = 0; n < NT; ++n) b[n] = *(const LAS bf16x8*)(sb + (wc * 16 * NT + n * 16 + fr) * AST + kk * 64 + fq * 16);
#pragma unroll
            for (int m = 0; m < 4; ++m)
#pragma unroll
                for (int n = 0; n < NT; ++n) acc[m][n] = __builtin_amdgcn_mfma_f32_16x16x32_bf16(a[m], b[n], acc[m][n], 0, 0, 0);
        }
    }
    __syncthreads();
}
struct LdRows {
    const bf16_t* base; int ld;
    __device__ __forceinline__ u32x4 operator()(int row, int k) const { return *(const u32x4*)(base + (size_t)row * ld + k); }
};
__device__ __forceinline__ u32x4 scale8(u32x4 v, float s0, float s1, float s2, float s3, float s4, float s5, float s6, float s7) {
    u32x4 o; o.x = pk2(bflo(v.x) * s0, bfhi(v.x) * s1); o.y = pk2(bflo(v.y) * s2, bfhi(v.y) * s3); o.z = pk2(bflo(v.z) * s4, bfhi(v.z) * s5); o.w = pk2(bflo(v.w) * s6, bfhi(v.w) * s7); return o;
}
}


#define XB_TMO      128
#define XB_XCNT(j)  (256  + 64 * (j))
#define XB_XSUB(j)  (1280 + 64 * (j))
#define XB_XGEN(j)  (2304 + 64 * (j))
#define XB_TOP      3328
#define XB_TOPGEN   3392
#define XCD_BAR_WORDS 3456
#define XB_SPIN_CAP (1u << 18)
__device__ __forceinline__ unsigned xb_ld(unsigned* p)              { return __hip_atomic_load(p, __ATOMIC_RELAXED, __HIP_MEMORY_SCOPE_AGENT); }
__device__ __forceinline__ unsigned xb_add(unsigned* p, unsigned v) { return __hip_atomic_fetch_add(p, v, __ATOMIC_RELAXED, __HIP_MEMORY_SCOPE_AGENT); }
__device__ __forceinline__ unsigned xb_xcc_id() { return (unsigned)__builtin_amdgcn_s_getreg((3 << 11) | 20) & 0xFu; }
#define XB_SPIN(cond, bar) do { unsigned _sp = 0; while (cond) { __builtin_amdgcn_s_sleep(1); \
    if ((++_sp & 255u) == 0u) { if (xb_ld(&(bar)[XB_TMO])) break; if (_sp > XB_SPIN_CAP) { atomicAdd(&(bar)[XB_TMO], 1u); break; } } } } while (0)
struct XcdBarrier { unsigned* bar; unsigned x; volatile LAS unsigned* st; };
__device__ __forceinline__ XcdBarrier xcd_barrier_post(unsigned* bar, volatile LAS unsigned* st) {
    XcdBarrier b; b.bar = bar; b.x = xb_xcc_id(); b.st = st;
    if (threadIdx.x == 0) (void)xb_add(&bar[XB_XCNT(b.x)], 1u);
    return b;
}
__device__ __forceinline__ void xcd_barrier_complete(unsigned* bar, unsigned x, unsigned& nloc, unsigned& nx) {
    const unsigned G = gridDim.x * gridDim.y * gridDim.z;
    unsigned sum, cnt, mine, sp = 0u;
    for (;;) {
        sum = 0u; cnt = 0u; mine = 0u;
#pragma unroll
        for (unsigned j = 0; j < 16; ++j) { const unsigned c = xb_ld(&bar[XB_XCNT(j)]); sum += c; cnt += (c > 0u) ? 1u : 0u; mine = (j == x) ? c : mine; }
        if (sum == G) break;
        __builtin_amdgcn_s_sleep(1);
        if ((++sp & 255u) == 0u) { if (xb_ld(&bar[XB_TMO])) break; if (sp > XB_SPIN_CAP) { atomicAdd(&bar[XB_TMO], 1u); break; } }
    }
    nloc = mine > 0u ? mine : 1u; nx = cnt > 0u ? cnt : 1u;
}
__device__ __forceinline__ void xcd_barrier(const XcdBarrier& b) {
    asm volatile("s_waitcnt vmcnt(0)" ::: "memory");
    __syncthreads();
    if (threadIdx.x == 0) {
        unsigned* bar = b.bar;
        __builtin_amdgcn_s_waitcnt(0);
        unsigned nloc = b.st[0], nx = b.st[1];
        if (nloc == 0u) { xcd_barrier_complete(bar, b.x, nloc, nx); b.st[0] = nloc; b.st[1] = nx; }
        const unsigned old = xb_add(&bar[XB_XSUB(b.x)], 1u);
        const unsigned gen = old / nloc;
        if (old + 1u == (gen + 1u) * nloc) {
            __builtin_amdgcn_fence(__ATOMIC_RELEASE, "agent");
            asm volatile("s_waitcnt vmcnt(0)" ::: "memory");
            const unsigned og = xb_add(&bar[XB_TOP], 1u);
            const unsigned tg = og / nx;
            if (og + 1u == (tg + 1u) * nx) xb_add(&bar[XB_TOPGEN], 1u);
            else XB_SPIN(xb_ld(&bar[XB_TOPGEN]) == tg, bar);
            __builtin_amdgcn_fence(__ATOMIC_ACQUIRE, "agent");
            xb_add(&bar[XB_XGEN(b.x)], 1u);
            asm volatile("s_waitcnt vmcnt(0)" ::: "memory");
        } else {
            XB_SPIN(xb_ld(&bar[XB_XGEN(b.x)]) == gen, bar);
            __builtin_amdgcn_fence(__ATOMIC_ACQUIRE, "agent");
            asm volatile("s_waitcnt vmcnt(0)" ::: "memory");
        }
    }
    __syncthreads();
}

struct Args { const float* in[31]; float* out; unsigned char* ws; };
enum { I_X = 0, I_C, I_CTX, I_CCTX, I_ADAW, I_ADAB, I_N1G, I_N2G, I_WIN, I_BIN, I_DECAY, I_RETWO, I_HCW, I_HCB, I_HW1, I_HB1, I_HFREQ, I_HW2, I_HB2, I_HW3, I_HSKIP, I_HYWO, I_WOUT,
       I_RGW, I_RGB, I_REW, I_REB, I_EW1, I_EW3, I_EW2, I_FNG };

template <class RowMap>
__device__ __forceinline__ void transpose_item(const float* W, int N, int k0, int n0, bf16_t* WT, int ldt, const RowMap& rm, LAS float* scr, int lane) {
    const int lr = lane >> 4, lc = (lane & 15) * 4;
#pragma unroll
    for (int i = 0; i < 16; ++i) { const int kk = 4 * i + lr; const f32x4 v = *(const f32x4*)(W + (size_t)(k0 + kk) * N + n0 + lc); LAS float* s = scr + kk * 69 + lc; s[0] = v[0]; s[1] = v[1]; s[2] = v[2]; s[3] = v[3]; }
    asm volatile("s_waitcnt lgkmcnt(0)" ::: "memory");
    const int c = lane & 7;
#pragma unroll
    for (int j = 0; j < 8; ++j) { const int n = (lane >> 3) + 8 * j; const LAS float* s = scr + (8 * c) * 69 + n;
        u32x4 o; o.x = pk2(s[0 * 69], s[1 * 69]); o.y = pk2(s[2 * 69], s[3 * 69]); o.z = pk2(s[4 * 69], s[5 * 69]); o.w = pk2(s[6 * 69], s[7 * 69]);
        *(u32x4*)(WT + (size_t)rm(n0 + n) * ldt + k0 + 8 * c) = o; }
    asm volatile("s_waitcnt lgkmcnt(0)" ::: "memory");
}
using pg8::pk_fp8x4;
template <class RowMap>
__device__ __forceinline__ void transpose_item_f8(const float* W, int N, int k0, int n0, unsigned char* WT, int ldt, const RowMap& rm, float scale, LAS float* scr, int lane) {
    const int lr = lane >> 4, lc = (lane & 15) * 4;
#pragma unroll
    for (int i = 0; i < 16; ++i) { const int kk = 4 * i + lr; const f32x4 v = *(const f32x4*)(W + (size_t)(k0 + kk) * N + n0 + lc); LAS float* s = scr + kk * 69 + lc; s[0] = v[0]; s[1] = v[1]; s[2] = v[2]; s[3] = v[3]; }
    asm volatile("s_waitcnt lgkmcnt(0)" ::: "memory");
    const int c = lane & 7;
#pragma unroll
    for (int j = 0; j < 8; ++j) { const int n = (lane >> 3) + 8 * j; const LAS float* s = scr + (8 * c) * 69 + n;
        u32x2 o; o.x = pk_fp8x4(s[0 * 69] * scale, s[1 * 69] * scale, s[2 * 69] * scale, s[3 * 69] * scale); o.y = pk_fp8x4(s[4 * 69] * scale, s[5 * 69] * scale, s[6 * 69] * scale, s[7 * 69] * scale);
        *(u32x2*)(WT + (size_t)rm(n0 + n) * ldt + k0 + 8 * c) = o; }
    asm volatile("s_waitcnt lgkmcnt(0)" ::: "memory");
}
struct RmId { __device__ __forceinline__ int operator()(int n) const { return n; } };
struct RmWin { __device__ __forceinline__ int operator()(int n) const { return win_destrow(n); } };
struct RmE13 { int add; __device__ __forceinline__ int operator()(int n) const { return 256 * (n >> 7) + (n & 127) + add; } };

__device__ __forceinline__ float lg2_decay(float logit) { return -log1pf(expf(-logit)) * 1.4426950408889634f; }

__device__ __forceinline__ void short_conv8(const bf16_t* HU, int row, int t, int ch, const float* cw, const float* cb, float (&o)[8]) {
    const f32x4 b0 = *(const f32x4*)(cb + ch), b1 = *(const f32x4*)(cb + ch + 4);
#pragma unroll
    for (int e = 0; e < 4; ++e) { o[e] = b0[e]; o[4 + e] = b1[e]; }
#pragma unroll
    for (int j = 0; j < 3; ++j) {
        const int tt = t + j - 1;
        if (tt >= 0 && tt < SEQ) {
            const u32x4 v = *(const u32x4*)(HU + (size_t)(row + j - 1) * 1536 + ch);
            const f32x4 w0 = *(const f32x4*)(cw + j * 1536 + ch), w1 = *(const f32x4*)(cw + j * 1536 + ch + 4);
            o[0] += bflo(v.x) * w0[0]; o[1] += bfhi(v.x) * w0[1]; o[2] += bflo(v.y) * w0[2]; o[3] += bfhi(v.y) * w0[3];
            o[4] += bflo(v.z) * w1[0]; o[5] += bfhi(v.z) * w1[1]; o[6] += bflo(v.w) * w1[2]; o[7] += bfhi(v.w) * w1[3];
        }
    }
}


__device__ __forceinline__ void short_conv8x8(const bf16_t* HU, int row0, int t0, int ch, const float* cw, const float* cb, float (&o)[8][8]) {
    u32x4 rw[10];
#pragma unroll
    for (int r = 0; r < 10; ++r) { const int tt = t0 + r - 1; rw[r] = (u32x4){0u, 0u, 0u, 0u}; if (tt >= 0 && tt < SEQ) rw[r] = *(const u32x4*)(HU + (size_t)(row0 + r - 1) * 1536 + ch); }
    float w[3][8], bb[8];
#pragma unroll
    for (int j = 0; j < 3; ++j) { const f32x4 w0 = *(const f32x4*)(cw + j * 1536 + ch), w1 = *(const f32x4*)(cw + j * 1536 + ch + 4);
#pragma unroll
        for (int e = 0; e < 4; ++e) { w[j][e] = w0[e]; w[j][4 + e] = w1[e]; } }
    { const f32x4 b0 = *(const f32x4*)(cb + ch), b1 = *(const f32x4*)(cb + ch + 4);
#pragma unroll
      for (int e = 0; e < 4; ++e) { bb[e] = b0[e]; bb[4 + e] = b1[e]; } }
#pragma unroll
    for (int t = 0; t < 8; ++t)
#pragma unroll
        for (int e = 0; e < 8; ++e) o[t][e] = bb[e];
#pragma unroll
    for (int r = 0; r < 10; ++r) {
        float u[8]; u[0] = bflo(rw[r].x); u[1] = bfhi(rw[r].x); u[2] = bflo(rw[r].y); u[3] = bfhi(rw[r].y); u[4] = bflo(rw[r].z); u[5] = bfhi(rw[r].z); u[6] = bflo(rw[r].w); u[7] = bfhi(rw[r].w);
#pragma unroll
        for (int j = 0; j < 3; ++j) { const int t = r - j;
            if (t >= 0 && t < 8) {
#pragma unroll
                for (int e = 0; e < 8; ++e) o[t][e] += u[e] * w[j][e]; } }
    }
}

typedef const __attribute__((address_space(4))) Args CArgs;
__device__ __forceinline__ CArgs* args_ptr() { CArgs* p = (CArgs*)__builtin_amdgcn_kernarg_segment_ptr(); asm volatile("" : "+s"(p)); return p; }
#define DECL_PTRS \
    CArgs& a = *args_ptr(); unsigned char* ws = a.ws; unsigned char* dob = (unsigned char*)a.out; \
    int tid = threadIdx.x; asm volatile("" : "+v"(tid)); const int lane = tid & 63, wave = tid >> 6, gw = bid * 8 + wave; (void)lane; (void)gw; \
    int* cnt = (int*)(ws + WS_CTL); \
    float* MOD = (float*)(ws + WS_MOD); float* ROPE = (float*)(ws + WS_ROPE); float* BINP = (float*)(ws + WS_BINP); float* FPART = (float*)(ws + WS_FPART); \
    int* TOKINFO = (int*)(ws + WS_TOKINFO); int* LISTS = (int*)(ws + WS_LISTS); \
    bf16_t* TR = (bf16_t*)(ws + WS_TR); \
    bf16_t* WT_IN = (bf16_t*)(ws + WS_WT_IN); bf16_t* WT_RETO = (bf16_t*)(ws + WS_WT_RETO); bf16_t* WT_HYO = (bf16_t*)(ws + WS_WT_HYO); bf16_t* WT_OUT = (bf16_t*)(ws + WS_WT_OUT); \
    bf16_t* Qb = (bf16_t*)(ws + WS_Q); bf16_t* Kb = (bf16_t*)(ws + WS_K); bf16_t* KT = (bf16_t*)(ws + WS_KT); bf16_t* VT = (bf16_t*)(ws + WS_VT); \
    float* FILT = (float*)(ws + WS_KV); \
    bf16_t* SGR = (bf16_t*)(ws + WS_SGR); bf16_t* SGH = (bf16_t*)(ws + WS_SGH); bf16_t* XB = (bf16_t*)(ws + WS_XB); \
    bf16_t* SG = (bf16_t*)(ws + WS_SG); bf16_t* HU = (bf16_t*)(ws + WS_HU); bf16_t* HM = (bf16_t*)(ws + WS_HU); \
    bf16_t* KV = (bf16_t*)(ws + WS_KV); bf16_t* WE13 = (bf16_t*)(ws + WS_WE13); bf16_t* WE2 = (bf16_t*)(ws + WS_WE2); \
    bf16_t* XN = (bf16_t*)(dob + DO_XN); bf16_t* ZT = (bf16_t*)(dob + DO_ZT); unsigned char* XN8 = dob + DO_XN8; unsigned char* WTG8 = (unsigned char*)(ws + WS_WT_IN) + (size_t)NINA * 1024 * 2; (void)XN8; (void)WTG8; \
    float* X1 = a.out; \
    (void)cnt; (void)MOD; (void)ROPE; (void)BINP; (void)FPART; (void)TOKINFO; (void)LISTS; (void)TR; (void)WT_IN; (void)WT_RETO; (void)WT_HYO; (void)WT_OUT; (void)Qb; (void)Kb; (void)KT; (void)VT; (void)FILT; \
    (void)SGR; (void)SGH; (void)XB; (void)SG; (void)HU; (void)HM; (void)KV; (void)WE13; (void)WE2; (void)XN; (void)ZT; (void)X1;

__global__ void __launch_bounds__(512, 2) fwd_kernel(Args a_) {
    extern __shared__ __attribute__((aligned(16))) unsigned char lds_raw[];
    LAS unsigned char* lds = (LAS unsigned char*)lds_raw;
    cg::grid_group grid = cg::this_grid();
    const int G = gridDim.x, bid = blockIdx.x, NGW = G * 8;
    volatile LAS unsigned* bst = (volatile LAS unsigned*)(lds + LDS_BYTES - 16);
    if (threadIdx.x == 0) { bst[0] = 0u; bst[1] = 0u; }
    __syncthreads();
    if (blockIdx.x == 0) { unsigned* bw = (unsigned*)(args_ptr()->ws + WS_CTL) + 1024; for (int i = threadIdx.x; i < XCD_BAR_WORDS; i += 512) bw[i] = 0u; }
#define GRID_BAR() xcd_barrier(xbar)
    unsigned long long tprev_ = 0, spin_ = 0;
    if (PROBE_PHASE >= 0) tprev_ = __builtin_amdgcn_s_memrealtime();
#define STAMP(k) do { if (PROBE_PHASE >= 0 && blockIdx.x == 0 && threadIdx.x == 0) { const unsigned long long now_ = __builtin_amdgcn_s_memrealtime(); if ((k) == PROBE_PHASE) spin_ = now_ - tprev_; tprev_ = now_; } } while (0)

    { DECL_PTRS
    for (int it = bid; it < 193; it += G) {
        if (it < 192) {
            const int col0 = it * 32, kq = tid >> 5, cl = tid & 31;
            LAS float* sl = (LAS float*)(lds + 32768);
            for (int idx = tid; idx < 9 * 1024; idx += 512) { const int r = idx >> 10, k = idx & 1023; sl[k * 12 + r] = silu_f(r < 8 ? a.in[I_C][r * 1024 + k] : a.in[I_CCTX][k]); }
            __syncthreads();
            float acc9[9];
#pragma unroll
            for (int r = 0; r < 9; ++r) acc9[r] = 0.f;
#pragma unroll 8
            for (int kk = 0; kk < 64; ++kk) { const int k = kq * 64 + kk; const float w = a.in[I_ADAW][(size_t)k * 6144 + col0 + cl];
                const f32x4 s0 = *(const LAS f32x4*)(sl + k * 12), s1 = *(const LAS f32x4*)(sl + k * 12 + 4); const float s8 = sl[k * 12 + 8];
                acc9[0] += s0[0] * w; acc9[1] += s0[1] * w; acc9[2] += s0[2] * w; acc9[3] += s0[3] * w; acc9[4] += s1[0] * w; acc9[5] += s1[1] * w; acc9[6] += s1[2] * w; acc9[7] += s1[3] * w; acc9[8] += s8 * w; }
            LAS float* red = (LAS float*)lds;
#pragma unroll
            for (int r = 0; r < 9; ++r) red[(kq * 9 + r) * 32 + cl] = acc9[r];
            __syncthreads();
            if (tid < 288) { const int r = tid >> 5, c2 = tid & 31; float s = 0.f; for (int q = 0; q < 16; ++q) s += red[(q * 9 + r) * 32 + c2]; MOD[r * 6144 + col0 + c2] = s + a.in[I_ADAB][col0 + c2]; }
            __syncthreads();
        } else {
            for (int idx = tid; idx < 2048; idx += 512) { const int pos = idx >> 5, i = idx & 31; const float inv = powf(10000.f, -(float)i / 32.f); const float ang = (float)pos * inv; ROPE[idx] = cosf(ang); ROPE[2048 + idx] = sinf(ang); }
            for (int n = tid; n < 6656; n += 512) BINP[win_destrow(n)] = a.in[I_BIN][n];
        }
    }
    __syncthreads();
    {
        LAS float* scr = (LAS float*)(lds + wave * 17664);
        constexpr int I_IN = 16 * 104, I_RO = 16 * 16, I_HO = 8 * 16, I_OU = 16 * 16;
        for (int it = gw; it < I_IN + I_RO + I_HO + I_OU; it += NGW) {
            int r = it;
            if (r < I_IN) { const int nb = r % 104;
                if (nb < 72) transpose_item(a.in[I_WIN], 6656, 64 * (r / 104), 64 * nb, WT_IN, 1024, RmWin{}, scr, lane);
                else transpose_item_f8(a.in[I_WIN] + NINA, 6656, 64 * (r / 104), 64 * (nb - 72), WTG8, 1024, RmId{}, 32.f, scr, lane);
                continue; } r -= I_IN;
            if (r < I_RO) { transpose_item(a.in[I_RETWO], 1024, 64 * (r / 16), 64 * (r % 16), WT_RETO, 1024, RmId{}, scr, lane); continue; } r -= I_RO;
            if (r < I_HO) { transpose_item(a.in[I_HYWO], 1024, 64 * (r / 16), 64 * (r % 16), WT_HYO, 512, RmId{}, scr, lane); continue; } r -= I_HO;
            transpose_item(a.in[I_WOUT], 1024, 64 * (r / 16), 64 * (r % 16), WT_OUT, 1024, RmId{}, scr, lane);
        }
    }
    }
    grid.sync();
    const XcdBarrier xbar = xcd_barrier_post((unsigned*)(args_ptr()->ws + WS_CTL) + 1024, bst);
    STAMP(0);

    { DECL_PTRS
    for (int fi = bid; fi < 256; fi += G) {
        {
            const int t0 = fi * 16;
            LAS float* feats = (LAS float*)lds; LAS float* hid1 = feats + 544; LAS float* hid2 = hid1 + 1024;
            for (int idx = tid; idx < 16 * 33; idx += 512) { const int row = idx / 33, f = idx % 33; const float t = (float)(t0 + row) * (1.f / 4096.f); float v;
                if (f == 0) v = t; else { const int mb = (f - 1) & 15; const float band = 1e-4f + (float)mb * ((15.f - 1e-4f) / 15.f); const float ph = (6.283185307179586f * t) * band; v = f <= 16 ? cosf(ph) : -sinf(ph); }
                feats[idx] = v; }
            __syncthreads();
            for (int idx = tid; idx < 1024; idx += 512) { const int row = idx >> 6, j = idx & 63; float s = a.in[I_HB1][j]; for (int f = 0; f < 33; ++f) s += feats[row * 33 + f] * a.in[I_HW1][f * 64 + j]; hid1[idx] = sinf(a.in[I_HFREQ][j] * s); }
            __syncthreads();
            for (int idx = tid; idx < 1024; idx += 512) { const int row = idx >> 6, j = idx & 63; float s = a.in[I_HB2][j]; for (int k = 0; k < 64; ++k) s += hid1[row * 64 + k] * a.in[I_HW2][k * 64 + j]; hid2[j * 16 + row] = sinf(a.in[I_HFREQ][j] * s); }
            __syncthreads();
            const float slow = 4.605170185988091f / 1.5f, fast = 4.605170185988091f / 0.3f;
            for (int col = tid; col < 1024; col += 512) {
                float ac[16];
#pragma unroll
                for (int r = 0; r < 16; ++r) ac[r] = 0.f;
#pragma unroll 4
                for (int k = 0; k < 64; ++k) { const float w = a.in[I_HW3][k * 1024 + col];
#pragma unroll
                    for (int r4 = 0; r4 < 4; ++r4) { const f32x4 hv = *(const LAS f32x4*)(hid2 + k * 16 + 4 * r4); ac[4 * r4] += hv[0] * w; ac[4 * r4 + 1] += hv[1] * w; ac[4 * r4 + 2] += hv[2] * w; ac[4 * r4 + 3] += hv[3] * w; } }
                const float delta = slow + (float)(col & 511) * ((fast - slow) / 511.f); float ps = 0.f;
#pragma unroll
                for (int r = 0; r < 16; ++r) { const float t = (float)(t0 + r) * (1.f / 4096.f); ac[r] *= expf(-t * delta); ps += fabsf(ac[r]); }
#pragma unroll
                for (int r = 0; r < 4; ++r) *(f32x4*)(FILT + (size_t)col * 4096 + t0 + 4 * r) = (f32x4){ac[4 * r], ac[4 * r + 1], ac[4 * r + 2], ac[4 * r + 3]};
                FPART[fi * 1024 + col] = ps;
            }
            __syncthreads();
        }
    }
    for (int m0 = gw; m0 < MT; m0 += 2 * NGW) {
        f32x4 v[2][4]; float s[2] = {0.f, 0.f};
#pragma unroll
        for (int q = 0; q < 2; ++q) { const int m = m0 + q * NGW; const bool ok = m < MT; const bool lat = m < T;
            const float* xr = !ok ? a.in[I_X] : lat ? a.in[I_X] + (size_t)m * D : a.in[I_CTX] + (size_t)(m - T) * D;
#pragma unroll
            for (int j = 0; j < 4; ++j) { v[q][j] = *(const f32x4*)(xr + 4 * lane + 256 * j); s[q] += (v[q][j][0] * v[q][j][0] + v[q][j][1] * v[q][j][1]) + (v[q][j][2] * v[q][j][2] + v[q][j][3] * v[q][j][3]); } }
#pragma unroll
        for (int q = 0; q < 2; ++q) { const int m = m0 + q * NGW; if (m >= MT) break; const bool lat = m < T;
            const float* md = MOD + (size_t)(lat ? (m >> 12) : 8) * 6144;
            const float rstd = rsqrtf(wave_sum(s[q]) * (1.f / D) + EPS);
#pragma unroll
            for (int j = 0; j < 4; ++j) { const int c0 = 4 * lane + 256 * j; const f32x4 g = *(const f32x4*)(a.in[I_N1G] + c0), sh = *(const f32x4*)(md + c0), sc = *(const f32x4*)(md + 1024 + c0);
                const f32x4 o = (v[q][j] * rstd * g) * (sc + 1.f) + sh; u32x2 w; w.x = pk2(o[0], o[1]); w.y = pk2(o[2], o[3]); *(u32x2*)(XN + (size_t)m * D + c0) = w;
                if (lat) *(unsigned*)(XN8 + (size_t)m * D + c0) = pk_fp8x4(o[0], o[1], o[2], o[3]); } }
    }
    }
    GRID_BAR();
    STAMP(1);

    { DECL_PTRS
    for (int c = bid; c < 512; c += G) {
        LAS float* red = (LAS float*)lds;
        float p = 0.f; if (tid < 256) p = FPART[tid * 1024 + c]; else p = FPART[(tid - 256) * 1024 + 512 + c];
        p = wave_sum(p); if (lane == 0) red[wave] = p;
        __syncthreads();
        const float nf = 1.f / ((red[0] + red[1]) + (red[2] + red[3])), nb = 1.f / ((red[4] + red[5]) + (red[6] + red[7]));
        for (int i = tid; i < 8192; i += 512) { const int x = 4096 - i; float v = 0.f;
            if (x >= 0 && x < 4096) v += FILT[(size_t)c * 4096 + x] * nf;
            if (x <= 0 && x > -4096) v += FILT[(size_t)(512 + c) * 4096 - x] * nb;
            TR[(size_t)c * 8192 + i] = (bf16_t)f2bf(v); }
        __syncthreads();
    }
    __syncthreads();
    {
        pg8::Gemm g{XN, WT_IN, 1024, 1024, 1024}; pg8::InProjOrder S; S.init(G, bid);
        pg8::EpiInA E{Qb, Kb, KT, VT, SG, HU, BINP, ROPE};
        pg8::gemm_phase(lds, g, S, E);
    }
    }
    GRID_BAR();
    STAMP(2);

    { DECL_PTRS
    for (int it = bid; it < 512; it += G) {
        const int b = it >> 6, tt = (it >> 3) & 7, cc = it & 7;
        LAS bf16_t* zt = (LAS bf16_t*)lds;
        { int tl = tid; asm volatile("" : "+v"(tl));
          const int tq = tl >> 3, cg = tl & 7, c0 = cc * 64 + cg * 8, t0 = tt * 512 + tq * 8, row0 = b * SEQ + t0;
          float x1[8][8], vv[8][8];
          short_conv8x8(HU, row0, t0, 512 + c0, a.in[I_HCW], a.in[I_HCB], x1);
          short_conv8x8(HU, row0, t0, 1024 + c0, a.in[I_HCW], a.in[I_HCB], vv);
#pragma unroll
          for (int e = 0; e < 8; ++e) { u32x4 w; w.x = pk2(x1[0][e] * vv[0][e], x1[1][e] * vv[1][e]); w.y = pk2(x1[2][e] * vv[2][e], x1[3][e] * vv[3][e]); w.z = pk2(x1[4][e] * vv[4][e], x1[5][e] * vv[5][e]); w.w = pk2(x1[6][e] * vv[6][e], x1[7][e] * vv[7][e]);
              *(LAS u32x4*)(zt + (cg * 8 + e) * 520 + tq * 8) = w; } }
        __syncthreads();
#pragma unroll
        for (int i = 0; i < 8; ++i) { const int ch = wave * 8 + i; *(u32x4*)(ZT + ((size_t)(cc * 64 + ch) * 8 + b) * SEQ + tt * 512 + lane * 8) = *(const LAS u32x4*)(zt + ch * 520 + lane * 8); }
        __syncthreads();
    }
    {
        LAS float* wtab = (LAS float*)(lds + 104448);
        LAS bf16_t* ot = (LAS bf16_t*)lds;
        for (int u = bid; u < 32 * 34; u += G) {
            int tl = tid; asm volatile("" : "+v"(tl));
            const int bh = u / 34, ch = u % 34, h = bh & 3;
            const int tok0 = ch == 0 ? 4096 : ch == 1 ? 4224 : (ch - 2) * 128;
            const int slf = ch, slb = ch == 0 ? 1 : ch == 1 ? 0 : 35 - ch;
            if (tl < 256) { const int dir = tl >> 7, j = tl & 127; wtab[tl] = exp2f((float)(dir == 0 ? 127 - j : j) * lg2_decay(a.in[I_DECAY][dir * 4 + h])); }
            __syncthreads();
            struct LdKTw { const bf16_t* base; const LAS float* w;
                __device__ __forceinline__ u32x4 operator()(int row, int k) const { const u32x4 v = *(const u32x4*)(base + (size_t)(row & 127) * TOKP + k); const LAS float* wp = w + (row >> 7) * 128 + k;
                    const f32x4 w0 = *(const LAS f32x4*)wp, w1 = *(const LAS f32x4*)(wp + 4);
                    return gt::scale8(v, w0[0], w0[1], w0[2], w0[3], w1[0], w1[1], w1[2], w1[3]); } };
            const LdKTw bl{KT + (size_t)bh * 128 * TOKP + tok0, wtab};
            const int wr = tl >> 8, wc = (tl >> 6) & 3, fr = tl & 15, fq = (tl >> 4) & 3;
            for (int mt = 0; mt < 2; ++mt) {
                f32x4 acc[4][4];
#pragma unroll
                for (int m = 0; m < 4; ++m)
#pragma unroll
                    for (int n = 0; n < 4; ++n) acc[m][n] = (f32x4){0.f, 0.f, 0.f, 0.f};
                const gt::LdRows al{VT + ((size_t)bh * 256 + mt * 128) * TOKP + tok0, TOKP};
                gt::gemm_tile<4, 128>(acc, al, bl, 1, lds, tl);
#pragma unroll
                for (int m = 0; m < 4; ++m)
#pragma unroll
                    for (int n = 0; n < 4; ++n)
#pragma unroll
                        for (int j = 0; j < 4; ++j) ot[(wr * 64 + m * 16 + 4 * fq + j) * 264 + wc * 64 + n * 16 + fr] = (bf16_t)f2bf(acc[m][n][j]);
                __syncthreads();
#pragma unroll
                for (int i = 0; i < 8; ++i) { const int pz = tl + 512 * i, row = pz >> 5, c8 = pz & 31, dir = c8 >> 4;
                    const bool ok = dir ? (ch != 2) : (ch != 33);
                    if (ok) *(u32x4*)(KV + (((size_t)(bh * 2 + dir) * 33 + (dir ? slb : slf)) * 256 + mt * 128 + row) * 128 + (c8 & 15) * 8) = *(const LAS u32x4*)(ot + row * 264 + c8 * 8); }
                __syncthreads();
            }
        }
    }
    }
    GRID_BAR();
    STAMP(3);

    { DECL_PTRS
    for (int idx = bid * 512 + tid; idx < 64 * 4096; idx += G * 512) {
        const int chain = idx >> 12, eg = idx & 4095, dir = chain & 1, h = (chain >> 1) & 3;
        const float g128 = exp2f(128.f * lg2_decay(a.in[I_DECAY][dir * 4 + h]));
        float run[8];
#pragma unroll
        for (int e = 0; e < 8; ++e) run[e] = 0.f;
        bf16_t* p = KV + (size_t)chain * 33 * 32768 + eg * 8;
        for (int s = 0; s < 33; ++s) {
            const u32x4 v = *(const u32x4*)(p + (size_t)s * 32768);
            run[0] = run[0] * g128 + bflo(v.x); run[1] = run[1] * g128 + bfhi(v.x); run[2] = run[2] * g128 + bflo(v.y); run[3] = run[3] * g128 + bfhi(v.y);
            run[4] = run[4] * g128 + bflo(v.z); run[5] = run[5] * g128 + bfhi(v.z); run[6] = run[6] * g128 + bflo(v.w); run[7] = run[7] * g128 + bfhi(v.w);
            u32x4 o; o.x = pk2(run[0], run[1]); o.y = pk2(run[2], run[3]); o.z = pk2(run[4], run[5]); o.w = pk2(run[6], run[7]);
            *(u32x4*)(p + (size_t)s * 32768) = o;
        }
    }
    {
        typedef float f32x16 __attribute__((ext_vector_type(16)));
        constexpr int CPB = 16448, ZOFF = 4 * CPB, ROWB = 10256, PADB = 992;
        for (int i = tid; i < (8 * ROWB) / 16; i += 512) *(LAS u32x4*)(lds + ZOFF + i * 16) = (u32x4){0u, 0u, 0u, 0u};
        __syncthreads();
        u32x4 zr[8], tv0[2], tv1[2];
#define CV_FETCH(cc) do { int _t = tid; asm volatile("" : "+v"(_t)); const bf16_t* _z = ZT + (size_t)(cc) * 8 * SEQ; const bf16_t* _tr = TR + (size_t)(cc) * 8192; \
        _Pragma("unroll") for (int i = 0; i < 8; ++i) { const int q = _t + 512 * i; zr[i] = *(const u32x4*)(_z + (size_t)(q >> 9) * SEQ + (q & 511) * 8); } \
        _Pragma("unroll") for (int i = 0; i < 2; ++i) { const int u = _t + 512 * i; tv0[i] = *(const u32x4*)(_tr + 8 * u); tv1[i] = (u32x4){0u, 0u, 0u, 0u}; if (u < 1023) tv1[i] = *(const u32x4*)(_tr + 8 * u + 8); } } while (0)
        if (bid < 512) CV_FETCH(bid);
        for (int c = bid; c < 512; c += G) {
            int tl = tid; asm volatile("" : "+v"(tl));
            const int w = tl >> 6, l = tl & 63, col = l & 31, hh = l >> 5, Rl = col >> 3, nn = col & 7;
            bf16_t* zc = ZT + (size_t)c * 8 * SEQ;
#pragma unroll
            for (int i = 0; i < 8; ++i) { const int q = tl + 512 * i, n = q >> 9, off = (q & 511) * 8; *(LAS u32x4*)(lds + ZOFF + n * ROWB + PADB + off * 2) = zr[i]; }
#pragma unroll
            for (int i = 0; i < 2; ++i) { const int u = tl + 512 * i; const u32x4 v0 = tv0[i], v1 = tv1[i];
                const unsigned W0 = v0.x, W1 = v0.y, W2 = v0.z, W3 = v0.w, W4 = v1.x, W5 = v1.y;
                *(LAS u32x4*)(lds + 0 * CPB + 16 * u) = v0;
                *(LAS u32x4*)(lds + 1 * CPB + 16 * u) = (u32x4){(W0 >> 16) | (W1 << 16), (W1 >> 16) | (W2 << 16), (W2 >> 16) | (W3 << 16), (W3 >> 16) | (W4 << 16)};
                *(LAS u32x4*)(lds + 2 * CPB + 16 * u) = (u32x4){W1, W2, W3, W4};
                *(LAS u32x4*)(lds + 3 * CPB + 16 * u) = (u32x4){(W1 >> 16) | (W2 << 16), (W2 >> 16) | (W3 << 16), (W3 >> 16) | (W4 << 16), (W4 >> 16) | (W5 << 16)}; }
            __syncthreads();
            if (c + G < 512) CV_FETCH(c + G);
            const int dlo = 32 * w - 255;
            const int e0 = 4096 - 16 * dlo - col + 8 * hh;
            int aaddr = (e0 & 3) * CPB + 2 * (e0 & ~3);
            int baddr = ZOFF + nn * ROWB + PADB + 2 * (512 * w + 64 * Rl + 8 * hh - 16 * dlo);
            f32x16 acc[4];
#pragma unroll
            for (int q = 0; q < 4; ++q)
#pragma unroll
                for (int i = 0; i < 16; ++i) acc[q][i] = 0.f;
            u32x2 alo = *(const LAS u32x2*)(lds + aaddr), ahi = *(const LAS u32x2*)(lds + aaddr + 8);
            u32x4 bq[4];
#pragma unroll
            for (int q = 0; q < 4; ++q) bq[q] = *(const LAS u32x4*)(lds + baddr + 512 * (q >> 1) + 64 * (q & 1));
            for (int it = 0; it < 285; ++it) {
                aaddr -= 32; baddr -= 32;
                const u32x2 nlo = *(const LAS u32x2*)(lds + aaddr), nhi = *(const LAS u32x2*)(lds + aaddr + 8);
                u32x4 nb[4];
#pragma unroll
                for (int q = 0; q < 4; ++q) nb[q] = *(const LAS u32x4*)(lds + baddr + 512 * (q >> 1) + 64 * (q & 1));
                const bf16x8 af = __builtin_bit_cast(bf16x8, (u32x4){alo.x, alo.y, ahi.x, ahi.y});
#pragma unroll
                for (int q = 0; q < 4; ++q) acc[q] = __builtin_amdgcn_mfma_f32_32x32x16_bf16(af, __builtin_bit_cast(bf16x8, bq[q]), acc[q], 0, 0, 0);
                alo = nlo; ahi = nhi;
#pragma unroll
                for (int q = 0; q < 4; ++q) bq[q] = nb[q];
            }
            {
                const bf16x8 af = __builtin_bit_cast(bf16x8, (u32x4){alo.x, alo.y, ahi.x, ahi.y});
#pragma unroll
                for (int q = 0; q < 4; ++q) acc[q] = __builtin_amdgcn_mfma_f32_32x32x16_bf16(af, __builtin_bit_cast(bf16x8, bq[q]), acc[q], 0, 0, 0);
            }
            const float skip = a.in[I_HSKIP][c];
#pragma unroll
            for (int q = 0; q < 4; ++q)
#pragma unroll
                for (int gq = 0; gq < 4; ++gq) {
                    const int t0 = 512 * w + 256 * (q >> 1) + 32 * (q & 1) + 64 * Rl + 8 * gq + 4 * hh;
                    const u32x2 zz = *(const LAS u32x2*)(lds + ZOFF + nn * ROWB + PADB + 2 * t0);
                    u32x2 o; o.x = pk2(acc[q][4 * gq] + skip * bflo(zz.x), acc[q][4 * gq + 1] + skip * bfhi(zz.x)); o.y = pk2(acc[q][4 * gq + 2] + skip * bflo(zz.y), acc[q][4 * gq + 3] + skip * bfhi(zz.y));
                    *(u32x2*)(zc + (size_t)nn * SEQ + t0) = o;
                }
            __syncthreads();
        }
    }
    }
    GRID_BAR();
    STAMP(4);

    { DECL_PTRS
    {
        LAS unsigned char* Pl = lds + 104448;
        LAS float* sfb = (LAS float*)(lds + 104448 + 128 * 272);
        LAS float* rsum = sfb + 256;
        LAS bf16_t* ot = (LAS bf16_t*)lds;
        for (int u = bid; u < 1024; u += G) {
            int tl = tid; asm volatile("" : "+v"(tl));
            const int wr = tl >> 8, wc = (tl >> 6) & 3, fr = tl & 15, fq = (tl >> 4) & 3;
            const int bh = u >> 5, c = u & 31, b = bh >> 2, h = bh & 3, row0 = b * SEQ + c * 128;
            const float lgf = lg2_decay(a.in[I_DECAY][h]), lgb = lg2_decay(a.in[I_DECAY][4 + h]);
            if (tl < 128) sfb[tl] = exp2f((float)(tl + 1) * lgf); else if (tl < 256) sfb[tl] = exp2f((float)(128 - (tl - 128)) * lgb);
            {
                f32x4 sacc[4][2];
#pragma unroll
                for (int m = 0; m < 4; ++m)
#pragma unroll
                    for (int n = 0; n < 2; ++n) sacc[m][n] = (f32x4){0.f, 0.f, 0.f, 0.f};
                gt::gemm_tile<2, 128>(sacc, gt::LdRows{Qb + (size_t)row0 * 512 + h * 128, 512}, gt::LdRows{Kb + (size_t)row0 * 512 + h * 128, 512}, 1, lds, tl);
#pragma unroll
                for (int m = 0; m < 4; ++m)
#pragma unroll
                    for (int n = 0; n < 2; ++n)
#pragma unroll
                        for (int j = 0; j < 4; ++j) { const int i = wr * 64 + m * 16 + 4 * fq + j, jj = wc * 32 + n * 16 + fr, df = i - jj;
                            const float dcy = df >= 0 ? exp2f((float)df * lgf) : exp2f((float)(-df) * lgb);
                            *(LAS bf16_t*)(Pl + i * 272 + jj * 2) = (bf16_t)f2bf(sacc[m][n][j] * dcy); }
                asm volatile("" ::: "memory");
            }
            __syncthreads();
            struct LdA2 { LAS unsigned char* P; const bf16_t* q; const LAS float* sc;
                __device__ __forceinline__ u32x4 operator()(int row, int k) const {
                    if (k < 128) return *(const LAS u32x4*)(P + row * 272 + k * 2);
                    const bool fw = k < 256; const u32x4 v = *(const u32x4*)(q + (size_t)row * 512 + (fw ? k - 128 : k - 256)); const float s = sc[fw ? row : 128 + row];
                    return gt::scale8(v, s, s, s, s, s, s, s, s); } };
            struct LdB2 { const bf16_t* vt; const bf16_t* sf; const bf16_t* sb;
                __device__ __forceinline__ u32x4 operator()(int dv, int k) const {
                    if (k < 128) return *(const u32x4*)(vt + (size_t)dv * TOKP + k);
                    if (k < 256) return *(const u32x4*)(sf + (size_t)dv * 128 + (k - 128));
                    return *(const u32x4*)(sb + (size_t)dv * 128 + (k - 256)); } };
            f32x4 acc[4][4];
#pragma unroll
            for (int m = 0; m < 4; ++m)
#pragma unroll
                for (int n = 0; n < 4; ++n) acc[m][n] = (f32x4){0.f, 0.f, 0.f, 0.f};
            const LdA2 al{Pl, Qb + (size_t)row0 * 512 + h * 128, sfb};
            const LdB2 bl{VT + (size_t)bh * 256 * TOKP + c * 128, KV + ((size_t)(bh * 2 + 0) * 33 + (c + 1)) * 32768, KV + ((size_t)(bh * 2 + 1) * 33 + (32 - c)) * 32768};
            gt::gemm_tile<4, 128>(acc, al, bl, 3, lds, tl);
#pragma unroll
            for (int m = 0; m < 4; ++m)
#pragma unroll
                for (int j = 0; j < 4; ++j) { float s = 0.f;
#pragma unroll
                    for (int n = 0; n < 4; ++n) s += acc[m][n][j] * acc[m][n][j];
                    s += __shfl_xor(s, 1); s += __shfl_xor(s, 2); s += __shfl_xor(s, 4); s += __shfl_xor(s, 8);
                    if (fr == 0) rsum[(wr * 64 + m * 16 + 4 * fq + j) * 4 + wc] = s; }
            __syncthreads();
#pragma unroll
            for (int m = 0; m < 4; ++m)
#pragma unroll
                for (int j = 0; j < 4; ++j) { const int i = wr * 64 + m * 16 + 4 * fq + j; const f32x4 rs = *(const LAS f32x4*)(rsum + i * 4);
                    const float rstd = rsqrtf(((rs[0] + rs[1]) + (rs[2] + rs[3])) * (1.f / 256.f) + EPS);
#pragma unroll
                    for (int n = 0; n < 4; ++n) ot[i * 264 + wc * 64 + n * 16 + fr] = (bf16_t)f2bf(acc[m][n][j] * rstd); }
            __syncthreads();
#pragma unroll
            for (int i = 0; i < 8; ++i) { const int pz = tl + 512 * i, row = pz >> 5, c8 = pz & 31;
                bf16_t* gp = SG + (size_t)(row0 + row) * 1024 + h * 256 + c8 * 8;
                const u32x4 gv = *(const u32x4*)gp, ov = *(const LAS u32x4*)(ot + row * 264 + c8 * 8);
                u32x4 o; o.x = pk2(bflo(gv.x) * bflo(ov.x), bfhi(gv.x) * bfhi(ov.x)); o.y = pk2(bflo(gv.y) * bflo(ov.y), bfhi(gv.y) * bfhi(ov.y)); o.z = pk2(bflo(gv.z) * bflo(ov.z), bfhi(gv.z) * bfhi(ov.z)); o.w = pk2(bflo(gv.w) * bflo(ov.w), bfhi(gv.w) * bfhi(ov.w));
                *(u32x4*)gp = o; }
            __syncthreads();
        }
    }
    for (int it = bid; it < 512; it += G) {
        const int b = it >> 6, tt = (it >> 3) & 7, cc = it & 7;
        LAS bf16_t* yt = (LAS bf16_t*)lds;
#pragma unroll
        for (int i = 0; i < 8; ++i) { const int ch = wave * 8 + i; *(LAS u32x4*)(yt + ch * 520 + lane * 8) = *(const u32x4*)(ZT + ((size_t)(cc * 64 + ch) * 8 + b) * SEQ + tt * 512 + lane * 8); }
        __syncthreads();
        { int tl = tid; asm volatile("" : "+v"(tl));
          const int tq = tl >> 3, cg = tl & 7, c0 = cc * 64 + cg * 8, t0 = tt * 512 + tq * 8, row0 = b * SEQ + t0;
          float x0[8][8];
          short_conv8x8(HU, row0, t0, c0, a.in[I_HCW], a.in[I_HCB], x0);
          u32x4 yv[8];
#pragma unroll
          for (int e = 0; e < 8; ++e) yv[e] = *(const LAS u32x4*)(yt + (cg * 8 + e) * 520 + tq * 8);
#pragma unroll
          for (int t = 0; t < 8; ++t) { float o[8];
#pragma unroll
              for (int e = 0; e < 8; ++e) { const unsigned wd = (t >> 1) == 0 ? yv[e].x : (t >> 1) == 1 ? yv[e].y : (t >> 1) == 2 ? yv[e].z : yv[e].w; o[e] = x0[t][e] * ((t & 1) ? bfhi(wd) : bflo(wd)); }
              u32x4 w; w.x = pk2(o[0], o[1]); w.y = pk2(o[2], o[3]); w.z = pk2(o[4], o[5]); w.w = pk2(o[6], o[7]);
              *(u32x4*)(HU + (size_t)(row0 + t) * 1536 + 512 + c0) = w; } }
        __syncthreads();
    }
    }
    GRID_BAR();
    STAMP(5);

    { DECL_PTRS
    {
        pg8::Gemm g{(const bf16_t*)XN8, (const bf16_t*)(WTG8 + (size_t)1024 * 1024), 512, 512, 512}; pg8::StaticOrder S; S.init(T, 1024, G, bid);
        pg8::EpiGate E{SGH, a.in[I_BIN] + NINA + 1024, 0.03125f};
        pg8::gemm_phase<pg8::EpiGate, pg8::StaticOrder, false, true>(lds, g, S, E);
    }
    {
        pg8::Gemm g{HU + 512, WT_HYO, 512, 1536, 512}; pg8::StaticOrder S; S.init(T, 1024, G, bid);
        pg8::EpiMerge<0> E{SGH, nullptr};
        pg8::gemm_phase(lds, g, S, E);
    }
    {
        pg8::Gemm g{(const bf16_t*)XN8, (const bf16_t*)WTG8, 512, 512, 512}; pg8::StaticOrder S; S.init(T, 1024, G, bid);
        pg8::EpiGate E{SGR, a.in[I_BIN] + NINA, 0.03125f};
        pg8::gemm_phase<pg8::EpiGate, pg8::StaticOrder, false, true>(lds, g, S, E);
    }
    {
        pg8::Gemm g{SG, WT_RETO, 1024, 1024, 1024}; pg8::StaticOrder S; S.init(T, 1024, G, bid);
        pg8::EpiMerge<1> E{SGR, SGH};
        pg8::gemm_phase(lds, g, S, E);
    }
    __syncthreads();
    {
        LAS float* scr = (LAS float*)(lds + wave * 17664);
        constexpr int PER = 16 * 8;
        for (int it = gw; it < NE * 3 * PER; it += NGW) {
            const int e = it / (3 * PER), r3 = it % (3 * PER), which = r3 / PER, r = r3 % PER;
            unsigned char* W13 = (unsigned char*)WE13; unsigned char* W2 = (unsigned char*)WE2;
            if (which == 0) transpose_item_f8(a.in[I_EW1] + (size_t)e * 1024 * 512, 512, 64 * (r / 8), 64 * (r % 8), W13 + (size_t)e * 1024 * 1024, 1024, RmE13{0}, 32.f, scr, lane);
            else if (which == 1) transpose_item_f8(a.in[I_EW3] + (size_t)e * 1024 * 512, 512, 64 * (r / 8), 64 * (r % 8), W13 + (size_t)e * 1024 * 1024, 1024, RmE13{128}, 32.f, scr, lane);
            else transpose_item_f8(a.in[I_EW2] + (size_t)e * 512 * 1024, 1024, 64 * (r / 16), 64 * (r % 16), W2 + (size_t)e * 1024 * 512, 512, RmId{}, 32.f, scr, lane);
        }
    }
    }
    GRID_BAR();
    STAMP(6);
    STAMP(7);
    STAMP(8);
    { DECL_PTRS
    {
        pg8::Gemm g{SGR, WT_OUT, 1024, 1024, 1024}; pg8::StaticOrder S; S.init(T, 1024, G, bid);
        pg8::EpiX1 E{a.in[I_X], MOD, X1};
        pg8::gemm_phase(lds, g, S, E);
    }
    }
    GRID_BAR();
    STAMP(9);

    { DECL_PTRS
    {
        LAS float* Wl = (LAS float*)lds;
#pragma unroll
        for (int i = 0; i < 18; ++i) { const int q = tid + 512 * i, k = q / 9, p4 = q % 9;
            const f32x4 v = p4 == 0 ? *(const f32x4*)(a.in[I_RGW] + k * 4) : *(const f32x4*)(a.in[I_REW] + k * 32 + (p4 - 1) * 4);
            *(LAS f32x4*)(Wl + k * 36 + p4 * 4) = v; }
        __syncthreads();
        unsigned char* H2 = (unsigned char*)SG;
        LAS float* Sw = (LAS float*)(lds + 147456 + wave * 1152);
        LAS int* lcnt = (LAS int*)(lds + 147456 + 9216);
        if (tid < NE) lcnt[tid] = 0;
        __syncthreads();
        for (int rb = gw; rb < T / 16; rb += NGW) {
            int ll = lane; asm volatile("" : "+v"(ll));
            const int r = ll & 15, kq = ll >> 4, row = rb * 16 + r, b = (rb * 16) >> 12;
            const float* md = MOD + (size_t)b * 6144; const float* xr = X1 + (size_t)row * D + 4 * kq;
            float s = 0.f;
#pragma unroll 16
            for (int i = 0; i < 64; ++i) { const f32x4 xv = *(const f32x4*)(xr + 16 * i); s += (xv[0] * xv[0] + xv[1] * xv[1]) + (xv[2] * xv[2] + xv[3] * xv[3]); }
            s += __shfl_xor(s, 16); s += __shfl_xor(s, 32);
            const float rstd = rsqrtf(s * (1.f / D) + EPS);
            f32x4 lacc[3];
#pragma unroll
            for (int ct = 0; ct < 3; ++ct) lacc[ct] = (f32x4){0.f, 0.f, 0.f, 0.f};
            const int c0 = ll & 15, c2 = (32 + c0) < 36 ? 32 + c0 : 35;
#pragma unroll 4
            for (int i = 0; i < 64; ++i) {
                const int k0 = 16 * i + 4 * kq;
                const f32x4 xv = *(const f32x4*)(xr + 16 * i), gv = *(const f32x4*)(a.in[I_N2G] + k0), sc = *(const f32x4*)(md + 4096 + k0), sh = *(const f32x4*)(md + 3072 + k0);
                const f32x4 hv = (xv * rstd * gv) * (sc + 1.f) + sh;
                *(unsigned*)(H2 + (size_t)row * D + k0) = pk_fp8x4(hv[0], hv[1], hv[2], hv[3]);
#pragma unroll
                for (int e = 0; e < 4; ++e) { const LAS float* wr_ = Wl + (k0 + e) * 36;
                    lacc[0] = __builtin_amdgcn_mfma_f32_16x16x4f32(hv[e], wr_[c0], lacc[0], 0, 0, 0);
                    lacc[1] = __builtin_amdgcn_mfma_f32_16x16x4f32(hv[e], wr_[16 + c0], lacc[1], 0, 0, 0);
                    lacc[2] = __builtin_amdgcn_mfma_f32_16x16x4f32(hv[e], wr_[c2], lacc[2], 0, 0, 0); }
            }
#pragma unroll
            for (int hf = 0; hf < 2; ++hf) {
                if ((kq >> 1) == hf) {
#pragma unroll
                    for (int j = 0; j < 4; ++j) { LAS float* sp = Sw + (4 * (kq & 1) + j) * 36 + c0; sp[0] = lacc[0][j]; sp[16] = lacc[1][j]; if (c0 < 4) sp[32] = lacc[2][j]; }
                }
                asm volatile("s_waitcnt lgkmcnt(0)" ::: "memory");
                if (ll < 8) {
                    const int rrow = rb * 16 + 8 * hf + ll;
                    float lg[36];
#pragma unroll
                    for (int q = 0; q < 9; ++q) { const f32x4 v = *(const LAS f32x4*)(Sw + ll * 36 + 4 * q); lg[4 * q] = v[0]; lg[4 * q + 1] = v[1]; lg[4 * q + 2] = v[2]; lg[4 * q + 3] = v[3]; }
                    float gl[4];
#pragma unroll
                    for (int j = 0; j < 4; ++j) gl[j] = lg[j] + a.in[I_RGB][j];
                    int gs = 0; float gm = gl[0];
#pragma unroll
                    for (int j = 1; j < 4; ++j) if (gl[j] > gm) { gm = gl[j]; gs = j; }
                    float den = 0.f;
#pragma unroll
                    for (int j = 0; j < 4; ++j) den += expf(gl[j] - gm);
                    const float pstar = 1.f / den;
                    float el[8];
#pragma unroll
                    for (int e = 0; e < 8; ++e) { const float v0 = lg[4 + e], v1 = lg[12 + e], v2 = lg[20 + e], v3 = lg[28 + e]; el[e] = (gs == 0 ? v0 : gs == 1 ? v1 : gs == 2 ? v2 : v3) + a.in[I_REB][gs * 8 + e]; }
                    int e0 = 0; float m0 = el[0];
#pragma unroll
                    for (int e = 1; e < 8; ++e) if (el[e] > m0) { m0 = el[e]; e0 = e; }
                            int e1 = e0 == 0 ? 1 : 0; float m1 = e0 == 0 ? el[1] : el[0];
#pragma unroll
                    for (int e = 1; e < 8; ++e) if (e != e0 && el[e] > m1) { m1 = el[e]; e1 = e; }
                    const float ex = expf(m1 - m0); const float w0 = pstar / (1.f + ex), w1 = pstar * ex / (1.f + ex);
                    const int E0 = gs * 8 + e0, E1 = gs * 8 + e1;
                    const int s0 = __hip_atomic_fetch_add(lcnt + E0, 1, __ATOMIC_RELAXED, __HIP_MEMORY_SCOPE_WORKGROUP), s1 = __hip_atomic_fetch_add(lcnt + E1, 1, __ATOMIC_RELAXED, __HIP_MEMORY_SCOPE_WORKGROUP);
                    int4 ti; ti.x = (E0 << 16) | s0; ti.y = (E1 << 16) | s1; ti.z = __float_as_int(w0); ti.w = __float_as_int(w1);
                    *(int4*)(TOKINFO + (size_t)rrow * 4) = ti;
                }
                asm volatile("s_waitcnt lgkmcnt(0)" ::: "memory");
            }
        }
        __syncthreads();
        if (tid < NE) LISTS[bid * NE + tid] = lcnt[tid];
    }
    }
    GRID_BAR();
    STAMP(10);

    LAS int* tbase = (LAS int*)(lds + MISC_OFF);
    LAS int* texp = tbase + 64;
    int ntiles = 0;
    { DECL_PTRS
    {
        LAS int* ptot = texp + 320;
        LAS int* pbas = ptot + 512; LAS int* total = pbas + 512; LAS int* mybase = total + 32;
        { const int e = tid & 31, part = tid >> 5, per = (G + 15) >> 4; int s = 0, sb = 0;
          for (int b = part * per; b < (part + 1) * per && b < G; ++b) { const int v = LISTS[b * NE + e]; s += v; if (b < bid) sb += v; }
          ptot[part * 32 + e] = s; pbas[part * 32 + e] = sb; }
        __syncthreads();
        if (tid < NE) { int s = 0, sb = 0; for (int q = 0; q < 16; ++q) { s += ptot[q * 32 + tid]; sb += pbas[q * 32 + tid]; } total[tid] = s; mybase[tid] = sb; }
        __syncthreads();
        if (tid == 0) { int acc = 0; for (int e = 0; e < NE; ++e) { tbase[e] = acc; const int nt = (total[e] + 255) >> 8; for (int q = 0; q < nt; ++q) texp[acc + q] = e; acc += nt; } tbase[NE] = acc; }
        __syncthreads();
        ntiles = tbase[NE];
        int* ROWTOK = LISTS + 16384;
        for (int rb = gw; rb < T / 16; rb += NGW) {
            if (lane < 16) { const int row = rb * 16 + lane;
                const int4 ti = *(const int4*)(TOKINFO + (size_t)row * 4);
                const int e0 = ti.x >> 16, e1 = ti.y >> 16;
                const int r0 = tbase[e0] * 256 + mybase[e0] + (ti.x & 0xffff), r1 = tbase[e1] * 256 + mybase[e1] + (ti.y & 0xffff);
                ROWTOK[r0] = row; ROWTOK[r1] = row;
                int4 to = ti; to.x = r0; to.y = r1; *(int4*)(TOKINFO + (size_t)row * 4) = to; }
        }
        if (bid < NE) { const int rlo = tbase[bid] * 256 + total[bid], rhi = tbase[bid + 1] * 256; for (int r = rlo + tid; r < rhi; r += 512) ROWTOK[r] = 0; }
    }
    }
    GRID_BAR();
    STAMP(11);

    { DECL_PTRS
    {
        pg8::Gemm g{SG  , WE13, 512, 512, 512}; pg8::MoeOrder S{ntiles, G, bid, texp};
        pg8::EpiMoe1 E{(unsigned char*)HM};
        pg8::gemm_phase<pg8::EpiMoe1, pg8::MoeOrder, true, true>(lds, g, S, E, LISTS + 16384);
    }
    }
    GRID_BAR();
    STAMP(12);
    { DECL_PTRS
    {
        pg8::Gemm g{HM  , WE2, 256, 256, 256}; pg8::MoeOrder S{ntiles, G, bid, texp};
        pg8::EpiBf E{XB, 1024, 0.03125f};
        pg8::gemm_phase<pg8::EpiBf, pg8::MoeOrder, false, true>(lds, g, S, E);
    }
    }
    GRID_BAR();
    STAMP(13);

    { DECL_PTRS
    {
        const bf16_t* YB = XB;
        for (int row = gw; row < T; row += NGW) {
            const int b = row >> 12; const float* gt2 = MOD + (size_t)b * 6144 + 5120;
            const int4 ti = *(const int4*)(TOKINFO + (size_t)row * 4);
            const size_t r0 = (size_t)ti.x, r1 = (size_t)ti.y;
            const float w0 = __int_as_float(ti.z), w1 = __int_as_float(ti.w);
            f32x4 v[4]; float s = 0.f;
#pragma unroll
            for (int j = 0; j < 4; ++j) { const int c0 = 4 * lane + 256 * j;
                const f32x4 xv = *(const f32x4*)(X1 + (size_t)row * D + c0), gv = *(const f32x4*)(gt2 + c0);
                const u32x2 y0 = *(const u32x2*)(YB + r0 * D + c0), y1 = *(const u32x2*)(YB + r1 * D + c0);
                f32x4 mo; mo[0] = w0 * bflo(y0.x) + w1 * bflo(y1.x); mo[1] = w0 * bfhi(y0.x) + w1 * bfhi(y1.x); mo[2] = w0 * bflo(y0.y) + w1 * bflo(y1.y); mo[3] = w0 * bfhi(y0.y) + w1 * bfhi(y1.y);
                v[j] = xv + gv * mo; s += (v[j][0] * v[j][0] + v[j][1] * v[j][1]) + (v[j][2] * v[j][2] + v[j][3] * v[j][3]); }
            const float rstd = rsqrtf(wave_sum(s) * (1.f / D) + EPS);
#pragma unroll
            for (int j = 0; j < 4; ++j) { const int c0 = 4 * lane + 256 * j; const f32x4 fg = *(const f32x4*)(a.in[I_FNG] + c0); *(f32x4*)(X1 + (size_t)row * D + c0) = v[j] * rstd * fg; }
        }
    }
    }
    STAMP(14);
    if (PROBE_PHASE >= 0 && blockIdx.x == 0 && threadIdx.x == 0) { const unsigned long long t0_ = __builtin_amdgcn_s_memrealtime(); while (__builtin_amdgcn_s_memrealtime() - t0_ < spin_) __builtin_amdgcn_s_sleep(8); }
}

extern "C" void kernel_launch(void* const* d_in, const int* in_sizes, int n_in, void* d_out, int out_size, void* d_ws, size_t ws_size, hipStream_t stream) {
    static int grid = 0;
    if (grid == 0) {
        if (n_in != 31 || out_size != T * D || ws_size < WS_END) { fprintf(stderr, "kernel_launch: unexpected shapes: n_in %d out %d ws %zu (need %zu)\n", n_in, out_size, ws_size, (size_t)WS_END); grid = -1; return; }
        int dev = 0, cus = 0, per_cu = 0;
        if (hipGetDevice(&dev) != hipSuccess || hipDeviceGetAttribute(&cus, hipDeviceAttributeMultiprocessorCount, dev) != hipSuccess) { grid = -1; return; }
        if (hipFuncSetAttribute((const void*)fwd_kernel, hipFuncAttributeMaxDynamicSharedMemorySize, LDS_BYTES) != hipSuccess) { fprintf(stderr, "kernel_launch: hipFuncSetAttribute failed\n"); grid = -1; return; }
        if (hipOccupancyMaxActiveBlocksPerMultiprocessor(&per_cu, (const void*)fwd_kernel, 512, LDS_BYTES) != hipSuccess || per_cu < 1) { fprintf(stderr, "kernel_launch: occupancy query says %d blocks per CU\n", per_cu); grid = -1; return; }
        grid = cus;
        fprintf(stderr, "kernel_launch: cus %d per_cu %d grid %d ws %zu\n", cus, per_cu, grid, ws_size);
    }
    if (grid < 0) return;
    Args a{};
    for (int i = 0; i < 31; ++i) a.in[i] = (const float*)d_in[i];
    a.out = (float*)d_out; a.ws = (unsigned char*)d_ws;
    void* args[] = {&a};
    const hipError_t e = hipLaunchCooperativeKernel((const void*)fwd_kernel, dim3(grid), dim3(512), args, LDS_BYTES, stream);
    if (e != hipSuccess) fprintf(stderr, "kernel_launch: cooperative launch failed: %s (grid %d)\n", hipGetErrorString(e), grid);
}
```

```cpp
#ifndef PROBE_PHASE
#define PROBE_PHASE -1
#endif
#ifndef REPMASK
#define REPMASK 0
#endif
#include <hip/hip_runtime.h>
#include <hip/hip_cooperative_groups.h>
#include <cstdio>
#include <cstdint>
namespace cg = cooperative_groups;

#define LAS __attribute__((address_space(3)))
typedef unsigned short bf16_t;
typedef short bf16x8 __attribute__((ext_vector_type(8)));
typedef float f32x4 __attribute__((ext_vector_type(4)));
typedef unsigned u32x4 __attribute__((ext_vector_type(4)));
typedef unsigned u32x2 __attribute__((ext_vector_type(2)));

constexpr int BATCH = 8, SEQ = 4096, D = 1024, T = BATCH * SEQ, CTXL = 256, TC = BATCH * CTXL, MT = T + TC;
constexpr int NH = 4, DK = 128, DV = 256, TOKP = SEQ + CTXL;
constexpr int NINA = 4608;
constexpr int NE = 32, EH = 512;
constexpr float EPS = 1e-6f;
constexpr int LDS_BYTES = 163840;
constexpr int MISC_OFF = 131072;

constexpr size_t MiB = 1u << 20;
constexpr size_t WS_CTL = 0, CTL_BYTES = 65536;
constexpr size_t WS_MOD = 65536;
constexpr size_t WS_ROPE = 327680;
constexpr size_t WS_BINP = 344064;
constexpr size_t WS_FPART = 524288;
constexpr size_t WS_TOKINFO = 2 * MiB;
constexpr size_t WS_LISTS = 3 * MiB;
constexpr size_t WS_TR = 8 * MiB;
constexpr size_t WS_WT_IN = 16 * MiB;
constexpr size_t WS_WT_RETO = 29 * MiB, WS_WT_HYO = 31 * MiB, WS_WT_OUT = 32 * MiB;
constexpr size_t WS_R1 = 34 * MiB;
constexpr size_t WS_Q = WS_R1, WS_K = WS_R1 + 32 * MiB, WS_KT = WS_R1 + 66 * MiB, WS_VT = WS_R1 + 100 * MiB;
constexpr size_t WS_FILT = WS_R1;
constexpr size_t WS_SGR = WS_R1, WS_SGH = WS_R1 + 64 * MiB;
constexpr size_t WS_XB = WS_R1;
constexpr size_t WS_SG = 202 * MiB;
constexpr size_t WS_HU = 266 * MiB;
constexpr size_t WS_KV = 362 * MiB;
constexpr size_t WS_WE13 = 362 * MiB, WS_WE2 = 426 * MiB;
constexpr size_t WS_END = 494 * MiB;
constexpr size_t DO_XN = 0, DO_ZT = 64 * MiB, DO_XN8 = 96 * MiB;

__device__ __forceinline__ unsigned f2bf(float f) { unsigned u = __float_as_uint(f); return (u + 0x7fffu + ((u >> 16) & 1u)) >> 16; }
__device__ __forceinline__ unsigned pk2(float lo, float hi) { return f2bf(lo) | (f2bf(hi) << 16); }
__device__ __forceinline__ float bflo(unsigned w) { return __uint_as_float(w << 16); }
__device__ __forceinline__ float bfhi(unsigned w) { return __uint_as_float(w & 0xffff0000u); }
__device__ __forceinline__ float bf2f(bf16_t h) { return __uint_as_float((unsigned)h << 16); }
__device__ __forceinline__ float silu_f(float v) { return v / (1.f + __expf(-v)); }
__device__ __forceinline__ float sigm_f(float v) { return 1.f / (1.f + __expf(-v)); }
__device__ __forceinline__ float wave_sum(float v) {
#pragma unroll
    for (int o = 1; o < 64; o <<= 1) v += __shfl_xor(v, o);
    return v;
}
__host__ __device__ __forceinline__ int dimperm(int p) { const int wc = p >> 5, n = (p >> 4) & 1, i16 = p & 15; return 64 * (wc >> 1) + 32 * n + 16 * (wc & 1) + i16; }
__host__ __device__ __forceinline__ int inv_dimperm(int d) { const int half = d >> 6, n = (d >> 5) & 1, idx = d & 31; return 32 * (2 * half + (idx >> 4)) + 16 * n + (idx & 15); }
__host__ __device__ __forceinline__ int win_destrow(int n) { return n < 1024 ? (n & ~127) + inv_dimperm(n & 127) : n; }

namespace pg8 {
constexpr int BM = 256, BK = 64, HALF = 128, HTB = HALF * BK * 2, STAGE_BYTES = 8 * HTB, NXCD = 8, WGM = 8;
__host__ __device__ __forceinline__ int lds_byte(int r, int c) { const int st = (r >> 4) * 2 + (c >> 5), rr = r & 15, cc = c & 31, ob = rr * 64 + cc * 2; return st * 1024 + (ob ^ (((ob >> 9) & 1) << 5)); }
__host__ __device__ __forceinline__ void stage_rc(int b, int& R, int& C) { const int st = b / 1024, sb = b % 1024, swz = sb ^ (((sb >> 9) & 1) << 5); R = (st >> 1) * 16 + swz / 64; C = (st & 1) * 32 + (swz % 64) / 2; }
__host__ __device__ __forceinline__ int perm32(int rho) { const int n = rho >> 4, i = rho & 15; return 8 * (i >> 2) + 4 * n + (i & 3); }

struct Unit { int pm, pn, pc; };
struct Gemm { const bf16_t* A; const bf16_t* Bt; int K, lda, ldb; };

struct StaticOrder {
    int nM, nN, nwg, G, c;
    __device__ void init(int M, int N, int G_, int c_) { nM = M / BM; nN = N / BM; nwg = nM * nN; G = G_; c = c_; }
    __device__ bool next(int i, Unit& u) const {
        const long L = (long)i * G + c; if (L >= nwg) return false;
        int wgid = (int)L; { const int q = nwg / NXCD, r = nwg % NXCD, xcd = wgid % NXCD, off = wgid / NXCD; wgid = (xcd < r ? xcd * (q + 1) : r * (q + 1) + (xcd - r) * q) + off; }
        const int nig = WGM * nN, gid = wgid / nig, fm = gid * WGM, gsz = (nM - fm) < WGM ? (nM - fm) : WGM;
        u.pm = fm + ((wgid % nig) % gsz); u.pn = (wgid % nig) / gsz; u.pc = u.pn; return true;
    }
};
struct InProjOrder {
    StaticOrder so; int G, c;
    __device__ void init(int G_, int c_) { so.init(T, NINA, G_, c_); G = G_; c = c_; }
    __device__ bool next(int i, Unit& u) const {
        const long L = (long)i * G + c;
        if (L < so.nwg) return so.next(i, u);
        const int l = (int)(L - so.nwg); if (l >= 48) return false;
        u.pm = 128 + (l & 7); u.pn = 2 + (l >> 3); u.pc = u.pn; return true;
    }
};
struct MoeOrder {
    int ntiles, G, c; const LAS int* texp;
    __device__ bool next(int i, Unit& u) const {
        const long L = (long)i * G + c; if (L >= (long)ntiles * 4) return false;
        const int full = (ntiles >> 3) * 32, l = (int)L;
        if (l < full) { u.pm = (l >> 5) * 8 + (l & 7); u.pc = (l & 31) >> 3; } else { u.pm = (ntiles & ~7) + ((l - full) >> 2); u.pc = (l - full) & 3; }
        u.pn = texp[u.pm] * 4 + u.pc; return true;
    }
};

__device__ __forceinline__ unsigned cvt_pk_bf16(float lo, float hi) { unsigned r; asm volatile("v_cvt_pk_bf16_f32 %0, %1, %2" : "=v"(r) : "v"(lo), "v"(hi)); return r; }

typedef int v8i __attribute__((ext_vector_type(8)));
__device__ __forceinline__ unsigned pk_fp8x4(float a, float b, float c, float d) { int w = 0; w = __builtin_amdgcn_cvt_pk_fp8_f32(a, b, w, false); w = __builtin_amdgcn_cvt_pk_fp8_f32(c, d, w, true); return (unsigned)w; }
template <class Epi, class Sched, bool GATHER = false, bool FP8 = false>
__device__ __forceinline__ void gemm_phase(LAS unsigned char* lds, const Gemm g, const Sched& S, const Epi& E, const int* rowidx = nullptr) {
    int tid = threadIdx.x; asm volatile("" : "+v"(tid));
    const int wid = __builtin_amdgcn_readfirstlane(tid >> 6), lane = tid & 63, wr = wid >> 2, wc = wid & 3, fr = lane & 15, fq = lane >> 4;
    const int K = g.K; int nt = K / BK; asm volatile("" : "+s"(nt));
    int Ra[2], Ca[2]; unsigned voffA[2], voffB[2];
#pragma unroll
    for (int i = 0; i < 2; ++i) { int R, C; stage_rc(tid * 16 + i * 8192, R, C); const int Rb = Epi::PERM ? ((R & ~31) + perm32(R & 31)) : R;
        Ra[i] = R; Ca[i] = C; voffA[i] = (unsigned)(R * g.lda + C) * 2u; voffB[i] = (unsigned)(Rb * g.ldb + C) * 2u; }
    const size_t hstepA = (size_t)HALF * g.lda * 2, tstepA = 2 * hstepA;
    const size_t kstep = (size_t)(BK * 2);
    const size_t hstepB = (size_t)HALF * g.ldb * 2, tstepB = 2 * hstepB;
    const unsigned ldsw = (unsigned)wid * 1024u;
    const int aoff = lds_byte(wr * 64 + fr, fq * 8), boff = lds_byte(wc * 32 + fr, fq * 8);
#define PG8_AOFF(dst, u) do { _Pragma("unroll") for (int _h = 0; _h < 2; ++_h) _Pragma("unroll") for (int _i = 0; _i < 2; ++_i) { int _row = (u).pm * BM + _h * HALF + Ra[_i]; if (GATHER) _row = rowidx[_row]; \
        dst[_h][_i] = (unsigned)(_row * g.lda + Ca[_i]) * 2u; } } while (0)
#define PG8_SA(b, h) (((b) * 2 + (h)) * HTB)
#define PG8_SB(b, h) ((4 + (b) * 2 + (h)) * HTB)
#define PG8_STAGE(bufoff, gbase, voff) do { _Pragma("unroll") for (int _i = 0; _i < 2; ++_i) \
        __builtin_amdgcn_global_load_lds((const unsigned*)((const char*)(gbase) + (voff)[_i]), (LAS unsigned*)(lds + (bufoff) + ldsw + _i * 8192), 16, 0, 0); } while (0)
#define PG8_STAGE_A(bufoff, ubase, vsel, h, kb) do { if constexpr (GATHER) { PG8_STAGE(bufoff, gA + (kb), (vsel)[h]); } else { PG8_STAGE(bufoff, (ubase) + (size_t)(h) * hstepA + (kb), voffA); } } while (0)
#define PG8_LD8(p) ({ const u32x4 _lo = *(const LAS u32x4*)(p), _hi = *(const LAS u32x4*)((p) + 1024); v8i _r; _r[0] = (int)_lo.x; _r[1] = (int)_lo.y; _r[2] = (int)_lo.z; _r[3] = (int)_lo.w; _r[4] = (int)_hi.x; _r[5] = (int)_hi.y; _r[6] = (int)_hi.z; _r[7] = (int)_hi.w; _r; })
#define PG8_LDA(dst, b, h) do { _Pragma("unroll") for (int m = 0; m < 4; ++m) dst[m] = PG8_LD8(lds + PG8_SA(b, h) + aoff + m * 2048); } while (0)
#define PG8_LDB(dst, b, h) do { _Pragma("unroll") for (int n = 0; n < 2; ++n) dst[n] = PG8_LD8(lds + PG8_SB(b, h) + boff + n * 2048); } while (0)
#define PG8_LO(v) __builtin_bit_cast(bf16x8, __builtin_shufflevector(v, v, 0, 1, 2, 3))
#define PG8_HI(v) __builtin_bit_cast(bf16x8, __builtin_shufflevector(v, v, 4, 5, 6, 7))
#define PG8_MMA(ai, bj, At, Bt) do { __builtin_amdgcn_s_setprio(1); _Pragma("unroll") for (int m = 0; m < 4; ++m) _Pragma("unroll") for (int n = 0; n < 2; ++n) { \
        if constexpr (FP8) { asm volatile("v_mfma_scale_f32_16x16x128_f8f6f4 %0, %1, %2, %0, %3, %3 op_sel_hi:[0,0,0]" : "+v"(acc[ai][bj][m][n]) : "v"(Bt[n]), "v"(At[m]), "v"(one_scale)); } \
        else { acc[ai][bj][m][n] = __builtin_amdgcn_mfma_f32_16x16x32_bf16(PG8_LO(Bt[n]), PG8_LO(At[m]), acc[ai][bj][m][n], 0, 0, 0); \
               acc[ai][bj][m][n] = __builtin_amdgcn_mfma_f32_16x16x32_bf16(PG8_HI(Bt[n]), PG8_HI(At[m]), acc[ai][bj][m][n], 0, 0, 0); } } __builtin_amdgcn_s_setprio(0); } while (0)
#define PG8_WAIT_V(n) asm volatile("s_waitcnt vmcnt(" #n ")" ::: "memory")
#define PG8_WAIT_L(n) asm volatile("s_waitcnt lgkmcnt(" #n ")" ::: "memory")
#define PG8_BAR __builtin_amdgcn_s_barrier()
#define PG8_SCHED __builtin_amdgcn_sched_barrier(0)
    Unit cur, nxt; int ui = 0;
    if (!S.next(0, cur)) return;
    f32x4 acc[2][2][4][2];
#pragma unroll
    for (int a = 0; a < 2; ++a)
#pragma unroll
        for (int b = 0; b < 2; ++b)
#pragma unroll
            for (int m = 0; m < 4; ++m)
#pragma unroll
                for (int n = 0; n < 2; ++n) { acc[a][b][m][n] = (f32x4){0.f, 0.f, 0.f, 0.f}; }
    v8i At[4], B0[2], B1[2];
    int one_scale = 0x7f7f7f7f; asm volatile("" : "+v"(one_scale)); (void)one_scale;
    unsigned vA[2][2], nvA[2][2];
    if constexpr (GATHER) PG8_AOFF(vA, cur);
    const char* gA = (const char*)g.A;
    const char* cA = gA + (size_t)cur.pm * tstepA;
    const char* cB = (const char*)g.Bt + (size_t)cur.pn * tstepB;
    PG8_STAGE(PG8_SB(0, 0), cB, voffB); PG8_STAGE(PG8_SB(0, 1), cB + hstepB, voffB); PG8_STAGE_A(PG8_SA(0, 0), cA, vA, 0, 0); PG8_STAGE_A(PG8_SA(0, 1), cA, vA, 1, 0);
    if (wr == 1) PG8_BAR;
    PG8_WAIT_V(2); PG8_BAR;
    PG8_STAGE(PG8_SB(1, 0), cB + kstep, voffB); PG8_STAGE_A(PG8_SA(1, 0), cA, vA, 0, kstep); PG8_STAGE(PG8_SB(1, 1), cB + hstepB + kstep, voffB);
    PG8_WAIT_V(6); PG8_BAR;
    for (;;) {
        const bool has_next = S.next(ui + 1, nxt);
        if constexpr (GATHER) { if (has_next) { PG8_AOFF(nvA, nxt); } else {
#pragma unroll
            for (int h = 0; h < 2; ++h)
#pragma unroll
                for (int i = 0; i < 2; ++i) nvA[h][i] = vA[h][i]; } }
        const char* nA = has_next ? gA + (size_t)nxt.pm * tstepA : cA;
        const char* nB = has_next ? (const char*)g.Bt + (size_t)nxt.pn * tstepB : cB;
#pragma unroll 1
        for (int t = 0; t < nt; t += 2) {
            const bool last = (t == nt - 2);
            const size_t k1 = (size_t)(t + 1) * kstep, k2 = last ? 0 : (size_t)(t + 2) * kstep, k3 = k2 + kstep;
            const char* u2 = last ? nA : cA; const char* b2 = last ? nB : cB + (size_t)(t + 2) * kstep; const char* b3 = b2 + kstep;
            unsigned v2[2][2];
            if constexpr (GATHER) {
#pragma unroll
                for (int h = 0; h < 2; ++h)
#pragma unroll
                    for (int i = 0; i < 2; ++i) v2[h][i] = last ? nvA[h][i] : vA[h][i]; }
            PG8_LDB(B0, 0, 0); PG8_LDB(B1, 0, 1); PG8_SCHED; PG8_LDA(At, 0, 0); PG8_STAGE_A(PG8_SA(1, 1), cA, vA, 1, k1);
            PG8_WAIT_V(8); PG8_WAIT_L(0); PG8_BAR; PG8_MMA(0, 0, At, B0); PG8_MMA(0, 1, At, B1); PG8_BAR; PG8_SCHED;
            PG8_LDA(At, 0, 1); PG8_STAGE(PG8_SB(0, 0), b2, voffB); PG8_STAGE(PG8_SB(0, 1), b2 + hstepB, voffB); PG8_STAGE_A(PG8_SA(0, 0), u2, v2, 0, k2);
            PG8_WAIT_V(8); PG8_WAIT_L(0); PG8_BAR; PG8_MMA(1, 0, At, B0); PG8_MMA(1, 1, At, B1); PG8_BAR; PG8_SCHED;
            PG8_LDB(B0, 1, 0); PG8_LDB(B1, 1, 1); PG8_SCHED; PG8_LDA(At, 1, 0); PG8_STAGE_A(PG8_SA(0, 1), u2, v2, 1, k2);
            PG8_WAIT_V(8); PG8_WAIT_L(0); PG8_BAR; PG8_MMA(0, 0, At, B0); PG8_MMA(0, 1, At, B1); PG8_BAR; PG8_SCHED;
            PG8_LDA(At, 1, 1); PG8_STAGE(PG8_SB(1, 0), b3, voffB); PG8_STAGE(PG8_SB(1, 1), b3 + hstepB, voffB); PG8_STAGE_A(PG8_SA(1, 0), u2, v2, 0, k3);
            PG8_WAIT_V(8); PG8_WAIT_L(0); PG8_BAR; PG8_MMA(1, 0, At, B0); PG8_MMA(1, 1, At, B1); PG8_BAR; PG8_SCHED;
        }
        if (wr == 0) PG8_BAR;
        if constexpr (FP8) asm volatile("s_nop 15\n\ts_nop 15" ::: "memory");
        E(acc, cur, wr, wc, fr, fq);
        if (!has_next) break;
#pragma unroll
        for (int a = 0; a < 2; ++a)
#pragma unroll
            for (int b = 0; b < 2; ++b)
#pragma unroll
                for (int m = 0; m < 4; ++m)
#pragma unroll
                    for (int n = 0; n < 2; ++n) { acc[a][b][m][n] = (f32x4){0.f, 0.f, 0.f, 0.f}; }
        cur = nxt; cA = nA; cB = nB; ++ui;
        if constexpr (GATHER) {
#pragma unroll
            for (int h = 0; h < 2; ++h)
#pragma unroll
                for (int i = 0; i < 2; ++i) vA[h][i] = nvA[h][i]; }
        if (wr == 1) PG8_BAR;
    }
    PG8_WAIT_V(0);
    PG8_BAR;
#undef PG8_AOFF
#undef PG8_SA
#undef PG8_SB
#undef PG8_STAGE
#undef PG8_LDA
#undef PG8_LDB
#undef PG8_STAGE_A
#undef PG8_LD8
#undef PG8_LO
#undef PG8_HI
#undef PG8_MMA
#undef PG8_WAIT_V
#undef PG8_WAIT_L
#undef PG8_BAR
#undef PG8_SCHED
}

__device__ __forceinline__ void st_bf4(bf16_t* p, f32x4 v) { u32x2 w; w.x = cvt_pk_bf16(v[0], v[1]); w.y = cvt_pk_bf16(v[2], v[3]); *(u32x2*)p = w; }
__device__ __forceinline__ void st_bf8(bf16_t* p, f32x4 v0, f32x4 v1) { u32x4 w; w.x = cvt_pk_bf16(v0[0], v0[1]); w.y = cvt_pk_bf16(v0[2], v0[3]); w.z = cvt_pk_bf16(v1[0], v1[1]); w.w = cvt_pk_bf16(v1[2], v1[3]); *(u32x4*)p = w; }

struct EpiInA {
    static constexpr bool PERM = false;
    bf16_t *Q, *Kn, *KT, *VT, *SG, *HU; const float* binp; const float* rope;
    __device__ __forceinline__ void operator()(const f32x4 (&acc)[2][2][4][2], const Unit& u, int wr, int wc, int fr, int fq) const {
        const int pc = u.pc, rbase = u.pm * BM + wr * 64 + fr, cbase = pc * BM + wc * 32 + 4 * fq;
        f32x4 bv[2][2];
#pragma unroll
        for (int bj = 0; bj < 2; ++bj)
#pragma unroll
            for (int n = 0; n < 2; ++n) bv[bj][n] = *(const f32x4*)(binp + cbase + bj * HALF + n * 16);
        const bool lat = u.pm < 128;
        const int bidx = lat ? (u.pm >> 4) : (u.pm - 128);
        if (pc < 4) {
            const bool isk = pc >= 2; const float ks = isk ? 0.08838834764831845f : 1.f;
            const int h0 = (pc & 1) * 2;
#pragma unroll
            for (int ai = 0; ai < 2; ++ai)
#pragma unroll
                for (int m = 0; m < 4; ++m) {
                    const int r = rbase + ai * HALF + m * 16, t = r & 4095;
                    const int tok = lat ? t : 4096 + ((r - T) & 255);
                    f32x4 cs = (f32x4){1.f, 1.f, 1.f, 1.f}, sn = (f32x4){0.f, 0.f, 0.f, 0.f};
                    if (lat) { const int pos = (wc >> 1) ? (t & 63) : (t >> 6); const float* rp = rope + pos * 32 + 16 * (wc & 1) + 4 * fq; cs = *(const f32x4*)rp; sn = *(const f32x4*)(rp + 2048); }
#pragma unroll
                    for (int bj = 0; bj < 2; ++bj) {
                        const f32x4 x1 = acc[ai][bj][m][0] + bv[bj][0], x2 = acc[ai][bj][m][1] + bv[bj][1];
                        const f32x4 o1 = (x1 * cs - x2 * sn) * ks, o2 = (x1 * sn + x2 * cs) * ks;
                        const int col = (pc & 1) * BM + bj * HALF + wc * 32 + 4 * fq;
                        if (!isk) { st_bf4(Q + (size_t)r * 512 + col, o1); st_bf4(Q + (size_t)r * 512 + col + 16, o2); }
                        else {
                            st_bf4(Kn + (size_t)r * 512 + col, o1); st_bf4(Kn + (size_t)r * 512 + col + 16, o2);
                            bf16_t* kt = KT + (((size_t)((bidx * 4 + h0 + bj) * 34 + (tok >> 7)) * 128 + wc * 32 + 4 * fq)) * 128 + (tok & 127);
#pragma unroll
                            for (int e = 0; e < 4; ++e) { kt[e * 128] = (bf16_t)f2bf(o1[e]); kt[(16 + e) * 128] = (bf16_t)f2bf(o2[e]); }
                        }
                    }
                }
        } else if (pc < 8) {
            const int h = pc - 4;
#pragma unroll
            for (int ai = 0; ai < 2; ++ai)
#pragma unroll
                for (int m = 0; m < 4; ++m) {
                    const int r = rbase + ai * HALF + m * 16;
                    const int tok = lat ? (r & 4095) : 4096 + ((r - T) & 255);
#pragma unroll
                    for (int bj = 0; bj < 2; ++bj)
#pragma unroll
                        for (int n = 0; n < 2; ++n) {
                            const f32x4 v = acc[ai][bj][m][n] + bv[bj][n];
                            bf16_t* vt = VT + (((size_t)((bidx * 4 + h) * 34 + (tok >> 7)) * 256 + bj * HALF + wc * 32 + n * 16 + 4 * fq)) * 128 + (tok & 127);
#pragma unroll
                            for (int e = 0; e < 4; ++e) vt[e * 128] = (bf16_t)f2bf(v[e]);
                        }
                }
        } else {
            const bool isg = pc < 12;
            bf16_t* O = isg ? SG : HU; const int ldo = isg ? 1024 : 1536; const int c0 = (isg ? pc - 8 : pc - 12) * BM + wc * 32 + 4 * fq;
#pragma unroll
            for (int ai = 0; ai < 2; ++ai)
#pragma unroll
                for (int m = 0; m < 4; ++m) {
                    const int r = rbase + ai * HALF + m * 16;
#pragma unroll
                    for (int bj = 0; bj < 2; ++bj)
#pragma unroll
                        for (int n = 0; n < 2; ++n) {
                            f32x4 v = acc[ai][bj][m][n] + bv[bj][n];
                            if (isg) { v[0] = silu_f(v[0]); v[1] = silu_f(v[1]); v[2] = silu_f(v[2]); v[3] = silu_f(v[3]); }
                            st_bf4(O + (size_t)r * ldo + c0 + bj * HALF + n * 16, v);
                        }
                }
        }
    }
};
struct EpiGate {
    static constexpr bool PERM = true;
    bf16_t* O; const float* bias; float scale;
    __device__ __forceinline__ void operator()(const f32x4 (&acc)[2][2][4][2], const Unit& u, int wr, int wc, int fr, int fq) const {
        const int rbase = u.pm * BM + wr * 64 + fr, col0 = u.pc * BM + wc * 32 + 8 * fq;
        f32x4 bv[2][2];
#pragma unroll
        for (int bj = 0; bj < 2; ++bj)
#pragma unroll
            for (int n = 0; n < 2; ++n) bv[bj][n] = *(const f32x4*)(bias + col0 + bj * HALF + 4 * n);
#pragma unroll
        for (int ai = 0; ai < 2; ++ai)
#pragma unroll
            for (int m = 0; m < 4; ++m) { bf16_t* rowp = O + (size_t)(rbase + ai * HALF + m * 16) * 1024 + col0;
#pragma unroll
                for (int bj = 0; bj < 2; ++bj) { f32x4 v0 = acc[ai][bj][m][0] * scale + bv[bj][0], v1 = acc[ai][bj][m][1] * scale + bv[bj][1];
#pragma unroll
                    for (int e = 0; e < 4; ++e) { v0[e] = sigm_f(v0[e]); v1[e] = sigm_f(v1[e]); }
                    st_bf8(rowp + bj * HALF, v0, v1); } }
    }
};
template <int MODE> struct EpiMerge {
    static constexpr bool PERM = true;
    bf16_t* O; const bf16_t* P;
    __device__ __forceinline__ void operator()(const f32x4 (&acc)[2][2][4][2], const Unit& u, int wr, int wc, int fr, int fq) const {
        const int rbase = u.pm * BM + wr * 64 + fr, col0 = u.pc * BM + wc * 32 + 8 * fq;
#pragma unroll
        for (int ai = 0; ai < 2; ++ai)
#pragma unroll
            for (int m = 0; m < 4; ++m) { const size_t off = (size_t)(rbase + ai * HALF + m * 16) * 1024 + col0;
#pragma unroll
                for (int bj = 0; bj < 2; ++bj) {
                    const u32x4 gw = *(const u32x4*)(O + off + bj * HALF);
                    f32x4 v0 = acc[ai][bj][m][0], v1 = acc[ai][bj][m][1];
                    v0[0] *= bflo(gw.x); v0[1] *= bfhi(gw.x); v0[2] *= bflo(gw.y); v0[3] *= bfhi(gw.y);
                    v1[0] *= bflo(gw.z); v1[1] *= bfhi(gw.z); v1[2] *= bflo(gw.w); v1[3] *= bfhi(gw.w);
                    if (MODE == 1) { const u32x4 pw = *(const u32x4*)(P + off + bj * HALF);
                        v0[0] += bflo(pw.x); v0[1] += bfhi(pw.x); v0[2] += bflo(pw.y); v0[3] += bfhi(pw.y);
                        v1[0] += bflo(pw.z); v1[1] += bfhi(pw.z); v1[2] += bflo(pw.w); v1[3] += bfhi(pw.w); }
                    st_bf8(O + off + bj * HALF, v0, v1); } }
    }
};
struct EpiX1 {
    static constexpr bool PERM = false;
    const float* x; const float* mod; float* out;
    __device__ __forceinline__ void operator()(const f32x4 (&acc)[2][2][4][2], const Unit& u, int wr, int wc, int fr, int fq) const {
        const int rbase = u.pm * BM + wr * 64 + fr, col0 = u.pc * BM + wc * 32 + 4 * fq;
        const float* gt = mod + (size_t)(u.pm >> 4) * 6144 + 2048 + col0;
        f32x4 gv[2][2];
#pragma unroll
        for (int bj = 0; bj < 2; ++bj)
#pragma unroll
            for (int n = 0; n < 2; ++n) gv[bj][n] = *(const f32x4*)(gt + bj * HALF + n * 16);
#pragma unroll
        for (int ai = 0; ai < 2; ++ai)
#pragma unroll
            for (int m = 0; m < 4; ++m) { const size_t off = (size_t)(rbase + ai * HALF + m * 16) * 1024 + col0;
#pragma unroll
                for (int bj = 0; bj < 2; ++bj)
#pragma unroll
                    for (int n = 0; n < 2; ++n) { const f32x4 xv = *(const f32x4*)(x + off + bj * HALF + n * 16); *(f32x4*)(out + off + bj * HALF + n * 16) = xv + gv[bj][n] * acc[ai][bj][m][n]; } }
    }
};
struct EpiMoe1 {
    static constexpr bool PERM = true;
    unsigned char* HM;
    __device__ __forceinline__ void operator()(const f32x4 (&acc)[2][2][4][2], const Unit& u, int wr, int wc, int fr, int fq) const {
        const int rbase = u.pm * BM + wr * 64 + fr, col0 = u.pc * HALF + wc * 32 + 8 * fq;
#pragma unroll
        for (int ai = 0; ai < 2; ++ai)
#pragma unroll
            for (int m = 0; m < 4; ++m) {
                f32x4 v0, v1;
#pragma unroll
                for (int e = 0; e < 4; ++e) { v0[e] = silu_f(acc[ai][0][m][0][e] * 0.03125f) * (acc[ai][1][m][0][e] * 0.03125f); v1[e] = silu_f(acc[ai][0][m][1][e] * 0.03125f) * (acc[ai][1][m][1][e] * 0.03125f); }
                u32x2 w; w.x = pk_fp8x4(v0[0], v0[1], v0[2], v0[3]); w.y = pk_fp8x4(v1[0], v1[1], v1[2], v1[3]);
                *(u32x2*)(HM + (size_t)(rbase + ai * HALF + m * 16) * EH + col0) = w; }
    }
};
struct EpiBf {
    static constexpr bool PERM = true;
    bf16_t* O; int ldo; float scale;
    __device__ __forceinline__ void operator()(const f32x4 (&acc)[2][2][4][2], const Unit& u, int wr, int wc, int fr, int fq) const {
        const int rbase = u.pm * BM + wr * 64 + fr, col0 = u.pc * BM + wc * 32 + 8 * fq;
#pragma unroll
        for (int ai = 0; ai < 2; ++ai)
#pragma unroll
            for (int m = 0; m < 4; ++m)
#pragma unroll
                for (int bj = 0; bj < 2; ++bj) st_bf8(O + (size_t)(rbase + ai * HALF + m * 16) * ldo + col0 + bj * HALF, acc[ai][bj][m][0] * scale, acc[ai][bj][m][1] * scale);
    }
};
}

namespace gt {
constexpr int STAGE_BYTES = 128 * 144 + 256 * 144;
struct NoHook { template <class A> __device__ __forceinline__ void operator()(int, A&) const {} };
struct NoTf { __device__ __forceinline__ u32x4 operator()(int, int, u32x4 v) const { return v; } };
template <int NT, int BKT, class AL, class BL, class Pre = NoHook, class Post = NoHook, class TfA = NoTf>
__device__ __forceinline__ void gemm_tile(f32x4 (&acc)[4][NT], const AL& al, const BL& bl, int nk, LAS unsigned char* st, int tid, const Pre& pre = Pre(), const Post& post = Post(), const TfA& tfa = TfA()) {
    constexpr int AST = (BKT + 8) * 2, PPR = BKT / 8, NA = 128 * PPR / 512, NB = 64 * NT * PPR / 512;
    const int lane = tid & 63, wid = tid >> 6, wr = wid >> 2, wc = wid & 3, fr = lane & 15, fq = lane >> 4;
    LAS unsigned char* sa = st; LAS unsigned char* sb = st + 128 * AST;
    u32x4 ra[NA], rb[NB];
#pragma unroll
    for (int i = 0; i < NA; ++i) { const int p = tid + i * 512; ra[i] = al(p / PPR, (p % PPR) * 8); }
#pragma unroll
    for (int i = 0; i < NB; ++i) { const int p = tid + i * 512; rb[i] = bl(p / PPR, (p % PPR) * 8); }
    for (int kt = 0; kt < nk; ++kt) {
        __syncthreads();
#pragma unroll
        for (int i = 0; i < NA; ++i) { const int p = tid + i * 512; *(LAS u32x4*)(sa + (p / PPR) * AST + (p % PPR) * 16) = tfa(p / PPR, kt * BKT + (p % PPR) * 8, ra[i]); }
#pragma unroll
        for (int i = 0; i < NB; ++i) { const int p = tid + i * 512; *(LAS u32x4*)(sb + (p / PPR) * AST + (p % PPR) * 16) = rb[i]; }
        __syncthreads();
        if (kt + 1 < nk) {
            int t2 = tid; asm volatile("" : "+v"(t2));
#pragma unroll
            for (int i = 0; i < NA; ++i) { const int p = t2 + i * 512; ra[i] = al(p / PPR, (kt + 1) * BKT + (p % PPR) * 8); }
#pragma unroll
            for (int i = 0; i < NB; ++i) { const int p = t2 + i * 512; rb[i] = bl(p / PPR, (kt + 1) * BKT + (p % PPR) * 8); }
        }
        pre(kt, acc);
#pragma unroll
        for (int kk = 0; kk < BKT / 32; ++kk) {
            bf16x8 a[4], b[NT];
#pragma unroll
            for (int m = 0; m < 4; ++m) a[m] = *(const LAS bf16x8*)(sa + (wr * 64 + m * 16 + fr) * AST + kk * 64 + fq * 16);
#pragma unroll
            for (int n = 0; n < NT; ++n) b[n] = *(const LAS bf16x8*)(sb + (wc * 16 * NT + n * 16 + fr) * AST + kk * 64 + fq * 16);
#pragma unroll
            for (int m = 0; m < 4; ++m)
#pragma unroll
                for (int n = 0; n < NT; ++n) acc[m][n] = __builtin_amdgcn_mfma_f32_16x16x32_bf16(a[m], b[n], acc[m][n], 0, 0, 0);
        }
        post(kt, acc);
    }
    __syncthreads();
}
template <int NT, int BKT>
__device__ __forceinline__ void compute_tile(f32x4 (&acc)[4][NT], LAS unsigned char* st, int tid) {
    constexpr int AST = (BKT + 8) * 2;
    const int lane = tid & 63, wid = tid >> 6, wr = wid >> 2, wc = wid & 3, fr = lane & 15, fq = lane >> 4;
    LAS unsigned char* sa = st; LAS unsigned char* sb = st + 128 * AST;
#pragma unroll
    for (int kk = 0; kk < BKT / 32; ++kk) {
        bf16x8 a[4], b[NT];
#pragma unroll
        for (int m = 0; m < 4; ++m) a[m] = *(const LAS bf16x8*)(sa + (wr * 64 + m * 16 + fr) * AST + kk * 64 + fq * 16);
#pragma unroll
        for (int n = 0; n < NT; ++n) b[n] = *(const LAS bf16x8*)(sb + (wc * 16 * NT + n * 16 + fr) * AST + kk * 64 + fq * 16);
#pragma unroll
        for (int m = 0; m < 4; ++m)
#pragma unroll
            for (int n = 0; n < NT; ++n) acc[m][n] = __builtin_amdgcn_mfma_f32_16x16x32_bf16(a[m], b[n], acc[m][n], 0, 0, 0);
    }
}
struct LdRows {
    const bf16_t* base; int ld;
    __device__ __forceinline__ u32x4 operator()(int row, int k) const { return *(const u32x4*)(base + (size_t)row * ld + k); }
};
__device__ __forceinline__ u32x4 scale8(u32x4 v, float s0, float s1, float s2, float s3, float s4, float s5, float s6, float s7) {
    u32x4 o; o.x = pk2(bflo(v.x) * s0, bfhi(v.x) * s1); o.y = pk2(bflo(v.y) * s2, bfhi(v.y) * s3); o.z = pk2(bflo(v.z) * s4, bfhi(v.z) * s5); o.w = pk2(bflo(v.w) * s6, bfhi(v.w) * s7); return o;
}
}


#define XB_TMO      128
#define XB_XCNT(j)  (256  + 64 * (j))
#define XB_XSUB(j)  (1280 + 64 * (j))
#define XB_XGEN(j)  (2304 + 64 * (j))
#define XB_TOP      3328
#define XB_TOPGEN   3392
#define XCD_BAR_WORDS 3456
#define XB_SPIN_CAP (1u << 18)
__device__ __forceinline__ unsigned xb_ld(unsigned* p)              { return __hip_atomic_load(p, __ATOMIC_RELAXED, __HIP_MEMORY_SCOPE_AGENT); }
__device__ __forceinline__ unsigned xb_add(unsigned* p, unsigned v) { return __hip_atomic_fetch_add(p, v, __ATOMIC_RELAXED, __HIP_MEMORY_SCOPE_AGENT); }
__device__ __forceinline__ unsigned xb_xcc_id() { return (unsigned)__builtin_amdgcn_s_getreg((3 << 11) | 20) & 0xFu; }
#define XB_SPIN(cond, bar) do { unsigned _sp = 0; while (cond) { __builtin_amdgcn_s_sleep(1); \
    if ((++_sp & 255u) == 0u) { if (xb_ld(&(bar)[XB_TMO])) break; if (_sp > XB_SPIN_CAP) { atomicAdd(&(bar)[XB_TMO], 1u); break; } } } } while (0)
struct XcdBarrier { unsigned* bar; unsigned x; volatile LAS unsigned* st; };
__device__ __forceinline__ XcdBarrier xcd_barrier_post(unsigned* bar, volatile LAS unsigned* st) {
    XcdBarrier b; b.bar = bar; b.x = xb_xcc_id(); b.st = st;
    if (threadIdx.x == 0) (void)xb_add(&bar[XB_XCNT(b.x)], 1u);
    return b;
}
__device__ __forceinline__ void xcd_barrier_complete(unsigned* bar, unsigned x, unsigned& nloc, unsigned& nx) {
    const unsigned G = gridDim.x * gridDim.y * gridDim.z;
    unsigned sum, cnt, mine, sp = 0u;
    for (;;) {
        sum = 0u; cnt = 0u; mine = 0u;
#pragma unroll
        for (unsigned j = 0; j < 16; ++j) { const unsigned c = xb_ld(&bar[XB_XCNT(j)]); sum += c; cnt += (c > 0u) ? 1u : 0u; mine = (j == x) ? c : mine; }
        if (sum == G) break;
        __builtin_amdgcn_s_sleep(1);
        if ((++sp & 255u) == 0u) { if (xb_ld(&bar[XB_TMO])) break; if (sp > XB_SPIN_CAP) { atomicAdd(&bar[XB_TMO], 1u); break; } }
    }
    nloc = mine > 0u ? mine : 1u; nx = cnt > 0u ? cnt : 1u;
}
__device__ __forceinline__ void xcd_barrier(const XcdBarrier& b) {
    asm volatile("s_waitcnt vmcnt(0)" ::: "memory");
    __syncthreads();
    if (threadIdx.x == 0) {
        unsigned* bar = b.bar;
        __builtin_amdgcn_s_waitcnt(0);
        unsigned nloc = b.st[0], nx = b.st[1];
        if (nloc == 0u) { xcd_barrier_complete(bar, b.x, nloc, nx); b.st[0] = nloc; b.st[1] = nx; }
        const unsigned old = xb_add(&bar[XB_XSUB(b.x)], 1u);
        const unsigned gen = old / nloc;
        if (old + 1u == (gen + 1u) * nloc) {
            __builtin_amdgcn_fence(__ATOMIC_RELEASE, "agent");
            asm volatile("s_waitcnt vmcnt(0)" ::: "memory");
            const unsigned og = xb_add(&bar[XB_TOP], 1u);
            const unsigned tg = og / nx;
            if (og + 1u == (tg + 1u) * nx) xb_add(&bar[XB_TOPGEN], 1u);
            else XB_SPIN(xb_ld(&bar[XB_TOPGEN]) == tg, bar);
            __builtin_amdgcn_fence(__ATOMIC_ACQUIRE, "agent");
            xb_add(&bar[XB_XGEN(b.x)], 1u);
            asm volatile("s_waitcnt vmcnt(0)" ::: "memory");
        } else {
            XB_SPIN(xb_ld(&bar[XB_XGEN(b.x)]) == gen, bar);
            __builtin_amdgcn_fence(__ATOMIC_ACQUIRE, "agent");
            asm volatile("s_waitcnt vmcnt(0)" ::: "memory");
        }
    }
    __syncthreads();
}

struct Args { const float* in[31]; float* out; unsigned char* ws; };
enum { I_X = 0, I_C, I_CTX, I_CCTX, I_ADAW, I_ADAB, I_N1G, I_N2G, I_WIN, I_BIN, I_DECAY, I_RETWO, I_HCW, I_HCB, I_HW1, I_HB1, I_HFREQ, I_HW2, I_HB2, I_HW3, I_HSKIP, I_HYWO, I_WOUT,
       I_RGW, I_RGB, I_REW, I_REB, I_EW1, I_EW3, I_EW2, I_FNG };

template <class RowMap>
__device__ __forceinline__ void transpose_item(const float* W, int N, int k0, int n0, bf16_t* WT, int ldt, const RowMap& rm, LAS float* scr, int lane) {
    const int lr = lane >> 4, lc = (lane & 15) * 4;
#pragma unroll
    for (int i = 0; i < 16; ++i) { const int kk = 4 * i + lr; const f32x4 v = *(const f32x4*)(W + (size_t)(k0 + kk) * N + n0 + lc); LAS float* s = scr + kk * 69 + lc; s[0] = v[0]; s[1] = v[1]; s[2] = v[2]; s[3] = v[3]; }
    asm volatile("s_waitcnt lgkmcnt(0)" ::: "memory");
    const int c = lane & 7;
#pragma unroll
    for (int j = 0; j < 8; ++j) { const int n = (lane >> 3) + 8 * j; const LAS float* s = scr + (8 * c) * 69 + n;
        u32x4 o; o.x = pk2(s[0 * 69], s[1 * 69]); o.y = pk2(s[2 * 69], s[3 * 69]); o.z = pk2(s[4 * 69], s[5 * 69]); o.w = pk2(s[6 * 69], s[7 * 69]);
        *(u32x4*)(WT + (size_t)rm(n0 + n) * ldt + k0 + 8 * c) = o; }
    asm volatile("s_waitcnt lgkmcnt(0)" ::: "memory");
}
using pg8::pk_fp8x4;
template <class RowMap>
__device__ __forceinline__ void transpose_item_f8(const float* W, int N, int k0, int n0, unsigned char* WT, int ldt, const RowMap& rm, float scale, LAS float* scr, int lane) {
    const int lr = lane >> 4, lc = (lane & 15) * 4;
#pragma unroll
    for (int i = 0; i < 16; ++i) { const int kk = 4 * i + lr; const f32x4 v = *(const f32x4*)(W + (size_t)(k0 + kk) * N + n0 + lc); LAS float* s = scr + kk * 69 + lc; s[0] = v[0]; s[1] = v[1]; s[2] = v[2]; s[3] = v[3]; }
    asm volatile("s_waitcnt lgkmcnt(0)" ::: "memory");
    const int c = lane & 7;
#pragma unroll
    for (int j = 0; j < 8; ++j) { const int n = (lane >> 3) + 8 * j; const LAS float* s = scr + (8 * c) * 69 + n;
        u32x2 o; o.x = pk_fp8x4(s[0 * 69] * scale, s[1 * 69] * scale, s[2 * 69] * scale, s[3 * 69] * scale); o.y = pk_fp8x4(s[4 * 69] * scale, s[5 * 69] * scale, s[6 * 69] * scale, s[7 * 69] * scale);
        *(u32x2*)(WT + (size_t)rm(n0 + n) * ldt + k0 + 8 * c) = o; }
    asm volatile("s_waitcnt lgkmcnt(0)" ::: "memory");
}
struct RmId { __device__ __forceinline__ int operator()(int n) const { return n; } };
struct RmWin { __device__ __forceinline__ int operator()(int n) const { return win_destrow(n); } };
struct RmE13 { int add; __device__ __forceinline__ int operator()(int n) const { return 256 * (n >> 7) + (n & 127) + add; } };

__device__ __forceinline__ float lg2_decay(float logit) { return -log1pf(expf(-logit)) * 1.4426950408889634f; }

__device__ __forceinline__ void short_conv8(const bf16_t* HU, int row, int t, int ch, const float* cw, const float* cb, float (&o)[8]) {
    const f32x4 b0 = *(const f32x4*)(cb + ch), b1 = *(const f32x4*)(cb + ch + 4);
#pragma unroll
    for (int e = 0; e < 4; ++e) { o[e] = b0[e]; o[4 + e] = b1[e]; }
#pragma unroll
    for (int j = 0; j < 3; ++j) {
        const int tt = t + j - 1;
        if (tt >= 0 && tt < SEQ) {
            const u32x4 v = *(const u32x4*)(HU + (size_t)(row + j - 1) * 1536 + ch);
            const f32x4 w0 = *(const f32x4*)(cw + j * 1536 + ch), w1 = *(const f32x4*)(cw + j * 1536 + ch + 4);
            o[0] += bflo(v.x) * w0[0]; o[1] += bfhi(v.x) * w0[1]; o[2] += bflo(v.y) * w0[2]; o[3] += bfhi(v.y) * w0[3];
            o[4] += bflo(v.z) * w1[0]; o[5] += bfhi(v.z) * w1[1]; o[6] += bflo(v.w) * w1[2]; o[7] += bfhi(v.w) * w1[3];
        }
    }
}


__device__ __forceinline__ void short_conv8x8(const bf16_t* HU, int row0, int t0, int ch, const float* cw, const float* cb, float (&o)[8][8]) {
    u32x4 rw[10];
#pragma unroll
    for (int r = 0; r < 10; ++r) { const int tt = t0 + r - 1; rw[r] = (u32x4){0u, 0u, 0u, 0u}; if (tt >= 0 && tt < SEQ) rw[r] = *(const u32x4*)(HU + (size_t)(row0 + r - 1) * 1536 + ch); }
    float w[3][8], bb[8];
#pragma unroll
    for (int j = 0; j < 3; ++j) { const f32x4 w0 = *(const f32x4*)(cw + j * 1536 + ch), w1 = *(const f32x4*)(cw + j * 1536 + ch + 4);
#pragma unroll
        for (int e = 0; e < 4; ++e) { w[j][e] = w0[e]; w[j][4 + e] = w1[e]; } }
    { const f32x4 b0 = *(const f32x4*)(cb + ch), b1 = *(const f32x4*)(cb + ch + 4);
#pragma unroll
      for (int e = 0; e < 4; ++e) { bb[e] = b0[e]; bb[4 + e] = b1[e]; } }
#pragma unroll
    for (int t = 0; t < 8; ++t)
#pragma unroll
        for (int e = 0; e < 8; ++e) o[t][e] = bb[e];
#pragma unroll
    for (int r = 0; r < 10; ++r) {
        float u[8]; u[0] = bflo(rw[r].x); u[1] = bfhi(rw[r].x); u[2] = bflo(rw[r].y); u[3] = bfhi(rw[r].y); u[4] = bflo(rw[r].z); u[5] = bfhi(rw[r].z); u[6] = bflo(rw[r].w); u[7] = bfhi(rw[r].w);
#pragma unroll
        for (int j = 0; j < 3; ++j) { const int t = r - j;
            if (t >= 0 && t < 8) {
#pragma unroll
                for (int e = 0; e < 8; ++e) o[t][e] += u[e] * w[j][e]; } }
    }
}

typedef const __attribute__((address_space(4))) Args CArgs;
__device__ __forceinline__ CArgs* args_ptr() { CArgs* p = (CArgs*)__builtin_amdgcn_kernarg_segment_ptr(); asm volatile("" : "+s"(p)); return p; }
#define DECL_PTRS \
    CArgs& a = *args_ptr(); unsigned char* ws = a.ws; unsigned char* dob = (unsigned char*)a.out; \
    int tid = threadIdx.x; asm volatile("" : "+v"(tid)); const int lane = tid & 63, wave = tid >> 6, gw = bid * 8 + wave; (void)lane; (void)gw; \
    int* cnt = (int*)(ws + WS_CTL); \
    float* MOD = (float*)(ws + WS_MOD); float* ROPE = (float*)(ws + WS_ROPE); float* BINP = (float*)(ws + WS_BINP); float* FPART = (float*)(ws + WS_FPART); \
    int* TOKINFO = (int*)(ws + WS_TOKINFO); int* LISTS = (int*)(ws + WS_LISTS); \
    bf16_t* TR = (bf16_t*)(ws + WS_TR); \
    bf16_t* WT_IN = (bf16_t*)(ws + WS_WT_IN); bf16_t* WT_RETO = (bf16_t*)(ws + WS_WT_RETO); bf16_t* WT_HYO = (bf16_t*)(ws + WS_WT_HYO); bf16_t* WT_OUT = (bf16_t*)(ws + WS_WT_OUT); \
    bf16_t* Qb = (bf16_t*)(ws + WS_Q); bf16_t* Kb = (bf16_t*)(ws + WS_K); bf16_t* KT = (bf16_t*)(ws + WS_KT); bf16_t* VT = (bf16_t*)(ws + WS_VT); \
    float* FILT = (float*)(ws + WS_KV); \
    bf16_t* SGR = (bf16_t*)(ws + WS_SGR); bf16_t* SGH = (bf16_t*)(ws + WS_SGH); bf16_t* XB = (bf16_t*)(ws + WS_XB); \
    bf16_t* SG = (bf16_t*)(ws + WS_SG); bf16_t* HU = (bf16_t*)(ws + WS_HU); bf16_t* HM = (bf16_t*)(ws + WS_HU); \
    bf16_t* KV = (bf16_t*)(ws + WS_KV); bf16_t* WE13 = (bf16_t*)(ws + WS_WE13); bf16_t* WE2 = (bf16_t*)(ws + WS_WE2); \
    bf16_t* XN = (bf16_t*)(dob + DO_XN); bf16_t* ZT = (bf16_t*)(dob + DO_ZT); unsigned char* XN8 = dob + DO_XN8; unsigned char* WTG8 = (unsigned char*)(ws + WS_WT_IN) + (size_t)NINA * 1024 * 2; (void)XN8; (void)WTG8; \
    float* X1 = a.out; \
    (void)cnt; (void)MOD; (void)ROPE; (void)BINP; (void)FPART; (void)TOKINFO; (void)LISTS; (void)TR; (void)WT_IN; (void)WT_RETO; (void)WT_HYO; (void)WT_OUT; (void)Qb; (void)Kb; (void)KT; (void)VT; (void)FILT; \
    (void)SGR; (void)SGH; (void)XB; (void)SG; (void)HU; (void)HM; (void)KV; (void)WE13; (void)WE2; (void)XN; (void)ZT; (void)X1;

__global__ void __launch_bounds__(512, 2) fwd_kernel(Args a_) {
    extern __shared__ __attribute__((aligned(16))) unsigned char lds_raw[];
    LAS unsigned char* lds = (LAS unsigned char*)lds_raw;
    cg::grid_group grid = cg::this_grid();
    const int G = gridDim.x, bid = blockIdx.x, NGW = G * 8;
    volatile LAS unsigned* bst = (volatile LAS unsigned*)(lds + LDS_BYTES - 16);
    if (threadIdx.x == 0) { bst[0] = 0u; bst[1] = 0u; }
    __syncthreads();
    if (blockIdx.x == 0) { unsigned* bw = (unsigned*)(args_ptr()->ws + WS_CTL) + 1024; for (int i = threadIdx.x; i < XCD_BAR_WORDS; i += 512) bw[i] = 0u; }
#define GRID_BAR() xcd_barrier(xbar)
    unsigned long long tprev_ = 0, spin_ = 0;
    if (PROBE_PHASE >= 0) tprev_ = __builtin_amdgcn_s_memrealtime();
#define STAMP(k) do { if (PROBE_PHASE >= 0 && blockIdx.x == 0 && threadIdx.x == 0) { const unsigned long long now_ = __builtin_amdgcn_s_memrealtime(); if ((k) == PROBE_PHASE) spin_ = now_ - tprev_; tprev_ = now_; } } while (0)

    { DECL_PTRS
    for (int it = bid; it < 193; it += G) {
        if (it < 192) {
            const int col0 = it * 32, kq = tid >> 5, cl = tid & 31;
            LAS float* sl = (LAS float*)(lds + 32768);
            for (int idx = tid; idx < 9 * 1024; idx += 512) { const int r = idx >> 10, k = idx & 1023; sl[k * 12 + r] = silu_f(r < 8 ? a.in[I_C][r * 1024 + k] : a.in[I_CCTX][k]); }
            __syncthreads();
            float acc9[9];
#pragma unroll
            for (int r = 0; r < 9; ++r) acc9[r] = 0.f;
#pragma unroll 8
            for (int kk = 0; kk < 64; ++kk) { const int k = kq * 64 + kk; const float w = a.in[I_ADAW][(size_t)k * 6144 + col0 + cl];
                const f32x4 s0 = *(const LAS f32x4*)(sl + k * 12), s1 = *(const LAS f32x4*)(sl + k * 12 + 4); const float s8 = sl[k * 12 + 8];
                acc9[0] += s0[0] * w; acc9[1] += s0[1] * w; acc9[2] += s0[2] * w; acc9[3] += s0[3] * w; acc9[4] += s1[0] * w; acc9[5] += s1[1] * w; acc9[6] += s1[2] * w; acc9[7] += s1[3] * w; acc9[8] += s8 * w; }
            LAS float* red = (LAS float*)lds;
#pragma unroll
            for (int r = 0; r < 9; ++r) red[(kq * 9 + r) * 32 + cl] = acc9[r];
            __syncthreads();
            if (tid < 288) { const int r = tid >> 5, c2 = tid & 31; float s = 0.f; for (int q = 0; q < 16; ++q) s += red[(q * 9 + r) * 32 + c2]; MOD[r * 6144 + col0 + c2] = s + a.in[I_ADAB][col0 + c2]; }
            __syncthreads();
        } else {
            for (int idx = tid; idx < 2048; idx += 512) { const int pos = idx >> 5, i = idx & 31; const float inv = powf(10000.f, -(float)i / 32.f); const float ang = (float)pos * inv; ROPE[idx] = cosf(ang); ROPE[2048 + idx] = sinf(ang); }
            for (int n = tid; n < 6656; n += 512) BINP[win_destrow(n)] = a.in[I_BIN][n];
        }
    }
    __syncthreads();
    {
        LAS float* scr = (LAS float*)(lds + wave * 17664);
        constexpr int I_IN = 16 * 104, I_RO = 16 * 16, I_HO = 8 * 16, I_OU = 16 * 16;
        for (int it = gw; it < I_IN + I_RO + I_HO + I_OU; it += NGW) {
            int r = it;
            if (r < I_IN) { const int nb = r % 104;
                if (nb < 72) transpose_item(a.in[I_WIN], 6656, 64 * (r / 104), 64 * nb, WT_IN, 1024, RmWin{}, scr, lane);
                else transpose_item_f8(a.in[I_WIN] + NINA, 6656, 64 * (r / 104), 64 * (nb - 72), WTG8, 1024, RmId{}, 32.f, scr, lane);
                continue; } r -= I_IN;
            if (r < I_RO) { transpose_item(a.in[I_RETWO], 1024, 64 * (r / 16), 64 * (r % 16), WT_RETO, 1024, RmId{}, scr, lane); continue; } r -= I_RO;
            if (r < I_HO) { transpose_item(a.in[I_HYWO], 1024, 64 * (r / 16), 64 * (r % 16), WT_HYO, 512, RmId{}, scr, lane); continue; } r -= I_HO;
            transpose_item(a.in[I_WOUT], 1024, 64 * (r / 16), 64 * (r % 16), WT_OUT, 1024, RmId{}, scr, lane);
        }
    }
    }
    grid.sync();
    const XcdBarrier xbar = xcd_barrier_post((unsigned*)(args_ptr()->ws + WS_CTL) + 1024, bst);
    STAMP(0);

    { DECL_PTRS
    for (int fi = bid; fi < 256; fi += G) {
        {
            const int t0 = fi * 16;
            LAS float* feats = (LAS float*)lds; LAS float* hid1 = feats + 544; LAS float* hid2 = hid1 + 1024;
            for (int idx = tid; idx < 16 * 33; idx += 512) { const int row = idx / 33, f = idx % 33; const float t = (float)(t0 + row) * (1.f / 4096.f); float v;
                if (f == 0) v = t; else { const int mb = (f - 1) & 15; const float band = 1e-4f + (float)mb * ((15.f - 1e-4f) / 15.f); const float ph = (6.283185307179586f * t) * band; v = f <= 16 ? cosf(ph) : -sinf(ph); }
                feats[idx] = v; }
            __syncthreads();
            for (int idx = tid; idx < 1024; idx += 512) { const int row = idx >> 6, j = idx & 63; float s = a.in[I_HB1][j]; for (int f = 0; f < 33; ++f) s += feats[row * 33 + f] * a.in[I_HW1][f * 64 + j]; hid1[idx] = sinf(a.in[I_HFREQ][j] * s); }
            __syncthreads();
            for (int idx = tid; idx < 1024; idx += 512) { const int row = idx >> 6, j = idx & 63; float s = a.in[I_HB2][j]; for (int k = 0; k < 64; ++k) s += hid1[row * 64 + k] * a.in[I_HW2][k * 64 + j]; hid2[j * 16 + row] = sinf(a.in[I_HFREQ][j] * s); }
            __syncthreads();
            const float slow = 4.605170185988091f / 1.5f, fast = 4.605170185988091f / 0.3f;
            for (int col = tid; col < 1024; col += 512) {
                float ac[16];
#pragma unroll
                for (int r = 0; r < 16; ++r) ac[r] = 0.f;
#pragma unroll 4
                for (int k = 0; k < 64; ++k) { const float w = a.in[I_HW3][k * 1024 + col];
#pragma unroll
                    for (int r4 = 0; r4 < 4; ++r4) { const f32x4 hv = *(const LAS f32x4*)(hid2 + k * 16 + 4 * r4); ac[4 * r4] += hv[0] * w; ac[4 * r4 + 1] += hv[1] * w; ac[4 * r4 + 2] += hv[2] * w; ac[4 * r4 + 3] += hv[3] * w; } }
                const float delta = slow + (float)(col & 511) * ((fast - slow) / 511.f); float ps = 0.f;
#pragma unroll
                for (int r = 0; r < 16; ++r) { const float t = (float)(t0 + r) * (1.f / 4096.f); ac[r] *= expf(-t * delta); ps += fabsf(ac[r]); }
#pragma unroll
                for (int r = 0; r < 4; ++r) *(f32x4*)(FILT + (size_t)col * 4096 + t0 + 4 * r) = (f32x4){ac[4 * r], ac[4 * r + 1], ac[4 * r + 2], ac[4 * r + 3]};
                FPART[fi * 1024 + col] = ps;
            }
            __syncthreads();
        }
    }
    for (int m0 = gw; m0 < MT; m0 += 2 * NGW) {
        f32x4 v[2][4]; float s[2] = {0.f, 0.f};
#pragma unroll
        for (int q = 0; q < 2; ++q) { const int m = m0 + q * NGW; const bool ok = m < MT; const bool lat = m < T;
            const float* xr = !ok ? a.in[I_X] : lat ? a.in[I_X] + (size_t)m * D : a.in[I_CTX] + (size_t)(m - T) * D;
#pragma unroll
            for (int j = 0; j < 4; ++j) { v[q][j] = *(const f32x4*)(xr + 4 * lane + 256 * j); s[q] += (v[q][j][0] * v[q][j][0] + v[q][j][1] * v[q][j][1]) + (v[q][j][2] * v[q][j][2] + v[q][j][3] * v[q][j][3]); } }
#pragma unroll
        for (int q = 0; q < 2; ++q) { const int m = m0 + q * NGW; if (m >= MT) break; const bool lat = m < T;
            const float* md = MOD + (size_t)(lat ? (m >> 12) : 8) * 6144;
            const float rstd = rsqrtf(wave_sum(s[q]) * (1.f / D) + EPS);
#pragma unroll
            for (int j = 0; j < 4; ++j) { const int c0 = 4 * lane + 256 * j; const f32x4 g = *(const f32x4*)(a.in[I_N1G] + c0), sh = *(const f32x4*)(md + c0), sc = *(const f32x4*)(md + 1024 + c0);
                const f32x4 o = (v[q][j] * rstd * g) * (sc + 1.f) + sh; u32x2 w; w.x = pk2(o[0], o[1]); w.y = pk2(o[2], o[3]); *(u32x2*)(XN + (size_t)m * D + c0) = w;
                if (lat) *(unsigned*)(XN8 + (size_t)m * D + c0) = pk_fp8x4(o[0], o[1], o[2], o[3]); } }
    }
    }
    GRID_BAR();
    STAMP(1);

    { DECL_PTRS
    for (int c = bid; c < 512; c += G) {
        LAS float* red = (LAS float*)lds;
        float p = 0.f; if (tid < 256) p = FPART[tid * 1024 + c]; else p = FPART[(tid - 256) * 1024 + 512 + c];
        p = wave_sum(p); if (lane == 0) red[wave] = p;
        __syncthreads();
        const float nf = 1.f / ((red[0] + red[1]) + (red[2] + red[3])), nb = 1.f / ((red[4] + red[5]) + (red[6] + red[7]));
        for (int i = tid; i < 8192; i += 512) { const int x = 4096 - i; float v = 0.f;
            if (x >= 0 && x < 4096) v += FILT[(size_t)c * 4096 + x] * nf;
            if (x <= 0 && x > -4096) v += FILT[(size_t)(512 + c) * 4096 - x] * nb;
            TR[(size_t)c * 8192 + i] = (bf16_t)f2bf(v); }
        __syncthreads();
    }
    __syncthreads();
    {
        pg8::Gemm g{XN, WT_IN, 1024, 1024, 1024}; pg8::InProjOrder S; S.init(G, bid);
        pg8::EpiInA E{Qb, Kb, KT, VT, SG, HU, BINP, ROPE};
        pg8::gemm_phase(lds, g, S, E);
    }
    }
    GRID_BAR();
    STAMP(2);

    { DECL_PTRS
    for (int it = bid; it < 512; it += G) {
        const int b = it >> 6, tt = (it >> 3) & 7, cc = it & 7;
        LAS bf16_t* zt = (LAS bf16_t*)lds;
        { int tl = tid; asm volatile("" : "+v"(tl));
          const int tq = tl >> 3, cg = tl & 7, c0 = cc * 64 + cg * 8, t0 = tt * 512 + tq * 8, row0 = b * SEQ + t0;
          float x1[8][8], vv[8][8];
          short_conv8x8(HU, row0, t0, 512 + c0, a.in[I_HCW], a.in[I_HCB], x1);
          short_conv8x8(HU, row0, t0, 1024 + c0, a.in[I_HCW], a.in[I_HCB], vv);
#pragma unroll
          for (int e = 0; e < 8; ++e) { u32x4 w; w.x = pk2(x1[0][e] * vv[0][e], x1[1][e] * vv[1][e]); w.y = pk2(x1[2][e] * vv[2][e], x1[3][e] * vv[3][e]); w.z = pk2(x1[4][e] * vv[4][e], x1[5][e] * vv[5][e]); w.w = pk2(x1[6][e] * vv[6][e], x1[7][e] * vv[7][e]);
              *(LAS u32x4*)(zt + (cg * 8 + e) * 520 + tq * 8) = w; } }
        __syncthreads();
#pragma unroll
        for (int i = 0; i < 8; ++i) { const int ch = wave * 8 + i; *(u32x4*)(ZT + ((size_t)(cc * 64 + ch) * 8 + b) * SEQ + tt * 512 + lane * 8) = *(const LAS u32x4*)(zt + ch * 520 + lane * 8); }
        __syncthreads();
    }
    {
        LAS float* wtab = (LAS float*)(lds + 104448);
        for (int u0 = bid; u0 < 256; u0 += G) {
            int tl = tid; asm volatile("" : "+v"(tl));
            const int u = (G == 256) ? (((u0 & 7) + 8 * (u0 >> 6)) * 8 + ((u0 >> 3) & 7)) : u0;
            const int chain = u >> 2, dvq = u & 3, bh = chain >> 1, dir = chain & 1, h = bh & 3;
            const float lg = lg2_decay(a.in[I_DECAY][dir * 4 + h]); const float g128 = exp2f(128.f * lg);
            if (tl < 128) wtab[tl] = exp2f((float)(dir == 0 ? 127 - tl : tl) * lg);
            __syncthreads();
            struct LdK { const bf16_t* base; const LAS float* w; int dir;
                __device__ __forceinline__ u32x4 operator()(int row, int k) const { const int kt = k >> 7, j = k & 127;
                    const int ck = dir == 0 ? (kt == 0 ? 32 : kt == 1 ? 33 : kt - 2) : (kt == 0 ? 33 : kt == 1 ? 32 : 33 - kt);
                    return *(const u32x4*)(base + ((size_t)ck * 128 + row) * 128 + j); } };
            struct LdV { const bf16_t* base; int dir;
                __device__ __forceinline__ u32x4 operator()(int row, int k) const { const int kt = k >> 7, j = k & 127;
                    const int ck = dir == 0 ? (kt == 0 ? 32 : kt == 1 ? 33 : kt - 2) : (kt == 0 ? 33 : kt == 1 ? 32 : 33 - kt);
                    return *(const u32x4*)(base + ((size_t)ck * 256 + row) * 128 + j); } };
            struct Pre { float g;
                __device__ __forceinline__ void operator()(int, f32x4 (&acc)[4][1]) const {
#pragma unroll
                    for (int m = 0; m < 4; ++m) acc[m][0] = acc[m][0] * g; } };
            struct Post { bf16_t* out; int tl;
                __device__ __forceinline__ void operator()(int kt, f32x4 (&acc)[4][1]) const {
                    const int wr = tl >> 8, wc = (tl >> 6) & 3, fr = tl & 15, fq = (tl >> 4) & 3;
                    bf16_t* o = out + (size_t)kt * 32768 + (size_t)(wc * 16 + fr) * 128 + wr * 64 + 4 * fq;
#pragma unroll
                    for (int m = 0; m < 4; ++m) { u32x2 w; w.x = pk2(acc[m][0][0], acc[m][0][1]); w.y = pk2(acc[m][0][2], acc[m][0][3]); *(u32x2*)(o + m * 16) = w; } } };
            f32x4 acc[4][1];
#pragma unroll
            for (int m = 0; m < 4; ++m) acc[m][0] = (f32x4){0.f, 0.f, 0.f, 0.f};
            const LdK al{KT + (size_t)bh * 34 * 128 * 128, wtab, dir}; const LdV bl{VT + (size_t)bh * 34 * 256 * 128 + (size_t)dvq * 64 * 128, dir};
            const Pre pre{g128}; const Post post{KV + (size_t)chain * 33 * 32768 + (size_t)dvq * 64 * 128, tl};
            u32x4 rg[3][6];
#define CH_LOAD(slot, kt) do { int _t = tl; asm volatile("" : "+v"(_t)); _Pragma("unroll") for (int i = 0; i < 4; ++i) { const int pz = _t + 512 * i; rg[slot][i] = al(pz >> 4, (kt) * 128 + (pz & 15) * 8); } \
        _Pragma("unroll") for (int i = 0; i < 2; ++i) { const int pz = _t + 512 * i; rg[slot][4 + i] = bl(pz >> 4, (kt) * 128 + (pz & 15) * 8); } } while (0)
#define CH_STEP(slot, kt) do { __syncthreads(); \
        _Pragma("unroll") for (int i = 0; i < 4; ++i) { const int pz = tl + 512 * i; const LAS float* wp = wtab + (pz & 15) * 8; const f32x4 w0 = *(const LAS f32x4*)wp, w1 = *(const LAS f32x4*)(wp + 4); \
            *(LAS u32x4*)(lds + (pz >> 4) * 272 + (pz & 15) * 16) = gt::scale8(rg[slot][i], w0[0], w0[1], w0[2], w0[3], w1[0], w1[1], w1[2], w1[3]); } \
        _Pragma("unroll") for (int i = 0; i < 2; ++i) { const int pz = tl + 512 * i; *(LAS u32x4*)(lds + 128 * 272 + (pz >> 4) * 272 + (pz & 15) * 16) = rg[slot][4 + i]; } \
        __syncthreads(); if ((kt) + 3 < 33) CH_LOAD(slot, (kt) + 3); pre(kt, acc); gt::compute_tile<1, 128>(acc, lds, tl); post(kt, acc); } while (0)
            CH_LOAD(0, 0); CH_LOAD(1, 1); CH_LOAD(2, 2);
            for (int kt = 0; kt < 33; kt += 3) { CH_STEP(0, kt); CH_STEP(1, kt + 1); CH_STEP(2, kt + 2); }
            __syncthreads();
#undef CH_LOAD
#undef CH_STEP
        }
    }
    }
    GRID_BAR();
    STAMP(3);

    { DECL_PTRS
    {
        typedef float f32x16 __attribute__((ext_vector_type(16)));
        constexpr int CPB = 16448, ZOFF = 4 * CPB, ROWB = 10256, PADB = 992;
        for (int i = tid; i < (8 * ROWB) / 16; i += 512) *(LAS u32x4*)(lds + ZOFF + i * 16) = (u32x4){0u, 0u, 0u, 0u};
        __syncthreads();
        u32x4 zr[8], tv0[2], tv1[2];
#define CV_FETCH(cc) do { int _t = tid; asm volatile("" : "+v"(_t)); const bf16_t* _z = ZT + (size_t)(cc) * 8 * SEQ; const bf16_t* _tr = TR + (size_t)(cc) * 8192; \
        _Pragma("unroll") for (int i = 0; i < 8; ++i) { const int q = _t + 512 * i; zr[i] = *(const u32x4*)(_z + (size_t)(q >> 9) * SEQ + (q & 511) * 8); } \
        _Pragma("unroll") for (int i = 0; i < 2; ++i) { const int u = _t + 512 * i; tv0[i] = *(const u32x4*)(_tr + 8 * u); tv1[i] = (u32x4){0u, 0u, 0u, 0u}; if (u < 1023) tv1[i] = *(const u32x4*)(_tr + 8 * u + 8); } } while (0)
        if (bid < 512) CV_FETCH(bid);
        for (int c = bid; c < 512; c += G) {
            int tl = tid; asm volatile("" : "+v"(tl));
            const int w = tl >> 6, l = tl & 63, col = l & 31, hh = l >> 5, Rl = col >> 3, nn = col & 7;
            bf16_t* zc = ZT + (size_t)c * 8 * SEQ;
#pragma unroll
            for (int i = 0; i < 8; ++i) { const int q = tl + 512 * i, n = q >> 9, off = (q & 511) * 8; *(LAS u32x4*)(lds + ZOFF + n * ROWB + PADB + off * 2) = zr[i]; }
#pragma unroll
            for (int i = 0; i < 2; ++i) { const int u = tl + 512 * i; const u32x4 v0 = tv0[i], v1 = tv1[i];
                const unsigned W0 = v0.x, W1 = v0.y, W2 = v0.z, W3 = v0.w, W4 = v1.x, W5 = v1.y;
                *(LAS u32x4*)(lds + 0 * CPB + 16 * u) = v0;
                *(LAS u32x4*)(lds + 1 * CPB + 16 * u) = (u32x4){(W0 >> 16) | (W1 << 16), (W1 >> 16) | (W2 << 16), (W2 >> 16) | (W3 << 16), (W3 >> 16) | (W4 << 16)};
                *(LAS u32x4*)(lds + 2 * CPB + 16 * u) = (u32x4){W1, W2, W3, W4};
                *(LAS u32x4*)(lds + 3 * CPB + 16 * u) = (u32x4){(W1 >> 16) | (W2 << 16), (W2 >> 16) | (W3 << 16), (W3 >> 16) | (W4 << 16), (W4 >> 16) | (W5 << 16)}; }
            __syncthreads();
            if (c + G < 512) CV_FETCH(c + G);
            const int dlo = 32 * w - 255;
            const int e0 = 4096 - 16 * dlo - col + 8 * hh;
            int aaddr = (e0 & 3) * CPB + 2 * (e0 & ~3);
            int baddr = ZOFF + nn * ROWB + PADB + 2 * (512 * w + 64 * Rl + 8 * hh - 16 * dlo);
            f32x16 acc[4];
#pragma unroll
            for (int q = 0; q < 4; ++q)
#pragma unroll
                for (int i = 0; i < 16; ++i) acc[q][i] = 0.f;
            u32x2 alo = *(const LAS u32x2*)(lds + aaddr), ahi = *(const LAS u32x2*)(lds + aaddr + 8);
            u32x4 bq[4];
#pragma unroll
            for (int q = 0; q < 4; ++q) bq[q] = *(const LAS u32x4*)(lds + baddr + 512 * (q >> 1) + 64 * (q & 1));
            for (int it = 0; it < 285; ++it) {
                aaddr -= 32; baddr -= 32;
                const u32x2 nlo = *(const LAS u32x2*)(lds + aaddr), nhi = *(const LAS u32x2*)(lds + aaddr + 8);
                u32x4 nb[4];
#pragma unroll
                for (int q = 0; q < 4; ++q) nb[q] = *(const LAS u32x4*)(lds + baddr + 512 * (q >> 1) + 64 * (q & 1));
                const bf16x8 af = __builtin_bit_cast(bf16x8, (u32x4){alo.x, alo.y, ahi.x, ahi.y});
#pragma unroll
                for (int q = 0; q < 4; ++q) acc[q] = __builtin_amdgcn_mfma_f32_32x32x16_bf16(af, __builtin_bit_cast(bf16x8, bq[q]), acc[q], 0, 0, 0);
                alo = nlo; ahi = nhi;
#pragma unroll
                for (int q = 0; q < 4; ++q) bq[q] = nb[q];
            }
            {
                const bf16x8 af = __builtin_bit_cast(bf16x8, (u32x4){alo.x, alo.y, ahi.x, ahi.y});
#pragma unroll
                for (int q = 0; q < 4; ++q) acc[q] = __builtin_amdgcn_mfma_f32_32x32x16_bf16(af, __builtin_bit_cast(bf16x8, bq[q]), acc[q], 0, 0, 0);
            }
            const float skip = a.in[I_HSKIP][c];
#pragma unroll
            for (int q = 0; q < 4; ++q)
#pragma unroll
                for (int gq = 0; gq < 4; ++gq) {
                    const int t0 = 512 * w + 256 * (q >> 1) + 32 * (q & 1) + 64 * Rl + 8 * gq + 4 * hh;
                    const u32x2 zz = *(const LAS u32x2*)(lds + ZOFF + nn * ROWB + PADB + 2 * t0);
                    u32x2 o; o.x = pk2(acc[q][4 * gq] + skip * bflo(zz.x), acc[q][4 * gq + 1] + skip * bfhi(zz.x)); o.y = pk2(acc[q][4 * gq + 2] + skip * bflo(zz.y), acc[q][4 * gq + 3] + skip * bfhi(zz.y));
                    *(u32x2*)(zc + (size_t)nn * SEQ + t0) = o;
                }
            __syncthreads();
        }
    }
    }
    GRID_BAR();
    STAMP(4);

    { DECL_PTRS
    {
        LAS unsigned char* Pl = lds + 104448;
        LAS float* sfb = (LAS float*)(lds + 104448 + 128 * 272);
        LAS float* rsum = sfb + 256;
        LAS bf16_t* ot = (LAS bf16_t*)lds;
        for (int u = bid; u < 1024; u += G) {
            int tl = tid; asm volatile("" : "+v"(tl));
            const int wr = tl >> 8, wc = (tl >> 6) & 3, fr = tl & 15, fq = (tl >> 4) & 3;
            const int bh = u >> 5, c = u & 31, b = bh >> 2, h = bh & 3, row0 = b * SEQ + c * 128;
            const float lgf = lg2_decay(a.in[I_DECAY][h]), lgb = lg2_decay(a.in[I_DECAY][4 + h]);
            if (tl < 128) sfb[tl] = exp2f((float)(tl + 1) * lgf); else if (tl < 256) sfb[tl] = exp2f((float)(128 - (tl - 128)) * lgb);
            {
                f32x4 sacc[4][2];
#pragma unroll
                for (int m = 0; m < 4; ++m)
#pragma unroll
                    for (int n = 0; n < 2; ++n) sacc[m][n] = (f32x4){0.f, 0.f, 0.f, 0.f};
                gt::gemm_tile<2, 128>(sacc, gt::LdRows{Qb + (size_t)row0 * 512 + h * 128, 512}, gt::LdRows{Kb + (size_t)row0 * 512 + h * 128, 512}, 1, lds, tl);
#pragma unroll
                for (int m = 0; m < 4; ++m)
#pragma unroll
                    for (int n = 0; n < 2; ++n)
#pragma unroll
                        for (int j = 0; j < 4; ++j) { const int i = wr * 64 + m * 16 + 4 * fq + j, jj = wc * 32 + n * 16 + fr, df = i - jj;
                            const float dcy = df >= 0 ? exp2f((float)df * lgf) : exp2f((float)(-df) * lgb);
                            *(LAS bf16_t*)(Pl + i * 272 + jj * 2) = (bf16_t)f2bf(sacc[m][n][j] * dcy); }
                asm volatile("" ::: "memory");
            }
            __syncthreads();
            struct LdA2 { LAS unsigned char* P; const bf16_t* q; const LAS float* sc;
                __device__ __forceinline__ u32x4 operator()(int row, int k) const {
                    if (k < 128) return *(const LAS u32x4*)(P + row * 272 + k * 2);
                    return *(const u32x4*)(q + (size_t)row * 512 + (k < 256 ? k - 128 : k - 256)); } };
            struct TfA2 { const LAS float* sc;
                __device__ __forceinline__ u32x4 operator()(int row, int k, u32x4 v) const { if (k < 128) return v; const float s = sc[k < 256 ? row : 128 + row]; return gt::scale8(v, s, s, s, s, s, s, s, s); } };
            struct LdB2 { const bf16_t* vt; const bf16_t* sf; const bf16_t* sb;
                __device__ __forceinline__ u32x4 operator()(int dv, int k) const {
                    if (k < 128) return *(const u32x4*)(vt + (size_t)dv * 128 + k);
                    if (k < 256) return *(const u32x4*)(sf + (size_t)dv * 128 + (k - 128));
                    return *(const u32x4*)(sb + (size_t)dv * 128 + (k - 256)); } };
            f32x4 acc[4][4];
#pragma unroll
            for (int m = 0; m < 4; ++m)
#pragma unroll
                for (int n = 0; n < 4; ++n) acc[m][n] = (f32x4){0.f, 0.f, 0.f, 0.f};
            const LdA2 al{Pl, Qb + (size_t)row0 * 512 + h * 128, sfb};
            const LdB2 bl{VT + ((size_t)bh * 34 + c) * 256 * 128, KV + ((size_t)(bh * 2 + 0) * 33 + (c + 1)) * 32768, KV + ((size_t)(bh * 2 + 1) * 33 + (32 - c)) * 32768};
            gt::gemm_tile<4, 64>(acc, al, bl, 6, lds, tl, gt::NoHook(), gt::NoHook(), TfA2{sfb});
#pragma unroll
            for (int m = 0; m < 4; ++m)
#pragma unroll
                for (int j = 0; j < 4; ++j) { float s = 0.f;
#pragma unroll
                    for (int n = 0; n < 4; ++n) s += acc[m][n][j] * acc[m][n][j];
                    s += __shfl_xor(s, 1); s += __shfl_xor(s, 2); s += __shfl_xor(s, 4); s += __shfl_xor(s, 8);
                    if (fr == 0) rsum[(wr * 64 + m * 16 + 4 * fq + j) * 4 + wc] = s; }
            __syncthreads();
#pragma unroll
            for (int m = 0; m < 4; ++m)
#pragma unroll
                for (int j = 0; j < 4; ++j) { const int i = wr * 64 + m * 16 + 4 * fq + j; const f32x4 rs = *(const LAS f32x4*)(rsum + i * 4);
                    const float rstd = rsqrtf(((rs[0] + rs[1]) + (rs[2] + rs[3])) * (1.f / 256.f) + EPS);
#pragma unroll
                    for (int n = 0; n < 4; ++n) ot[i * 264 + wc * 64 + n * 16 + fr] = (bf16_t)f2bf(acc[m][n][j] * rstd); }
            __syncthreads();
#pragma unroll
            for (int i = 0; i < 8; ++i) { const int pz = tl + 512 * i, row = pz >> 5, c8 = pz & 31;
                bf16_t* gp = SG + (size_t)(row0 + row) * 1024 + h * 256 + c8 * 8;
                const u32x4 gv = *(const u32x4*)gp, ov = *(const LAS u32x4*)(ot + row * 264 + c8 * 8);
                u32x4 o; o.x = pk2(bflo(gv.x) * bflo(ov.x), bfhi(gv.x) * bfhi(ov.x)); o.y = pk2(bflo(gv.y) * bflo(ov.y), bfhi(gv.y) * bfhi(ov.y)); o.z = pk2(bflo(gv.z) * bflo(ov.z), bfhi(gv.z) * bfhi(ov.z)); o.w = pk2(bflo(gv.w) * bflo(ov.w), bfhi(gv.w) * bfhi(ov.w));
                *(u32x4*)gp = o; }
            __syncthreads();
        }
    }
    for (int it = bid; it < 512; it += G) {
        const int b = it >> 6, tt = (it >> 3) & 7, cc = it & 7;
        LAS bf16_t* yt = (LAS bf16_t*)lds;
#pragma unroll
        for (int i = 0; i < 8; ++i) { const int ch = wave * 8 + i; *(LAS u32x4*)(yt + ch * 520 + lane * 8) = *(const u32x4*)(ZT + ((size_t)(cc * 64 + ch) * 8 + b) * SEQ + tt * 512 + lane * 8); }
        __syncthreads();
        { int tl = tid; asm volatile("" : "+v"(tl));
          const int tq = tl >> 3, cg = tl & 7, c0 = cc * 64 + cg * 8, t0 = tt * 512 + tq * 8, row0 = b * SEQ + t0;
          float x0[8][8];
          short_conv8x8(HU, row0, t0, c0, a.in[I_HCW], a.in[I_HCB], x0);
          u32x4 yv[8];
#pragma unroll
          for (int e = 0; e < 8; ++e) yv[e] = *(const LAS u32x4*)(yt + (cg * 8 + e) * 520 + tq * 8);
#pragma unroll
          for (int t = 0; t < 8; ++t) { float o[8];
#pragma unroll
              for (int e = 0; e < 8; ++e) { const unsigned wd = (t >> 1) == 0 ? yv[e].x : (t >> 1) == 1 ? yv[e].y : (t >> 1) == 2 ? yv[e].z : yv[e].w; o[e] = x0[t][e] * ((t & 1) ? bfhi(wd) : bflo(wd)); }
              u32x4 w; w.x = pk2(o[0], o[1]); w.y = pk2(o[2], o[3]); w.z = pk2(o[4], o[5]); w.w = pk2(o[6], o[7]);
              *(u32x4*)(HU + (size_t)(row0 + t) * 1536 + 512 + c0) = w; } }
        __syncthreads();
    }
    }
    GRID_BAR();
    STAMP(5);

    { DECL_PTRS
    {
        pg8::Gemm g{(const bf16_t*)XN8, (const bf16_t*)(WTG8 + (size_t)1024 * 1024), 512, 512, 512}; pg8::StaticOrder S; S.init(T, 1024, G, bid);
        pg8::EpiGate E{SGH, a.in[I_BIN] + NINA + 1024, 0.03125f};
        pg8::gemm_phase<pg8::EpiGate, pg8::StaticOrder, false, true>(lds, g, S, E);
    }
    {
        pg8::Gemm g{HU + 512, WT_HYO, 512, 1536, 512}; pg8::StaticOrder S; S.init(T, 1024, G, bid);
        pg8::EpiMerge<0> E{SGH, nullptr};
        pg8::gemm_phase(lds, g, S, E);
    }
    {
        pg8::Gemm g{(const bf16_t*)XN8, (const bf16_t*)WTG8, 512, 512, 512}; pg8::StaticOrder S; S.init(T, 1024, G, bid);
        pg8::EpiGate E{SGR, a.in[I_BIN] + NINA, 0.03125f};
        pg8::gemm_phase<pg8::EpiGate, pg8::StaticOrder, false, true>(lds, g, S, E);
    }
    {
        pg8::Gemm g{SG, WT_RETO, 1024, 1024, 1024}; pg8::StaticOrder S; S.init(T, 1024, G, bid);
        pg8::EpiMerge<1> E{SGR, SGH};
        pg8::gemm_phase(lds, g, S, E);
    }
    __syncthreads();
    {
        LAS float* scr = (LAS float*)(lds + wave * 17664);
        constexpr int PER = 16 * 8;
        for (int it = gw; it < NE * 3 * PER; it += NGW) {
            const int e = it / (3 * PER), r3 = it % (3 * PER), which = r3 / PER, r = r3 % PER;
            unsigned char* W13 = (unsigned char*)WE13; unsigned char* W2 = (unsigned char*)WE2;
            if (which == 0) transpose_item_f8(a.in[I_EW1] + (size_t)e * 1024 * 512, 512, 64 * (r / 8), 64 * (r % 8), W13 + (size_t)e * 1024 * 1024, 1024, RmE13{0}, 32.f, scr, lane);
            else if (which == 1) transpose_item_f8(a.in[I_EW3] + (size_t)e * 1024 * 512, 512, 64 * (r / 8), 64 * (r % 8), W13 + (size_t)e * 1024 * 1024, 1024, RmE13{128}, 32.f, scr, lane);
            else transpose_item_f8(a.in[I_EW2] + (size_t)e * 512 * 1024, 1024, 64 * (r / 16), 64 * (r % 16), W2 + (size_t)e * 1024 * 512, 512, RmId{}, 32.f, scr, lane);
        }
    }
    }
    GRID_BAR();
    STAMP(6);
    STAMP(7);
    STAMP(8);
    { DECL_PTRS
    {
        pg8::Gemm g{SGR, WT_OUT, 1024, 1024, 1024}; pg8::StaticOrder S; S.init(T, 1024, G, bid);
        pg8::EpiX1 E{a.in[I_X], MOD, X1};
        pg8::gemm_phase(lds, g, S, E);
    }
    }
    GRID_BAR();
    STAMP(9);

    { DECL_PTRS
    {
        LAS float* Wl = (LAS float*)lds;
#pragma unroll
        for (int i = 0; i < 18; ++i) { const int q = tid + 512 * i, k = q / 9, p4 = q % 9;
            const f32x4 v = p4 == 0 ? *(const f32x4*)(a.in[I_RGW] + k * 4) : *(const f32x4*)(a.in[I_REW] + k * 32 + (p4 - 1) * 4);
            *(LAS f32x4*)(Wl + k * 36 + p4 * 4) = v; }
        __syncthreads();
        unsigned char* H2 = (unsigned char*)SG;
        LAS float* Sw = (LAS float*)(lds + 147456 + wave * 1152);
        LAS int* lcnt = (LAS int*)(lds + 147456 + 9216);
        if (tid < NE) lcnt[tid] = 0;
        __syncthreads();
        for (int rb = gw; rb < T / 16; rb += NGW) {
            int ll = lane; asm volatile("" : "+v"(ll));
            const int r = ll & 15, kq = ll >> 4, row = rb * 16 + r, b = (rb * 16) >> 12;
            const float* md = MOD + (size_t)b * 6144; const float* xr = X1 + (size_t)row * D + 4 * kq;
            float s = 0.f;
#pragma unroll 16
            for (int i = 0; i < 64; ++i) { const f32x4 xv = *(const f32x4*)(xr + 16 * i); s += (xv[0] * xv[0] + xv[1] * xv[1]) + (xv[2] * xv[2] + xv[3] * xv[3]); }
            s += __shfl_xor(s, 16); s += __shfl_xor(s, 32);
            const float rstd = rsqrtf(s * (1.f / D) + EPS);
            f32x4 lacc[3];
#pragma unroll
            for (int ct = 0; ct < 3; ++ct) lacc[ct] = (f32x4){0.f, 0.f, 0.f, 0.f};
            const int c0 = ll & 15, c2 = (32 + c0) < 36 ? 32 + c0 : 35;
#pragma unroll 4
            for (int i = 0; i < 64; ++i) {
                const int k0 = 16 * i + 4 * kq;
                const f32x4 xv = *(const f32x4*)(xr + 16 * i), gv = *(const f32x4*)(a.in[I_N2G] + k0), sc = *(const f32x4*)(md + 4096 + k0), sh = *(const f32x4*)(md + 3072 + k0);
                const f32x4 hv = (xv * rstd * gv) * (sc + 1.f) + sh;
                *(unsigned*)(H2 + (size_t)row * D + k0) = pk_fp8x4(hv[0], hv[1], hv[2], hv[3]);
#pragma unroll
                for (int e = 0; e < 4; ++e) { const LAS float* wr_ = Wl + (k0 + e) * 36;
                    lacc[0] = __builtin_amdgcn_mfma_f32_16x16x4f32(hv[e], wr_[c0], lacc[0], 0, 0, 0);
                    lacc[1] = __builtin_amdgcn_mfma_f32_16x16x4f32(hv[e], wr_[16 + c0], lacc[1], 0, 0, 0);
                    lacc[2] = __builtin_amdgcn_mfma_f32_16x16x4f32(hv[e], wr_[c2], lacc[2], 0, 0, 0); }
            }
#pragma unroll
            for (int hf = 0; hf < 2; ++hf) {
                if ((kq >> 1) == hf) {
#pragma unroll
                    for (int j = 0; j < 4; ++j) { LAS float* sp = Sw + (4 * (kq & 1) + j) * 36 + c0; sp[0] = lacc[0][j]; sp[16] = lacc[1][j]; if (c0 < 4) sp[32] = lacc[2][j]; }
                }
                asm volatile("s_waitcnt lgkmcnt(0)" ::: "memory");
                if (ll < 8) {
                    const int rrow = rb * 16 + 8 * hf + ll;
                    float lg[36];
#pragma unroll
                    for (int q = 0; q < 9; ++q) { const f32x4 v = *(const LAS f32x4*)(Sw + ll * 36 + 4 * q); lg[4 * q] = v[0]; lg[4 * q + 1] = v[1]; lg[4 * q + 2] = v[2]; lg[4 * q + 3] = v[3]; }
                    float gl[4];
#pragma unroll
                    for (int j = 0; j < 4; ++j) gl[j] = lg[j] + a.in[I_RGB][j];
                    int gs = 0; float gm = gl[0];
#pragma unroll
                    for (int j = 1; j < 4; ++j) if (gl[j] > gm) { gm = gl[j]; gs = j; }
                    float den = 0.f;
#pragma unroll
                    for (int j = 0; j < 4; ++j) den += expf(gl[j] - gm);
                    const float pstar = 1.f / den;
                    float el[8];
#pragma unroll
                    for (int e = 0; e < 8; ++e) { const float v0 = lg[4 + e], v1 = lg[12 + e], v2 = lg[20 + e], v3 = lg[28 + e]; el[e] = (gs == 0 ? v0 : gs == 1 ? v1 : gs == 2 ? v2 : v3) + a.in[I_REB][gs * 8 + e]; }
                    int e0 = 0; float m0 = el[0];
#pragma unroll
                    for (int e = 1; e < 8; ++e) if (el[e] > m0) { m0 = el[e]; e0 = e; }
                            int e1 = e0 == 0 ? 1 : 0; float m1 = e0 == 0 ? el[1] : el[0];
#pragma unroll
                    for (int e = 1; e < 8; ++e) if (e != e0 && el[e] > m1) { m1 = el[e]; e1 = e; }
                    const float ex = expf(m1 - m0); const float w0 = pstar / (1.f + ex), w1 = pstar * ex / (1.f + ex);
                    const int E0 = gs * 8 + e0, E1 = gs * 8 + e1;
                    const int s0 = __hip_atomic_fetch_add(lcnt + E0, 1, __ATOMIC_RELAXED, __HIP_MEMORY_SCOPE_WORKGROUP), s1 = __hip_atomic_fetch_add(lcnt + E1, 1, __ATOMIC_RELAXED, __HIP_MEMORY_SCOPE_WORKGROUP);
                    int4 ti; ti.x = (E0 << 16) | s0; ti.y = (E1 << 16) | s1; ti.z = __float_as_int(w0); ti.w = __float_as_int(w1);
                    *(int4*)(TOKINFO + (size_t)rrow * 4) = ti;
                }
                asm volatile("s_waitcnt lgkmcnt(0)" ::: "memory");
            }
        }
        __syncthreads();
        if (tid < NE) LISTS[bid * NE + tid] = lcnt[tid];
    }
    }
    GRID_BAR();
    STAMP(10);

    LAS int* tbase = (LAS int*)(lds + MISC_OFF);
    LAS int* texp = tbase + 64;
    int ntiles = 0;
    { DECL_PTRS
    {
        LAS int* ptot = texp + 320;
        LAS int* pbas = ptot + 512; LAS int* total = pbas + 512; LAS int* mybase = total + 32;
        { const int e = tid & 31, part = tid >> 5, per = (G + 15) >> 4; int s = 0, sb = 0;
          for (int b = part * per; b < (part + 1) * per && b < G; ++b) { const int v = LISTS[b * NE + e]; s += v; if (b < bid) sb += v; }
          ptot[part * 32 + e] = s; pbas[part * 32 + e] = sb; }
        __syncthreads();
        if (tid < NE) { int s = 0, sb = 0; for (int q = 0; q < 16; ++q) { s += ptot[q * 32 + tid]; sb += pbas[q * 32 + tid]; } total[tid] = s; mybase[tid] = sb; }
        __syncthreads();
        if (tid == 0) { int acc = 0; for (int e = 0; e < NE; ++e) { tbase[e] = acc; const int nt = (total[e] + 255) >> 8; for (int q = 0; q < nt; ++q) texp[acc + q] = e; acc += nt; } tbase[NE] = acc; }
        __syncthreads();
        ntiles = tbase[NE];
        int* ROWTOK = LISTS + 16384;
        for (int rb = gw; rb < T / 16; rb += NGW) {
            if (lane < 16) { const int row = rb * 16 + lane;
                const int4 ti = *(const int4*)(TOKINFO + (size_t)row * 4);
                const int e0 = ti.x >> 16, e1 = ti.y >> 16;
                const int r0 = tbase[e0] * 256 + mybase[e0] + (ti.x & 0xffff), r1 = tbase[e1] * 256 + mybase[e1] + (ti.y & 0xffff);
                ROWTOK[r0] = row; ROWTOK[r1] = row;
                int4 to = ti; to.x = r0; to.y = r1; *(int4*)(TOKINFO + (size_t)row * 4) = to; }
        }
        if (bid < NE) { const int rlo = tbase[bid] * 256 + total[bid], rhi = tbase[bid + 1] * 256; for (int r = rlo + tid; r < rhi; r += 512) ROWTOK[r] = 0; }
    }
    }
    GRID_BAR();
    STAMP(11);

    { DECL_PTRS
    {
        pg8::Gemm g{SG  , WE13, 512, 512, 512}; pg8::MoeOrder S{ntiles, G, bid, texp};
        pg8::EpiMoe1 E{(unsigned char*)HM};
        pg8::gemm_phase<pg8::EpiMoe1, pg8::MoeOrder, true, true>(lds, g, S, E, LISTS + 16384);
    }
    }
    GRID_BAR();
    STAMP(12);
    { DECL_PTRS
    {
        pg8::Gemm g{HM  , WE2, 256, 256, 256}; pg8::MoeOrder S{ntiles, G, bid, texp};
        pg8::EpiBf E{XB, 1024, 0.03125f};
        pg8::gemm_phase<pg8::EpiBf, pg8::MoeOrder, false, true>(lds, g, S, E);
    }
    }
    GRID_BAR();
    STAMP(13);

    { DECL_PTRS
    {
        const bf16_t* YB = XB;
        for (int row = gw; row < T; row += NGW) {
            const int b = row >> 12; const float* gt2 = MOD + (size_t)b * 6144 + 5120;
            const int4 ti = *(const int4*)(TOKINFO + (size_t)row * 4);
            const size_t r0 = (size_t)ti.x, r1 = (size_t)ti.y;
            const float w0 = __int_as_float(ti.z), w1 = __int_as_float(ti.w);
            f32x4 v[4]; float s = 0.f;
#pragma unroll
            for (int j = 0; j < 4; ++j) { const int c0 = 4 * lane + 256 * j;
                const f32x4 xv = *(const f32x4*)(X1 + (size_t)row * D + c0), gv = *(const f32x4*)(gt2 + c0);
                const u32x2 y0 = *(const u32x2*)(YB + r0 * D + c0), y1 = *(const u32x2*)(YB + r1 * D + c0);
                f32x4 mo; mo[0] = w0 * bflo(y0.x) + w1 * bflo(y1.x); mo[1] = w0 * bfhi(y0.x) + w1 * bfhi(y1.x); mo[2] = w0 * bflo(y0.y) + w1 * bflo(y1.y); mo[3] = w0 * bfhi(y0.y) + w1 * bfhi(y1.y);
                v[j] = xv + gv * mo; s += (v[j][0] * v[j][0] + v[j][1] * v[j][1]) + (v[j][2] * v[j][2] + v[j][3] * v[j][3]); }
            const float rstd = rsqrtf(wave_sum(s) * (1.f / D) + EPS);
#pragma unroll
            for (int j = 0; j < 4; ++j) { const int c0 = 4 * lane + 256 * j; const f32x4 fg = *(const f32x4*)(a.in[I_FNG] + c0); *(f32x4*)(X1 + (size_t)row * D + c0) = v[j] * rstd * fg; }
        }
    }
    }
    STAMP(14);
    if (PROBE_PHASE >= 0 && blockIdx.x == 0 && threadIdx.x == 0) { const unsigned long long t0_ = __builtin_amdgcn_s_memrealtime(); while (__builtin_amdgcn_s_memrealtime() - t0_ < spin_) __builtin_amdgcn_s_sleep(8); }
}

extern "C" void kernel_launch(void* const* d_in, const int* in_sizes, int n_in, void* d_out, int out_size, void* d_ws, size_t ws_size, hipStream_t stream) {
    static int grid = 0;
    if (grid == 0) {
        if (n_in != 31 || out_size != T * D || ws_size < WS_END) { fprintf(stderr, "kernel_launch: unexpected shapes: n_in %d out %d ws %zu (need %zu)\n", n_in, out_size, ws_size, (size_t)WS_END); grid = -1; return; }
        int dev = 0, cus = 0, per_cu = 0;
        if (hipGetDevice(&dev) != hipSuccess || hipDeviceGetAttribute(&cus, hipDeviceAttributeMultiprocessorCount, dev) != hipSuccess) { grid = -1; return; }
        if (hipFuncSetAttribute((const void*)fwd_kernel, hipFuncAttributeMaxDynamicSharedMemorySize, LDS_BYTES) != hipSuccess) { fprintf(stderr, "kernel_launch: hipFuncSetAttribute failed\n"); grid = -1; return; }
        if (hipOccupancyMaxActiveBlocksPerMultiprocessor(&per_cu, (const void*)fwd_kernel, 512, LDS_BYTES) != hipSuccess || per_cu < 1) { fprintf(stderr, "kernel_launch: occupancy query says %d blocks per CU\n", per_cu); grid = -1; return; }
        grid = cus;
        fprintf(stderr, "kernel_launch: cus %d per_cu %d grid %d ws %zu\n", cus, per_cu, grid, ws_size);
    }
    if (grid < 0) return;
    Args a{};
    for (int i = 0; i < 31; ++i) a.in[i] = (const float*)d_in[i];
    a.out = (float*)d_out; a.ws = (unsigned char*)d_ws;
    void* args[] = {&a};
    const hipError_t e = hipLaunchCooperativeKernel((const void*)fwd_kernel, dim3(grid), dim3(512), args, LDS_BYTES, stream);
    if (e != hipSuccess) fprintf(stderr, "kernel_launch: cooperative launch failed: %s (grid %d)\n", hipGetErrorString(e), grid);
}
```

```cpp
#ifndef PROBE_PHASE
#define PROBE_PHASE -1
#endif
#ifndef REPMASK
#define REPMASK 0
#endif
#include <hip/hip_runtime.h>
#include <hip/hip_cooperative_groups.h>
#include <cstdio>
#include <cstdint>
namespace cg = cooperative_groups;

#define LAS __attribute__((address_space(3)))
typedef unsigned short bf16_t;
typedef short bf16x8 __attribute__((ext_vector_type(8)));
typedef float f32x4 __attribute__((ext_vector_type(4)));
typedef unsigned u32x4 __attribute__((ext_vector_type(4)));
typedef unsigned u32x2 __attribute__((ext_vector_type(2)));

constexpr int BATCH = 8, SEQ = 4096, D = 1024, T = BATCH * SEQ, CTXL = 256, TC = BATCH * CTXL, MT = T + TC;
constexpr int NH = 4, DK = 128, DV = 256, TOKP = SEQ + CTXL;
constexpr int NINA = 4608;
constexpr int NE = 32, EH = 512;
constexpr float EPS = 1e-6f;
constexpr int LDS_BYTES = 163840;
constexpr int MISC_OFF = 131072;

constexpr size_t MiB = 1u << 20;
constexpr size_t WS_CTL = 0, CTL_BYTES = 65536;
constexpr size_t WS_MOD = 65536;
constexpr size_t WS_ROPE = 327680;
constexpr size_t WS_BINP = 344064;
constexpr size_t WS_FPART = 524288;
constexpr size_t WS_TOKINFO = 2 * MiB;
constexpr size_t WS_LISTS = 3 * MiB;
constexpr size_t WS_TR = 8 * MiB;
constexpr size_t WS_WT_IN = 16 * MiB;
constexpr size_t WS_WT_RETO = 29 * MiB, WS_WT_HYO = 31 * MiB, WS_WT_OUT = 32 * MiB;
constexpr size_t WS_R1 = 34 * MiB;
constexpr size_t WS_Q = WS_R1, WS_K = WS_R1 + 32 * MiB, WS_KT = WS_R1 + 66 * MiB, WS_VT = WS_R1 + 100 * MiB;
constexpr size_t WS_FILT = WS_R1;
constexpr size_t WS_SGR = WS_R1, WS_SGH = WS_R1 + 64 * MiB;
constexpr size_t WS_XB = WS_R1;
constexpr size_t WS_SG = 202 * MiB;
constexpr size_t WS_HU = 266 * MiB;
constexpr size_t WS_KV = 362 * MiB;
constexpr size_t WS_WE13 = 362 * MiB, WS_WE2 = 426 * MiB;
constexpr size_t WS_END = 494 * MiB;
constexpr size_t DO_XN = 0, DO_ZT = 64 * MiB, DO_XN8 = 96 * MiB;

__device__ __forceinline__ unsigned f2bf(float f) { unsigned u = __float_as_uint(f); return (u + 0x7fffu + ((u >> 16) & 1u)) >> 16; }
__device__ __forceinline__ unsigned pk2(float lo, float hi) { return f2bf(lo) | (f2bf(hi) << 16); }
__device__ __forceinline__ float bflo(unsigned w) { return __uint_as_float(w << 16); }
__device__ __forceinline__ float bfhi(unsigned w) { return __uint_as_float(w & 0xffff0000u); }
__device__ __forceinline__ float bf2f(bf16_t h) { return __uint_as_float((unsigned)h << 16); }
__device__ __forceinline__ float silu_f(float v) { return v / (1.f + __expf(-v)); }
__device__ __forceinline__ float sigm_f(float v) { return 1.f / (1.f + __expf(-v)); }
__device__ __forceinline__ float wave_sum(float v) {
#pragma unroll
    for (int o = 1; o < 64; o <<= 1) v += __shfl_xor(v, o);
    return v;
}
__host__ __device__ __forceinline__ int dimperm(int p) { const int wc = p >> 5, n = (p >> 4) & 1, i16 = p & 15; return 64 * (wc >> 1) + 32 * n + 16 * (wc & 1) + i16; }
__host__ __device__ __forceinline__ int inv_dimperm(int d) { const int half = d >> 6, n = (d >> 5) & 1, idx = d & 31; return 32 * (2 * half + (idx >> 4)) + 16 * n + (idx & 15); }
__host__ __device__ __forceinline__ int win_destrow(int n) { return n < 1024 ? (n & ~127) + inv_dimperm(n & 127) : n; }

namespace pg8 {
constexpr int BM = 256, BK = 64, HALF = 128, HTB = HALF * BK * 2, STAGE_BYTES = 8 * HTB, NXCD = 8, WGM = 8;
__host__ __device__ __forceinline__ int lds_byte(int r, int c) { const int st = (r >> 4) * 2 + (c >> 5), rr = r & 15, cc = c & 31, ob = rr * 64 + cc * 2; return st * 1024 + (ob ^ (((ob >> 9) & 1) << 5)); }
__host__ __device__ __forceinline__ void stage_rc(int b, int& R, int& C) { const int st = b / 1024, sb = b % 1024, swz = sb ^ (((sb >> 9) & 1) << 5); R = (st >> 1) * 16 + swz / 64; C = (st & 1) * 32 + (swz % 64) / 2; }
__host__ __device__ __forceinline__ int perm32(int rho) { const int n = rho >> 4, i = rho & 15; return 8 * (i >> 2) + 4 * n + (i & 3); }

struct Unit { int pm, pn, pc; };
struct Gemm { const bf16_t* A; const bf16_t* Bt; int K, lda, ldb; };

struct StaticOrder {
    int nM, nN, nwg, G, c;
    __device__ void init(int M, int N, int G_, int c_) { nM = M / BM; nN = N / BM; nwg = nM * nN; G = G_; c = c_; }
    __device__ bool next(int i, Unit& u) const {
        const long L = (long)i * G + c; if (L >= nwg) return false;
        int wgid = (int)L; { const int q = nwg / NXCD, r = nwg % NXCD, xcd = wgid % NXCD, off = wgid / NXCD; wgid = (xcd < r ? xcd * (q + 1) : r * (q + 1) + (xcd - r) * q) + off; }
        const int nig = WGM * nN, gid = wgid / nig, fm = gid * WGM, gsz = (nM - fm) < WGM ? (nM - fm) : WGM;
        u.pm = fm + ((wgid % nig) % gsz); u.pn = (wgid % nig) / gsz; u.pc = u.pn; return true;
    }
};
struct InProjOrder {
    StaticOrder so; int G, c;
    __device__ void init(int G_, int c_) { so.init(T, NINA, G_, c_); G = G_; c = c_; }
    __device__ bool next(int i, Unit& u) const {
        const long L = (long)i * G + c;
        if (L < so.nwg) return so.next(i, u);
        const int l = (int)(L - so.nwg); if (l >= 48) return false;
        u.pm = 128 + (l & 7); u.pn = 2 + (l >> 3); u.pc = u.pn; return true;
    }
};
struct MoeOrder {
    int ntiles, G, c; const LAS int* texp;
    __device__ bool next(int i, Unit& u) const {
        const long L = (long)i * G + c; if (L >= (long)ntiles * 4) return false;
        const int full = (ntiles >> 3) * 32, l = (int)L;
        if (l < full) { u.pm = (l >> 5) * 8 + (l & 7); u.pc = (l & 31) >> 3; } else { u.pm = (ntiles & ~7) + ((l - full) >> 2); u.pc = (l - full) & 3; }
        u.pn = texp[u.pm] * 4 + u.pc; return true;
    }
};

__device__ __forceinline__ unsigned cvt_pk_bf16(float lo, float hi) { unsigned r; asm volatile("v_cvt_pk_bf16_f32 %0, %1, %2" : "=v"(r) : "v"(lo), "v"(hi)); return r; }

typedef int v8i __attribute__((ext_vector_type(8)));
__device__ __forceinline__ unsigned pk_fp8x4(float a, float b, float c, float d) { int w = 0; w = __builtin_amdgcn_cvt_pk_fp8_f32(a, b, w, false); w = __builtin_amdgcn_cvt_pk_fp8_f32(c, d, w, true); return (unsigned)w; }
template <class Epi, class Sched, bool GATHER = false, bool FP8 = false>
__device__ __forceinline__ void gemm_phase(LAS unsigned char* lds, const Gemm g, const Sched& S, const Epi& E, const int* rowidx = nullptr) {
    int tid = threadIdx.x; asm volatile("" : "+v"(tid));
    const int wid = __builtin_amdgcn_readfirstlane(tid >> 6), lane = tid & 63, wr = wid >> 2, wc = wid & 3, fr = lane & 15, fq = lane >> 4;
    const int K = g.K; int nt = K / BK; asm volatile("" : "+s"(nt));
    int Ra[2], Ca[2]; unsigned voffA[2], voffB[2];
#pragma unroll
    for (int i = 0; i < 2; ++i) { int R, C; stage_rc(tid * 16 + i * 8192, R, C); const int Rb = Epi::PERM ? ((R & ~31) + perm32(R & 31)) : R;
        Ra[i] = R; Ca[i] = C; voffA[i] = (unsigned)(R * g.lda + C) * 2u; voffB[i] = (unsigned)(Rb * g.ldb + C) * 2u; }
    const size_t hstepA = (size_t)HALF * g.lda * 2, tstepA = 2 * hstepA;
    const size_t kstep = (size_t)(BK * 2);
    const size_t hstepB = (size_t)HALF * g.ldb * 2, tstepB = 2 * hstepB;
    const unsigned ldsw = (unsigned)wid * 1024u;
    const int aoff = lds_byte(wr * 64 + fr, fq * 8), boff = lds_byte(wc * 32 + fr, fq * 8);
#define PG8_AOFF(dst, u) do { _Pragma("unroll") for (int _h = 0; _h < 2; ++_h) _Pragma("unroll") for (int _i = 0; _i < 2; ++_i) { int _row = (u).pm * BM + _h * HALF + Ra[_i]; if (GATHER) _row = rowidx[_row]; \
        dst[_h][_i] = (unsigned)(_row * g.lda + Ca[_i]) * 2u; } } while (0)
#define PG8_SA(b, h) (((b) * 2 + (h)) * HTB)
#define PG8_SB(b, h) ((4 + (b) * 2 + (h)) * HTB)
#define PG8_STAGE(bufoff, gbase, voff) do { _Pragma("unroll") for (int _i = 0; _i < 2; ++_i) \
        __builtin_amdgcn_global_load_lds((const unsigned*)((const char*)(gbase) + (voff)[_i]), (LAS unsigned*)(lds + (bufoff) + ldsw + _i * 8192), 16, 0, 0); } while (0)
#define PG8_STAGE_A(bufoff, ubase, vsel, h, kb) do { if constexpr (GATHER) { PG8_STAGE(bufoff, gA + (kb), (vsel)[h]); } else { PG8_STAGE(bufoff, (ubase) + (size_t)(h) * hstepA + (kb), voffA); } } while (0)
#define PG8_LD8(p) ({ const u32x4 _lo = *(const LAS u32x4*)(p), _hi = *(const LAS u32x4*)((p) + 1024); v8i _r; _r[0] = (int)_lo.x; _r[1] = (int)_lo.y; _r[2] = (int)_lo.z; _r[3] = (int)_lo.w; _r[4] = (int)_hi.x; _r[5] = (int)_hi.y; _r[6] = (int)_hi.z; _r[7] = (int)_hi.w; _r; })
#define PG8_LDA(dst, b, h) do { _Pragma("unroll") for (int m = 0; m < 4; ++m) dst[m] = PG8_LD8(lds + PG8_SA(b, h) + aoff + m * 2048); } while (0)
#define PG8_LDB(dst, b, h) do { _Pragma("unroll") for (int n = 0; n < 2; ++n) dst[n] = PG8_LD8(lds + PG8_SB(b, h) + boff + n * 2048); } while (0)
#define PG8_LO(v) __builtin_bit_cast(bf16x8, __builtin_shufflevector(v, v, 0, 1, 2, 3))
#define PG8_HI(v) __builtin_bit_cast(bf16x8, __builtin_shufflevector(v, v, 4, 5, 6, 7))
#define PG8_MMA(ai, bj, At, Bt) do { __builtin_amdgcn_s_setprio(1); _Pragma("unroll") for (int m = 0; m < 4; ++m) _Pragma("unroll") for (int n = 0; n < 2; ++n) { \
        if constexpr (FP8) { asm volatile("v_mfma_scale_f32_16x16x128_f8f6f4 %0, %1, %2, %0, %3, %3 op_sel_hi:[0,0,0]" : "+v"(acc[ai][bj][m][n]) : "v"(Bt[n]), "v"(At[m]), "v"(one_scale)); } \
        else { acc[ai][bj][m][n] = __builtin_amdgcn_mfma_f32_16x16x32_bf16(PG8_LO(Bt[n]), PG8_LO(At[m]), acc[ai][bj][m][n], 0, 0, 0); \
               acc[ai][bj][m][n] = __builtin_amdgcn_mfma_f32_16x16x32_bf16(PG8_HI(Bt[n]), PG8_HI(At[m]), acc[ai][bj][m][n], 0, 0, 0); } } __builtin_amdgcn_s_setprio(0); } while (0)
#define PG8_WAIT_V(n) asm volatile("s_waitcnt vmcnt(" #n ")" ::: "memory")
#define PG8_WAIT_L(n) asm volatile("s_waitcnt lgkmcnt(" #n ")" ::: "memory")
#define PG8_BAR __builtin_amdgcn_s_barrier()
#define PG8_SCHED __builtin_amdgcn_sched_barrier(0)
    Unit cur, nxt; int ui = 0;
    if (!S.next(0, cur)) return;
    f32x4 acc[2][2][4][2];
#pragma unroll
    for (int a = 0; a < 2; ++a)
#pragma unroll
        for (int b = 0; b < 2; ++b)
#pragma unroll
            for (int m = 0; m < 4; ++m)
#pragma unroll
                for (int n = 0; n < 2; ++n) { acc[a][b][m][n] = (f32x4){0.f, 0.f, 0.f, 0.f}; }
    v8i At[4], B0[2], B1[2];
    int one_scale = 0x7f7f7f7f; asm volatile("" : "+v"(one_scale)); (void)one_scale;
    unsigned vA[2][2], nvA[2][2];
    if constexpr (GATHER) PG8_AOFF(vA, cur);
    const char* gA = (const char*)g.A;
    const char* cA = gA + (size_t)cur.pm * tstepA;
    const char* cB = (const char*)g.Bt + (size_t)cur.pn * tstepB;
    PG8_STAGE(PG8_SB(0, 0), cB, voffB); PG8_STAGE(PG8_SB(0, 1), cB + hstepB, voffB); PG8_STAGE_A(PG8_SA(0, 0), cA, vA, 0, 0); PG8_STAGE_A(PG8_SA(0, 1), cA, vA, 1, 0);
    if (wr == 1) PG8_BAR;
    PG8_WAIT_V(2); PG8_BAR;
    PG8_STAGE(PG8_SB(1, 0), cB + kstep, voffB); PG8_STAGE_A(PG8_SA(1, 0), cA, vA, 0, kstep); PG8_STAGE(PG8_SB(1, 1), cB + hstepB + kstep, voffB);
    PG8_WAIT_V(6); PG8_BAR;
    for (;;) {
        const bool has_next = S.next(ui + 1, nxt);
        if constexpr (GATHER) { if (has_next) { PG8_AOFF(nvA, nxt); } else {
#pragma unroll
            for (int h = 0; h < 2; ++h)
#pragma unroll
                for (int i = 0; i < 2; ++i) nvA[h][i] = vA[h][i]; } }
        const char* nA = has_next ? gA + (size_t)nxt.pm * tstepA : cA;
        const char* nB = has_next ? (const char*)g.Bt + (size_t)nxt.pn * tstepB : cB;
#pragma unroll 1
        for (int t = 0; t < nt; t += 2) {
            const bool last = (t == nt - 2);
            const size_t k1 = (size_t)(t + 1) * kstep, k2 = last ? 0 : (size_t)(t + 2) * kstep, k3 = k2 + kstep;
            const char* u2 = last ? nA : cA; const char* b2 = last ? nB : cB + (size_t)(t + 2) * kstep; const char* b3 = b2 + kstep;
            unsigned v2[2][2];
            if constexpr (GATHER) {
#pragma unroll
                for (int h = 0; h < 2; ++h)
#pragma unroll
                    for (int i = 0; i < 2; ++i) v2[h][i] = last ? nvA[h][i] : vA[h][i]; }
            PG8_LDB(B0, 0, 0); PG8_LDB(B1, 0, 1); PG8_SCHED; PG8_LDA(At, 0, 0); PG8_STAGE_A(PG8_SA(1, 1), cA, vA, 1, k1);
            PG8_WAIT_V(8); PG8_WAIT_L(0); PG8_BAR; PG8_MMA(0, 0, At, B0); PG8_MMA(0, 1, At, B1); PG8_BAR; PG8_SCHED;
            PG8_LDA(At, 0, 1); PG8_STAGE(PG8_SB(0, 0), b2, voffB); PG8_STAGE(PG8_SB(0, 1), b2 + hstepB, voffB); PG8_STAGE_A(PG8_SA(0, 0), u2, v2, 0, k2);
            PG8_WAIT_V(8); PG8_WAIT_L(0); PG8_BAR; PG8_MMA(1, 0, At, B0); PG8_MMA(1, 1, At, B1); PG8_BAR; PG8_SCHED;
            PG8_LDB(B0, 1, 0); PG8_LDB(B1, 1, 1); PG8_SCHED; PG8_LDA(At, 1, 0); PG8_STAGE_A(PG8_SA(0, 1), u2, v2, 1, k2);
            PG8_WAIT_V(8); PG8_WAIT_L(0); PG8_BAR; PG8_MMA(0, 0, At, B0); PG8_MMA(0, 1, At, B1); PG8_BAR; PG8_SCHED;
            PG8_LDA(At, 1, 1); PG8_STAGE(PG8_SB(1, 0), b3, voffB); PG8_STAGE(PG8_SB(1, 1), b3 + hstepB, voffB); PG8_STAGE_A(PG8_SA(1, 0), u2, v2, 0, k3);
            PG8_WAIT_V(8); PG8_WAIT_L(0); PG8_BAR; PG8_MMA(1, 0, At, B0); PG8_MMA(1, 1, At, B1); PG8_BAR; PG8_SCHED;
        }
        if (wr == 0) PG8_BAR;
        if constexpr (FP8) asm volatile("s_nop 15\n\ts_nop 15" ::: "memory");
        E(acc, cur, wr, wc, fr, fq);
        if (!has_next) break;
#pragma unroll
        for (int a = 0; a < 2; ++a)
#pragma unroll
            for (int b = 0; b < 2; ++b)
#pragma unroll
                for (int m = 0; m < 4; ++m)
#pragma unroll
                    for (int n = 0; n < 2; ++n) { acc[a][b][m][n] = (f32x4){0.f, 0.f, 0.f, 0.f}; }
        cur = nxt; cA = nA; cB = nB; ++ui;
        if constexpr (GATHER) {
#pragma unroll
            for (int h = 0; h < 2; ++h)
#pragma unroll
                for (int i = 0; i < 2; ++i) vA[h][i] = nvA[h][i]; }
        if (wr == 1) PG8_BAR;
    }
    PG8_WAIT_V(0);
    PG8_BAR;
#undef PG8_AOFF
#undef PG8_SA
#undef PG8_SB
#undef PG8_STAGE
#undef PG8_LDA
#undef PG8_LDB
#undef PG8_STAGE_A
#undef PG8_LD8
#undef PG8_LO
#undef PG8_HI
#undef PG8_MMA
#undef PG8_WAIT_V
#undef PG8_WAIT_L
#undef PG8_BAR
#undef PG8_SCHED
}

__device__ __forceinline__ void st_bf4(bf16_t* p, f32x4 v) { u32x2 w; w.x = cvt_pk_bf16(v[0], v[1]); w.y = cvt_pk_bf16(v[2], v[3]); *(u32x2*)p = w; }
__device__ __forceinline__ void st_bf8(bf16_t* p, f32x4 v0, f32x4 v1) { u32x4 w; w.x = cvt_pk_bf16(v0[0], v0[1]); w.y = cvt_pk_bf16(v0[2], v0[3]); w.z = cvt_pk_bf16(v1[0], v1[1]); w.w = cvt_pk_bf16(v1[2], v1[3]); *(u32x4*)p = w; }

struct EpiInA {
    static constexpr bool PERM = false;
    bf16_t *Q, *Kn, *KT, *VT, *SG, *HU; const float* binp; const float* rope;
    __device__ __forceinline__ void operator()(const f32x4 (&acc)[2][2][4][2], const Unit& u, int wr, int wc, int fr, int fq) const {
        const int pc = u.pc, rbase = u.pm * BM + wr * 64 + fr, cbase = pc * BM + wc * 32 + 4 * fq;
        f32x4 bv[2][2];
#pragma unroll
        for (int bj = 0; bj < 2; ++bj)
#pragma unroll
            for (int n = 0; n < 2; ++n) bv[bj][n] = *(const f32x4*)(binp + cbase + bj * HALF + n * 16);
        const bool lat = u.pm < 128;
        const int bidx = lat ? (u.pm >> 4) : (u.pm - 128);
        if (pc < 4) {
            const bool isk = pc >= 2; const float ks = isk ? 0.08838834764831845f : 1.f;
            const int h0 = (pc & 1) * 2;
#pragma unroll
            for (int ai = 0; ai < 2; ++ai)
#pragma unroll
                for (int m = 0; m < 4; ++m) {
                    const int r = rbase + ai * HALF + m * 16, t = r & 4095;
                    const int tok = lat ? t : 4096 + ((r - T) & 255);
                    f32x4 cs = (f32x4){1.f, 1.f, 1.f, 1.f}, sn = (f32x4){0.f, 0.f, 0.f, 0.f};
                    if (lat) { const int pos = (wc >> 1) ? (t & 63) : (t >> 6); const float* rp = rope + pos * 32 + 16 * (wc & 1) + 4 * fq; cs = *(const f32x4*)rp; sn = *(const f32x4*)(rp + 2048); }
#pragma unroll
                    for (int bj = 0; bj < 2; ++bj) {
                        const f32x4 x1 = acc[ai][bj][m][0] + bv[bj][0], x2 = acc[ai][bj][m][1] + bv[bj][1];
                        const f32x4 o1 = (x1 * cs - x2 * sn) * ks, o2 = (x1 * sn + x2 * cs) * ks;
                        const int col = (pc & 1) * BM + bj * HALF + wc * 32 + 4 * fq;
                        if (!isk) { st_bf4(Q + (size_t)r * 512 + col, o1); st_bf4(Q + (size_t)r * 512 + col + 16, o2); }
                        else {
                            st_bf4(Kn + (size_t)r * 512 + col, o1); st_bf4(Kn + (size_t)r * 512 + col + 16, o2);
                            bf16_t* kt = KT + (((size_t)((bidx * 4 + h0 + bj) * 34 + (tok >> 7)) * 128 + wc * 32 + 4 * fq)) * 128 + (tok & 127);
#pragma unroll
                            for (int e = 0; e < 4; ++e) { kt[e * 128] = (bf16_t)f2bf(o1[e]); kt[(16 + e) * 128] = (bf16_t)f2bf(o2[e]); }
                        }
                    }
                }
        } else if (pc < 8) {
            const int h = pc - 4;
#pragma unroll
            for (int ai = 0; ai < 2; ++ai)
#pragma unroll
                for (int m = 0; m < 4; ++m) {
                    const int r = rbase + ai * HALF + m * 16;
                    const int tok = lat ? (r & 4095) : 4096 + ((r - T) & 255);
#pragma unroll
                    for (int bj = 0; bj < 2; ++bj)
#pragma unroll
                        for (int n = 0; n < 2; ++n) {
                            const f32x4 v = acc[ai][bj][m][n] + bv[bj][n];
                            bf16_t* vt = VT + (((size_t)((bidx * 4 + h) * 34 + (tok >> 7)) * 256 + bj * HALF + wc * 32 + n * 16 + 4 * fq)) * 128 + (tok & 127);
#pragma unroll
                            for (int e = 0; e < 4; ++e) vt[e * 128] = (bf16_t)f2bf(v[e]);
                        }
                }
        } else {
            const bool isg = pc < 12;
            bf16_t* O = isg ? SG : HU; const int ldo = isg ? 1024 : 1536; const int c0 = (isg ? pc - 8 : pc - 12) * BM + wc * 32 + 4 * fq;
#pragma unroll
            for (int ai = 0; ai < 2; ++ai)
#pragma unroll
                for (int m = 0; m < 4; ++m) {
                    const int r = rbase + ai * HALF + m * 16;
#pragma unroll
                    for (int bj = 0; bj < 2; ++bj)
#pragma unroll
                        for (int n = 0; n < 2; ++n) {
                            f32x4 v = acc[ai][bj][m][n] + bv[bj][n];
                            if (isg) { v[0] = silu_f(v[0]); v[1] = silu_f(v[1]); v[2] = silu_f(v[2]); v[3] = silu_f(v[3]); }
                            st_bf4(O + (size_t)r * ldo + c0 + bj * HALF + n * 16, v);
                        }
                }
        }
    }
};
struct EpiGate {
    static constexpr bool PERM = true;
    bf16_t* O; const float* bias; float scale;
    __device__ __forceinline__ void operator()(const f32x4 (&acc)[2][2][4][2], const Unit& u, int wr, int wc, int fr, int fq) const {
        const int rbase = u.pm * BM + wr * 64 + fr, col0 = u.pc * BM + wc * 32 + 8 * fq;
        f32x4 bv[2][2];
#pragma unroll
        for (int bj = 0; bj < 2; ++bj)
#pragma unroll
            for (int n = 0; n < 2; ++n) bv[bj][n] = *(const f32x4*)(bias + col0 + bj * HALF + 4 * n);
#pragma unroll
        for (int ai = 0; ai < 2; ++ai)
#pragma unroll
            for (int m = 0; m < 4; ++m) { bf16_t* rowp = O + (size_t)(rbase + ai * HALF + m * 16) * 1024 + col0;
#pragma unroll
                for (int bj = 0; bj < 2; ++bj) { f32x4 v0 = acc[ai][bj][m][0] * scale + bv[bj][0], v1 = acc[ai][bj][m][1] * scale + bv[bj][1];
#pragma unroll
                    for (int e = 0; e < 4; ++e) { v0[e] = sigm_f(v0[e]); v1[e] = sigm_f(v1[e]); }
                    st_bf8(rowp + bj * HALF, v0, v1); } }
    }
};
template <int MODE> struct EpiMerge {
    static constexpr bool PERM = true;
    bf16_t* O; const bf16_t* P;
    __device__ __forceinline__ void operator()(const f32x4 (&acc)[2][2][4][2], const Unit& u, int wr, int wc, int fr, int fq) const {
        const int rbase = u.pm * BM + wr * 64 + fr, col0 = u.pc * BM + wc * 32 + 8 * fq;
#pragma unroll
        for (int ai = 0; ai < 2; ++ai)
#pragma unroll
            for (int m = 0; m < 4; ++m) { const size_t off = (size_t)(rbase + ai * HALF + m * 16) * 1024 + col0;
#pragma unroll
                for (int bj = 0; bj < 2; ++bj) {
                    const u32x4 gw = *(const u32x4*)(O + off + bj * HALF);
                    f32x4 v0 = acc[ai][bj][m][0], v1 = acc[ai][bj][m][1];
                    v0[0] *= bflo(gw.x); v0[1] *= bfhi(gw.x); v0[2] *= bflo(gw.y); v0[3] *= bfhi(gw.y);
                    v1[0] *= bflo(gw.z); v1[1] *= bfhi(gw.z); v1[2] *= bflo(gw.w); v1[3] *= bfhi(gw.w);
                    if (MODE == 1) { const u32x4 pw = *(const u32x4*)(P + off + bj * HALF);
                        v0[0] += bflo(pw.x); v0[1] += bfhi(pw.x); v0[2] += bflo(pw.y); v0[3] += bfhi(pw.y);
                        v1[0] += bflo(pw.z); v1[1] += bfhi(pw.z); v1[2] += bflo(pw.w); v1[3] += bfhi(pw.w); }
                    st_bf8(O + off + bj * HALF, v0, v1); } }
    }
};
struct EpiX1 {
    static constexpr bool PERM = false;
    const float* x; const float* mod; float* out;
    __device__ __forceinline__ void operator()(const f32x4 (&acc)[2][2][4][2], const Unit& u, int wr, int wc, int fr, int fq) const {
        const int rbase = u.pm * BM + wr * 64 + fr, col0 = u.pc * BM + wc * 32 + 4 * fq;
        const float* gt = mod + (size_t)(u.pm >> 4) * 6144 + 2048 + col0;
        f32x4 gv[2][2];
#pragma unroll
        for (int bj = 0; bj < 2; ++bj)
#pragma unroll
            for (int n = 0; n < 2; ++n) gv[bj][n] = *(const f32x4*)(gt + bj * HALF + n * 16);
#pragma unroll
        for (int ai = 0; ai < 2; ++ai)
#pragma unroll
            for (int m = 0; m < 4; ++m) { const size_t off = (size_t)(rbase + ai * HALF + m * 16) * 1024 + col0;
#pragma unroll
                for (int bj = 0; bj < 2; ++bj)
#pragma unroll
                    for (int n = 0; n < 2; ++n) { const f32x4 xv = *(const f32x4*)(x + off + bj * HALF + n * 16); *(f32x4*)(out + off + bj * HALF + n * 16) = xv + gv[bj][n] * acc[ai][bj][m][n]; } }
    }
};
struct EpiMoe1 {
    static constexpr bool PERM = true;
    unsigned char* HM;
    __device__ __forceinline__ void operator()(const f32x4 (&acc)[2][2][4][2], const Unit& u, int wr, int wc, int fr, int fq) const {
        const int rbase = u.pm * BM + wr * 64 + fr, col0 = u.pc * HALF + wc * 32 + 8 * fq;
#pragma unroll
        for (int ai = 0; ai < 2; ++ai)
#pragma unroll
            for (int m = 0; m < 4; ++m) {
                f32x4 v0, v1;
#pragma unroll
                for (int e = 0; e < 4; ++e) { v0[e] = silu_f(acc[ai][0][m][0][e] * 0.03125f) * (acc[ai][1][m][0][e] * 0.03125f); v1[e] = silu_f(acc[ai][0][m][1][e] * 0.03125f) * (acc[ai][1][m][1][e] * 0.03125f); }
                u32x2 w; w.x = pk_fp8x4(v0[0], v0[1], v0[2], v0[3]); w.y = pk_fp8x4(v1[0], v1[1], v1[2], v1[3]);
                *(u32x2*)(HM + (size_t)(rbase + ai * HALF + m * 16) * EH + col0) = w; }
    }
};
struct EpiBf {
    static constexpr bool PERM = true;
    bf16_t* O; int ldo; float scale;
    __device__ __forceinline__ void operator()(const f32x4 (&acc)[2][2][4][2], const Unit& u, int wr, int wc, int fr, int fq) const {
        const int rbase = u.pm * BM + wr * 64 + fr, col0 = u.pc * BM + wc * 32 + 8 * fq;
#pragma unroll
        for (int ai = 0; ai < 2; ++ai)
#pragma unroll
            for (int m = 0; m < 4; ++m)
#pragma unroll
                for (int bj = 0; bj < 2; ++bj) st_bf8(O + (size_t)(rbase + ai * HALF + m * 16) * ldo + col0 + bj * HALF, acc[ai][bj][m][0] * scale, acc[ai][bj][m][1] * scale);
    }
};
}

namespace gt {
constexpr int STAGE_BYTES = 128 * 144 + 256 * 144;
struct NoHook { template <class A> __device__ __forceinline__ void operator()(int, A&) const {} };
struct NoTf { __device__ __forceinline__ u32x4 operator()(int, int, u32x4 v) const { return v; } };
template <int NT, int BKT, class AL, class BL, class Pre = NoHook, class Post = NoHook, class TfA = NoTf>
__device__ __forceinline__ void gemm_tile(f32x4 (&acc)[4][NT], const AL& al, const BL& bl, int nk, LAS unsigned char* st, int tid, const Pre& pre = Pre(), const Post& post = Post(), const TfA& tfa = TfA()) {
    constexpr int AST = (BKT + 8) * 2, PPR = BKT / 8, NA = 128 * PPR / 512, NB = 64 * NT * PPR / 512;
    const int lane = tid & 63, wid = tid >> 6, wr = wid >> 2, wc = wid & 3, fr = lane & 15, fq = lane >> 4;
    LAS unsigned char* sa = st; LAS unsigned char* sb = st + 128 * AST;
    u32x4 ra[NA], rb[NB];
#pragma unroll
    for (int i = 0; i < NA; ++i) { const int p = tid + i * 512; ra[i] = al(p / PPR, (p % PPR) * 8); }
#pragma unroll
    for (int i = 0; i < NB; ++i) { const int p = tid + i * 512; rb[i] = bl(p / PPR, (p % PPR) * 8); }
    for (int kt = 0; kt < nk; ++kt) {
        __syncthreads();
#pragma unroll
        for (int i = 0; i < NA; ++i) { const int p = tid + i * 512; *(LAS u32x4*)(sa + (p / PPR) * AST + (p % PPR) * 16) = tfa(p / PPR, kt * BKT + (p % PPR) * 8, ra[i]); }
#pragma unroll
        for (int i = 0; i < NB; ++i) { const int p = tid + i * 512; *(LAS u32x4*)(sb + (p / PPR) * AST + (p % PPR) * 16) = rb[i]; }
        __syncthreads();
        if (kt + 1 < nk) {
            int t2 = tid; asm volatile("" : "+v"(t2));
#pragma unroll
            for (int i = 0; i < NA; ++i) { const int p = t2 + i * 512; ra[i] = al(p / PPR, (kt + 1) * BKT + (p % PPR) * 8); }
#pragma unroll
            for (int i = 0; i < NB; ++i) { const int p = t2 + i * 512; rb[i] = bl(p / PPR, (kt + 1) * BKT + (p % PPR) * 8); }
        }
        pre(kt, acc);
#pragma unroll
        for (int kk = 0; kk < BKT / 32; ++kk) {
            bf16x8 a[4], b[NT];
#pragma unroll
            for (int m = 0; m < 4; ++m) a[m] = *(const LAS bf16x8*)(sa + (wr * 64 + m * 16 + fr) * AST + kk * 64 + fq * 16);
#pragma unroll
            for (int n = 0; n < NT; ++n) b[n] = *(const LAS bf16x8*)(sb + (wc * 16 * NT + n * 16 + fr) * AST + kk * 64 + fq * 16);
#pragma unroll
            for (int m = 0; m < 4; ++m)
#pragma unroll
                for (int n = 0; n < NT; ++n) acc[m][n] = __builtin_amdgcn_mfma_f32_16x16x32_bf16(a[m], b[n], acc[m][n], 0, 0, 0);
        }
        post(kt, acc);
    }
    __syncthreads();
}
template <int NT, int BKT>
__device__ __forceinline__ void compute_tile(f32x4 (&acc)[4][NT], LAS unsigned char* st, int tid) {
    constexpr int AST = (BKT + 8) * 2;
    const int lane = tid & 63, wid = tid >> 6, wr = wid >> 2, wc = wid & 3, fr = lane & 15, fq = lane >> 4;
    LAS unsigned char* sa = st; LAS unsigned char* sb = st + 128 * AST;
#pragma unroll
    for (int kk = 0; kk < BKT / 32; ++kk) {
        bf16x8 a[4], b[NT];
#pragma unroll
        for (int m = 0; m < 4; ++m) a[m] = *(const LAS bf16x8*)(sa + (wr * 64 + m * 16 + fr) * AST + kk * 64 + fq * 16);
#pragma unroll
        for (int n = 0; n < NT; ++n) b[n] = *(const LAS bf16x8*)(sb + (wc * 16 * NT + n * 16 + fr) * AST + kk * 64 + fq * 16);
#pragma unroll
        for (int m = 0; m < 4; ++m)
#pragma unroll
            for (int n = 0; n < NT; ++n) acc[m][n] = __builtin_amdgcn_mfma_f32_16x16x32_bf16(a[m], b[n], acc[m][n], 0, 0, 0);
    }
}
struct LdRows {
    const bf16_t* base; int ld;
    __device__ __forceinline__ u32x4 operator()(int row, int k) const { return *(const u32x4*)(base + (size_t)row * ld + k); }
};
__device__ __forceinline__ u32x4 scale8(u32x4 v, float s0, float s1, float s2, float s3, float s4, float s5, float s6, float s7) {
    u32x4 o; o.x = pk2(bflo(v.x) * s0, bfhi(v.x) * s1); o.y = pk2(bflo(v.y) * s2, bfhi(v.y) * s3); o.z = pk2(bflo(v.z) * s4, bfhi(v.z) * s5); o.w = pk2(bflo(v.w) * s6, bfhi(v.w) * s7); return o;
}
}


#define XB_TMO      128
#define XB_XCNT(j)  (256  + 64 * (j))
#define XB_XSUB(j)  (1280 + 64 * (j))
#define XB_XGEN(j)  (2304 + 64 * (j))
#define XB_TOP      3328
#define XB_TOPGEN   3392
#define XCD_BAR_WORDS 3456
#define XB_SPIN_CAP (1u << 18)
__device__ __forceinline__ unsigned xb_ld(unsigned* p)              { return __hip_atomic_load(p, __ATOMIC_RELAXED, __HIP_MEMORY_SCOPE_AGENT); }
__device__ __forceinline__ unsigned xb_add(unsigned* p, unsigned v) { return __hip_atomic_fetch_add(p, v, __ATOMIC_RELAXED, __HIP_MEMORY_SCOPE_AGENT); }
__device__ __forceinline__ unsigned xb_xcc_id() { return (unsigned)__builtin_amdgcn_s_getreg((3 << 11) | 20) & 0xFu; }
#define XB_SPIN(cond, bar) do { unsigned _sp = 0; while (cond) { __builtin_amdgcn_s_sleep(1); \
    if ((++_sp & 255u) == 0u) { if (xb_ld(&(bar)[XB_TMO])) break; if (_sp > XB_SPIN_CAP) { atomicAdd(&(bar)[XB_TMO], 1u); break; } } } } while (0)
struct XcdBarrier { unsigned* bar; unsigned x; volatile LAS unsigned* st; };
__device__ __forceinline__ XcdBarrier xcd_barrier_post(unsigned* bar, volatile LAS unsigned* st) {
    XcdBarrier b; b.bar = bar; b.x = xb_xcc_id(); b.st = st;
    if (threadIdx.x == 0) (void)xb_add(&bar[XB_XCNT(b.x)], 1u);
    return b;
}
__device__ __forceinline__ void xcd_barrier_complete(unsigned* bar, unsigned x, unsigned& nloc, unsigned& nx) {
    const unsigned G = gridDim.x * gridDim.y * gridDim.z;
    unsigned sum, cnt, mine, sp = 0u;
    for (;;) {
        sum = 0u; cnt = 0u; mine = 0u;
#pragma unroll
        for (unsigned j = 0; j < 16; ++j) { const unsigned c = xb_ld(&bar[XB_XCNT(j)]); sum += c; cnt += (c > 0u) ? 1u : 0u; mine = (j == x) ? c : mine; }
        if (sum == G) break;
        __builtin_amdgcn_s_sleep(1);
        if ((++sp & 255u) == 0u) { if (xb_ld(&bar[XB_TMO])) break; if (sp > XB_SPIN_CAP) { atomicAdd(&bar[XB_TMO], 1u); break; } }
    }
    nloc = mine > 0u ? mine : 1u; nx = cnt > 0u ? cnt : 1u;
}
__device__ __forceinline__ void xcd_barrier(const XcdBarrier& b) {
    asm volatile("s_waitcnt vmcnt(0)" ::: "memory");
    __syncthreads();
    if (threadIdx.x == 0) {
        unsigned* bar = b.bar;
        __builtin_amdgcn_s_waitcnt(0);
        unsigned nloc = b.st[0], nx = b.st[1];
        if (nloc == 0u) { xcd_barrier_complete(bar, b.x, nloc, nx); b.st[0] = nloc; b.st[1] = nx; }
        const unsigned old = xb_add(&bar[XB_XSUB(b.x)], 1u);
        const unsigned gen = old / nloc;
        if (old + 1u == (gen + 1u) * nloc) {
            __builtin_amdgcn_fence(__ATOMIC_RELEASE, "agent");
            asm volatile("s_waitcnt vmcnt(0)" ::: "memory");
            const unsigned og = xb_add(&bar[XB_TOP], 1u);
            const unsigned tg = og / nx;
            if (og + 1u == (tg + 1u) * nx) xb_add(&bar[XB_TOPGEN], 1u);
            else XB_SPIN(xb_ld(&bar[XB_TOPGEN]) == tg, bar);
            __builtin_amdgcn_fence(__ATOMIC_ACQUIRE, "agent");
            xb_add(&bar[XB_XGEN(b.x)], 1u);
            asm volatile("s_waitcnt vmcnt(0)" ::: "memory");
        } else {
            XB_SPIN(xb_ld(&bar[XB_XGEN(b.x)]) == gen, bar);
            __builtin_amdgcn_fence(__ATOMIC_ACQUIRE, "agent");
            asm volatile("s_waitcnt vmcnt(0)" ::: "memory");
        }
    }
    __syncthreads();
}

struct Args { const float* in[31]; float* out; unsigned char* ws; };
enum { I_X = 0, I_C, I_CTX, I_CCTX, I_ADAW, I_ADAB, I_N1G, I_N2G, I_WIN, I_BIN, I_DECAY, I_RETWO, I_HCW, I_HCB, I_HW1, I_HB1, I_HFREQ, I_HW2, I_HB2, I_HW3, I_HSKIP, I_HYWO, I_WOUT,
       I_RGW, I_RGB, I_REW, I_REB, I_EW1, I_EW3, I_EW2, I_FNG };

template <class RowMap>
__device__ __forceinline__ void transpose_item(const float* W, int N, int k0, int n0, bf16_t* WT, int ldt, const RowMap& rm, LAS float* scr, int lane) {
    const int lr = lane >> 4, lc = (lane & 15) * 4;
#pragma unroll
    for (int i = 0; i < 16; ++i) { const int kk = 4 * i + lr; const f32x4 v = *(const f32x4*)(W + (size_t)(k0 + kk) * N + n0 + lc); LAS float* s = scr + kk * 69 + lc; s[0] = v[0]; s[1] = v[1]; s[2] = v[2]; s[3] = v[3]; }
    asm volatile("s_waitcnt lgkmcnt(0)" ::: "memory");
    const int c = lane & 7;
#pragma unroll
    for (int j = 0; j < 8; ++j) { const int n = (lane >> 3) + 8 * j; const LAS float* s = scr + (8 * c) * 69 + n;
        u32x4 o; o.x = pk2(s[0 * 69], s[1 * 69]); o.y = pk2(s[2 * 69], s[3 * 69]); o.z = pk2(s[4 * 69], s[5 * 69]); o.w = pk2(s[6 * 69], s[7 * 69]);
        *(u32x4*)(WT + (size_t)rm(n0 + n) * ldt + k0 + 8 * c) = o; }
    asm volatile("s_waitcnt lgkmcnt(0)" ::: "memory");
}
using pg8::pk_fp8x4;
template <class RowMap>
__device__ __forceinline__ void transpose_item_f8(const float* W, int N, int k0, int n0, unsigned char* WT, int ldt, const RowMap& rm, float scale, LAS float* scr, int lane) {
    const int lr = lane >> 4, lc = (lane & 15) * 4;
#pragma unroll
    for (int i = 0; i < 16; ++i) { const int kk = 4 * i + lr; const f32x4 v = *(const f32x4*)(W + (size_t)(k0 + kk) * N + n0 + lc); LAS float* s = scr + kk * 69 + lc; s[0] = v[0]; s[1] = v[1]; s[2] = v[2]; s[3] = v[3]; }
    asm volatile("s_waitcnt lgkmcnt(0)" ::: "memory");
    const int c = lane & 7;
#pragma unroll
    for (int j = 0; j < 8; ++j) { const int n = (lane >> 3) + 8 * j; const LAS float* s = scr + (8 * c) * 69 + n;
        u32x2 o; o.x = pk_fp8x4(s[0 * 69] * scale, s[1 * 69] * scale, s[2 * 69] * scale, s[3 * 69] * scale); o.y = pk_fp8x4(s[4 * 69] * scale, s[5 * 69] * scale, s[6 * 69] * scale, s[7 * 69] * scale);
        *(u32x2*)(WT + (size_t)rm(n0 + n) * ldt + k0 + 8 * c) = o; }
    asm volatile("s_waitcnt lgkmcnt(0)" ::: "memory");
}
struct RmId { __device__ __forceinline__ int operator()(int n) const { return n; } };
struct RmWin { __device__ __forceinline__ int operator()(int n) const { return win_destrow(n); } };
struct RmE13 { int add; __device__ __forceinline__ int operator()(int n) const { return 256 * (n >> 7) + (n & 127) + add; } };

__device__ __forceinline__ float lg2_decay(float logit) { return -log1pf(expf(-logit)) * 1.4426950408889634f; }

__device__ __forceinline__ void short_conv8(const bf16_t* HU, int row, int t, int ch, const float* cw, const float* cb, float (&o)[8]) {
    const f32x4 b0 = *(const f32x4*)(cb + ch), b1 = *(const f32x4*)(cb + ch + 4);
#pragma unroll
    for (int e = 0; e < 4; ++e) { o[e] = b0[e]; o[4 + e] = b1[e]; }
#pragma unroll
    for (int j = 0; j < 3; ++j) {
        const int tt = t + j - 1;
        if (tt >= 0 && tt < SEQ) {
            const u32x4 v = *(const u32x4*)(HU + (size_t)(row + j - 1) * 1536 + ch);
            const f32x4 w0 = *(const f32x4*)(cw + j * 1536 + ch), w1 = *(const f32x4*)(cw + j * 1536 + ch + 4);
            o[0] += bflo(v.x) * w0[0]; o[1] += bfhi(v.x) * w0[1]; o[2] += bflo(v.y) * w0[2]; o[3] += bfhi(v.y) * w0[3];
            o[4] += bflo(v.z) * w1[0]; o[5] += bfhi(v.z) * w1[1]; o[6] += bflo(v.w) * w1[2]; o[7] += bfhi(v.w) * w1[3];
        }
    }
}


__device__ __forceinline__ void short_conv8x8(const bf16_t* HU, int row0, int t0, int ch, const float* cw, const float* cb, float (&o)[8][8]) {
    u32x4 rw[10];
#pragma unroll
    for (int r = 0; r < 10; ++r) { const int tt = t0 + r - 1; rw[r] = (u32x4){0u, 0u, 0u, 0u}; if (tt >= 0 && tt < SEQ) rw[r] = *(const u32x4*)(HU + (size_t)(row0 + r - 1) * 1536 + ch); }
    float w[3][8], bb[8];
#pragma unroll
    for (int j = 0; j < 3; ++j) { const f32x4 w0 = *(const f32x4*)(cw + j * 1536 + ch), w1 = *(const f32x4*)(cw + j * 1536 + ch + 4);
#pragma unroll
        for (int e = 0; e < 4; ++e) { w[j][e] = w0[e]; w[j][4 + e] = w1[e]; } }
    { const f32x4 b0 = *(const f32x4*)(cb + ch), b1 = *(const f32x4*)(cb + ch + 4);
#pragma unroll
      for (int e = 0; e < 4; ++e) { bb[e] = b0[e]; bb[4 + e] = b1[e]; } }
#pragma unroll
    for (int t = 0; t < 8; ++t)
#pragma unroll
        for (int e = 0; e < 8; ++e) o[t][e] = bb[e];
#pragma unroll
    for (int r = 0; r < 10; ++r) {
        float u[8]; u[0] = bflo(rw[r].x); u[1] = bfhi(rw[r].x); u[2] = bflo(rw[r].y); u[3] = bfhi(rw[r].y); u[4] = bflo(rw[r].z); u[5] = bfhi(rw[r].z); u[6] = bflo(rw[r].w); u[7] = bfhi(rw[r].w);
#pragma unroll
        for (int j = 0; j < 3; ++j) { const int t = r - j;
            if (t >= 0 && t < 8) {
#pragma unroll
                for (int e = 0; e < 8; ++e) o[t][e] += u[e] * w[j][e]; } }
    }
}

typedef const __attribute__((address_space(4))) Args CArgs;
__device__ __forceinline__ CArgs* args_ptr() { CArgs* p = (CArgs*)__builtin_amdgcn_kernarg_segment_ptr(); asm volatile("" : "+s"(p)); return p; }
#define DECL_PTRS \
    CArgs& a = *args_ptr(); unsigned char* ws = a.ws; unsigned char* dob = (unsigned char*)a.out; \
    int tid = threadIdx.x; asm volatile("" : "+v"(tid)); const int lane = tid & 63, wave = tid >> 6, gw = bid * 8 + wave; (void)lane; (void)gw; \
    int* cnt = (int*)(ws + WS_CTL); \
    float* MOD = (float*)(ws + WS_MOD); float* ROPE = (float*)(ws + WS_ROPE); float* BINP = (float*)(ws + WS_BINP); float* FPART = (float*)(ws + WS_FPART); \
    int* TOKINFO = (int*)(ws + WS_TOKINFO); int* LISTS = (int*)(ws + WS_LISTS); \
    bf16_t* TR = (bf16_t*)(ws + WS_TR); \
    bf16_t* WT_IN = (bf16_t*)(ws + WS_WT_IN); bf16_t* WT_RETO = (bf16_t*)(ws + WS_WT_RETO); bf16_t* WT_HYO = (bf16_t*)(ws + WS_WT_HYO); bf16_t* WT_OUT = (bf16_t*)(ws + WS_WT_OUT); \
    bf16_t* Qb = (bf16_t*)(ws + WS_Q); bf16_t* Kb = (bf16_t*)(ws + WS_K); bf16_t* KT = (bf16_t*)(ws + WS_KT); bf16_t* VT = (bf16_t*)(ws + WS_VT); \
    float* FILT = (float*)(ws + WS_KV); \
    bf16_t* SGR = (bf16_t*)(ws + WS_SGR); bf16_t* SGH = (bf16_t*)(ws + WS_SGH); bf16_t* XB = (bf16_t*)(ws + WS_XB); \
    bf16_t* SG = (bf16_t*)(ws + WS_SG); bf16_t* HU = (bf16_t*)(ws + WS_HU); bf16_t* HM = (bf16_t*)(ws + WS_HU); \
    bf16_t* KV = (bf16_t*)(ws + WS_KV); bf16_t* WE13 = (bf16_t*)(ws + WS_WE13); bf16_t* WE2 = (bf16_t*)(ws + WS_WE2); \
    bf16_t* XN = (bf16_t*)(dob + DO_XN); bf16_t* ZT = (bf16_t*)(dob + DO_ZT); unsigned char* XN8 = dob + DO_XN8; unsigned char* WTG8 = (unsigned char*)(ws + WS_WT_IN) + (size_t)NINA * 1024 * 2; (void)XN8; (void)WTG8; \
    float* X1 = a.out; \
    (void)cnt; (void)MOD; (void)ROPE; (void)BINP; (void)FPART; (void)TOKINFO; (void)LISTS; (void)TR; (void)WT_IN; (void)WT_RETO; (void)WT_HYO; (void)WT_OUT; (void)Qb; (void)Kb; (void)KT; (void)VT; (void)FILT; \
    (void)SGR; (void)SGH; (void)XB; (void)SG; (void)HU; (void)HM; (void)KV; (void)WE13; (void)WE2; (void)XN; (void)ZT; (void)X1;

__global__ void __launch_bounds__(512, 2) fwd_kernel(Args a_) {
    extern __shared__ __attribute__((aligned(16))) unsigned char lds_raw[];
    LAS unsigned char* lds = (LAS unsigned char*)lds_raw;
    cg::grid_group grid = cg::this_grid();
    const int G = gridDim.x, bid = blockIdx.x, NGW = G * 8;
    volatile LAS unsigned* bst = (volatile LAS unsigned*)(lds + LDS_BYTES - 16);
    if (threadIdx.x == 0) { bst[0] = 0u; bst[1] = 0u; }
    __syncthreads();
    if (blockIdx.x == 0) { unsigned* bw = (unsigned*)(args_ptr()->ws + WS_CTL) + 1024; for (int i = threadIdx.x; i < XCD_BAR_WORDS; i += 512) bw[i] = 0u; }
#define GRID_BAR() xcd_barrier(xbar)
    unsigned long long tprev_ = 0, spin_ = 0;
    if (PROBE_PHASE >= 0) tprev_ = __builtin_amdgcn_s_memrealtime();
#define STAMP(k) do { if (PROBE_PHASE >= 0 && blockIdx.x == 0 && threadIdx.x == 0) { const unsigned long long now_ = __builtin_amdgcn_s_memrealtime(); if ((k) == PROBE_PHASE) spin_ = now_ - tprev_; tprev_ = now_; } } while (0)

    { DECL_PTRS
    for (int it = bid; it < 193; it += G) {
        if (it < 192) {
            const int col0 = it * 32, kq = tid >> 5, cl = tid & 31;
            LAS float* sl = (LAS float*)(lds + 32768);
            for (int idx = tid; idx < 9 * 1024; idx += 512) { const int r = idx >> 10, k = idx & 1023; sl[k * 12 + r] = silu_f(r < 8 ? a.in[I_C][r * 1024 + k] : a.in[I_CCTX][k]); }
            __syncthreads();
            float acc9[9];
#pragma unroll
            for (int r = 0; r < 9; ++r) acc9[r] = 0.f;
#pragma unroll 8
            for (int kk = 0; kk < 64; ++kk) { const int k = kq * 64 + kk; const float w = a.in[I_ADAW][(size_t)k * 6144 + col0 + cl];
                const f32x4 s0 = *(const LAS f32x4*)(sl + k * 12), s1 = *(const LAS f32x4*)(sl + k * 12 + 4); const float s8 = sl[k * 12 + 8];
                acc9[0] += s0[0] * w; acc9[1] += s0[1] * w; acc9[2] += s0[2] * w; acc9[3] += s0[3] * w; acc9[4] += s1[0] * w; acc9[5] += s1[1] * w; acc9[6] += s1[2] * w; acc9[7] += s1[3] * w; acc9[8] += s8 * w; }
            LAS float* red = (LAS float*)lds;
#pragma unroll
            for (int r = 0; r < 9; ++r) red[(kq * 9 + r) * 32 + cl] = acc9[r];
            __syncthreads();
            if (tid < 288) { const int r = tid >> 5, c2 = tid & 31; float s = 0.f; for (int q = 0; q < 16; ++q) s += red[(q * 9 + r) * 32 + c2]; MOD[r * 6144 + col0 + c2] = s + a.in[I_ADAB][col0 + c2]; }
            __syncthreads();
        } else {
            for (int idx = tid; idx < 2048; idx += 512) { const int pos = idx >> 5, i = idx & 31; const float inv = powf(10000.f, -(float)i / 32.f); const float ang = (float)pos * inv; ROPE[idx] = cosf(ang); ROPE[2048 + idx] = sinf(ang); }
            for (int n = tid; n < 6656; n += 512) BINP[win_destrow(n)] = a.in[I_BIN][n];
        }
    }
    for (int fi0 = bid + 63; fi0 < 256 + 63 + 256; fi0 += G) {
        const int fi = fi0 - 256; if (fi < 0 || fi >= 256) continue;
        {
            const int t0 = fi * 16;
            LAS float* feats = (LAS float*)lds; LAS float* hid1 = feats + 544; LAS float* hid2 = hid1 + 1024;
            for (int idx = tid; idx < 16 * 33; idx += 512) { const int row = idx / 33, f = idx % 33; const float t = (float)(t0 + row) * (1.f / 4096.f); float v;
                if (f == 0) v = t; else { const int mb = (f - 1) & 15; const float band = 1e-4f + (float)mb * ((15.f - 1e-4f) / 15.f); const float ph = (6.283185307179586f * t) * band; v = f <= 16 ? cosf(ph) : -sinf(ph); }
                feats[idx] = v; }
            __syncthreads();
            for (int idx = tid; idx < 1024; idx += 512) { const int row = idx >> 6, j = idx & 63; float s = a.in[I_HB1][j]; for (int f = 0; f < 33; ++f) s += feats[row * 33 + f] * a.in[I_HW1][f * 64 + j]; hid1[idx] = sinf(a.in[I_HFREQ][j] * s); }
            __syncthreads();
            for (int idx = tid; idx < 1024; idx += 512) { const int row = idx >> 6, j = idx & 63; float s = a.in[I_HB2][j]; for (int k = 0; k < 64; ++k) s += hid1[row * 64 + k] * a.in[I_HW2][k * 64 + j]; hid2[j * 16 + row] = sinf(a.in[I_HFREQ][j] * s); }
            __syncthreads();
            const float slow = 4.605170185988091f / 1.5f, fast = 4.605170185988091f / 0.3f;
            for (int col = tid; col < 1024; col += 512) {
                float ac[16];
#pragma unroll
                for (int r = 0; r < 16; ++r) ac[r] = 0.f;
#pragma unroll 4
                for (int k = 0; k < 64; ++k) { const float w = a.in[I_HW3][k * 1024 + col];
#pragma unroll
                    for (int r4 = 0; r4 < 4; ++r4) { const f32x4 hv = *(const LAS f32x4*)(hid2 + k * 16 + 4 * r4); ac[4 * r4] += hv[0] * w; ac[4 * r4 + 1] += hv[1] * w; ac[4 * r4 + 2] += hv[2] * w; ac[4 * r4 + 3] += hv[3] * w; } }
                const float delta = slow + (float)(col & 511) * ((fast - slow) / 511.f); float ps = 0.f;
#pragma unroll
                for (int r = 0; r < 16; ++r) { const float t = (float)(t0 + r) * (1.f / 4096.f); ac[r] *= expf(-t * delta); ps += fabsf(ac[r]); }
#pragma unroll
                for (int r = 0; r < 4; ++r) *(f32x4*)(FILT + (size_t)col * 4096 + t0 + 4 * r) = (f32x4){ac[4 * r], ac[4 * r + 1], ac[4 * r + 2], ac[4 * r + 3]};
                FPART[fi * 1024 + col] = ps;
            }
            __syncthreads();
        }
    }
    __syncthreads();
    {
        LAS float* scr = (LAS float*)(lds + wave * 17664);
        constexpr int I_IN = 16 * 104, I_RO = 16 * 16, I_HO = 8 * 16, I_OU = 16 * 16;
        for (int it = gw; it < I_IN + I_RO + I_HO + I_OU; it += NGW) {
            int r = it;
            if (r < I_IN) { const int nb = r % 104;
                if (nb < 72) transpose_item(a.in[I_WIN], 6656, 64 * (r / 104), 64 * nb, WT_IN, 1024, RmWin{}, scr, lane);
                else transpose_item_f8(a.in[I_WIN] + NINA, 6656, 64 * (r / 104), 64 * (nb - 72), WTG8, 1024, RmId{}, 32.f, scr, lane);
                continue; } r -= I_IN;
            if (r < I_RO) { transpose_item(a.in[I_RETWO], 1024, 64 * (r / 16), 64 * (r % 16), WT_RETO, 1024, RmId{}, scr, lane); continue; } r -= I_RO;
            if (r < I_HO) { transpose_item(a.in[I_HYWO], 1024, 64 * (r / 16), 64 * (r % 16), WT_HYO, 512, RmId{}, scr, lane); continue; } r -= I_HO;
            transpose_item(a.in[I_WOUT], 1024, 64 * (r / 16), 64 * (r % 16), WT_OUT, 1024, RmId{}, scr, lane);
        }
    }
    }
    grid.sync();
    const XcdBarrier xbar = xcd_barrier_post((unsigned*)(args_ptr()->ws + WS_CTL) + 1024, bst);
    STAMP(0);

    { DECL_PTRS
    for (int m0 = gw; m0 < MT; m0 += 2 * NGW) {
        f32x4 v[2][4]; float s[2] = {0.f, 0.f};
#pragma unroll
        for (int q = 0; q < 2; ++q) { const int m = m0 + q * NGW; const bool ok = m < MT; const bool lat = m < T;
            const float* xr = !ok ? a.in[I_X] : lat ? a.in[I_X] + (size_t)m * D : a.in[I_CTX] + (size_t)(m - T) * D;
#pragma unroll
            for (int j = 0; j < 4; ++j) { v[q][j] = *(const f32x4*)(xr + 4 * lane + 256 * j); s[q] += (v[q][j][0] * v[q][j][0] + v[q][j][1] * v[q][j][1]) + (v[q][j][2] * v[q][j][2] + v[q][j][3] * v[q][j][3]); } }
#pragma unroll
        for (int q = 0; q < 2; ++q) { const int m = m0 + q * NGW; if (m >= MT) break; const bool lat = m < T;
            const float* md = MOD + (size_t)(lat ? (m >> 12) : 8) * 6144;
            const float rstd = rsqrtf(wave_sum(s[q]) * (1.f / D) + EPS);
#pragma unroll
            for (int j = 0; j < 4; ++j) { const int c0 = 4 * lane + 256 * j; const f32x4 g = *(const f32x4*)(a.in[I_N1G] + c0), sh = *(const f32x4*)(md + c0), sc = *(const f32x4*)(md + 1024 + c0);
                const f32x4 o = (v[q][j] * rstd * g) * (sc + 1.f) + sh; u32x2 w; w.x = pk2(o[0], o[1]); w.y = pk2(o[2], o[3]); *(u32x2*)(XN + (size_t)m * D + c0) = w;
                if (lat) *(unsigned*)(XN8 + (size_t)m * D + c0) = pk_fp8x4(o[0], o[1], o[2], o[3]); } }
    }
    }
    GRID_BAR();
    STAMP(1);

    { DECL_PTRS
    for (int c = bid; c < 512; c += G) {
        LAS float* red = (LAS float*)lds;
        float p = 0.f; if (tid < 256) p = FPART[tid * 1024 + c]; else p = FPART[(tid - 256) * 1024 + 512 + c];
        p = wave_sum(p); if (lane == 0) red[wave] = p;
        __syncthreads();
        const float nf = 1.f / ((red[0] + red[1]) + (red[2] + red[3])), nb = 1.f / ((red[4] + red[5]) + (red[6] + red[7]));
        for (int i = tid; i < 8192; i += 512) { const int x = 4096 - i; float v = 0.f;
            if (x >= 0 && x < 4096) v += FILT[(size_t)c * 4096 + x] * nf;
            if (x <= 0 && x > -4096) v += FILT[(size_t)(512 + c) * 4096 - x] * nb;
            TR[(size_t)c * 8192 + i] = (bf16_t)f2bf(v); }
        __syncthreads();
    }
    __syncthreads();
    {
        pg8::Gemm g{XN, WT_IN, 1024, 1024, 1024}; pg8::InProjOrder S; S.init(G, bid);
        pg8::EpiInA E{Qb, Kb, KT, VT, SG, HU, BINP, ROPE};
        pg8::gemm_phase(lds, g, S, E);
    }
    }
    GRID_BAR();
    STAMP(2);

    { DECL_PTRS
    for (int it = bid; it < 512; it += G) {
        const int b = it >> 6, tt = (it >> 3) & 7, cc = it & 7;
        LAS bf16_t* zt = (LAS bf16_t*)lds;
        { int tl = tid; asm volatile("" : "+v"(tl));
          const int tq = tl >> 3, cg = tl & 7, c0 = cc * 64 + cg * 8, t0 = tt * 512 + tq * 8, row0 = b * SEQ + t0;
          float x1[8][8], vv[8][8];
          short_conv8x8(HU, row0, t0, 512 + c0, a.in[I_HCW], a.in[I_HCB], x1);
          short_conv8x8(HU, row0, t0, 1024 + c0, a.in[I_HCW], a.in[I_HCB], vv);
#pragma unroll
          for (int e = 0; e < 8; ++e) { u32x4 w; w.x = pk2(x1[0][e] * vv[0][e], x1[1][e] * vv[1][e]); w.y = pk2(x1[2][e] * vv[2][e], x1[3][e] * vv[3][e]); w.z = pk2(x1[4][e] * vv[4][e], x1[5][e] * vv[5][e]); w.w = pk2(x1[6][e] * vv[6][e], x1[7][e] * vv[7][e]);
              *(LAS u32x4*)(zt + (cg * 8 + e) * 520 + tq * 8) = w; } }
        __syncthreads();
#pragma unroll
        for (int i = 0; i < 8; ++i) { const int ch = wave * 8 + i; *(u32x4*)(ZT + ((size_t)(cc * 64 + ch) * 8 + b) * SEQ + tt * 512 + lane * 8) = *(const LAS u32x4*)(zt + ch * 520 + lane * 8); }
        __syncthreads();
    }
    {
        LAS float* wtab = (LAS float*)(lds + 104448);
        for (int u0 = bid; u0 < 256; u0 += G) {
            int tl = tid; asm volatile("" : "+v"(tl));
            const int u = (G == 256) ? (((u0 & 7) + 8 * (u0 >> 6)) * 8 + ((u0 >> 3) & 7)) : u0;
            const int chain = u >> 2, dvq = u & 3, bh = chain >> 1, dir = chain & 1, h = bh & 3;
            const float lg = lg2_decay(a.in[I_DECAY][dir * 4 + h]); const float g128 = exp2f(128.f * lg);
            if (tl < 128) wtab[tl] = exp2f((float)(dir == 0 ? 127 - tl : tl) * lg);
            __syncthreads();
            struct LdK { const bf16_t* base; const LAS float* w; int dir;
                __device__ __forceinline__ u32x4 operator()(int row, int k) const { const int kt = k >> 7, j = k & 127;
                    const int ck = dir == 0 ? (kt == 0 ? 32 : kt == 1 ? 33 : kt - 2) : (kt == 0 ? 33 : kt == 1 ? 32 : 33 - kt);
                    return *(const u32x4*)(base + ((size_t)ck * 128 + row) * 128 + j); } };
            struct LdV { const bf16_t* base; int dir;
                __device__ __forceinline__ u32x4 operator()(int row, int k) const { const int kt = k >> 7, j = k & 127;
                    const int ck = dir == 0 ? (kt == 0 ? 32 : kt == 1 ? 33 : kt - 2) : (kt == 0 ? 33 : kt == 1 ? 32 : 33 - kt);
                    return *(const u32x4*)(base + ((size_t)ck * 256 + row) * 128 + j); } };
            struct Pre { float g;
                __device__ __forceinline__ void operator()(int, f32x4 (&acc)[4][1]) const {
#pragma unroll
                    for (int m = 0; m < 4; ++m) acc[m][0] = acc[m][0] * g; } };
            struct Post { bf16_t* out; int tl;
                __device__ __forceinline__ void operator()(int kt, f32x4 (&acc)[4][1]) const {
                    const int wr = tl >> 8, wc = (tl >> 6) & 3, fr = tl & 15, fq = (tl >> 4) & 3;
                    bf16_t* o = out + (size_t)kt * 32768 + (size_t)(wc * 16 + fr) * 128 + wr * 64 + 4 * fq;
#pragma unroll
                    for (int m = 0; m < 4; ++m) { u32x2 w; w.x = pk2(acc[m][0][0], acc[m][0][1]); w.y = pk2(acc[m][0][2], acc[m][0][3]); *(u32x2*)(o + m * 16) = w; } } };
            f32x4 acc[4][1];
#pragma unroll
            for (int m = 0; m < 4; ++m) acc[m][0] = (f32x4){0.f, 0.f, 0.f, 0.f};
            const LdK al{KT + (size_t)bh * 34 * 128 * 128, wtab, dir}; const LdV bl{VT + (size_t)bh * 34 * 256 * 128 + (size_t)dvq * 64 * 128, dir};
            const Pre pre{g128}; const Post post{KV + (size_t)chain * 33 * 32768 + (size_t)dvq * 64 * 128, tl};
            u32x4 rg[3][6];
#define CH_LOAD(slot, kt) do { int _t = tl; asm volatile("" : "+v"(_t)); _Pragma("unroll") for (int i = 0; i < 4; ++i) { const int pz = _t + 512 * i; rg[slot][i] = al(pz >> 4, (kt) * 128 + (pz & 15) * 8); } \
        _Pragma("unroll") for (int i = 0; i < 2; ++i) { const int pz = _t + 512 * i; rg[slot][4 + i] = bl(pz >> 4, (kt) * 128 + (pz & 15) * 8); } } while (0)
#define CH_STEP(slot, kt) do { __syncthreads(); \
        _Pragma("unroll") for (int i = 0; i < 4; ++i) { const int pz = tl + 512 * i; const LAS float* wp = wtab + (pz & 15) * 8; const f32x4 w0 = *(const LAS f32x4*)wp, w1 = *(const LAS f32x4*)(wp + 4); \
            *(LAS u32x4*)(lds + (pz >> 4) * 272 + (pz & 15) * 16) = gt::scale8(rg[slot][i], w0[0], w0[1], w0[2], w0[3], w1[0], w1[1], w1[2], w1[3]); } \
        _Pragma("unroll") for (int i = 0; i < 2; ++i) { const int pz = tl + 512 * i; *(LAS u32x4*)(lds + 128 * 272 + (pz >> 4) * 272 + (pz & 15) * 16) = rg[slot][4 + i]; } \
        __syncthreads(); if ((kt) + 3 < 33) CH_LOAD(slot, (kt) + 3); pre(kt, acc); gt::compute_tile<1, 128>(acc, lds, tl); post(kt, acc); } while (0)
            CH_LOAD(0, 0); CH_LOAD(1, 1); CH_LOAD(2, 2);
            for (int kt = 0; kt < 33; kt += 3) { CH_STEP(0, kt); CH_STEP(1, kt + 1); CH_STEP(2, kt + 2); }
            __syncthreads();
#undef CH_LOAD
#undef CH_STEP
        }
    }
    }
    GRID_BAR();
    STAMP(3);

    { DECL_PTRS
    {
        typedef float f32x16 __attribute__((ext_vector_type(16)));
        constexpr int CPB = 16448, ZOFF = 4 * CPB, ROWB = 10256, PADB = 992;
        for (int i = tid; i < (8 * ROWB) / 16; i += 512) *(LAS u32x4*)(lds + ZOFF + i * 16) = (u32x4){0u, 0u, 0u, 0u};
        __syncthreads();
        u32x4 zr[8], tv0[2], tv1[2];
#define CV_FETCH(cc) do { int _t = tid; asm volatile("" : "+v"(_t)); const bf16_t* _z = ZT + (size_t)(cc) * 8 * SEQ; const bf16_t* _tr = TR + (size_t)(cc) * 8192; \
        _Pragma("unroll") for (int i = 0; i < 8; ++i) { const int q = _t + 512 * i; zr[i] = *(const u32x4*)(_z + (size_t)(q >> 9) * SEQ + (q & 511) * 8); } \
        _Pragma("unroll") for (int i = 0; i < 2; ++i) { const int u = _t + 512 * i; tv0[i] = *(const u32x4*)(_tr + 8 * u); tv1[i] = (u32x4){0u, 0u, 0u, 0u}; if (u < 1023) tv1[i] = *(const u32x4*)(_tr + 8 * u + 8); } } while (0)
        if (bid < 512) CV_FETCH(bid);
        for (int c = bid; c < 512; c += G) {
            int tl = tid; asm volatile("" : "+v"(tl));
            const int w = tl >> 6, l = tl & 63, col = l & 31, hh = l >> 5, Rl = col >> 3, nn = col & 7;
            bf16_t* zc = ZT + (size_t)c * 8 * SEQ;
#pragma unroll
            for (int i = 0; i < 8; ++i) { const int q = tl + 512 * i, n = q >> 9, off = (q & 511) * 8; *(LAS u32x4*)(lds + ZOFF + n * ROWB + PADB + off * 2) = zr[i]; }
#pragma unroll
            for (int i = 0; i < 2; ++i) { const int u = tl + 512 * i; const u32x4 v0 = tv0[i], v1 = tv1[i];
                const unsigned W0 = v0.x, W1 = v0.y, W2 = v0.z, W3 = v0.w, W4 = v1.x, W5 = v1.y;
                *(LAS u32x4*)(lds + 0 * CPB + 16 * u) = v0;
                *(LAS u32x4*)(lds + 1 * CPB + 16 * u) = (u32x4){(W0 >> 16) | (W1 << 16), (W1 >> 16) | (W2 << 16), (W2 >> 16) | (W3 << 16), (W3 >> 16) | (W4 << 16)};
                *(LAS u32x4*)(lds + 2 * CPB + 16 * u) = (u32x4){W1, W2, W3, W4};
                *(LAS u32x4*)(lds + 3 * CPB + 16 * u) = (u32x4){(W1 >> 16) | (W2 << 16), (W2 >> 16) | (W3 << 16), (W3 >> 16) | (W4 << 16), (W4 >> 16) | (W5 << 16)}; }
            __syncthreads();
            if (c + G < 512) CV_FETCH(c + G);
            const int dlo = 32 * w - 255;
            const int e0 = 4096 - 16 * dlo - col + 8 * hh;
            int aaddr = (e0 & 3) * CPB + 2 * (e0 & ~3);
            int baddr = ZOFF + nn * ROWB + PADB + 2 * (512 * w + 64 * Rl + 8 * hh - 16 * dlo);
            f32x16 acc[4];
#pragma unroll
            for (int q = 0; q < 4; ++q)
#pragma unroll
                for (int i = 0; i < 16; ++i) acc[q][i] = 0.f;
            u32x2 alo = *(const LAS u32x2*)(lds + aaddr), ahi = *(const LAS u32x2*)(lds + aaddr + 8);
            u32x4 bq[4];
#pragma unroll
            for (int q = 0; q < 4; ++q) bq[q] = *(const LAS u32x4*)(lds + baddr + 512 * (q >> 1) + 64 * (q & 1));
            for (int it = 0; it < 285; ++it) {
                aaddr -= 32; baddr -= 32;
                const u32x2 nlo = *(const LAS u32x2*)(lds + aaddr), nhi = *(const LAS u32x2*)(lds + aaddr + 8);
                u32x4 nb[4];
#pragma unroll
                for (int q = 0; q < 4; ++q) nb[q] = *(const LAS u32x4*)(lds + baddr + 512 * (q >> 1) + 64 * (q & 1));
                const bf16x8 af = __builtin_bit_cast(bf16x8, (u32x4){alo.x, alo.y, ahi.x, ahi.y});
#pragma unroll
                for (int q = 0; q < 4; ++q) acc[q] = __builtin_amdgcn_mfma_f32_32x32x16_bf16(af, __builtin_bit_cast(bf16x8, bq[q]), acc[q], 0, 0, 0);
                alo = nlo; ahi = nhi;
#pragma unroll
                for (int q = 0; q < 4; ++q) bq[q] = nb[q];
            }
            {
                const bf16x8 af = __builtin_bit_cast(bf16x8, (u32x4){alo.x, alo.y, ahi.x, ahi.y});
#pragma unroll
                for (int q = 0; q < 4; ++q) acc[q] = __builtin_amdgcn_mfma_f32_32x32x16_bf16(af, __builtin_bit_cast(bf16x8, bq[q]), acc[q], 0, 0, 0);
            }
            const float skip = a.in[I_HSKIP][c];
#pragma unroll
            for (int q = 0; q < 4; ++q)
#pragma unroll
                for (int gq = 0; gq < 4; ++gq) {
                    const int t0 = 512 * w + 256 * (q >> 1) + 32 * (q & 1) + 64 * Rl + 8 * gq + 4 * hh;
                    const u32x2 zz = *(const LAS u32x2*)(lds + ZOFF + nn * ROWB + PADB + 2 * t0);
                    u32x2 o; o.x = pk2(acc[q][4 * gq] + skip * bflo(zz.x), acc[q][4 * gq + 1] + skip * bfhi(zz.x)); o.y = pk2(acc[q][4 * gq + 2] + skip * bflo(zz.y), acc[q][4 * gq + 3] + skip * bfhi(zz.y));
                    *(u32x2*)(zc + (size_t)nn * SEQ + t0) = o;
                }
            __syncthreads();
        }
    }
    }
    GRID_BAR();
    STAMP(4);

    { DECL_PTRS
    {
        LAS unsigned char* Pl = lds + 104448;
        LAS float* sfb = (LAS float*)(lds + 104448 + 128 * 272);
        LAS float* rsum = sfb + 256;
        LAS bf16_t* ot = (LAS bf16_t*)lds;
        for (int u = bid; u < 1024; u += G) {
            int tl = tid; asm volatile("" : "+v"(tl));
            const int wr = tl >> 8, wc = (tl >> 6) & 3, fr = tl & 15, fq = (tl >> 4) & 3;
            const int bh = u >> 5, c = u & 31, b = bh >> 2, h = bh & 3, row0 = b * SEQ + c * 128;
            const float lgf = lg2_decay(a.in[I_DECAY][h]), lgb = lg2_decay(a.in[I_DECAY][4 + h]);
            if (tl < 128) sfb[tl] = exp2f((float)(tl + 1) * lgf); else if (tl < 256) sfb[tl] = exp2f((float)(128 - (tl - 128)) * lgb);
            {
                f32x4 sacc[4][2];
#pragma unroll
                for (int m = 0; m < 4; ++m)
#pragma unroll
                    for (int n = 0; n < 2; ++n) sacc[m][n] = (f32x4){0.f, 0.f, 0.f, 0.f};
                gt::gemm_tile<2, 128>(sacc, gt::LdRows{Qb + (size_t)row0 * 512 + h * 128, 512}, gt::LdRows{Kb + (size_t)row0 * 512 + h * 128, 512}, 1, lds, tl);
#pragma unroll
                for (int m = 0; m < 4; ++m)
#pragma unroll
                    for (int n = 0; n < 2; ++n)
#pragma unroll
                        for (int j = 0; j < 4; ++j) { const int i = wr * 64 + m * 16 + 4 * fq + j, jj = wc * 32 + n * 16 + fr, df = i - jj;
                            const float dcy = df >= 0 ? exp2f((float)df * lgf) : exp2f((float)(-df) * lgb);
                            *(LAS bf16_t*)(Pl + i * 272 + jj * 2) = (bf16_t)f2bf(sacc[m][n][j] * dcy); }
                asm volatile("" ::: "memory");
            }
            __syncthreads();
            struct LdA2 { LAS unsigned char* P; const bf16_t* q; const LAS float* sc;
                __device__ __forceinline__ u32x4 operator()(int row, int k) const {
                    if (k < 128) return *(const LAS u32x4*)(P + row * 272 + k * 2);
                    return *(const u32x4*)(q + (size_t)row * 512 + (k < 256 ? k - 128 : k - 256)); } };
            struct TfA2 { const LAS float* sc;
                __device__ __forceinline__ u32x4 operator()(int row, int k, u32x4 v) const { if (k < 128) return v; const float s = sc[k < 256 ? row : 128 + row]; return gt::scale8(v, s, s, s, s, s, s, s, s); } };
            struct LdB2 { const bf16_t* vt; const bf16_t* sf; const bf16_t* sb;
                __device__ __forceinline__ u32x4 operator()(int dv, int k) const {
                    if (k < 128) return *(const u32x4*)(vt + (size_t)dv * 128 + k);
                    if (k < 256) return *(const u32x4*)(sf + (size_t)dv * 128 + (k - 128));
                    return *(const u32x4*)(sb + (size_t)dv * 128 + (k - 256)); } };
            f32x4 acc[4][4];
#pragma unroll
            for (int m = 0; m < 4; ++m)
#pragma unroll
                for (int n = 0; n < 4; ++n) acc[m][n] = (f32x4){0.f, 0.f, 0.f, 0.f};
            const LdA2 al{Pl, Qb + (size_t)row0 * 512 + h * 128, sfb};
            const LdB2 bl{VT + ((size_t)bh * 34 + c) * 256 * 128, KV + ((size_t)(bh * 2 + 0) * 33 + (c + 1)) * 32768, KV + ((size_t)(bh * 2 + 1) * 33 + (32 - c)) * 32768};
            gt::gemm_tile<4, 64>(acc, al, bl, 6, lds, tl, gt::NoHook(), gt::NoHook(), TfA2{sfb});
#pragma unroll
            for (int m = 0; m < 4; ++m)
#pragma unroll
                for (int j = 0; j < 4; ++j) { float s = 0.f;
#pragma unroll
                    for (int n = 0; n < 4; ++n) s += acc[m][n][j] * acc[m][n][j];
                    s += __shfl_xor(s, 1); s += __shfl_xor(s, 2); s += __shfl_xor(s, 4); s += __shfl_xor(s, 8);
                    if (fr == 0) rsum[(wr * 64 + m * 16 + 4 * fq + j) * 4 + wc] = s; }
            __syncthreads();
#pragma unroll
            for (int m = 0; m < 4; ++m)
#pragma unroll
                for (int j = 0; j < 4; ++j) { const int i = wr * 64 + m * 16 + 4 * fq + j; const f32x4 rs = *(const LAS f32x4*)(rsum + i * 4);
                    const float rstd = rsqrtf(((rs[0] + rs[1]) + (rs[2] + rs[3])) * (1.f / 256.f) + EPS);
#pragma unroll
                    for (int n = 0; n < 4; ++n) ot[i * 264 + wc * 64 + n * 16 + fr] = (bf16_t)f2bf(acc[m][n][j] * rstd); }
            __syncthreads();
#pragma unroll
            for (int i = 0; i < 8; ++i) { const int pz = tl + 512 * i, row = pz >> 5, c8 = pz & 31;
                bf16_t* gp = SG + (size_t)(row0 + row) * 1024 + h * 256 + c8 * 8;
                const u32x4 gv = *(const u32x4*)gp, ov = *(const LAS u32x4*)(ot + row * 264 + c8 * 8);
                u32x4 o; o.x = pk2(bflo(gv.x) * bflo(ov.x), bfhi(gv.x) * bfhi(ov.x)); o.y = pk2(bflo(gv.y) * bflo(ov.y), bfhi(gv.y) * bfhi(ov.y)); o.z = pk2(bflo(gv.z) * bflo(ov.z), bfhi(gv.z) * bfhi(ov.z)); o.w = pk2(bflo(gv.w) * bflo(ov.w), bfhi(gv.w) * bfhi(ov.w));
                *(u32x4*)gp = o; }
            __syncthreads();
        }
    }
    for (int it = bid; it < 512; it += G) {
        const int b = it >> 6, tt = (it >> 3) & 7, cc = it & 7;
        LAS bf16_t* yt = (LAS bf16_t*)lds;
#pragma unroll
        for (int i = 0; i < 8; ++i) { const int ch = wave * 8 + i; *(LAS u32x4*)(yt + ch * 520 + lane * 8) = *(const u32x4*)(ZT + ((size_t)(cc * 64 + ch) * 8 + b) * SEQ + tt * 512 + lane * 8); }
        __syncthreads();
        { int tl = tid; asm volatile("" : "+v"(tl));
          const int tq = tl >> 3, cg = tl & 7, c0 = cc * 64 + cg * 8, t0 = tt * 512 + tq * 8, row0 = b * SEQ + t0;
          float x0[8][8];
          short_conv8x8(HU, row0, t0, c0, a.in[I_HCW], a.in[I_HCB], x0);
          u32x4 yv[8];
#pragma unroll
          for (int e = 0; e < 8; ++e) yv[e] = *(const LAS u32x4*)(yt + (cg * 8 + e) * 520 + tq * 8);
#pragma unroll
          for (int t = 0; t < 8; ++t) { float o[8];
#pragma unroll
              for (int e = 0; e < 8; ++e) { const unsigned wd = (t >> 1) == 0 ? yv[e].x : (t >> 1) == 1 ? yv[e].y : (t >> 1) == 2 ? yv[e].z : yv[e].w; o[e] = x0[t][e] * ((t & 1) ? bfhi(wd) : bflo(wd)); }
              u32x4 w; w.x = pk2(o[0], o[1]); w.y = pk2(o[2], o[3]); w.z = pk2(o[4], o[5]); w.w = pk2(o[6], o[7]);
              *(u32x4*)(HU + (size_t)(row0 + t) * 1536 + 512 + c0) = w; } }
        __syncthreads();
    }
    }
    GRID_BAR();
    STAMP(5);

    { DECL_PTRS
    {
        pg8::Gemm g{(const bf16_t*)XN8, (const bf16_t*)(WTG8 + (size_t)1024 * 1024), 512, 512, 512}; pg8::StaticOrder S; S.init(T, 1024, G, bid);
        pg8::EpiGate E{SGH, a.in[I_BIN] + NINA + 1024, 0.03125f};
        pg8::gemm_phase<pg8::EpiGate, pg8::StaticOrder, false, true>(lds, g, S, E);
    }
    {
        pg8::Gemm g{HU + 512, WT_HYO, 512, 1536, 512}; pg8::StaticOrder S; S.init(T, 1024, G, bid);
        pg8::EpiMerge<0> E{SGH, nullptr};
        pg8::gemm_phase(lds, g, S, E);
    }
    {
        pg8::Gemm g{(const bf16_t*)XN8, (const bf16_t*)WTG8, 512, 512, 512}; pg8::StaticOrder S; S.init(T, 1024, G, bid);
        pg8::EpiGate E{SGR, a.in[I_BIN] + NINA, 0.03125f};
        pg8::gemm_phase<pg8::EpiGate, pg8::StaticOrder, false, true>(lds, g, S, E);
    }
    {
        pg8::Gemm g{SG, WT_RETO, 1024, 1024, 1024}; pg8::StaticOrder S; S.init(T, 1024, G, bid);
        pg8::EpiMerge<1> E{SGR, SGH};
        pg8::gemm_phase(lds, g, S, E);
    }
    __syncthreads();
    {
        LAS float* scr = (LAS float*)(lds + wave * 17664);
        constexpr int PER = 16 * 8;
        for (int it = gw; it < NE * 3 * PER; it += NGW) {
            const int e = it / (3 * PER), r3 = it % (3 * PER), which = r3 / PER, r = r3 % PER;
            unsigned char* W13 = (unsigned char*)WE13; unsigned char* W2 = (unsigned char*)WE2;
            if (which == 0) transpose_item_f8(a.in[I_EW1] + (size_t)e * 1024 * 512, 512, 64 * (r / 8), 64 * (r % 8), W13 + (size_t)e * 1024 * 1024, 1024, RmE13{0}, 32.f, scr, lane);
            else if (which == 1) transpose_item_f8(a.in[I_EW3] + (size_t)e * 1024 * 512, 512, 64 * (r / 8), 64 * (r % 8), W13 + (size_t)e * 1024 * 1024, 1024, RmE13{128}, 32.f, scr, lane);
            else transpose_item_f8(a.in[I_EW2] + (size_t)e * 512 * 1024, 1024, 64 * (r / 16), 64 * (r % 16), W2 + (size_t)e * 1024 * 512, 512, RmId{}, 32.f, scr, lane);
        }
    }
    }
    GRID_BAR();
    STAMP(6);
    STAMP(7);
    STAMP(8);
    { DECL_PTRS
    {
        pg8::Gemm g{SGR, WT_OUT, 1024, 1024, 1024}; pg8::StaticOrder S; S.init(T, 1024, G, bid);
        pg8::EpiX1 E{a.in[I_X], MOD, X1};
        pg8::gemm_phase(lds, g, S, E);
    }
    }
    GRID_BAR();
    STAMP(9);

    { DECL_PTRS
    {
        LAS float* Wl = (LAS float*)lds;
#pragma unroll
        for (int i = 0; i < 18; ++i) { const int q = tid + 512 * i, k = q / 9, p4 = q % 9;
            const f32x4 v = p4 == 0 ? *(const f32x4*)(a.in[I_RGW] + k * 4) : *(const f32x4*)(a.in[I_REW] + k * 32 + (p4 - 1) * 4);
            *(LAS f32x4*)(Wl + k * 36 + p4 * 4) = v; }
        __syncthreads();
        unsigned char* H2 = (unsigned char*)SG;
        LAS float* Sw = (LAS float*)(lds + 147456 + wave * 1152);
        LAS int* lcnt = (LAS int*)(lds + 147456 + 9216);
        if (tid < NE) lcnt[tid] = 0;
        __syncthreads();
        for (int rb = gw; rb < T / 16; rb += NGW) {
            int ll = lane; asm volatile("" : "+v"(ll));
            const int r = ll & 15, kq = ll >> 4, row = rb * 16 + r, b = (rb * 16) >> 12;
            const float* md = MOD + (size_t)b * 6144; const float* xr = X1 + (size_t)row * D + 4 * kq;
            float s = 0.f;
#pragma unroll 16
            for (int i = 0; i < 64; ++i) { const f32x4 xv = *(const f32x4*)(xr + 16 * i); s += (xv[0] * xv[0] + xv[1] * xv[1]) + (xv[2] * xv[2] + xv[3] * xv[3]); }
            s += __shfl_xor(s, 16); s += __shfl_xor(s, 32);
            const float rstd = rsqrtf(s * (1.f / D) + EPS);
            f32x4 lacc[3];
#pragma unroll
            for (int ct = 0; ct < 3; ++ct) lacc[ct] = (f32x4){0.f, 0.f, 0.f, 0.f};
            const int c0 = ll & 15, c2 = (32 + c0) < 36 ? 32 + c0 : 35;
#pragma unroll 4
            for (int i = 0; i < 64; ++i) {
                const int k0 = 16 * i + 4 * kq;
                const f32x4 xv = *(const f32x4*)(xr + 16 * i), gv = *(const f32x4*)(a.in[I_N2G] + k0), sc = *(const f32x4*)(md + 4096 + k0), sh = *(const f32x4*)(md + 3072 + k0);
                const f32x4 hv = (xv * rstd * gv) * (sc + 1.f) + sh;
                *(unsigned*)(H2 + (size_t)row * D + k0) = pk_fp8x4(hv[0], hv[1], hv[2], hv[3]);
#pragma unroll
                for (int e = 0; e < 4; ++e) { const LAS float* wr_ = Wl + (k0 + e) * 36;
                    lacc[0] = __builtin_amdgcn_mfma_f32_16x16x4f32(hv[e], wr_[c0], lacc[0], 0, 0, 0);
                    lacc[1] = __builtin_amdgcn_mfma_f32_16x16x4f32(hv[e], wr_[16 + c0], lacc[1], 0, 0, 0);
                    lacc[2] = __builtin_amdgcn_mfma_f32_16x16x4f32(hv[e], wr_[c2], lacc[2], 0, 0, 0); }
            }
#pragma unroll
            for (int hf = 0; hf < 2; ++hf) {
                if ((kq >> 1) == hf) {
#pragma unroll
                    for (int j = 0; j < 4; ++j) { LAS float* sp = Sw + (4 * (kq & 1) + j) * 36 + c0; sp[0] = lacc[0][j]; sp[16] = lacc[1][j]; if (c0 < 4) sp[32] = lacc[2][j]; }
                }
                asm volatile("s_waitcnt lgkmcnt(0)" ::: "memory");
                if (ll < 8) {
                    const int rrow = rb * 16 + 8 * hf + ll;
                    float lg[36];
#pragma unroll
                    for (int q = 0; q < 9; ++q) { const f32x4 v = *(const LAS f32x4*)(Sw + ll * 36 + 4 * q); lg[4 * q] = v[0]; lg[4 * q + 1] = v[1]; lg[4 * q + 2] = v[2]; lg[4 * q + 3] = v[3]; }
                    float gl[4];
#pragma unroll
                    for (int j = 0; j < 4; ++j) gl[j] = lg[j] + a.in[I_RGB][j];
                    int gs = 0; float gm = gl[0];
#pragma unroll
                    for (int j = 1; j < 4; ++j) if (gl[j] > gm) { gm = gl[j]; gs = j; }
                    float den = 0.f;
#pragma unroll
                    for (int j = 0; j < 4; ++j) den += expf(gl[j] - gm);
                    const float pstar = 1.f / den;
                    float el[8];
#pragma unroll
                    for (int e = 0; e < 8; ++e) { const float v0 = lg[4 + e], v1 = lg[12 + e], v2 = lg[20 + e], v3 = lg[28 + e]; el[e] = (gs == 0 ? v0 : gs == 1 ? v1 : gs == 2 ? v2 : v3) + a.in[I_REB][gs * 8 + e]; }
                    int e0 = 0; float m0 = el[0];
#pragma unroll
                    for (int e = 1; e < 8; ++e) if (el[e] > m0) { m0 = el[e]; e0 = e; }
                            int e1 = e0 == 0 ? 1 : 0; float m1 = e0 == 0 ? el[1] : el[0];
#pragma unroll
                    for (int e = 1; e < 8; ++e) if (e != e0 && el[e] > m1) { m1 = el[e]; e1 = e; }
                    const float ex = expf(m1 - m0); const float w0 = pstar / (1.f + ex), w1 = pstar * ex / (1.f + ex);
                    const int E0 = gs * 8 + e0, E1 = gs * 8 + e1;
                    const int s0 = __hip_atomic_fetch_add(lcnt + E0, 1, __ATOMIC_RELAXED, __HIP_MEMORY_SCOPE_WORKGROUP), s1 = __hip_atomic_fetch_add(lcnt + E1, 1, __ATOMIC_RELAXED, __HIP_MEMORY_SCOPE_WORKGROUP);
                    int4 ti; ti.x = (E0 << 16) | s0; ti.y = (E1 << 16) | s1; ti.z = __float_as_int(w0); ti.w = __float_as_int(w1);
                    *(int4*)(TOKINFO + (size_t)rrow * 4) = ti;
                }
                asm volatile("s_waitcnt lgkmcnt(0)" ::: "memory");
            }
        }
        __syncthreads();
        if (tid < NE) LISTS[bid * NE + tid] = lcnt[tid];
    }
    }
    GRID_BAR();
    STAMP(10);

    LAS int* tbase = (LAS int*)(lds + MISC_OFF);
    LAS int* texp = tbase + 64;
    int ntiles = 0;
    { DECL_PTRS
    {
        LAS int* ptot = texp + 320;
        LAS int* pbas = ptot + 512; LAS int* total = pbas + 512; LAS int* mybase = total + 32;
        { const int e = tid & 31, part = tid >> 5, per = (G + 15) >> 4; int s = 0, sb = 0;
          for (int b = part * per; b < (part + 1) * per && b < G; ++b) { const int v = LISTS[b * NE + e]; s += v; if (b < bid) sb += v; }
          ptot[part * 32 + e] = s; pbas[part * 32 + e] = sb; }
        __syncthreads();
        if (tid < NE) { int s = 0, sb = 0; for (int q = 0; q < 16; ++q) { s += ptot[q * 32 + tid]; sb += pbas[q * 32 + tid]; } total[tid] = s; mybase[tid] = sb; }
        __syncthreads();
        if (tid == 0) { int acc = 0; for (int e = 0; e < NE; ++e) { tbase[e] = acc; const int nt = (total[e] + 255) >> 8; for (int q = 0; q < nt; ++q) texp[acc + q] = e; acc += nt; } tbase[NE] = acc; }
        __syncthreads();
        ntiles = tbase[NE];
        int* ROWTOK = LISTS + 16384;
        for (int rb = gw; rb < T / 16; rb += NGW) {
            if (lane < 16) { const int row = rb * 16 + lane;
                const int4 ti = *(const int4*)(TOKINFO + (size_t)row * 4);
                const int e0 = ti.x >> 16, e1 = ti.y >> 16;
                const int r0 = tbase[e0] * 256 + mybase[e0] + (ti.x & 0xffff), r1 = tbase[e1] * 256 + mybase[e1] + (ti.y & 0xffff);
                ROWTOK[r0] = row; ROWTOK[r1] = row;
                int4 to = ti; to.x = r0; to.y = r1; *(int4*)(TOKINFO + (size_t)row * 4) = to; }
        }
        if (bid < NE) { const int rlo = tbase[bid] * 256 + total[bid], rhi = tbase[bid + 1] * 256; for (int r = rlo + tid; r < rhi; r += 512) ROWTOK[r] = 0; }
    }
    }
    GRID_BAR();
    STAMP(11);

    { DECL_PTRS
    {
        pg8::Gemm g{SG  , WE13, 512, 512, 512}; pg8::MoeOrder S{ntiles, G, bid, texp};
        pg8::EpiMoe1 E{(unsigned char*)HM};
        pg8::gemm_phase<pg8::EpiMoe1, pg8::MoeOrder, true, true>(lds, g, S, E, LISTS + 16384);
    }
    }
    GRID_BAR();
    STAMP(12);
    { DECL_PTRS
    {
        pg8::Gemm g{HM  , WE2, 256, 256, 256}; pg8::MoeOrder S{ntiles, G, bid, texp};
        pg8::EpiBf E{XB, 1024, 0.03125f};
        pg8::gemm_phase<pg8::EpiBf, pg8::MoeOrder, false, true>(lds, g, S, E);
    }
    }
    GRID_BAR();
    STAMP(13);

    { DECL_PTRS
    {
        const bf16_t* YB = XB;
        for (int row = gw; row < T; row += NGW) {
            const int b = row >> 12; const float* gt2 = MOD + (size_t)b * 6144 + 5120;
            const int4 ti = *(const int4*)(TOKINFO + (size_t)row * 4);
            const size_t r0 = (size_t)ti.x, r1 = (size_t)ti.y;
            const float w0 = __int_as_float(ti.z), w1 = __int_as_float(ti.w);
            f32x4 v[4]; float s = 0.f;
#pragma unroll
            for (int j = 0; j < 4; ++j) { const int c0 = 4 * lane + 256 * j;
                const f32x4 xv = *(const f32x4*)(X1 + (size_t)row * D + c0), gv = *(const f32x4*)(gt2 + c0);
                const u32x2 y0 = *(const u32x2*)(YB + r0 * D + c0), y1 = *(const u32x2*)(YB + r1 * D + c0);
                f32x4 mo; mo[0] = w0 * bflo(y0.x) + w1 * bflo(y1.x); mo[1] = w0 * bfhi(y0.x) + w1 * bfhi(y1.x); mo[2] = w0 * bflo(y0.y) + w1 * bflo(y1.y); mo[3] = w0 * bfhi(y0.y) + w1 * bfhi(y1.y);
                v[j] = xv + gv * mo; s += (v[j][0] * v[j][0] + v[j][1] * v[j][1]) + (v[j][2] * v[j][2] + v[j][3] * v[j][3]); }
            const float rstd = rsqrtf(wave_sum(s) * (1.f / D) + EPS);
#pragma unroll
            for (int j = 0; j < 4; ++j) { const int c0 = 4 * lane + 256 * j; const f32x4 fg = *(const f32x4*)(a.in[I_FNG] + c0); *(f32x4*)(X1 + (size_t)row * D + c0) = v[j] * rstd * fg; }
        }
    }
    }
    STAMP(14);
    if (PROBE_PHASE >= 0 && blockIdx.x == 0 && threadIdx.x == 0) { const unsigned long long t0_ = __builtin_amdgcn_s_memrealtime(); while (__builtin_amdgcn_s_memrealtime() - t0_ < spin_) __builtin_amdgcn_s_sleep(8); }
}

extern "C" void kernel_launch(void* const* d_in, const int* in_sizes, int n_in, void* d_out, int out_size, void* d_ws, size_t ws_size, hipStream_t stream) {
    static int grid = 0;
    if (grid == 0) {
        if (n_in != 31 || out_size != T * D || ws_size < WS_END) { fprintf(stderr, "kernel_launch: unexpected shapes: n_in %d out %d ws %zu (need %zu)\n", n_in, out_size, ws_size, (size_t)WS_END); grid = -1; return; }
        int dev = 0, cus = 0, per_cu = 0;
        if (hipGetDevice(&dev) != hipSuccess || hipDeviceGetAttribute(&cus, hipDeviceAttributeMultiprocessorCount, dev) != hipSuccess) { grid = -1; return; }
        if (hipFuncSetAttribute((const void*)fwd_kernel, hipFuncAttributeMaxDynamicSharedMemorySize, LDS_BYTES) != hipSuccess) { fprintf(stderr, "kernel_launch: hipFuncSetAttribute failed\n"); grid = -1; return; }
        if (hipOccupancyMaxActiveBlocksPerMultiprocessor(&per_cu, (const void*)fwd_kernel, 512, LDS_BYTES) != hipSuccess || per_cu < 1) { fprintf(stderr, "kernel_launch: occupancy query says %d blocks per CU\n", per_cu); grid = -1; return; }
        grid = cus;
        fprintf(stderr, "kernel_launch: cus %d per_cu %d grid %d ws %zu\n", cus, per_cu, grid, ws_size);
    }
    if (grid < 0) return;
    Args a{};
    for (int i = 0; i < 31; ++i) a.in[i] = (const float*)d_in[i];
    a.out = (float*)d_out; a.ws = (unsigned char*)d_ws;
    void* args[] = {&a};
    const hipError_t e = hipLaunchCooperativeKernel((const void*)fwd_kernel, dim3(grid), dim3(512), args, LDS_BYTES, stream);
    if (e != hipSuccess) fprintf(stderr, "kernel_launch: cooperative launch failed: %s (grid %d)\n", hipGetErrorString(e), grid);
}
```

```cpp
#ifndef PROBE_PHASE
#define PROBE_PHASE -1
#endif
#ifndef REPMASK
#define REPMASK 0
#endif
#include <hip/hip_runtime.h>
#include <hip/hip_cooperative_groups.h>
#include <cstdio>
#include <cstdint>
namespace cg = cooperative_groups;

#define LAS __attribute__((address_space(3)))
typedef unsigned short bf16_t;
typedef short bf16x8 __attribute__((ext_vector_type(8)));
typedef float f32x4 __attribute__((ext_vector_type(4)));
typedef unsigned u32x4 __attribute__((ext_vector_type(4)));
typedef unsigned u32x2 __attribute__((ext_vector_type(2)));

constexpr int BATCH = 8, SEQ = 4096, D = 1024, T = BATCH * SEQ, CTXL = 256, TC = BATCH * CTXL, MT = T + TC;
constexpr int NH = 4, DK = 128, DV = 256, TOKP = SEQ + CTXL;
constexpr int NINA = 4608;
constexpr int NE = 32, EH = 512;
constexpr float EPS = 1e-6f;
constexpr int LDS_BYTES = 163840;
constexpr int MISC_OFF = 131072;

constexpr size_t MiB = 1u << 20;
constexpr size_t WS_CTL = 0, CTL_BYTES = 65536;
constexpr size_t WS_MOD = 65536;
constexpr size_t WS_ROPE = 327680;
constexpr size_t WS_BINP = 344064;
constexpr size_t WS_FPART = 524288;
constexpr size_t WS_TOKINFO = 2 * MiB;
constexpr size_t WS_LISTS = 3 * MiB;
constexpr size_t WS_TR = 8 * MiB;
constexpr size_t WS_WT_IN = 16 * MiB;
constexpr size_t WS_WT_RETO = 29 * MiB, WS_WT_HYO = 31 * MiB, WS_WT_OUT = 32 * MiB;
constexpr size_t WS_R1 = 34 * MiB;
constexpr size_t WS_Q = WS_R1, WS_K = WS_R1 + 32 * MiB, WS_KT = WS_R1 + 66 * MiB, WS_VT = WS_R1 + 100 * MiB;
constexpr size_t WS_FILT = WS_R1;
constexpr size_t WS_SGR = WS_R1, WS_SGH = WS_R1 + 64 * MiB;
constexpr size_t WS_XB = WS_R1;
constexpr size_t WS_SG = 202 * MiB;
constexpr size_t WS_HU = 266 * MiB;
constexpr size_t WS_KV = 362 * MiB;
constexpr size_t WS_WE13 = 362 * MiB, WS_WE2 = 426 * MiB;
constexpr size_t WS_X1 = 106 * MiB;
constexpr size_t WS_END = 494 * MiB;
constexpr size_t DO_XN = 0, DO_ZT = 64 * MiB, DO_XN8 = 96 * MiB;

__device__ __forceinline__ unsigned f2bf(float f) { unsigned u = __float_as_uint(f); return (u + 0x7fffu + ((u >> 16) & 1u)) >> 16; }
__device__ __forceinline__ unsigned pk2(float lo, float hi) { return f2bf(lo) | (f2bf(hi) << 16); }
__device__ __forceinline__ float bflo(unsigned w) { return __uint_as_float(w << 16); }
__device__ __forceinline__ float bfhi(unsigned w) { return __uint_as_float(w & 0xffff0000u); }
__device__ __forceinline__ float bf2f(bf16_t h) { return __uint_as_float((unsigned)h << 16); }
__device__ __forceinline__ float silu_f(float v) { return v / (1.f + __expf(-v)); }
__device__ __forceinline__ float sigm_f(float v) { return 1.f / (1.f + __expf(-v)); }
__device__ __forceinline__ float wave_sum(float v) {
#pragma unroll
    for (int o = 1; o < 64; o <<= 1) v += __shfl_xor(v, o);
    return v;
}
__host__ __device__ __forceinline__ int dimperm(int p) { const int wc = p >> 5, n = (p >> 4) & 1, i16 = p & 15; return 64 * (wc >> 1) + 32 * n + 16 * (wc & 1) + i16; }
__host__ __device__ __forceinline__ int inv_dimperm(int d) { const int half = d >> 6, n = (d >> 5) & 1, idx = d & 31; return 32 * (2 * half + (idx >> 4)) + 16 * n + (idx & 15); }
__host__ __device__ __forceinline__ int win_destrow(int n) { return n < 1024 ? (n & ~127) + inv_dimperm(n & 127) : n; }

namespace pg8 {
constexpr int BM = 256, BK = 64, HALF = 128, HTB = HALF * BK * 2, STAGE_BYTES = 8 * HTB, NXCD = 8, WGM = 8;
__host__ __device__ __forceinline__ int lds_byte(int r, int c) { const int st = (r >> 4) * 2 + (c >> 5), rr = r & 15, cc = c & 31, ob = rr * 64 + cc * 2; return st * 1024 + (ob ^ (((ob >> 9) & 1) << 5)); }
__host__ __device__ __forceinline__ void stage_rc(int b, int& R, int& C) { const int st = b / 1024, sb = b % 1024, swz = sb ^ (((sb >> 9) & 1) << 5); R = (st >> 1) * 16 + swz / 64; C = (st & 1) * 32 + (swz % 64) / 2; }
__host__ __device__ __forceinline__ int perm32(int rho) { const int n = rho >> 4, i = rho & 15; return 8 * (i >> 2) + 4 * n + (i & 3); }

struct Unit { int pm, pn, pc; };
struct Gemm { const bf16_t* A; const bf16_t* Bt; int K, lda, ldb; };

struct StaticOrder {
    int nM, nN, nwg, G, c;
    __device__ void init(int M, int N, int G_, int c_) { nM = M / BM; nN = N / BM; nwg = nM * nN; G = G_; c = c_; }
    __device__ bool next(int i, Unit& u) const {
        const long L = (long)i * G + c; if (L >= nwg) return false;
        int wgid = (int)L; { const int q = nwg / NXCD, r = nwg % NXCD, xcd = wgid % NXCD, off = wgid / NXCD; wgid = (xcd < r ? xcd * (q + 1) : r * (q + 1) + (xcd - r) * q) + off; }
        const int nig = WGM * nN, gid = wgid / nig, fm = gid * WGM, gsz = (nM - fm) < WGM ? (nM - fm) : WGM;
        u.pm = fm + ((wgid % nig) % gsz); u.pn = (wgid % nig) / gsz; u.pc = u.pn; return true;
    }
};
struct InProjOrder {
    StaticOrder so; int G, c;
    __device__ void init(int G_, int c_) { so.init(T, NINA, G_, c_); G = G_; c = c_; }
    __device__ bool next(int i, Unit& u) const {
        const long L = (long)i * G + c;
        if (L < so.nwg) return so.next(i, u);
        const int l = (int)(L - so.nwg); if (l >= 48) return false;
        u.pm = 128 + (l & 7); u.pn = 2 + (l >> 3); u.pc = u.pn; return true;
    }
};
struct MoeOrder {
    int ntiles, G, c; const LAS int* texp;
    __device__ bool next(int i, Unit& u) const {
        const long L = (long)i * G + c; if (L >= (long)ntiles * 4) return false;
        const int full = (ntiles >> 3) * 32, l = (int)L;
        if (l < full) { u.pm = (l >> 5) * 8 + (l & 7); u.pc = (l & 31) >> 3; } else { u.pm = (ntiles & ~7) + ((l - full) >> 2); u.pc = (l - full) & 3; }
        u.pn = texp[u.pm] * 4 + u.pc; return true;
    }
};

__device__ __forceinline__ unsigned cvt_pk_bf16(float lo, float hi) { unsigned r; asm volatile("v_cvt_pk_bf16_f32 %0, %1, %2" : "=v"(r) : "v"(lo), "v"(hi)); return r; }

typedef int v8i __attribute__((ext_vector_type(8)));
__device__ __forceinline__ unsigned pk_fp8x4(float a, float b, float c, float d) { int w = 0; w = __builtin_amdgcn_cvt_pk_fp8_f32(a, b, w, false); w = __builtin_amdgcn_cvt_pk_fp8_f32(c, d, w, true); return (unsigned)w; }
template <class Epi, class Sched, bool GATHER = false, bool FP8 = false>
__device__ __forceinline__ void gemm_phase(LAS unsigned char* lds, const Gemm g, const Sched& S, const Epi& E, const int* rowidx = nullptr) {
    int tid = threadIdx.x; asm volatile("" : "+v"(tid));
    const int wid = __builtin_amdgcn_readfirstlane(tid >> 6), lane = tid & 63, wr = wid >> 2, wc = wid & 3, fr = lane & 15, fq = lane >> 4;
    const int K = g.K; int nt = K / BK; asm volatile("" : "+s"(nt));
    int Ra[2], Ca[2]; unsigned voffA[2], voffB[2];
#pragma unroll
    for (int i = 0; i < 2; ++i) { int R, C; stage_rc(tid * 16 + i * 8192, R, C); const int Rb = Epi::PERM ? ((R & ~31) + perm32(R & 31)) : R;
        Ra[i] = R; Ca[i] = C; voffA[i] = (unsigned)(R * g.lda + C) * 2u; voffB[i] = (unsigned)(Rb * g.ldb + C) * 2u; }
    const size_t hstepA = (size_t)HALF * g.lda * 2, tstepA = 2 * hstepA;
    const size_t kstep = (size_t)(BK * 2);
    const size_t hstepB = (size_t)HALF * g.ldb * 2, tstepB = 2 * hstepB;
    const unsigned ldsw = (unsigned)wid * 1024u;
    const int aoff = lds_byte(wr * 64 + fr, fq * 8), boff = lds_byte(wc * 32 + fr, fq * 8);
#define PG8_AOFF(dst, u) do { _Pragma("unroll") for (int _h = 0; _h < 2; ++_h) _Pragma("unroll") for (int _i = 0; _i < 2; ++_i) { int _row = (u).pm * BM + _h * HALF + Ra[_i]; if (GATHER) _row = rowidx[_row]; \
        dst[_h][_i] = (unsigned)(_row * g.lda + Ca[_i]) * 2u; } } while (0)
#define PG8_SA(b, h) (((b) * 2 + (h)) * HTB)
#define PG8_SB(b, h) ((4 + (b) * 2 + (h)) * HTB)
#define PG8_STAGE(bufoff, gbase, voff) do { _Pragma("unroll") for (int _i = 0; _i < 2; ++_i) \
        __builtin_amdgcn_global_load_lds((const unsigned*)((const char*)(gbase) + (voff)[_i]), (LAS unsigned*)(lds + (bufoff) + ldsw + _i * 8192), 16, 0, 0); } while (0)
#define PG8_STAGE_A(bufoff, ubase, vsel, h, kb) do { if constexpr (GATHER) { PG8_STAGE(bufoff, gA + (kb), (vsel)[h]); } else { PG8_STAGE(bufoff, (ubase) + (size_t)(h) * hstepA + (kb), voffA); } } while (0)
#define PG8_LD8(p) ({ const u32x4 _lo = *(const LAS u32x4*)(p), _hi = *(const LAS u32x4*)((p) + 1024); v8i _r; _r[0] = (int)_lo.x; _r[1] = (int)_lo.y; _r[2] = (int)_lo.z; _r[3] = (int)_lo.w; _r[4] = (int)_hi.x; _r[5] = (int)_hi.y; _r[6] = (int)_hi.z; _r[7] = (int)_hi.w; _r; })
#define PG8_LDA(dst, b, h) do { _Pragma("unroll") for (int m = 0; m < 4; ++m) dst[m] = PG8_LD8(lds + PG8_SA(b, h) + aoff + m * 2048); } while (0)
#define PG8_LDB(dst, b, h) do { _Pragma("unroll") for (int n = 0; n < 2; ++n) dst[n] = PG8_LD8(lds + PG8_SB(b, h) + boff + n * 2048); } while (0)
#define PG8_LO(v) __builtin_bit_cast(bf16x8, __builtin_shufflevector(v, v, 0, 1, 2, 3))
#define PG8_HI(v) __builtin_bit_cast(bf16x8, __builtin_shufflevector(v, v, 4, 5, 6, 7))
#define PG8_MMA(ai, bj, At, Bt) do { __builtin_amdgcn_s_setprio(1); _Pragma("unroll") for (int m = 0; m < 4; ++m) _Pragma("unroll") for (int n = 0; n < 2; ++n) { \
        if constexpr (FP8) { asm volatile("v_mfma_scale_f32_16x16x128_f8f6f4 %0, %1, %2, %0, %3, %3 op_sel_hi:[0,0,0]" : "+v"(acc[ai][bj][m][n]) : "v"(Bt[n]), "v"(At[m]), "v"(one_scale)); } \
        else { acc[ai][bj][m][n] = __builtin_amdgcn_mfma_f32_16x16x32_bf16(PG8_LO(Bt[n]), PG8_LO(At[m]), acc[ai][bj][m][n], 0, 0, 0); \
               acc[ai][bj][m][n] = __builtin_amdgcn_mfma_f32_16x16x32_bf16(PG8_HI(Bt[n]), PG8_HI(At[m]), acc[ai][bj][m][n], 0, 0, 0); } } __builtin_amdgcn_s_setprio(0); } while (0)
#define PG8_WAIT_V(n) asm volatile("s_waitcnt vmcnt(" #n ")" ::: "memory")
#define PG8_WAIT_L(n) asm volatile("s_waitcnt lgkmcnt(" #n ")" ::: "memory")
#define PG8_BAR __builtin_amdgcn_s_barrier()
#define PG8_SCHED __builtin_amdgcn_sched_barrier(0)
    Unit cur, nxt; int ui = 0;
    if (!S.next(0, cur)) return;
    f32x4 acc[2][2][4][2];
#pragma unroll
    for (int a = 0; a < 2; ++a)
#pragma unroll
        for (int b = 0; b < 2; ++b)
#pragma unroll
            for (int m = 0; m < 4; ++m)
#pragma unroll
                for (int n = 0; n < 2; ++n) { acc[a][b][m][n] = (f32x4){0.f, 0.f, 0.f, 0.f}; }
    v8i At[4], B0[2], B1[2];
    int one_scale = 0x7f7f7f7f; asm volatile("" : "+v"(one_scale)); (void)one_scale;
    unsigned vA[2][2], nvA[2][2];
    if constexpr (GATHER) PG8_AOFF(vA, cur);
    const char* gA = (const char*)g.A;
    const char* cA = gA + (size_t)cur.pm * tstepA;
    const char* cB = (const char*)g.Bt + (size_t)cur.pn * tstepB;
    PG8_STAGE(PG8_SB(0, 0), cB, voffB); PG8_STAGE(PG8_SB(0, 1), cB + hstepB, voffB); PG8_STAGE_A(PG8_SA(0, 0), cA, vA, 0, 0); PG8_STAGE_A(PG8_SA(0, 1), cA, vA, 1, 0);
    if (wr == 1) PG8_BAR;
    PG8_WAIT_V(2); PG8_BAR;
    PG8_STAGE(PG8_SB(1, 0), cB + kstep, voffB); PG8_STAGE_A(PG8_SA(1, 0), cA, vA, 0, kstep); PG8_STAGE(PG8_SB(1, 1), cB + hstepB + kstep, voffB);
    PG8_WAIT_V(6); PG8_BAR;
    for (;;) {
        const bool has_next = S.next(ui + 1, nxt);
        if constexpr (GATHER) { if (has_next) { PG8_AOFF(nvA, nxt); } else {
#pragma unroll
            for (int h = 0; h < 2; ++h)
#pragma unroll
                for (int i = 0; i < 2; ++i) nvA[h][i] = vA[h][i]; } }
        const char* nA = has_next ? gA + (size_t)nxt.pm * tstepA : cA;
        const char* nB = has_next ? (const char*)g.Bt + (size_t)nxt.pn * tstepB : cB;
#pragma unroll 1
        for (int t = 0; t < nt; t += 2) {
            const bool last = (t == nt - 2);
            const size_t k1 = (size_t)(t + 1) * kstep, k2 = last ? 0 : (size_t)(t + 2) * kstep, k3 = k2 + kstep;
            const char* u2 = last ? nA : cA; const char* b2 = last ? nB : cB + (size_t)(t + 2) * kstep; const char* b3 = b2 + kstep;
            unsigned v2[2][2];
            if constexpr (GATHER) {
#pragma unroll
                for (int h = 0; h < 2; ++h)
#pragma unroll
                    for (int i = 0; i < 2; ++i) v2[h][i] = last ? nvA[h][i] : vA[h][i]; }
            PG8_LDB(B0, 0, 0); PG8_LDB(B1, 0, 1); PG8_SCHED; PG8_LDA(At, 0, 0); PG8_STAGE_A(PG8_SA(1, 1), cA, vA, 1, k1);
            PG8_WAIT_V(8); PG8_WAIT_L(0); PG8_BAR; PG8_MMA(0, 0, At, B0); PG8_MMA(0, 1, At, B1); PG8_BAR; PG8_SCHED;
            PG8_LDA(At, 0, 1); PG8_STAGE(PG8_SB(0, 0), b2, voffB); PG8_STAGE(PG8_SB(0, 1), b2 + hstepB, voffB); PG8_STAGE_A(PG8_SA(0, 0), u2, v2, 0, k2);
            PG8_WAIT_V(8); PG8_WAIT_L(0); PG8_BAR; PG8_MMA(1, 0, At, B0); PG8_MMA(1, 1, At, B1); PG8_BAR; PG8_SCHED;
            PG8_LDB(B0, 1, 0); PG8_LDB(B1, 1, 1); PG8_SCHED; PG8_LDA(At, 1, 0); PG8_STAGE_A(PG8_SA(0, 1), u2, v2, 1, k2);
            PG8_WAIT_V(8); PG8_WAIT_L(0); PG8_BAR; PG8_MMA(0, 0, At, B0); PG8_MMA(0, 1, At, B1); PG8_BAR; PG8_SCHED;
            PG8_LDA(At, 1, 1); PG8_STAGE(PG8_SB(1, 0), b3, voffB); PG8_STAGE(PG8_SB(1, 1), b3 + hstepB, voffB); PG8_STAGE_A(PG8_SA(1, 0), u2, v2, 0, k3);
            PG8_WAIT_V(8); PG8_WAIT_L(0); PG8_BAR; PG8_MMA(1, 0, At, B0); PG8_MMA(1, 1, At, B1); PG8_BAR; PG8_SCHED;
        }
        if (wr == 0) PG8_BAR;
        if constexpr (FP8) asm volatile("s_nop 15\n\ts_nop 15" ::: "memory");
        E(acc, cur, wr, wc, fr, fq);
        if (!has_next) break;
#pragma unroll
        for (int a = 0; a < 2; ++a)
#pragma unroll
            for (int b = 0; b < 2; ++b)
#pragma unroll
                for (int m = 0; m < 4; ++m)
#pragma unroll
                    for (int n = 0; n < 2; ++n) { acc[a][b][m][n] = (f32x4){0.f, 0.f, 0.f, 0.f}; }
        cur = nxt; cA = nA; cB = nB; ++ui;
        if constexpr (GATHER) {
#pragma unroll
            for (int h = 0; h < 2; ++h)
#pragma unroll
                for (int i = 0; i < 2; ++i) vA[h][i] = nvA[h][i]; }
        if (wr == 1) PG8_BAR;
    }
    PG8_WAIT_V(0);
    PG8_BAR;
#undef PG8_AOFF
#undef PG8_SA
#undef PG8_SB
#undef PG8_STAGE
#undef PG8_LDA
#undef PG8_LDB
#undef PG8_STAGE_A
#undef PG8_LD8
#undef PG8_LO
#undef PG8_HI
#undef PG8_MMA
#undef PG8_WAIT_V
#undef PG8_WAIT_L
#undef PG8_BAR
#undef PG8_SCHED
}

__device__ __forceinline__ void st_bf4(bf16_t* p, f32x4 v) { u32x2 w; w.x = cvt_pk_bf16(v[0], v[1]); w.y = cvt_pk_bf16(v[2], v[3]); *(u32x2*)p = w; }
__device__ __forceinline__ void st_bf8(bf16_t* p, f32x4 v0, f32x4 v1) { u32x4 w; w.x = cvt_pk_bf16(v0[0], v0[1]); w.y = cvt_pk_bf16(v0[2], v0[3]); w.z = cvt_pk_bf16(v1[0], v1[1]); w.w = cvt_pk_bf16(v1[2], v1[3]); *(u32x4*)p = w; }

struct EpiInA {
    static constexpr bool PERM = false;
    bf16_t *Q, *Kn, *KT, *VT, *SG, *HU; const float* binp; const float* rope;
    __device__ __forceinline__ void operator()(const f32x4 (&acc)[2][2][4][2], const Unit& u, int wr, int wc, int fr, int fq) const {
        const int pc = u.pc, rbase = u.pm * BM + wr * 64 + fr, cbase = pc * BM + wc * 32 + 4 * fq;
        f32x4 bv[2][2];
#pragma unroll
        for (int bj = 0; bj < 2; ++bj)
#pragma unroll
            for (int n = 0; n < 2; ++n) bv[bj][n] = *(const f32x4*)(binp + cbase + bj * HALF + n * 16);
        const bool lat = u.pm < 128;
        const int bidx = lat ? (u.pm >> 4) : (u.pm - 128);
        if (pc < 4) {
            const bool isk = pc >= 2; const float ks = isk ? 0.08838834764831845f : 1.f;
            const int h0 = (pc & 1) * 2;
#pragma unroll
            for (int ai = 0; ai < 2; ++ai)
#pragma unroll
                for (int m = 0; m < 4; ++m) {
                    const int r = rbase + ai * HALF + m * 16, t = r & 4095;
                    const int tok = lat ? t : 4096 + ((r - T) & 255);
                    f32x4 cs = (f32x4){1.f, 1.f, 1.f, 1.f}, sn = (f32x4){0.f, 0.f, 0.f, 0.f};
                    if (lat) { const int pos = (wc >> 1) ? (t & 63) : (t >> 6); const float* rp = rope + pos * 32 + 16 * (wc & 1) + 4 * fq; cs = *(const f32x4*)rp; sn = *(const f32x4*)(rp + 2048); }
#pragma unroll
                    for (int bj = 0; bj < 2; ++bj) {
                        const f32x4 x1 = acc[ai][bj][m][0] + bv[bj][0], x2 = acc[ai][bj][m][1] + bv[bj][1];
                        const f32x4 o1 = (x1 * cs - x2 * sn) * ks, o2 = (x1 * sn + x2 * cs) * ks;
                        const int col = (pc & 1) * BM + bj * HALF + wc * 32 + 4 * fq;
                        if (!isk) { st_bf4(Q + (size_t)r * 512 + col, o1); st_bf4(Q + (size_t)r * 512 + col + 16, o2); }
                        else {
                            st_bf4(Kn + (size_t)r * 512 + col, o1); st_bf4(Kn + (size_t)r * 512 + col + 16, o2);
                            bf16_t* kt = KT + (((size_t)((bidx * 4 + h0 + bj) * 34 + (tok >> 7)) * 128 + wc * 32 + 4 * fq)) * 128 + (tok & 127);
#pragma unroll
                            for (int e = 0; e < 4; ++e) { kt[e * 128] = (bf16_t)f2bf(o1[e]); kt[(16 + e) * 128] = (bf16_t)f2bf(o2[e]); }
                        }
                    }
                }
        } else if (pc < 8) {
            const int h = pc - 4;
#pragma unroll
            for (int ai = 0; ai < 2; ++ai)
#pragma unroll
                for (int m = 0; m < 4; ++m) {
                    const int r = rbase + ai * HALF + m * 16;
                    const int tok = lat ? (r & 4095) : 4096 + ((r - T) & 255);
#pragma unroll
                    for (int bj = 0; bj < 2; ++bj)
#pragma unroll
                        for (int n = 0; n < 2; ++n) {
                            const f32x4 v = acc[ai][bj][m][n] + bv[bj][n];
                            bf16_t* vt = VT + (((size_t)((bidx * 4 + h) * 34 + (tok >> 7)) * 256 + bj * HALF + wc * 32 + n * 16 + 4 * fq)) * 128 + (tok & 127);
#pragma unroll
                            for (int e = 0; e < 4; ++e) vt[e * 128] = (bf16_t)f2bf(v[e]);
                        }
                }
        } else {
            const bool isg = pc < 12;
            bf16_t* O = isg ? SG : HU; const int ldo = isg ? 1024 : 1536; const int c0 = (isg ? pc - 8 : pc - 12) * BM + wc * 32 + 4 * fq;
#pragma unroll
            for (int ai = 0; ai < 2; ++ai)
#pragma unroll
                for (int m = 0; m < 4; ++m) {
                    const int r = rbase + ai * HALF + m * 16;
#pragma unroll
                    for (int bj = 0; bj < 2; ++bj)
#pragma unroll
                        for (int n = 0; n < 2; ++n) {
                            f32x4 v = acc[ai][bj][m][n] + bv[bj][n];
                            if (isg) { v[0] = silu_f(v[0]); v[1] = silu_f(v[1]); v[2] = silu_f(v[2]); v[3] = silu_f(v[3]); }
                            st_bf4(O + (size_t)r * ldo + c0 + bj * HALF + n * 16, v);
                        }
                }
        }
    }
};
struct EpiGate {
    static constexpr bool PERM = true;
    bf16_t* O; const float* bias; float scale;
    __device__ __forceinline__ void operator()(const f32x4 (&acc)[2][2][4][2], const Unit& u, int wr, int wc, int fr, int fq) const {
        const int rbase = u.pm * BM + wr * 64 + fr, col0 = u.pc * BM + wc * 32 + 8 * fq;
        f32x4 bv[2][2];
#pragma unroll
        for (int bj = 0; bj < 2; ++bj)
#pragma unroll
            for (int n = 0; n < 2; ++n) bv[bj][n] = *(const f32x4*)(bias + col0 + bj * HALF + 4 * n);
#pragma unroll
        for (int ai = 0; ai < 2; ++ai)
#pragma unroll
            for (int m = 0; m < 4; ++m) { bf16_t* rowp = O + (size_t)(rbase + ai * HALF + m * 16) * 1024 + col0;
#pragma unroll
                for (int bj = 0; bj < 2; ++bj) { f32x4 v0 = acc[ai][bj][m][0] * scale + bv[bj][0], v1 = acc[ai][bj][m][1] * scale + bv[bj][1];
#pragma unroll
                    for (int e = 0; e < 4; ++e) { v0[e] = sigm_f(v0[e]); v1[e] = sigm_f(v1[e]); }
                    st_bf8(rowp + bj * HALF, v0, v1); } }
    }
};
template <int MODE> struct EpiMerge {
    static constexpr bool PERM = true;
    bf16_t* O; const bf16_t* P;
    __device__ __forceinline__ void operator()(const f32x4 (&acc)[2][2][4][2], const Unit& u, int wr, int wc, int fr, int fq) const {
        const int rbase = u.pm * BM + wr * 64 + fr, col0 = u.pc * BM + wc * 32 + 8 * fq;
#pragma unroll
        for (int ai = 0; ai < 2; ++ai)
#pragma unroll
            for (int m = 0; m < 4; ++m) { const size_t off = (size_t)(rbase + ai * HALF + m * 16) * 1024 + col0;
#pragma unroll
                for (int bj = 0; bj < 2; ++bj) {
                    const u32x4 gw = *(const u32x4*)(O + off + bj * HALF);
                    f32x4 v0 = acc[ai][bj][m][0], v1 = acc[ai][bj][m][1];
                    v0[0] *= bflo(gw.x); v0[1] *= bfhi(gw.x); v0[2] *= bflo(gw.y); v0[3] *= bfhi(gw.y);
                    v1[0] *= bflo(gw.z); v1[1] *= bfhi(gw.z); v1[2] *= bflo(gw.w); v1[3] *= bfhi(gw.w);
                    if (MODE == 1) { const u32x4 pw = *(const u32x4*)(P + off + bj * HALF);
                        v0[0] += bflo(pw.x); v0[1] += bfhi(pw.x); v0[2] += bflo(pw.y); v0[3] += bfhi(pw.y);
                        v1[0] += bflo(pw.z); v1[1] += bfhi(pw.z); v1[2] += bflo(pw.w); v1[3] += bfhi(pw.w); }
                    st_bf8(O + off + bj * HALF, v0, v1); } }
    }
};
struct EpiX1 {
    static constexpr bool PERM = false;
    const float* x; const float* mod; bf16_t* out;
    __device__ __forceinline__ void operator()(const f32x4 (&acc)[2][2][4][2], const Unit& u, int wr, int wc, int fr, int fq) const {
        const int rbase = u.pm * BM + wr * 64 + fr, col0 = u.pc * BM + wc * 32 + 4 * fq;
        const float* gt = mod + (size_t)(u.pm >> 4) * 6144 + 2048 + col0;
        f32x4 gv[2][2];
#pragma unroll
        for (int bj = 0; bj < 2; ++bj)
#pragma unroll
            for (int n = 0; n < 2; ++n) gv[bj][n] = *(const f32x4*)(gt + bj * HALF + n * 16);
#pragma unroll
        for (int ai = 0; ai < 2; ++ai)
#pragma unroll
            for (int m = 0; m < 4; ++m) { const size_t off = (size_t)(rbase + ai * HALF + m * 16) * 1024 + col0;
#pragma unroll
                for (int bj = 0; bj < 2; ++bj)
#pragma unroll
                    for (int n = 0; n < 2; ++n) { const f32x4 xv = *(const f32x4*)(x + off + bj * HALF + n * 16); st_bf4(out + off + bj * HALF + n * 16, xv + gv[bj][n] * acc[ai][bj][m][n]); } }
    }
};
struct EpiMoe1 {
    static constexpr bool PERM = true;
    unsigned char* HM;
    __device__ __forceinline__ void operator()(const f32x4 (&acc)[2][2][4][2], const Unit& u, int wr, int wc, int fr, int fq) const {
        const int rbase = u.pm * BM + wr * 64 + fr, col0 = u.pc * HALF + wc * 32 + 8 * fq;
#pragma unroll
        for (int ai = 0; ai < 2; ++ai)
#pragma unroll
            for (int m = 0; m < 4; ++m) {
                f32x4 v0, v1;
#pragma unroll
                for (int e = 0; e < 4; ++e) { v0[e] = silu_f(acc[ai][0][m][0][e] * 0.03125f) * (acc[ai][1][m][0][e] * 0.03125f); v1[e] = silu_f(acc[ai][0][m][1][e] * 0.03125f) * (acc[ai][1][m][1][e] * 0.03125f); }
                u32x2 w; w.x = pk_fp8x4(v0[0], v0[1], v0[2], v0[3]); w.y = pk_fp8x4(v1[0], v1[1], v1[2], v1[3]);
                *(u32x2*)(HM + (size_t)(rbase + ai * HALF + m * 16) * EH + col0) = w; }
    }
};
struct EpiBf {
    static constexpr bool PERM = true;
    bf16_t* O; int ldo; float scale;
    __device__ __forceinline__ void operator()(const f32x4 (&acc)[2][2][4][2], const Unit& u, int wr, int wc, int fr, int fq) const {
        const int rbase = u.pm * BM + wr * 64 + fr, col0 = u.pc * BM + wc * 32 + 8 * fq;
#pragma unroll
        for (int ai = 0; ai < 2; ++ai)
#pragma unroll
            for (int m = 0; m < 4; ++m)
#pragma unroll
                for (int bj = 0; bj < 2; ++bj) st_bf8(O + (size_t)(rbase + ai * HALF + m * 16) * ldo + col0 + bj * HALF, acc[ai][bj][m][0] * scale, acc[ai][bj][m][1] * scale);
    }
};
struct EpiF8 {
    static constexpr bool PERM = true;
    unsigned char* O; int ldo; float scale;
    __device__ __forceinline__ void operator()(const f32x4 (&acc)[2][2][4][2], const Unit& u, int wr, int wc, int fr, int fq) const {
        const int rbase = u.pm * BM + wr * 64 + fr, col0 = u.pc * BM + wc * 32 + 8 * fq;
#pragma unroll
        for (int ai = 0; ai < 2; ++ai)
#pragma unroll
            for (int m = 0; m < 4; ++m)
#pragma unroll
                for (int bj = 0; bj < 2; ++bj) { const f32x4 v0 = acc[ai][bj][m][0] * scale, v1 = acc[ai][bj][m][1] * scale; u32x2 w; w.x = pk_fp8x4(v0[0], v0[1], v0[2], v0[3]); w.y = pk_fp8x4(v1[0], v1[1], v1[2], v1[3]);
                    *(u32x2*)(O + (size_t)(rbase + ai * HALF + m * 16) * ldo + col0 + bj * HALF) = w; }
    }
};
}

namespace gt {
constexpr int STAGE_BYTES = 128 * 144 + 256 * 144;
struct NoHook { template <class A> __device__ __forceinline__ void operator()(int, A&) const {} };
struct NoTf { __device__ __forceinline__ u32x4 operator()(int, int, u32x4 v) const { return v; } };
template <int NT, int BKT, class AL, class BL, class Pre = NoHook, class Post = NoHook, class TfA = NoTf>
__device__ __forceinline__ void gemm_tile(f32x4 (&acc)[4][NT], const AL& al, const BL& bl, int nk, LAS unsigned char* st, int tid, const Pre& pre = Pre(), const Post& post = Post(), const TfA& tfa = TfA()) {
    constexpr int AST = (BKT + 8) * 2, PPR = BKT / 8, NA = 128 * PPR / 512, NB = 64 * NT * PPR / 512;
    const int lane = tid & 63, wid = tid >> 6, wr = wid >> 2, wc = wid & 3, fr = lane & 15, fq = lane >> 4;
    LAS unsigned char* sa = st; LAS unsigned char* sb = st + 128 * AST;
    u32x4 ra[NA], rb[NB];
#pragma unroll
    for (int i = 0; i < NA; ++i) { const int p = tid + i * 512; ra[i] = al(p / PPR, (p % PPR) * 8); }
#pragma unroll
    for (int i = 0; i < NB; ++i) { const int p = tid + i * 512; rb[i] = bl(p / PPR, (p % PPR) * 8); }
    for (int kt = 0; kt < nk; ++kt) {
        __syncthreads();
#pragma unroll
        for (int i = 0; i < NA; ++i) { const int p = tid + i * 512; *(LAS u32x4*)(sa + (p / PPR) * AST + (p % PPR) * 16) = tfa(p / PPR, kt * BKT + (p % PPR) * 8, ra[i]); }
#pragma unroll
        for (int i = 0; i < NB; ++i) { const int p = tid + i * 512; *(LAS u32x4*)(sb + (p / PPR) * AST + (p % PPR) * 16) = rb[i]; }
        __syncthreads();
        if (kt + 1 < nk) {
            int t2 = tid; asm volatile("" : "+v"(t2));
#pragma unroll
            for (int i = 0; i < NA; ++i) { const int p = t2 + i * 512; ra[i] = al(p / PPR, (kt + 1) * BKT + (p % PPR) * 8); }
#pragma unroll
            for (int i = 0; i < NB; ++i) { const int p = t2 + i * 512; rb[i] = bl(p / PPR, (kt + 1) * BKT + (p % PPR) * 8); }
        }
        pre(kt, acc);
#pragma unroll
        for (int kk = 0; kk < BKT / 32; ++kk) {
            bf16x8 a[4], b[NT];
#pragma unroll
            for (int m = 0; m < 4; ++m) a[m] = *(const LAS bf16x8*)(sa + (wr * 64 + m * 16 + fr) * AST + kk * 64 + fq * 16);
#pragma unroll
            for (int n = 0; n < NT; ++n) b[n] = *(const LAS bf16x8*)(sb + (wc * 16 * NT + n * 16 + fr) * AST + kk * 64 + fq * 16);
#pragma unroll
            for (int m = 0; m < 4; ++m)
#pragma unroll
                for (int n = 0; n < NT; ++n) acc[m][n] = __builtin_amdgcn_mfma_f32_16x16x32_bf16(a[m], b[n], acc[m][n], 0, 0, 0);
        }
        post(kt, acc);
    }
    __syncthreads();
}
template <int NT, int BKT>
__device__ __forceinline__ void compute_tile(f32x4 (&acc)[4][NT], LAS unsigned char* st, int tid) {
    constexpr int AST = (BKT + 8) * 2;
    const int lane = tid & 63, wid = tid >> 6, wr = wid >> 2, wc = wid & 3, fr = lane & 15, fq = lane >> 4;
    LAS unsigned char* sa = st; LAS unsigned char* sb = st + 128 * AST;
#pragma unroll
    for (int kk = 0; kk < BKT / 32; ++kk) {
        bf16x8 a[4], b[NT];
#pragma unroll
        for (int m = 0; m < 4; ++m) a[m] = *(const LAS bf16x8*)(sa + (wr * 64 + m * 16 + fr) * AST + kk * 64 + fq * 16);
#pragma unroll
        for (int n = 0; n < NT; ++n) b[n] = *(const LAS bf16x8*)(sb + (wc * 16 * NT + n * 16 + fr) * AST + kk * 64 + fq * 16);
#pragma unroll
        for (int m = 0; m < 4; ++m)
#pragma unroll
            for (int n = 0; n < NT; ++n) acc[m][n] = __builtin_amdgcn_mfma_f32_16x16x32_bf16(a[m], b[n], acc[m][n], 0, 0, 0);
    }
}
struct LdRows {
    const bf16_t* base; int ld;
    __device__ __forceinline__ u32x4 operator()(int row, int k) const { return *(const u32x4*)(base + (size_t)row * ld + k); }
};
__device__ __forceinline__ u32x4 scale8(u32x4 v, float s0, float s1, float s2, float s3, float s4, float s5, float s6, float s7) {
    u32x4 o; o.x = pk2(bflo(v.x) * s0, bfhi(v.x) * s1); o.y = pk2(bflo(v.y) * s2, bfhi(v.y) * s3); o.z = pk2(bflo(v.z) * s4, bfhi(v.z) * s5); o.w = pk2(bflo(v.w) * s6, bfhi(v.w) * s7); return o;
}
}


#define XB_TMO      128
#define XB_XCNT(j)  (256  + 64 * (j))
#define XB_XSUB(j)  (1280 + 64 * (j))
#define XB_XGEN(j)  (2304 + 64 * (j))
#define XB_TOP      3328
#define XB_TOPGEN   3392
#define XCD_BAR_WORDS 3456
#define XB_SPIN_CAP (1u << 18)
__device__ __forceinline__ unsigned xb_ld(unsigned* p)              { return __hip_atomic_load(p, __ATOMIC_RELAXED, __HIP_MEMORY_SCOPE_AGENT); }
__device__ __forceinline__ unsigned xb_add(unsigned* p, unsigned v) { return __hip_atomic_fetch_add(p, v, __ATOMIC_RELAXED, __HIP_MEMORY_SCOPE_AGENT); }
__device__ __forceinline__ unsigned xb_xcc_id() { return (unsigned)__builtin_amdgcn_s_getreg((3 << 11) | 20) & 0xFu; }
#define XB_SPIN(cond, bar) do { unsigned _sp = 0; while (cond) { __builtin_amdgcn_s_sleep(1); \
    if ((++_sp & 255u) == 0u) { if (xb_ld(&(bar)[XB_TMO])) break; if (_sp > XB_SPIN_CAP) { atomicAdd(&(bar)[XB_TMO], 1u); break; } } } } while (0)
struct XcdBarrier { unsigned* bar; unsigned x; volatile LAS unsigned* st; };
__device__ __forceinline__ XcdBarrier xcd_barrier_post(unsigned* bar, volatile LAS unsigned* st) {
    XcdBarrier b; b.bar = bar; b.x = xb_xcc_id(); b.st = st;
    if (threadIdx.x == 0) (void)xb_add(&bar[XB_XCNT(b.x)], 1u);
    return b;
}
__device__ __forceinline__ void xcd_barrier_complete(unsigned* bar, unsigned x, unsigned& nloc, unsigned& nx) {
    const unsigned G = gridDim.x * gridDim.y * gridDim.z;
    unsigned sum, cnt, mine, sp = 0u;
    for (;;) {
        sum = 0u; cnt = 0u; mine = 0u;
#pragma unroll
        for (unsigned j = 0; j < 16; ++j) { const unsigned c = xb_ld(&bar[XB_XCNT(j)]); sum += c; cnt += (c > 0u) ? 1u : 0u; mine = (j == x) ? c : mine; }
        if (sum == G) break;
        __builtin_amdgcn_s_sleep(1);
        if ((++sp & 255u) == 0u) { if (xb_ld(&bar[XB_TMO])) break; if (sp > XB_SPIN_CAP) { atomicAdd(&bar[XB_TMO], 1u); break; } }
    }
    nloc = mine > 0u ? mine : 1u; nx = cnt > 0u ? cnt : 1u;
}
__device__ __forceinline__ void xcd_barrier(const XcdBarrier& b) {
    asm volatile("s_waitcnt vmcnt(0)" ::: "memory");
    __syncthreads();
    if (threadIdx.x == 0) {
        unsigned* bar = b.bar;
        __builtin_amdgcn_s_waitcnt(0);
        unsigned nloc = b.st[0], nx = b.st[1];
        if (nloc == 0u) { xcd_barrier_complete(bar, b.x, nloc, nx); b.st[0] = nloc; b.st[1] = nx; }
        const unsigned old = xb_add(&bar[XB_XSUB(b.x)], 1u);
        const unsigned gen = old / nloc;
        if (old + 1u == (gen + 1u) * nloc) {
            __builtin_amdgcn_fence(__ATOMIC_RELEASE, "agent");
            asm volatile("s_waitcnt vmcnt(0)" ::: "memory");
            const unsigned og = xb_add(&bar[XB_TOP], 1u);
            const unsigned tg = og / nx;
            if (og + 1u == (tg + 1u) * nx) xb_add(&bar[XB_TOPGEN], 1u);
            else XB_SPIN(xb_ld(&bar[XB_TOPGEN]) == tg, bar);
            __builtin_amdgcn_fence(__ATOMIC_ACQUIRE, "agent");
            xb_add(&bar[XB_XGEN(b.x)], 1u);
            asm volatile("s_waitcnt vmcnt(0)" ::: "memory");
        } else {
            XB_SPIN(xb_ld(&bar[XB_XGEN(b.x)]) == gen, bar);
            __builtin_amdgcn_fence(__ATOMIC_ACQUIRE, "agent");
            asm volatile("s_waitcnt vmcnt(0)" ::: "memory");
        }
    }
    __syncthreads();
}

struct Args { const float* in[31]; float* out; unsigned char* ws; };
enum { I_X = 0, I_C, I_CTX, I_CCTX, I_ADAW, I_ADAB, I_N1G, I_N2G, I_WIN, I_BIN, I_DECAY, I_RETWO, I_HCW, I_HCB, I_HW1, I_HB1, I_HFREQ, I_HW2, I_HB2, I_HW3, I_HSKIP, I_HYWO, I_WOUT,
       I_RGW, I_RGB, I_REW, I_REB, I_EW1, I_EW3, I_EW2, I_FNG };

template <class RowMap>
__device__ __forceinline__ void transpose_item(const float* W, int N, int k0, int n0, bf16_t* WT, int ldt, const RowMap& rm, LAS float* scr, int lane) {
    const int lr = lane >> 4, lc = (lane & 15) * 4;
#pragma unroll
    for (int i = 0; i < 16; ++i) { const int kk = 4 * i + lr; const f32x4 v = *(const f32x4*)(W + (size_t)(k0 + kk) * N + n0 + lc); LAS float* s = scr + kk * 69 + lc; s[0] = v[0]; s[1] = v[1]; s[2] = v[2]; s[3] = v[3]; }
    asm volatile("s_waitcnt lgkmcnt(0)" ::: "memory");
    const int c = lane & 7;
#pragma unroll
    for (int j = 0; j < 8; ++j) { const int n = (lane >> 3) + 8 * j; const LAS float* s = scr + (8 * c) * 69 + n;
        u32x4 o; o.x = pk2(s[0 * 69], s[1 * 69]); o.y = pk2(s[2 * 69], s[3 * 69]); o.z = pk2(s[4 * 69], s[5 * 69]); o.w = pk2(s[6 * 69], s[7 * 69]);
        *(u32x4*)(WT + (size_t)rm(n0 + n) * ldt + k0 + 8 * c) = o; }
    asm volatile("s_waitcnt lgkmcnt(0)" ::: "memory");
}
using pg8::pk_fp8x4;
template <class RowMap>
__device__ __forceinline__ void transpose_item_f8(const float* W, int N, int k0, int n0, unsigned char* WT, int ldt, const RowMap& rm, float scale, LAS float* scr, int lane) {
    const int lr = lane >> 4, lc = (lane & 15) * 4;
#pragma unroll
    for (int i = 0; i < 16; ++i) { const int kk = 4 * i + lr; const f32x4 v = *(const f32x4*)(W + (size_t)(k0 + kk) * N + n0 + lc); LAS float* s = scr + kk * 69 + lc; s[0] = v[0]; s[1] = v[1]; s[2] = v[2]; s[3] = v[3]; }
    asm volatile("s_waitcnt lgkmcnt(0)" ::: "memory");
    const int c = lane & 7;
#pragma unroll
    for (int j = 0; j < 8; ++j) { const int n = (lane >> 3) + 8 * j; const LAS float* s = scr + (8 * c) * 69 + n;
        u32x2 o; o.x = pk_fp8x4(s[0 * 69] * scale, s[1 * 69] * scale, s[2 * 69] * scale, s[3 * 69] * scale); o.y = pk_fp8x4(s[4 * 69] * scale, s[5 * 69] * scale, s[6 * 69] * scale, s[7 * 69] * scale);
        *(u32x2*)(WT + (size_t)rm(n0 + n) * ldt + k0 + 8 * c) = o; }
    asm volatile("s_waitcnt lgkmcnt(0)" ::: "memory");
}
struct RmId { __device__ __forceinline__ int operator()(int n) const { return n; } };
struct RmWin { __device__ __forceinline__ int operator()(int n) const { return win_destrow(n); } };
struct RmE13 { int add; __device__ __forceinline__ int operator()(int n) const { return 256 * (n >> 7) + (n & 127) + add; } };

__device__ __forceinline__ float lg2_decay(float logit) { return -log1pf(expf(-logit)) * 1.4426950408889634f; }

__device__ __forceinline__ void short_conv8(const bf16_t* HU, int row, int t, int ch, const float* cw, const float* cb, float (&o)[8]) {
    const f32x4 b0 = *(const f32x4*)(cb + ch), b1 = *(const f32x4*)(cb + ch + 4);
#pragma unroll
    for (int e = 0; e < 4; ++e) { o[e] = b0[e]; o[4 + e] = b1[e]; }
#pragma unroll
    for (int j = 0; j < 3; ++j) {
        const int tt = t + j - 1;
        if (tt >= 0 && tt < SEQ) {
            const u32x4 v = *(const u32x4*)(HU + (size_t)(row + j - 1) * 1536 + ch);
            const f32x4 w0 = *(const f32x4*)(cw + j * 1536 + ch), w1 = *(const f32x4*)(cw + j * 1536 + ch + 4);
            o[0] += bflo(v.x) * w0[0]; o[1] += bfhi(v.x) * w0[1]; o[2] += bflo(v.y) * w0[2]; o[3] += bfhi(v.y) * w0[3];
            o[4] += bflo(v.z) * w1[0]; o[5] += bfhi(v.z) * w1[1]; o[6] += bflo(v.w) * w1[2]; o[7] += bfhi(v.w) * w1[3];
        }
    }
}


__device__ __forceinline__ void short_conv8x8(const bf16_t* HU, int row0, int t0, int ch, const float* cw, const float* cb, float (&o)[8][8]) {
    u32x4 rw[10];
#pragma unroll
    for (int r = 0; r < 10; ++r) { const int tt = t0 + r - 1; rw[r] = (u32x4){0u, 0u, 0u, 0u}; if (tt >= 0 && tt < SEQ) rw[r] = *(const u32x4*)(HU + (size_t)(row0 + r - 1) * 1536 + ch); }
    float w[3][8], bb[8];
#pragma unroll
    for (int j = 0; j < 3; ++j) { const f32x4 w0 = *(const f32x4*)(cw + j * 1536 + ch), w1 = *(const f32x4*)(cw + j * 1536 + ch + 4);
#pragma unroll
        for (int e = 0; e < 4; ++e) { w[j][e] = w0[e]; w[j][4 + e] = w1[e]; } }
    { const f32x4 b0 = *(const f32x4*)(cb + ch), b1 = *(const f32x4*)(cb + ch + 4);
#pragma unroll
      for (int e = 0; e < 4; ++e) { bb[e] = b0[e]; bb[4 + e] = b1[e]; } }
#pragma unroll
    for (int t = 0; t < 8; ++t)
#pragma unroll
        for (int e = 0; e < 8; ++e) o[t][e] = bb[e];
#pragma unroll
    for (int r = 0; r < 10; ++r) {
        float u[8]; u[0] = bflo(rw[r].x); u[1] = bfhi(rw[r].x); u[2] = bflo(rw[r].y); u[3] = bfhi(rw[r].y); u[4] = bflo(rw[r].z); u[5] = bfhi(rw[r].z); u[6] = bflo(rw[r].w); u[7] = bfhi(rw[r].w);
#pragma unroll
        for (int j = 0; j < 3; ++j) { const int t = r - j;
            if (t >= 0 && t < 8) {
#pragma unroll
                for (int e = 0; e < 8; ++e) o[t][e] += u[e] * w[j][e]; } }
    }
}

typedef const __attribute__((address_space(4))) Args CArgs;
__device__ __forceinline__ CArgs* args_ptr() { CArgs* p = (CArgs*)__builtin_amdgcn_kernarg_segment_ptr(); asm volatile("" : "+s"(p)); return p; }
#define DECL_PTRS \
    CArgs& a = *args_ptr(); unsigned char* ws = a.ws; unsigned char* dob = (unsigned char*)a.out; \
    int tid = threadIdx.x; asm volatile("" : "+v"(tid)); const int lane = tid & 63, wave = tid >> 6, gw = bid * 8 + wave; (void)lane; (void)gw; \
    int* cnt = (int*)(ws + WS_CTL); \
    float* MOD = (float*)(ws + WS_MOD); float* ROPE = (float*)(ws + WS_ROPE); float* BINP = (float*)(ws + WS_BINP); float* FPART = (float*)(ws + WS_FPART); \
    int* TOKINFO = (int*)(ws + WS_TOKINFO); int* LISTS = (int*)(ws + WS_LISTS); \
    bf16_t* TR = (bf16_t*)(ws + WS_TR); \
    bf16_t* WT_IN = (bf16_t*)(ws + WS_WT_IN); bf16_t* WT_RETO = (bf16_t*)(ws + WS_WT_RETO); bf16_t* WT_HYO = (bf16_t*)(ws + WS_WT_HYO); bf16_t* WT_OUT = (bf16_t*)(ws + WS_WT_OUT); \
    bf16_t* Qb = (bf16_t*)(ws + WS_Q); bf16_t* Kb = (bf16_t*)(ws + WS_K); bf16_t* KT = (bf16_t*)(ws + WS_KT); bf16_t* VT = (bf16_t*)(ws + WS_VT); \
    float* FILT = (float*)(ws + WS_KV); \
    bf16_t* SGR = (bf16_t*)(ws + WS_SGR); bf16_t* SGH = (bf16_t*)(ws + WS_SGH); bf16_t* XB = (bf16_t*)(ws + WS_XB); \
    bf16_t* SG = (bf16_t*)(ws + WS_SG); bf16_t* HU = (bf16_t*)(ws + WS_HU); bf16_t* HM = (bf16_t*)(ws + WS_HU); \
    bf16_t* KV = (bf16_t*)(ws + WS_KV); bf16_t* WE13 = (bf16_t*)(ws + WS_WE13); bf16_t* WE2 = (bf16_t*)(ws + WS_WE2); \
    bf16_t* XN = (bf16_t*)(dob + DO_XN); bf16_t* ZT = (bf16_t*)(dob + DO_ZT); unsigned char* XN8 = dob + DO_XN8; unsigned char* WTG8 = (unsigned char*)(ws + WS_WT_IN) + (size_t)NINA * 1024 * 2; (void)XN8; (void)WTG8; \
    bf16_t* X1 = (bf16_t*)(ws + WS_X1);     \
    (void)cnt; (void)MOD; (void)ROPE; (void)BINP; (void)FPART; (void)TOKINFO; (void)LISTS; (void)TR; (void)WT_IN; (void)WT_RETO; (void)WT_HYO; (void)WT_OUT; (void)Qb; (void)Kb; (void)KT; (void)VT; (void)FILT; \
    (void)SGR; (void)SGH; (void)XB; (void)SG; (void)HU; (void)HM; (void)KV; (void)WE13; (void)WE2; (void)XN; (void)ZT; (void)X1;

__global__ void __launch_bounds__(512, 2) fwd_kernel(Args a_) {
    extern __shared__ __attribute__((aligned(16))) unsigned char lds_raw[];
    LAS unsigned char* lds = (LAS unsigned char*)lds_raw;
    cg::grid_group grid = cg::this_grid();
    const int G = gridDim.x, bid = blockIdx.x, NGW = G * 8;
    volatile LAS unsigned* bst = (volatile LAS unsigned*)(lds + LDS_BYTES - 16);
    if (threadIdx.x == 0) { bst[0] = 0u; bst[1] = 0u; }
    __syncthreads();
    if (blockIdx.x == 0) { unsigned* bw = (unsigned*)(args_ptr()->ws + WS_CTL) + 1024; for (int i = threadIdx.x; i < XCD_BAR_WORDS; i += 512) bw[i] = 0u; }
#define GRID_BAR() xcd_barrier(xbar)
    unsigned long long tprev_ = 0, spin_ = 0;
    if (PROBE_PHASE >= 0) tprev_ = __builtin_amdgcn_s_memrealtime();
#define STAMP(k) do { if (PROBE_PHASE >= 0 && blockIdx.x == 0 && threadIdx.x == 0) { const unsigned long long now_ = __builtin_amdgcn_s_memrealtime(); if ((k) == PROBE_PHASE) spin_ = now_ - tprev_; tprev_ = now_; } } while (0)

    { DECL_PTRS
    for (int it = bid; it < 193; it += G) {
        if (it < 192) {
            const int col0 = it * 32, kq = tid >> 5, cl = tid & 31;
            LAS float* sl = (LAS float*)(lds + 32768);
            for (int idx = tid; idx < 9 * 1024; idx += 512) { const int r = idx >> 10, k = idx & 1023; sl[k * 12 + r] = silu_f(r < 8 ? a.in[I_C][r * 1024 + k] : a.in[I_CCTX][k]); }
            __syncthreads();
            float acc9[9];
#pragma unroll
            for (int r = 0; r < 9; ++r) acc9[r] = 0.f;
#pragma unroll 8
            for (int kk = 0; kk < 64; ++kk) { const int k = kq * 64 + kk; const float w = a.in[I_ADAW][(size_t)k * 6144 + col0 + cl];
                const f32x4 s0 = *(const LAS f32x4*)(sl + k * 12), s1 = *(const LAS f32x4*)(sl + k * 12 + 4); const float s8 = sl[k * 12 + 8];
                acc9[0] += s0[0] * w; acc9[1] += s0[1] * w; acc9[2] += s0[2] * w; acc9[3] += s0[3] * w; acc9[4] += s1[0] * w; acc9[5] += s1[1] * w; acc9[6] += s1[2] * w; acc9[7] += s1[3] * w; acc9[8] += s8 * w; }
            LAS float* red = (LAS float*)lds;
#pragma unroll
            for (int r = 0; r < 9; ++r) red[(kq * 9 + r) * 32 + cl] = acc9[r];
            __syncthreads();
            if (tid < 288) { const int r = tid >> 5, c2 = tid & 31; float s = 0.f; for (int q = 0; q < 16; ++q) s += red[(q * 9 + r) * 32 + c2]; MOD[r * 6144 + col0 + c2] = s + a.in[I_ADAB][col0 + c2]; }
            __syncthreads();
        } else {
            for (int idx = tid; idx < 2048; idx += 512) { const int pos = idx >> 5, i = idx & 31; const float inv = powf(10000.f, -(float)i / 32.f); const float ang = (float)pos * inv; ROPE[idx] = cosf(ang); ROPE[2048 + idx] = sinf(ang); }
            for (int n = tid; n < 6656; n += 512) BINP[win_destrow(n)] = a.in[I_BIN][n];
        }
    }
    for (int fi0 = bid + 63; fi0 < 256 + 63 + 256; fi0 += G) {
        const int fi = fi0 - 256; if (fi < 0 || fi >= 256) continue;
        {
            const int t0 = fi * 16;
            LAS float* feats = (LAS float*)lds; LAS float* hid1 = feats + 544; LAS float* hid2 = hid1 + 1024;
            for (int idx = tid; idx < 16 * 33; idx += 512) { const int row = idx / 33, f = idx % 33; const float t = (float)(t0 + row) * (1.f / 4096.f); float v;
                if (f == 0) v = t; else { const int mb = (f - 1) & 15; const float band = 1e-4f + (float)mb * ((15.f - 1e-4f) / 15.f); const float ph = (6.283185307179586f * t) * band; v = f <= 16 ? cosf(ph) : -sinf(ph); }
                feats[idx] = v; }
            __syncthreads();
            for (int idx = tid; idx < 1024; idx += 512) { const int row = idx >> 6, j = idx & 63; float s = a.in[I_HB1][j]; for (int f = 0; f < 33; ++f) s += feats[row * 33 + f] * a.in[I_HW1][f * 64 + j]; hid1[idx] = sinf(a.in[I_HFREQ][j] * s); }
            __syncthreads();
            for (int idx = tid; idx < 1024; idx += 512) { const int row = idx >> 6, j = idx & 63; float s = a.in[I_HB2][j]; for (int k = 0; k < 64; ++k) s += hid1[row * 64 + k] * a.in[I_HW2][k * 64 + j]; hid2[j * 16 + row] = sinf(a.in[I_HFREQ][j] * s); }
            __syncthreads();
            const float slow = 4.605170185988091f / 1.5f, fast = 4.605170185988091f / 0.3f;
            for (int col = tid; col < 1024; col += 512) {
                float ac[16];
#pragma unroll
                for (int r = 0; r < 16; ++r) ac[r] = 0.f;
#pragma unroll 4
                for (int k = 0; k < 64; ++k) { const float w = a.in[I_HW3][k * 1024 + col];
#pragma unroll
                    for (int r4 = 0; r4 < 4; ++r4) { const f32x4 hv = *(const LAS f32x4*)(hid2 + k * 16 + 4 * r4); ac[4 * r4] += hv[0] * w; ac[4 * r4 + 1] += hv[1] * w; ac[4 * r4 + 2] += hv[2] * w; ac[4 * r4 + 3] += hv[3] * w; } }
                const float delta = slow + (float)(col & 511) * ((fast - slow) / 511.f); float ps = 0.f;
#pragma unroll
                for (int r = 0; r < 16; ++r) { const float t = (float)(t0 + r) * (1.f / 4096.f); ac[r] *= expf(-t * delta); ps += fabsf(ac[r]); }
#pragma unroll
                for (int r = 0; r < 4; ++r) *(f32x4*)(FILT + (size_t)col * 4096 + t0 + 4 * r) = (f32x4){ac[4 * r], ac[4 * r + 1], ac[4 * r + 2], ac[4 * r + 3]};
                FPART[fi * 1024 + col] = ps;
            }
            __syncthreads();
        }
    }
    __syncthreads();
    {
        LAS float* scr = (LAS float*)(lds + wave * 17664);
        constexpr int I_IN = 16 * 104, I_RO = 16 * 16, I_HO = 8 * 16, I_OU = 16 * 16;
        for (int it = gw; it < I_IN + I_RO + I_HO + I_OU; it += NGW) {
            int r = it;
            if (r < I_IN) { const int nb = r % 104;
                if (nb < 72) transpose_item(a.in[I_WIN], 6656, 64 * (r / 104), 64 * nb, WT_IN, 1024, RmWin{}, scr, lane);
                else transpose_item_f8(a.in[I_WIN] + NINA, 6656, 64 * (r / 104), 64 * (nb - 72), WTG8, 1024, RmId{}, 32.f, scr, lane);
                continue; } r -= I_IN;
            if (r < I_RO) { transpose_item(a.in[I_RETWO], 1024, 64 * (r / 16), 64 * (r % 16), WT_RETO, 1024, RmId{}, scr, lane); continue; } r -= I_RO;
            if (r < I_HO) { transpose_item(a.in[I_HYWO], 1024, 64 * (r / 16), 64 * (r % 16), WT_HYO, 512, RmId{}, scr, lane); continue; } r -= I_HO;
            transpose_item(a.in[I_WOUT], 1024, 64 * (r / 16), 64 * (r % 16), WT_OUT, 1024, RmId{}, scr, lane);
        }
    }
    }
    grid.sync();
    const XcdBarrier xbar = xcd_barrier_post((unsigned*)(args_ptr()->ws + WS_CTL) + 1024, bst);
    STAMP(0);

    { DECL_PTRS
    for (int m0 = gw; m0 < MT; m0 += 2 * NGW) {
        f32x4 v[2][4]; float s[2] = {0.f, 0.f};
#pragma unroll
        for (int q = 0; q < 2; ++q) { const int m = m0 + q * NGW; const bool ok = m < MT; const bool lat = m < T;
            const float* xr = !ok ? a.in[I_X] : lat ? a.in[I_X] + (size_t)m * D : a.in[I_CTX] + (size_t)(m - T) * D;
#pragma unroll
            for (int j = 0; j < 4; ++j) { v[q][j] = *(const f32x4*)(xr + 4 * lane + 256 * j); s[q] += (v[q][j][0] * v[q][j][0] + v[q][j][1] * v[q][j][1]) + (v[q][j][2] * v[q][j][2] + v[q][j][3] * v[q][j][3]); } }
#pragma unroll
        for (int q = 0; q < 2; ++q) { const int m = m0 + q * NGW; if (m >= MT) break; const bool lat = m < T;
            const float* md = MOD + (size_t)(lat ? (m >> 12) : 8) * 6144;
            const float rstd = rsqrtf(wave_sum(s[q]) * (1.f / D) + EPS);
#pragma unroll
            for (int j = 0; j < 4; ++j) { const int c0 = 4 * lane + 256 * j; const f32x4 g = *(const f32x4*)(a.in[I_N1G] + c0), sh = *(const f32x4*)(md + c0), sc = *(const f32x4*)(md + 1024 + c0);
                const f32x4 o = (v[q][j] * rstd * g) * (sc + 1.f) + sh; u32x2 w; w.x = pk2(o[0], o[1]); w.y = pk2(o[2], o[3]); *(u32x2*)(XN + (size_t)m * D + c0) = w;
                if (lat) *(unsigned*)(XN8 + (size_t)m * D + c0) = pk_fp8x4(o[0], o[1], o[2], o[3]); } }
    }
    }
    GRID_BAR();
    STAMP(1);

    { DECL_PTRS
    for (int c = bid; c < 512; c += G) {
        LAS float* red = (LAS float*)lds;
        float p = 0.f; if (tid < 256) p = FPART[tid * 1024 + c]; else p = FPART[(tid - 256) * 1024 + 512 + c];
        p = wave_sum(p); if (lane == 0) red[wave] = p;
        __syncthreads();
        const float nf = 1.f / ((red[0] + red[1]) + (red[2] + red[3])), nb = 1.f / ((red[4] + red[5]) + (red[6] + red[7]));
        for (int i = tid; i < 8192; i += 512) { const int x = 4096 - i; float v = 0.f;
            if (x >= 0 && x < 4096) v += FILT[(size_t)c * 4096 + x] * nf;
            if (x <= 0 && x > -4096) v += FILT[(size_t)(512 + c) * 4096 - x] * nb;
            TR[(size_t)c * 8192 + i] = (bf16_t)f2bf(v); }
        __syncthreads();
    }
    __syncthreads();
    {
        pg8::Gemm g{XN, WT_IN, 1024, 1024, 1024}; pg8::InProjOrder S; S.init(G, bid);
        pg8::EpiInA E{Qb, Kb, KT, VT, SG, HU, BINP, ROPE};
        pg8::gemm_phase(lds, g, S, E);
    }
    }
    GRID_BAR();
    STAMP(2);

    { DECL_PTRS
    for (int it = bid; it < 512; it += G) {
        const int b = it >> 6, tt = (it >> 3) & 7, cc = it & 7;
        LAS bf16_t* zt = (LAS bf16_t*)lds;
        { int tl = tid; asm volatile("" : "+v"(tl));
          const int tq = tl >> 3, cg = tl & 7, c0 = cc * 64 + cg * 8, t0 = tt * 512 + tq * 8, row0 = b * SEQ + t0;
          float x1[8][8], vv[8][8];
          short_conv8x8(HU, row0, t0, 512 + c0, a.in[I_HCW], a.in[I_HCB], x1);
          short_conv8x8(HU, row0, t0, 1024 + c0, a.in[I_HCW], a.in[I_HCB], vv);
#pragma unroll
          for (int e = 0; e < 8; ++e) { u32x4 w; w.x = pk2(x1[0][e] * vv[0][e], x1[1][e] * vv[1][e]); w.y = pk2(x1[2][e] * vv[2][e], x1[3][e] * vv[3][e]); w.z = pk2(x1[4][e] * vv[4][e], x1[5][e] * vv[5][e]); w.w = pk2(x1[6][e] * vv[6][e], x1[7][e] * vv[7][e]);
              *(LAS u32x4*)(zt + (cg * 8 + e) * 520 + tq * 8) = w; } }
        __syncthreads();
#pragma unroll
        for (int i = 0; i < 8; ++i) { const int ch = wave * 8 + i; *(u32x4*)(ZT + ((size_t)(cc * 64 + ch) * 8 + b) * SEQ + tt * 512 + lane * 8) = *(const LAS u32x4*)(zt + ch * 520 + lane * 8); }
        __syncthreads();
    }
    {
        LAS float* wtab = (LAS float*)(lds + 104448);
        for (int u0 = bid; u0 < 256; u0 += G) {
            int tl = tid; asm volatile("" : "+v"(tl));
            const int u = (G == 256) ? (((u0 & 7) + 8 * (u0 >> 6)) * 8 + ((u0 >> 3) & 7)) : u0;
            const int chain = u >> 2, dvq = u & 3, bh = chain >> 1, dir = chain & 1, h = bh & 3;
            const float lg = lg2_decay(a.in[I_DECAY][dir * 4 + h]); const float g128 = exp2f(128.f * lg);
            if (tl < 128) wtab[tl] = exp2f((float)(dir == 0 ? 127 - tl : tl) * lg);
            __syncthreads();
            struct LdK { const bf16_t* base; const LAS float* w; int dir;
                __device__ __forceinline__ u32x4 operator()(int row, int k) const { const int kt = k >> 7, j = k & 127;
                    const int ck = dir == 0 ? (kt == 0 ? 32 : kt == 1 ? 33 : kt - 2) : (kt == 0 ? 33 : kt == 1 ? 32 : 33 - kt);
                    return *(const u32x4*)(base + ((size_t)ck * 128 + row) * 128 + j); } };
            struct LdV { const bf16_t* base; int dir;
                __device__ __forceinline__ u32x4 operator()(int row, int k) const { const int kt = k >> 7, j = k & 127;
                    const int ck = dir == 0 ? (kt == 0 ? 32 : kt == 1 ? 33 : kt - 2) : (kt == 0 ? 33 : kt == 1 ? 32 : 33 - kt);
                    return *(const u32x4*)(base + ((size_t)ck * 256 + row) * 128 + j); } };
            struct Pre { float g;
                __device__ __forceinline__ void operator()(int, f32x4 (&acc)[4][1]) const {
#pragma unroll
                    for (int m = 0; m < 4; ++m) acc[m][0] = acc[m][0] * g; } };
            struct Post { bf16_t* out; int tl;
                __device__ __forceinline__ void operator()(int kt, f32x4 (&acc)[4][1]) const {
                    const int wr = tl >> 8, wc = (tl >> 6) & 3, fr = tl & 15, fq = (tl >> 4) & 3;
                    bf16_t* o = out + (size_t)kt * 32768 + (size_t)(wc * 16 + fr) * 128 + wr * 64 + 4 * fq;
#pragma unroll
                    for (int m = 0; m < 4; ++m) { u32x2 w; w.x = pk2(acc[m][0][0], acc[m][0][1]); w.y = pk2(acc[m][0][2], acc[m][0][3]); *(u32x2*)(o + m * 16) = w; } } };
            f32x4 acc[4][1];
#pragma unroll
            for (int m = 0; m < 4; ++m) acc[m][0] = (f32x4){0.f, 0.f, 0.f, 0.f};
            const LdK al{KT + (size_t)bh * 34 * 128 * 128, wtab, dir}; const LdV bl{VT + (size_t)bh * 34 * 256 * 128 + (size_t)dvq * 64 * 128, dir};
            const Pre pre{g128}; const Post post{KV + (size_t)chain * 33 * 32768 + (size_t)dvq * 64 * 128, tl};
            u32x4 rg[3][6];
#define CH_LOAD(slot, kt) do { int _t = tl; asm volatile("" : "+v"(_t)); _Pragma("unroll") for (int i = 0; i < 4; ++i) { const int pz = _t + 512 * i; rg[slot][i] = al(pz >> 4, (kt) * 128 + (pz & 15) * 8); } \
        _Pragma("unroll") for (int i = 0; i < 2; ++i) { const int pz = _t + 512 * i; rg[slot][4 + i] = bl(pz >> 4, (kt) * 128 + (pz & 15) * 8); } } while (0)
#define CH_STEP(slot, kt) do { __syncthreads(); \
        _Pragma("unroll") for (int i = 0; i < 4; ++i) { const int pz = tl + 512 * i; const LAS float* wp = wtab + (pz & 15) * 8; const f32x4 w0 = *(const LAS f32x4*)wp, w1 = *(const LAS f32x4*)(wp + 4); \
            *(LAS u32x4*)(lds + (pz >> 4) * 272 + (pz & 15) * 16) = gt::scale8(rg[slot][i], w0[0], w0[1], w0[2], w0[3], w1[0], w1[1], w1[2], w1[3]); } \
        _Pragma("unroll") for (int i = 0; i < 2; ++i) { const int pz = tl + 512 * i; *(LAS u32x4*)(lds + 128 * 272 + (pz >> 4) * 272 + (pz & 15) * 16) = rg[slot][4 + i]; } \
        __syncthreads(); if ((kt) + 3 < 33) CH_LOAD(slot, (kt) + 3); pre(kt, acc); gt::compute_tile<1, 128>(acc, lds, tl); post(kt, acc); } while (0)
            CH_LOAD(0, 0); CH_LOAD(1, 1); CH_LOAD(2, 2);
            for (int kt = 0; kt < 33; kt += 3) { CH_STEP(0, kt); CH_STEP(1, kt + 1); CH_STEP(2, kt + 2); }
            __syncthreads();
#undef CH_LOAD
#undef CH_STEP
        }
    }
    }
    GRID_BAR();
    STAMP(3);

    { DECL_PTRS
    {
        typedef float f32x16 __attribute__((ext_vector_type(16)));
        constexpr int CPB = 16448, ZOFF = 4 * CPB, ROWB = 10256, PADB = 992;
        for (int i = tid; i < (8 * ROWB) / 16; i += 512) *(LAS u32x4*)(lds + ZOFF + i * 16) = (u32x4){0u, 0u, 0u, 0u};
        __syncthreads();
        u32x4 zr[8], tv0[2], tv1[2];
#define CV_FETCH(cc) do { int _t = tid; asm volatile("" : "+v"(_t)); const bf16_t* _z = ZT + (size_t)(cc) * 8 * SEQ; const bf16_t* _tr = TR + (size_t)(cc) * 8192; \
        _Pragma("unroll") for (int i = 0; i < 8; ++i) { const int q = _t + 512 * i; zr[i] = *(const u32x4*)(_z + (size_t)(q >> 9) * SEQ + (q & 511) * 8); } \
        _Pragma("unroll") for (int i = 0; i < 2; ++i) { const int u = _t + 512 * i; tv0[i] = *(const u32x4*)(_tr + 8 * u); tv1[i] = (u32x4){0u, 0u, 0u, 0u}; if (u < 1023) tv1[i] = *(const u32x4*)(_tr + 8 * u + 8); } } while (0)
        if (bid < 512) CV_FETCH(bid);
        for (int c = bid; c < 512; c += G) {
            int tl = tid; asm volatile("" : "+v"(tl));
            const int w = tl >> 6, l = tl & 63, col = l & 31, hh = l >> 5, Rl = col >> 3, nn = col & 7;
            bf16_t* zc = ZT + (size_t)c * 8 * SEQ;
#pragma unroll
            for (int i = 0; i < 8; ++i) { const int q = tl + 512 * i, n = q >> 9, off = (q & 511) * 8; *(LAS u32x4*)(lds + ZOFF + n * ROWB + PADB + off * 2) = zr[i]; }
#pragma unroll
            for (int i = 0; i < 2; ++i) { const int u = tl + 512 * i; const u32x4 v0 = tv0[i], v1 = tv1[i];
                const unsigned W0 = v0.x, W1 = v0.y, W2 = v0.z, W3 = v0.w, W4 = v1.x, W5 = v1.y;
                *(LAS u32x4*)(lds + 0 * CPB + 16 * u) = v0;
                *(LAS u32x4*)(lds + 1 * CPB + 16 * u) = (u32x4){(W0 >> 16) | (W1 << 16), (W1 >> 16) | (W2 << 16), (W2 >> 16) | (W3 << 16), (W3 >> 16) | (W4 << 16)};
                *(LAS u32x4*)(lds + 2 * CPB + 16 * u) = (u32x4){W1, W2, W3, W4};
                *(LAS u32x4*)(lds + 3 * CPB + 16 * u) = (u32x4){(W1 >> 16) | (W2 << 16), (W2 >> 16) | (W3 << 16), (W3 >> 16) | (W4 << 16), (W4 >> 16) | (W5 << 16)}; }
            __syncthreads();
            if (c + G < 512) CV_FETCH(c + G);
            const int dlo = 32 * w - 255;
            const int e0 = 4096 - 16 * dlo - col + 8 * hh;
            int aaddr = (e0 & 3) * CPB + 2 * (e0 & ~3);
            int baddr = ZOFF + nn * ROWB + PADB + 2 * (512 * w + 64 * Rl + 8 * hh - 16 * dlo);
            f32x16 acc[4];
#pragma unroll
            for (int q = 0; q < 4; ++q)
#pragma unroll
                for (int i = 0; i < 16; ++i) acc[q][i] = 0.f;
            u32x2 alo = *(const LAS u32x2*)(lds + aaddr), ahi = *(const LAS u32x2*)(lds + aaddr + 8);
            u32x4 bq[4];
#pragma unroll
            for (int q = 0; q < 4; ++q) bq[q] = *(const LAS u32x4*)(lds + baddr + 512 * (q >> 1) + 64 * (q & 1));
            for (int it = 0; it < 285; ++it) {
                aaddr -= 32; baddr -= 32;
                const u32x2 nlo = *(const LAS u32x2*)(lds + aaddr), nhi = *(const LAS u32x2*)(lds + aaddr + 8);
                u32x4 nb[4];
#pragma unroll
                for (int q = 0; q < 4; ++q) nb[q] = *(const LAS u32x4*)(lds + baddr + 512 * (q >> 1) + 64 * (q & 1));
                const bf16x8 af = __builtin_bit_cast(bf16x8, (u32x4){alo.x, alo.y, ahi.x, ahi.y});
#pragma unroll
                for (int q = 0; q < 4; ++q) acc[q] = __builtin_amdgcn_mfma_f32_32x32x16_bf16(af, __builtin_bit_cast(bf16x8, bq[q]), acc[q], 0, 0, 0);
                alo = nlo; ahi = nhi;
#pragma unroll
                for (int q = 0; q < 4; ++q) bq[q] = nb[q];
            }
            {
                const bf16x8 af = __builtin_bit_cast(bf16x8, (u32x4){alo.x, alo.y, ahi.x, ahi.y});
#pragma unroll
                for (int q = 0; q < 4; ++q) acc[q] = __builtin_amdgcn_mfma_f32_32x32x16_bf16(af, __builtin_bit_cast(bf16x8, bq[q]), acc[q], 0, 0, 0);
            }
            const float skip = a.in[I_HSKIP][c];
#pragma unroll
            for (int q = 0; q < 4; ++q)
#pragma unroll
                for (int gq = 0; gq < 4; ++gq) {
                    const int t0 = 512 * w + 256 * (q >> 1) + 32 * (q & 1) + 64 * Rl + 8 * gq + 4 * hh;
                    const u32x2 zz = *(const LAS u32x2*)(lds + ZOFF + nn * ROWB + PADB + 2 * t0);
                    u32x2 o; o.x = pk2(acc[q][4 * gq] + skip * bflo(zz.x), acc[q][4 * gq + 1] + skip * bfhi(zz.x)); o.y = pk2(acc[q][4 * gq + 2] + skip * bflo(zz.y), acc[q][4 * gq + 3] + skip * bfhi(zz.y));
                    *(u32x2*)(zc + (size_t)nn * SEQ + t0) = o;
                }
            __syncthreads();
        }
    }
    }
    GRID_BAR();
    STAMP(4);

    { DECL_PTRS
    {
        LAS unsigned char* Pl = lds + 104448;
        LAS float* sfb = (LAS float*)(lds + 104448 + 128 * 272);
        LAS float* rsum = sfb + 256;
        LAS bf16_t* ot = (LAS bf16_t*)lds;
        for (int u = bid; u < 1024; u += G) {
            int tl = tid; asm volatile("" : "+v"(tl));
            const int wr = tl >> 8, wc = (tl >> 6) & 3, fr = tl & 15, fq = (tl >> 4) & 3;
            const int bh = u >> 5, c = u & 31, b = bh >> 2, h = bh & 3, row0 = b * SEQ + c * 128;
            const float lgf = lg2_decay(a.in[I_DECAY][h]), lgb = lg2_decay(a.in[I_DECAY][4 + h]);
            if (tl < 128) sfb[tl] = exp2f((float)(tl + 1) * lgf); else if (tl < 256) sfb[tl] = exp2f((float)(128 - (tl - 128)) * lgb);
            {
                f32x4 sacc[4][2];
#pragma unroll
                for (int m = 0; m < 4; ++m)
#pragma unroll
                    for (int n = 0; n < 2; ++n) sacc[m][n] = (f32x4){0.f, 0.f, 0.f, 0.f};
                gt::gemm_tile<2, 128>(sacc, gt::LdRows{Qb + (size_t)row0 * 512 + h * 128, 512}, gt::LdRows{Kb + (size_t)row0 * 512 + h * 128, 512}, 1, lds, tl);
#pragma unroll
                for (int m = 0; m < 4; ++m)
#pragma unroll
                    for (int n = 0; n < 2; ++n)
#pragma unroll
                        for (int j = 0; j < 4; ++j) { const int i = wr * 64 + m * 16 + 4 * fq + j, jj = wc * 32 + n * 16 + fr, df = i - jj;
                            const float dcy = df >= 0 ? exp2f((float)df * lgf) : exp2f((float)(-df) * lgb);
                            *(LAS bf16_t*)(Pl + i * 272 + jj * 2) = (bf16_t)f2bf(sacc[m][n][j] * dcy); }
                asm volatile("" ::: "memory");
            }
            __syncthreads();
            struct LdA2 { LAS unsigned char* P; const bf16_t* q; const LAS float* sc;
                __device__ __forceinline__ u32x4 operator()(int row, int k) const {
                    if (k < 128) return *(const LAS u32x4*)(P + row * 272 + k * 2);
                    return *(const u32x4*)(q + (size_t)row * 512 + (k < 256 ? k - 128 : k - 256)); } };
            struct TfA2 { const LAS float* sc;
                __device__ __forceinline__ u32x4 operator()(int row, int k, u32x4 v) const { if (k < 128) return v; const float s = sc[k < 256 ? row : 128 + row]; return gt::scale8(v, s, s, s, s, s, s, s, s); } };
            struct LdB2 { const bf16_t* vt; const bf16_t* sf; const bf16_t* sb;
                __device__ __forceinline__ u32x4 operator()(int dv, int k) const {
                    if (k < 128) return *(const u32x4*)(vt + (size_t)dv * 128 + k);
                    if (k < 256) return *(const u32x4*)(sf + (size_t)dv * 128 + (k - 128));
                    return *(const u32x4*)(sb + (size_t)dv * 128 + (k - 256)); } };
            f32x4 acc[4][4];
#pragma unroll
            for (int m = 0; m < 4; ++m)
#pragma unroll
                for (int n = 0; n < 4; ++n) acc[m][n] = (f32x4){0.f, 0.f, 0.f, 0.f};
            const LdA2 al{Pl, Qb + (size_t)row0 * 512 + h * 128, sfb};
            const LdB2 bl{VT + ((size_t)bh * 34 + c) * 256 * 128, KV + ((size_t)(bh * 2 + 0) * 33 + (c + 1)) * 32768, KV + ((size_t)(bh * 2 + 1) * 33 + (32 - c)) * 32768};
            gt::gemm_tile<4, 64>(acc, al, bl, 6, lds, tl, gt::NoHook(), gt::NoHook(), TfA2{sfb});
#pragma unroll
            for (int m = 0; m < 4; ++m)
#pragma unroll
                for (int j = 0; j < 4; ++j) { float s = 0.f;
#pragma unroll
                    for (int n = 0; n < 4; ++n) s += acc[m][n][j] * acc[m][n][j];
                    s += __shfl_xor(s, 1); s += __shfl_xor(s, 2); s += __shfl_xor(s, 4); s += __shfl_xor(s, 8);
                    if (fr == 0) rsum[(wr * 64 + m * 16 + 4 * fq + j) * 4 + wc] = s; }
            __syncthreads();
#pragma unroll
            for (int m = 0; m < 4; ++m)
#pragma unroll
                for (int j = 0; j < 4; ++j) { const int i = wr * 64 + m * 16 + 4 * fq + j; const f32x4 rs = *(const LAS f32x4*)(rsum + i * 4);
                    const float rstd = rsqrtf(((rs[0] + rs[1]) + (rs[2] + rs[3])) * (1.f / 256.f) + EPS);
#pragma unroll
                    for (int n = 0; n < 4; ++n) ot[i * 264 + wc * 64 + n * 16 + fr] = (bf16_t)f2bf(acc[m][n][j] * rstd); }
            __syncthreads();
#pragma unroll
            for (int i = 0; i < 8; ++i) { const int pz = tl + 512 * i, row = pz >> 5, c8 = pz & 31;
                bf16_t* gp = SG + (size_t)(row0 + row) * 1024 + h * 256 + c8 * 8;
                const u32x4 gv = *(const u32x4*)gp, ov = *(const LAS u32x4*)(ot + row * 264 + c8 * 8);
                u32x4 o; o.x = pk2(bflo(gv.x) * bflo(ov.x), bfhi(gv.x) * bfhi(ov.x)); o.y = pk2(bflo(gv.y) * bflo(ov.y), bfhi(gv.y) * bfhi(ov.y)); o.z = pk2(bflo(gv.z) * bflo(ov.z), bfhi(gv.z) * bfhi(ov.z)); o.w = pk2(bflo(gv.w) * bflo(ov.w), bfhi(gv.w) * bfhi(ov.w));
                *(u32x4*)gp = o; }
            __syncthreads();
        }
    }
    for (int it = bid; it < 512; it += G) {
        const int b = it >> 6, tt = (it >> 3) & 7, cc = it & 7;
        LAS bf16_t* yt = (LAS bf16_t*)lds;
#pragma unroll
        for (int i = 0; i < 8; ++i) { const int ch = wave * 8 + i; *(LAS u32x4*)(yt + ch * 520 + lane * 8) = *(const u32x4*)(ZT + ((size_t)(cc * 64 + ch) * 8 + b) * SEQ + tt * 512 + lane * 8); }
        __syncthreads();
        { int tl = tid; asm volatile("" : "+v"(tl));
          const int tq = tl >> 3, cg = tl & 7, c0 = cc * 64 + cg * 8, t0 = tt * 512 + tq * 8, row0 = b * SEQ + t0;
          float x0[8][8];
          short_conv8x8(HU, row0, t0, c0, a.in[I_HCW], a.in[I_HCB], x0);
          u32x4 yv[8];
#pragma unroll
          for (int e = 0; e < 8; ++e) yv[e] = *(const LAS u32x4*)(yt + (cg * 8 + e) * 520 + tq * 8);
#pragma unroll
          for (int t = 0; t < 8; ++t) { float o[8];
#pragma unroll
              for (int e = 0; e < 8; ++e) { const unsigned wd = (t >> 1) == 0 ? yv[e].x : (t >> 1) == 1 ? yv[e].y : (t >> 1) == 2 ? yv[e].z : yv[e].w; o[e] = x0[t][e] * ((t & 1) ? bfhi(wd) : bflo(wd)); }
              u32x4 w; w.x = pk2(o[0], o[1]); w.y = pk2(o[2], o[3]); w.z = pk2(o[4], o[5]); w.w = pk2(o[6], o[7]);
              *(u32x4*)(HU + (size_t)(row0 + t) * 1536 + 512 + c0) = w; } }
        __syncthreads();
    }
    }
    GRID_BAR();
    STAMP(5);

    { DECL_PTRS
    {
        pg8::Gemm g{(const bf16_t*)XN8, (const bf16_t*)(WTG8 + (size_t)1024 * 1024), 512, 512, 512}; pg8::StaticOrder S; S.init(T, 1024, G, bid);
        pg8::EpiGate E{SGH, a.in[I_BIN] + NINA + 1024, 0.03125f};
        pg8::gemm_phase<pg8::EpiGate, pg8::StaticOrder, false, true>(lds, g, S, E);
    }
    {
        pg8::Gemm g{HU + 512, WT_HYO, 512, 1536, 512}; pg8::StaticOrder S; S.init(T, 1024, G, bid);
        pg8::EpiMerge<0> E{SGH, nullptr};
        pg8::gemm_phase(lds, g, S, E);
    }
    {
        pg8::Gemm g{(const bf16_t*)XN8, (const bf16_t*)WTG8, 512, 512, 512}; pg8::StaticOrder S; S.init(T, 1024, G, bid);
        pg8::EpiGate E{SGR, a.in[I_BIN] + NINA, 0.03125f};
        pg8::gemm_phase<pg8::EpiGate, pg8::StaticOrder, false, true>(lds, g, S, E);
    }
    {
        pg8::Gemm g{SG, WT_RETO, 1024, 1024, 1024}; pg8::StaticOrder S; S.init(T, 1024, G, bid);
        pg8::EpiMerge<1> E{SGR, SGH};
        pg8::gemm_phase(lds, g, S, E);
    }
    __syncthreads();
    {
        LAS float* scr = (LAS float*)(lds + wave * 17664);
        constexpr int PER = 16 * 8;
        for (int it = gw; it < NE * 3 * PER; it += NGW) {
            const int e = it / (3 * PER), r3 = it % (3 * PER), which = r3 / PER, r = r3 % PER;
            unsigned char* W13 = (unsigned char*)WE13; unsigned char* W2 = (unsigned char*)WE2;
            if (which == 0) transpose_item_f8(a.in[I_EW1] + (size_t)e * 1024 * 512, 512, 64 * (r / 8), 64 * (r % 8), W13 + (size_t)e * 1024 * 1024, 1024, RmE13{0}, 32.f, scr, lane);
            else if (which == 1) transpose_item_f8(a.in[I_EW3] + (size_t)e * 1024 * 512, 512, 64 * (r / 8), 64 * (r % 8), W13 + (size_t)e * 1024 * 1024, 1024, RmE13{128}, 32.f, scr, lane);
            else transpose_item_f8(a.in[I_EW2] + (size_t)e * 512 * 1024, 1024, 64 * (r / 16), 64 * (r % 16), W2 + (size_t)e * 1024 * 512, 512, RmId{}, 32.f, scr, lane);
        }
    }
    }
    GRID_BAR();
    STAMP(6);
    STAMP(7);
    STAMP(8);
    { DECL_PTRS
    {
        pg8::Gemm g{SGR, WT_OUT, 1024, 1024, 1024}; pg8::StaticOrder S; S.init(T, 1024, G, bid);
        pg8::EpiX1 E{a.in[I_X], MOD, X1};
        pg8::gemm_phase(lds, g, S, E);
    }
    }
    GRID_BAR();
    STAMP(9);

    { DECL_PTRS
    {
        LAS float* Wl = (LAS float*)lds;
#pragma unroll
        for (int i = 0; i < 18; ++i) { const int q = tid + 512 * i, k = q / 9, p4 = q % 9;
            const f32x4 v = p4 == 0 ? *(const f32x4*)(a.in[I_RGW] + k * 4) : *(const f32x4*)(a.in[I_REW] + k * 32 + (p4 - 1) * 4);
            *(LAS f32x4*)(Wl + k * 36 + p4 * 4) = v; }
        __syncthreads();
        unsigned char* H2 = (unsigned char*)SG;
        LAS float* Sw = (LAS float*)(lds + 147456 + wave * 1152);
        LAS int* lcnt = (LAS int*)(lds + 147456 + 9216);
        if (tid < NE) lcnt[tid] = 0;
        __syncthreads();
        for (int rb = gw; rb < T / 16; rb += NGW) {
            int ll = lane; asm volatile("" : "+v"(ll));
            const int r = ll & 15, kq = ll >> 4, row = rb * 16 + r, b = (rb * 16) >> 12;
            const float* md = MOD + (size_t)b * 6144; const bf16_t* xr = X1 + (size_t)row * D + 4 * kq;
            float s = 0.f;
#pragma unroll 16
            for (int i = 0; i < 64; ++i) { const u32x2 xw = *(const u32x2*)(xr + 16 * i); const f32x4 xv = (f32x4){bflo(xw.x), bfhi(xw.x), bflo(xw.y), bfhi(xw.y)}; s += (xv[0] * xv[0] + xv[1] * xv[1]) + (xv[2] * xv[2] + xv[3] * xv[3]); }
            s += __shfl_xor(s, 16); s += __shfl_xor(s, 32);
            const float rstd = rsqrtf(s * (1.f / D) + EPS);
            f32x4 lacc[3];
#pragma unroll
            for (int ct = 0; ct < 3; ++ct) lacc[ct] = (f32x4){0.f, 0.f, 0.f, 0.f};
            const int c0 = ll & 15, c2 = (32 + c0) < 36 ? 32 + c0 : 35;
#pragma unroll 4
            for (int i = 0; i < 64; ++i) {
                const int k0 = 16 * i + 4 * kq;
                const u32x2 xw = *(const u32x2*)(xr + 16 * i); const f32x4 xv = (f32x4){bflo(xw.x), bfhi(xw.x), bflo(xw.y), bfhi(xw.y)}, gv = *(const f32x4*)(a.in[I_N2G] + k0), sc = *(const f32x4*)(md + 4096 + k0), sh = *(const f32x4*)(md + 3072 + k0);
                const f32x4 hv = (xv * rstd * gv) * (sc + 1.f) + sh;
                *(unsigned*)(H2 + (size_t)row * D + k0) = pk_fp8x4(hv[0], hv[1], hv[2], hv[3]);
#pragma unroll
                for (int e = 0; e < 4; ++e) { const LAS float* wr_ = Wl + (k0 + e) * 36;
                    lacc[0] = __builtin_amdgcn_mfma_f32_16x16x4f32(hv[e], wr_[c0], lacc[0], 0, 0, 0);
                    lacc[1] = __builtin_amdgcn_mfma_f32_16x16x4f32(hv[e], wr_[16 + c0], lacc[1], 0, 0, 0);
                    lacc[2] = __builtin_amdgcn_mfma_f32_16x16x4f32(hv[e], wr_[c2], lacc[2], 0, 0, 0); }
            }
#pragma unroll
            for (int hf = 0; hf < 2; ++hf) {
                if ((kq >> 1) == hf) {
#pragma unroll
                    for (int j = 0; j < 4; ++j) { LAS float* sp = Sw + (4 * (kq & 1) + j) * 36 + c0; sp[0] = lacc[0][j]; sp[16] = lacc[1][j]; if (c0 < 4) sp[32] = lacc[2][j]; }
                }
                asm volatile("s_waitcnt lgkmcnt(0)" ::: "memory");
                if (ll < 8) {
                    const int rrow = rb * 16 + 8 * hf + ll;
                    float lg[36];
#pragma unroll
                    for (int q = 0; q < 9; ++q) { const f32x4 v = *(const LAS f32x4*)(Sw + ll * 36 + 4 * q); lg[4 * q] = v[0]; lg[4 * q + 1] = v[1]; lg[4 * q + 2] = v[2]; lg[4 * q + 3] = v[3]; }
                    float gl[4];
#pragma unroll
                    for (int j = 0; j < 4; ++j) gl[j] = lg[j] + a.in[I_RGB][j];
                    int gs = 0; float gm = gl[0];
#pragma unroll
                    for (int j = 1; j < 4; ++j) if (gl[j] > gm) { gm = gl[j]; gs = j; }
                    float den = 0.f;
#pragma unroll
                    for (int j = 0; j < 4; ++j) den += expf(gl[j] - gm);
                    const float pstar = 1.f / den;
                    float el[8];
#pragma unroll
                    for (int e = 0; e < 8; ++e) { const float v0 = lg[4 + e], v1 = lg[12 + e], v2 = lg[20 + e], v3 = lg[28 + e]; el[e] = (gs == 0 ? v0 : gs == 1 ? v1 : gs == 2 ? v2 : v3) + a.in[I_REB][gs * 8 + e]; }
                    int e0 = 0; float m0 = el[0];
#pragma unroll
                    for (int e = 1; e < 8; ++e) if (el[e] > m0) { m0 = el[e]; e0 = e; }
                            int e1 = e0 == 0 ? 1 : 0; float m1 = e0 == 0 ? el[1] : el[0];
#pragma unroll
                    for (int e = 1; e < 8; ++e) if (e != e0 && el[e] > m1) { m1 = el[e]; e1 = e; }
                    const float ex = expf(m1 - m0); const float w0 = pstar / (1.f + ex), w1 = pstar * ex / (1.f + ex);
                    const int E0 = gs * 8 + e0, E1 = gs * 8 + e1;
                    const int s0 = __hip_atomic_fetch_add(lcnt + E0, 1, __ATOMIC_RELAXED, __HIP_MEMORY_SCOPE_WORKGROUP), s1 = __hip_atomic_fetch_add(lcnt + E1, 1, __ATOMIC_RELAXED, __HIP_MEMORY_SCOPE_WORKGROUP);
                    int4 ti; ti.x = (E0 << 16) | s0; ti.y = (E1 << 16) | s1; ti.z = __float_as_int(w0); ti.w = __float_as_int(w1);
                    *(int4*)(TOKINFO + (size_t)rrow * 4) = ti;
                }
                asm volatile("s_waitcnt lgkmcnt(0)" ::: "memory");
            }
        }
        __syncthreads();
        if (tid < NE) LISTS[bid * NE + tid] = lcnt[tid];
    }
    }
    GRID_BAR();
    STAMP(10);

    LAS int* tbase = (LAS int*)(lds + MISC_OFF);
    LAS int* texp = tbase + 64;
    int ntiles = 0;
    { DECL_PTRS
    {
        LAS int* ptot = texp + 320;
        LAS int* pbas = ptot + 512; LAS int* total = pbas + 512; LAS int* mybase = total + 32;
        { const int e = tid & 31, part = tid >> 5, per = (G + 15) >> 4; int s = 0, sb = 0;
          for (int b = part * per; b < (part + 1) * per && b < G; ++b) { const int v = LISTS[b * NE + e]; s += v; if (b < bid) sb += v; }
          ptot[part * 32 + e] = s; pbas[part * 32 + e] = sb; }
        __syncthreads();
        if (tid < NE) { int s = 0, sb = 0; for (int q = 0; q < 16; ++q) { s += ptot[q * 32 + tid]; sb += pbas[q * 32 + tid]; } total[tid] = s; mybase[tid] = sb; }
        __syncthreads();
        if (tid == 0) { int acc = 0; for (int e = 0; e < NE; ++e) { tbase[e] = acc; const int nt = (total[e] + 255) >> 8; for (int q = 0; q < nt; ++q) texp[acc + q] = e; acc += nt; } tbase[NE] = acc; }
        __syncthreads();
        ntiles = tbase[NE];
        int* ROWTOK = LISTS + 16384;
        for (int rb = gw; rb < T / 16; rb += NGW) {
            if (lane < 16) { const int row = rb * 16 + lane;
                const int4 ti = *(const int4*)(TOKINFO + (size_t)row * 4);
                const int e0 = ti.x >> 16, e1 = ti.y >> 16;
                const int r0 = tbase[e0] * 256 + mybase[e0] + (ti.x & 0xffff), r1 = tbase[e1] * 256 + mybase[e1] + (ti.y & 0xffff);
                ROWTOK[r0] = row; ROWTOK[r1] = row;
                int4 to = ti; to.x = r0; to.y = r1; *(int4*)(TOKINFO + (size_t)row * 4) = to; }
        }
        if (bid < NE) { const int rlo = tbase[bid] * 256 + total[bid], rhi = tbase[bid + 1] * 256; for (int r = rlo + tid; r < rhi; r += 512) ROWTOK[r] = 0; }
    }
    }
    GRID_BAR();
    STAMP(11);

    { DECL_PTRS
    {
        pg8::Gemm g{SG  , WE13, 512, 512, 512}; pg8::MoeOrder S{ntiles, G, bid, texp};
        pg8::EpiMoe1 E{(unsigned char*)HM};
        pg8::gemm_phase<pg8::EpiMoe1, pg8::MoeOrder, true, true>(lds, g, S, E, LISTS + 16384);
    }
    }
    GRID_BAR();
    STAMP(12);
    { DECL_PTRS
    {
        pg8::Gemm g{HM  , WE2, 256, 256, 256}; pg8::MoeOrder S{ntiles, G, bid, texp};
        pg8::EpiF8 E{(unsigned char*)XB, 1024, 0.5f};
        pg8::gemm_phase<pg8::EpiF8, pg8::MoeOrder, false, true>(lds, g, S, E);
    }
    }
    GRID_BAR();
    STAMP(13);

    { DECL_PTRS
    {
        const bf16_t* YB = XB;
        for (int row = gw; row < T; row += NGW) {
            const int b = row >> 12; const float* gt2 = MOD + (size_t)b * 6144 + 5120;
            const int4 ti = *(const int4*)(TOKINFO + (size_t)row * 4);
            const size_t r0 = (size_t)ti.x, r1 = (size_t)ti.y;
            const float w0 = __int_as_float(ti.z) * 0.0625f, w1 = __int_as_float(ti.w) * 0.0625f;
            f32x4 v[4]; float s = 0.f;
#pragma unroll
            for (int j = 0; j < 4; ++j) { const int c0 = 4 * lane + 256 * j;
                const u32x2 xw = *(const u32x2*)(X1 + (size_t)row * D + c0); const f32x4 xv = (f32x4){bflo(xw.x), bfhi(xw.x), bflo(xw.y), bfhi(xw.y)}, gv = *(const f32x4*)(gt2 + c0);
                const int y0 = *(const int*)((const unsigned char*)YB + r0 * D + c0), y1 = *(const int*)((const unsigned char*)YB + r1 * D + c0);
                f32x4 mo;
                mo[0] = w0 * __builtin_amdgcn_cvt_f32_fp8(y0, 0) + w1 * __builtin_amdgcn_cvt_f32_fp8(y1, 0); mo[1] = w0 * __builtin_amdgcn_cvt_f32_fp8(y0, 1) + w1 * __builtin_amdgcn_cvt_f32_fp8(y1, 1);
                mo[2] = w0 * __builtin_amdgcn_cvt_f32_fp8(y0, 2) + w1 * __builtin_amdgcn_cvt_f32_fp8(y1, 2); mo[3] = w0 * __builtin_amdgcn_cvt_f32_fp8(y0, 3) + w1 * __builtin_amdgcn_cvt_f32_fp8(y1, 3);
                v[j] = xv + gv * mo; s += (v[j][0] * v[j][0] + v[j][1] * v[j][1]) + (v[j][2] * v[j][2] + v[j][3] * v[j][3]); }
            const float rstd = rsqrtf(wave_sum(s) * (1.f / D) + EPS);
#pragma unroll
            for (int j = 0; j < 4; ++j) { const int c0 = 4 * lane + 256 * j; const f32x4 fg = *(const f32x4*)(a.in[I_FNG] + c0); *(f32x4*)(a.out + (size_t)row * D + c0) = v[j] * rstd * fg; }
        }
    }
    }
    STAMP(14);
    if (PROBE_PHASE >= 0 && blockIdx.x == 0 && threadIdx.x == 0) { const unsigned long long t0_ = __builtin_amdgcn_s_memrealtime(); while (__builtin_amdgcn_s_memrealtime() - t0_ < spin_) __builtin_amdgcn_s_sleep(8); }
}

extern "C" void kernel_launch(void* const* d_in, const int* in_sizes, int n_in, void* d_out, int out_size, void* d_ws, size_t ws_size, hipStream_t stream) {
    static int grid = 0;
    if (grid == 0) {
        if (n_in != 31 || out_size != T * D || ws_size < WS_END) { fprintf(stderr, "kernel_launch: unexpected shapes: n_in %d out %d ws %zu (need %zu)\n", n_in, out_size, ws_size, (size_t)WS_END); grid = -1; return; }
        int dev = 0, cus = 0, per_cu = 0;
        if (hipGetDevice(&dev) != hipSuccess || hipDeviceGetAttribute(&cus, hipDeviceAttributeMultiprocessorCount, dev) != hipSuccess) { grid = -1; return; }
        if (hipFuncSetAttribute((const void*)fwd_kernel, hipFuncAttributeMaxDynamicSharedMemorySize, LDS_BYTES) != hipSuccess) { fprintf(stderr, "kernel_launch: hipFuncSetAttribute failed\n"); grid = -1; return; }
        if (hipOccupancyMaxActiveBlocksPerMultiprocessor(&per_cu, (const void*)fwd_kernel, 512, LDS_BYTES) != hipSuccess || per_cu < 1) { fprintf(stderr, "kernel_launch: occupancy query says %d blocks per CU\n", per_cu); grid = -1; return; }
        grid = cus;
        fprintf(stderr, "kernel_launch: cus %d per_cu %d grid %d ws %zu\n", cus, per_cu, grid, ws_size);
    }
    if (grid < 0) return;
    Args a{};
    for (int i = 0; i < 31; ++i) a.in[i] = (const float*)d_in[i];
    a.out = (float*)d_out; a.ws = (unsigned char*)d_ws;
    void* args[] = {&a};
    const hipError_t e = hipLaunchCooperativeKernel((const void*)fwd_kernel, dim3(grid), dim3(512), args, LDS_BYTES, stream);
    if (e != hipSuccess) fprintf(stderr, "kernel_launch: cooperative launch failed: %s (grid %d)\n", hipGetErrorString(e), grid);
}
```

```cpp
#ifndef PROBE_PHASE
#define PROBE_PHASE -1
#endif
#ifndef REPMASK
#define REPMASK 0
#endif
#include <hip/hip_runtime.h>
#include <hip/hip_cooperative_groups.h>
#include <cstdio>
#include <cstdint>
namespace cg = cooperative_groups;

#define LAS __attribute__((address_space(3)))
typedef unsigned short bf16_t;
typedef short bf16x8 __attribute__((ext_vector_type(8)));
typedef float f32x4 __attribute__((ext_vector_type(4)));
typedef unsigned u32x4 __attribute__((ext_vector_type(4)));
typedef unsigned u32x2 __attribute__((ext_vector_type(2)));

constexpr int BATCH = 8, SEQ = 4096, D = 1024, T = BATCH * SEQ, CTXL = 256, TC = BATCH * CTXL, MT = T + TC;
constexpr int NH = 4, DK = 128, DV = 256, TOKP = SEQ + CTXL;
constexpr int NINA = 4608;
constexpr int NE = 32, EH = 512;
constexpr float EPS = 1e-6f;
constexpr int LDS_BYTES = 163840;
constexpr int MISC_OFF = 131072;

constexpr size_t MiB = 1u << 20;
constexpr size_t WS_CTL = 0, CTL_BYTES = 65536;
constexpr size_t WS_MOD = 65536;
constexpr size_t WS_ROPE = 327680;
constexpr size_t WS_BINP = 344064;
constexpr size_t WS_FPART = 524288;
constexpr size_t WS_TOKINFO = 2 * MiB;
constexpr size_t WS_LISTS = 3 * MiB;
constexpr size_t WS_TR = 8 * MiB;
constexpr size_t WS_WT_IN = 16 * MiB;
constexpr size_t WS_WT_RETO = 29 * MiB, WS_WT_HYO = 31 * MiB, WS_WT_OUT = 32 * MiB;
constexpr size_t WS_R1 = 34 * MiB;
constexpr size_t WS_Q = WS_R1, WS_K = WS_R1 + 32 * MiB, WS_KT = WS_R1 + 66 * MiB, WS_VT = WS_R1 + 100 * MiB;
constexpr size_t WS_FILT = WS_R1;
constexpr size_t WS_SGR = WS_R1, WS_SGH = WS_R1 + 64 * MiB;
constexpr size_t WS_XB = WS_R1;
constexpr size_t WS_SG = 202 * MiB;
constexpr size_t WS_HU = 266 * MiB;
constexpr size_t WS_KV = 362 * MiB;
constexpr size_t WS_WE13 = 428 * MiB, WS_WE2 = 460 * MiB;
constexpr size_t WS_X1 = 106 * MiB;
constexpr size_t WS_END = 494 * MiB;
constexpr size_t DO_XN = 0, DO_ZT = 64 * MiB, DO_XN8 = 96 * MiB;

__device__ __forceinline__ unsigned cvt_pk_bf16(float lo, float hi) { unsigned r; asm("s_nop 0\n\tv_cvt_pk_bf16_f32 %0, %1, %2" : "=v"(r) : "v"(lo), "v"(hi)); return r; }
__device__ __forceinline__ unsigned f2bf(float f) { return cvt_pk_bf16(f, f) & 0xffffu; }
__device__ __forceinline__ unsigned pk2(float lo, float hi) { return cvt_pk_bf16(lo, hi); }
__device__ __forceinline__ float bflo(unsigned w) { return __uint_as_float(w << 16); }
__device__ __forceinline__ float bfhi(unsigned w) { return __uint_as_float(w & 0xffff0000u); }
__device__ __forceinline__ float bf2f(bf16_t h) { return __uint_as_float((unsigned)h << 16); }
__device__ __forceinline__ float silu_f(float v) { return v * __builtin_amdgcn_rcpf(1.f + __expf(-v)); }
__device__ __forceinline__ float sigm_f(float v) { return __builtin_amdgcn_rcpf(1.f + __expf(-v)); }
__device__ __forceinline__ float wave_sum(float v) {
    v += __int_as_float(__builtin_amdgcn_update_dpp(0, __float_as_int(v), 0xB1, 0xf, 0xf, true));
    v += __int_as_float(__builtin_amdgcn_update_dpp(0, __float_as_int(v), 0x4E, 0xf, 0xf, true));
    v += __int_as_float(__builtin_amdgcn_update_dpp(0, __float_as_int(v), 0x124, 0xf, 0xf, true));
    v += __int_as_float(__builtin_amdgcn_update_dpp(0, __float_as_int(v), 0x128, 0xf, 0xf, true));
    const int vi = __float_as_int(v);
    return (__int_as_float(__builtin_amdgcn_readlane(vi, 0)) + __int_as_float(__builtin_amdgcn_readlane(vi, 16))) + (__int_as_float(__builtin_amdgcn_readlane(vi, 32)) + __int_as_float(__builtin_amdgcn_readlane(vi, 48)));
}
__host__ __device__ __forceinline__ int dimperm(int p) { const int wc = p >> 5, fq = (p >> 3) & 3, n = (p >> 2) & 1, e = p & 3; return 64 * (wc >> 1) + 32 * n + 16 * (wc & 1) + 4 * fq + e; }
__host__ __device__ __forceinline__ int inv_dimperm(int d) { const int half = d >> 6, n = (d >> 5) & 1, idx = d & 31; return 32 * (2 * half + (idx >> 4)) + 8 * ((idx >> 2) & 3) + 4 * n + (idx & 3); }
__host__ __device__ __forceinline__ int win_destrow(int n) { return n < 1024 ? (n & ~127) + inv_dimperm(n & 127) : n; }

namespace pg8 {
constexpr int BM = 256, BK = 64, HALF = 128, HTB = HALF * BK * 2, STAGE_BYTES = 8 * HTB, NXCD = 8, WGM = 8;
__host__ __device__ __forceinline__ int lds_byte(int r, int c) { const int st = (r >> 4) * 2 + (c >> 5), rr = r & 15, cc = c & 31, ob = rr * 64 + cc * 2; return st * 1024 + (ob ^ (((ob >> 9) & 1) << 5)); }
__host__ __device__ __forceinline__ void stage_rc(int b, int& R, int& C) { const int st = b / 1024, sb = b % 1024, swz = sb ^ (((sb >> 9) & 1) << 5); R = (st >> 1) * 16 + swz / 64; C = (st & 1) * 32 + (swz % 64) / 2; }
__host__ __device__ __forceinline__ int perm32(int rho) { const int n = rho >> 4, i = rho & 15; return 8 * (i >> 2) + 4 * n + (i & 3); }

struct Unit { int pm, pn, pc; };
struct Gemm { const bf16_t* A; const bf16_t* Bt; int K, lda, ldb; };

struct StaticOrder {
    int nM, nN, nwg, G, c;
    __device__ void init(int M, int N, int G_, int c_) { nM = M / BM; nN = N / BM; nwg = nM * nN; G = G_; c = c_; }
    __device__ bool next(int i, Unit& u) const {
        const long L = (long)i * G + c; if (L >= nwg) return false;
        int wgid = (int)L; { const int q = nwg / NXCD, r = nwg % NXCD, xcd = wgid % NXCD, off = wgid / NXCD; wgid = (xcd < r ? xcd * (q + 1) : r * (q + 1) + (xcd - r) * q) + off; }
        const int nig = WGM * nN, gid = wgid / nig, fm = gid * WGM, gsz = (nM - fm) < WGM ? (nM - fm) : WGM;
        u.pm = fm + ((wgid % nig) % gsz); u.pn = (wgid % nig) / gsz; u.pc = u.pn; return true;
    }
};
struct InProjOrder {
    StaticOrder so; int G, c;
    __device__ void init(int G_, int c_) { so.init(T, NINA, G_, c_); G = G_; c = c_; }
    __device__ bool next(int i, Unit& u) const {
        const long L = (long)i * G + c;
        if (L < so.nwg) return so.next(i, u);
        const int l = (int)(L - so.nwg); if (l >= 48) return false;
        u.pm = 128 + (l & 7); u.pn = 2 + (l >> 3); u.pc = u.pn; return true;
    }
};
struct MoeOrder {
    int ntiles, G, c; const LAS int* texp;
    __device__ bool next(int i, Unit& u) const {
        const long L = (long)i * G + c; if (L >= (long)ntiles * 4) return false;
        const int full = (ntiles >> 3) * 32, l = (int)L;
        if (l < full) { u.pm = (l >> 5) * 8 + (l & 7); u.pc = (l & 31) >> 3; } else { u.pm = (ntiles & ~7) + ((l - full) >> 2); u.pc = (l - full) & 3; }
        u.pn = texp[u.pm] * 4 + u.pc; return true;
    }
};


typedef int v8i __attribute__((ext_vector_type(8)));
__device__ __forceinline__ unsigned pk_fp8x4(float a, float b, float c, float d) { a = __builtin_amdgcn_fmed3f(a, -448.f, 448.f); b = __builtin_amdgcn_fmed3f(b, -448.f, 448.f); c = __builtin_amdgcn_fmed3f(c, -448.f, 448.f); d = __builtin_amdgcn_fmed3f(d, -448.f, 448.f);
    int w = 0; w = __builtin_amdgcn_cvt_pk_fp8_f32(a, b, w, false); w = __builtin_amdgcn_cvt_pk_fp8_f32(c, d, w, true); return (unsigned)w; }
template <class Epi, class Sched, bool GATHER = false, bool FP8 = false>
__device__ __forceinline__ void gemm_phase(LAS unsigned char* lds, const Gemm g, const Sched& S, const Epi& E, const int* rowidx = nullptr) {
    int tid = threadIdx.x; asm volatile("" : "+v"(tid));
    const int wid = __builtin_amdgcn_readfirstlane(tid >> 6), lane = tid & 63, wr = wid >> 2, wc = wid & 3, fr = lane & 15, fq = lane >> 4;
    const int K = g.K; int nt = K / BK; asm volatile("" : "+s"(nt));
    int Ra[2], Ca[2]; unsigned voffA[2], voffB[2];
#pragma unroll
    for (int i = 0; i < 2; ++i) { int R, C; stage_rc(tid * 16 + i * 8192, R, C); const int Rb = Epi::PERM ? ((R & ~31) + perm32(R & 31)) : R;
        Ra[i] = R; Ca[i] = C; voffA[i] = (unsigned)(R * g.lda + C) * 2u; voffB[i] = (unsigned)(Rb * g.ldb + C) * 2u; }
    const size_t hstepA = (size_t)HALF * g.lda * 2, tstepA = 2 * hstepA;
    const size_t kstep = (size_t)(BK * 2);
    const size_t hstepB = (size_t)HALF * g.ldb * 2, tstepB = 2 * hstepB;
    const unsigned ldsw = (unsigned)wid * 1024u;
    const int aoff = lds_byte(wr * 64 + fr, fq * 8), boff = lds_byte(wc * 32 + fr, fq * 8);
#define PG8_AOFF(dst, u) do { _Pragma("unroll") for (int _h = 0; _h < 2; ++_h) _Pragma("unroll") for (int _i = 0; _i < 2; ++_i) { int _row = (u).pm * BM + _h * HALF + Ra[_i]; if (GATHER) _row = rowidx[_row]; \
        dst[_h][_i] = (unsigned)(_row * g.lda + Ca[_i]) * 2u; } } while (0)
#define PG8_SA(b, h) (((b) * 2 + (h)) * HTB)
#define PG8_SB(b, h) ((4 + (b) * 2 + (h)) * HTB)
#define PG8_STAGE(bufoff, gbase, voff) do { _Pragma("unroll") for (int _i = 0; _i < 2; ++_i) \
        __builtin_amdgcn_global_load_lds((const unsigned*)((const char*)(gbase) + (voff)[_i]), (LAS unsigned*)(lds + (bufoff) + ldsw + _i * 8192), 16, 0, 0); } while (0)
#define PG8_STAGE_A(bufoff, ubase, vsel, h, kb) do { if constexpr (GATHER) { PG8_STAGE(bufoff, gA + (kb), (vsel)[h]); } else { PG8_STAGE(bufoff, (ubase) + (size_t)(h) * hstepA + (kb), voffA); } } while (0)
#define PG8_LD8(p) ({ const u32x4 _lo = *(const LAS u32x4*)(p), _hi = *(const LAS u32x4*)((p) + 1024); v8i _r; _r[0] = (int)_lo.x; _r[1] = (int)_lo.y; _r[2] = (int)_lo.z; _r[3] = (int)_lo.w; _r[4] = (int)_hi.x; _r[5] = (int)_hi.y; _r[6] = (int)_hi.z; _r[7] = (int)_hi.w; _r; })
#define PG8_LDA(dst, b, h) do { _Pragma("unroll") for (int m = 0; m < 4; ++m) dst[m] = PG8_LD8(lds + PG8_SA(b, h) + aoff + m * 2048); } while (0)
#define PG8_LDB(dst, b, h) do { _Pragma("unroll") for (int n = 0; n < 2; ++n) dst[n] = PG8_LD8(lds + PG8_SB(b, h) + boff + n * 2048); } while (0)
#define PG8_LO(v) __builtin_bit_cast(bf16x8, __builtin_shufflevector(v, v, 0, 1, 2, 3))
#define PG8_HI(v) __builtin_bit_cast(bf16x8, __builtin_shufflevector(v, v, 4, 5, 6, 7))
#define PG8_MMA(ai, bj, At, Bt) do { __builtin_amdgcn_s_setprio(1); _Pragma("unroll") for (int m = 0; m < 4; ++m) _Pragma("unroll") for (int n = 0; n < 2; ++n) { \
        if constexpr (FP8) { asm volatile("v_mfma_scale_f32_16x16x128_f8f6f4 %0, %1, %2, %0, %3, %3 op_sel_hi:[0,0,0]" : "+v"(acc[ai][bj][m][n]) : "v"(Bt[n]), "v"(At[m]), "v"(one_scale)); } \
        else { acc[ai][bj][m][n] = __builtin_amdgcn_mfma_f32_16x16x32_bf16(PG8_LO(Bt[n]), PG8_LO(At[m]), acc[ai][bj][m][n], 0, 0, 0); \
               acc[ai][bj][m][n] = __builtin_amdgcn_mfma_f32_16x16x32_bf16(PG8_HI(Bt[n]), PG8_HI(At[m]), acc[ai][bj][m][n], 0, 0, 0); } } __builtin_amdgcn_s_setprio(0); } while (0)
#define PG8_WAIT_V(n) asm volatile("s_waitcnt vmcnt(" #n ")" ::: "memory")
#define PG8_WAIT_L(n) asm volatile("s_waitcnt lgkmcnt(" #n ")" ::: "memory")
#define PG8_BAR __builtin_amdgcn_s_barrier()
#define PG8_SCHED __builtin_amdgcn_sched_barrier(0)
    Unit cur, nxt; int ui = 0;
    if (!S.next(0, cur)) return;
    f32x4 acc[2][2][4][2];
#pragma unroll
    for (int a = 0; a < 2; ++a)
#pragma unroll
        for (int b = 0; b < 2; ++b)
#pragma unroll
            for (int m = 0; m < 4; ++m)
#pragma unroll
                for (int n = 0; n < 2; ++n) { acc[a][b][m][n] = (f32x4){0.f, 0.f, 0.f, 0.f}; }
    v8i At[4], B0[2], B1[2];
    int one_scale = 0x7f7f7f7f; asm volatile("" : "+v"(one_scale)); (void)one_scale;
    unsigned vA[2][2], nvA[2][2];
    if constexpr (GATHER) PG8_AOFF(vA, cur);
    const char* gA = (const char*)g.A;
    const char* cA = gA + (size_t)cur.pm * tstepA;
    const char* cB = (const char*)g.Bt + (size_t)cur.pn * tstepB;
    PG8_STAGE(PG8_SB(0, 0), cB, voffB); PG8_STAGE(PG8_SB(0, 1), cB + hstepB, voffB); PG8_STAGE_A(PG8_SA(0, 0), cA, vA, 0, 0); PG8_STAGE_A(PG8_SA(0, 1), cA, vA, 1, 0);
    if (wr == 1) PG8_BAR;
    PG8_WAIT_V(2); PG8_BAR;
    PG8_STAGE(PG8_SB(1, 0), cB + kstep, voffB); PG8_STAGE_A(PG8_SA(1, 0), cA, vA, 0, kstep); PG8_STAGE(PG8_SB(1, 1), cB + hstepB + kstep, voffB);
    PG8_WAIT_V(6); PG8_BAR;
    for (;;) {
        const bool has_next = S.next(ui + 1, nxt);
        if constexpr (GATHER) { if (has_next) { PG8_AOFF(nvA, nxt); } else {
#pragma unroll
            for (int h = 0; h < 2; ++h)
#pragma unroll
                for (int i = 0; i < 2; ++i) nvA[h][i] = vA[h][i]; } }
        const char* nA = has_next ? gA + (size_t)nxt.pm * tstepA : cA;
        const char* nB = has_next ? (const char*)g.Bt + (size_t)nxt.pn * tstepB : cB;
#pragma unroll 1
        for (int t = 0; t < nt; t += 2) {
            const bool last = (t == nt - 2);
            const size_t k1 = (size_t)(t + 1) * kstep, k2 = last ? 0 : (size_t)(t + 2) * kstep, k3 = k2 + kstep;
            const char* u2 = last ? nA : cA; const char* b2 = last ? nB : cB + (size_t)(t + 2) * kstep; const char* b3 = b2 + kstep;
            unsigned v2[2][2];
            if constexpr (GATHER) {
#pragma unroll
                for (int h = 0; h < 2; ++h)
#pragma unroll
                    for (int i = 0; i < 2; ++i) v2[h][i] = last ? nvA[h][i] : vA[h][i]; }
            PG8_LDB(B0, 0, 0); PG8_LDB(B1, 0, 1); PG8_SCHED; PG8_LDA(At, 0, 0); PG8_STAGE_A(PG8_SA(1, 1), cA, vA, 1, k1);
            PG8_WAIT_V(8); PG8_WAIT_L(0); PG8_BAR; PG8_MMA(0, 0, At, B0); PG8_MMA(0, 1, At, B1); PG8_BAR; PG8_SCHED;
            PG8_LDA(At, 0, 1); PG8_STAGE(PG8_SB(0, 0), b2, voffB); PG8_STAGE(PG8_SB(0, 1), b2 + hstepB, voffB); PG8_STAGE_A(PG8_SA(0, 0), u2, v2, 0, k2);
            PG8_WAIT_V(8); PG8_WAIT_L(0); PG8_BAR; PG8_MMA(1, 0, At, B0); PG8_MMA(1, 1, At, B1); PG8_BAR; PG8_SCHED;
            PG8_LDB(B0, 1, 0); PG8_LDB(B1, 1, 1); PG8_SCHED; PG8_LDA(At, 1, 0); PG8_STAGE_A(PG8_SA(0, 1), u2, v2, 1, k2);
            PG8_WAIT_V(8); PG8_WAIT_L(0); PG8_BAR; PG8_MMA(0, 0, At, B0); PG8_MMA(0, 1, At, B1); PG8_BAR; PG8_SCHED;
            PG8_LDA(At, 1, 1); PG8_STAGE(PG8_SB(1, 0), b3, voffB); PG8_STAGE(PG8_SB(1, 1), b3 + hstepB, voffB); PG8_STAGE_A(PG8_SA(1, 0), u2, v2, 0, k3);
            PG8_WAIT_V(8); PG8_WAIT_L(0); PG8_BAR; PG8_MMA(1, 0, At, B0); PG8_MMA(1, 1, At, B1); PG8_BAR; PG8_SCHED;
        }
        if (wr == 0) PG8_BAR;
        if constexpr (FP8) { asm volatile("s_nop 15\n\ts_nop 15" ::: "memory");
#pragma unroll
            for (int a_ = 0; a_ < 2; ++a_)
#pragma unroll
                for (int b_ = 0; b_ < 2; ++b_)
#pragma unroll
                    for (int m_ = 0; m_ < 4; ++m_)
#pragma unroll
                        for (int n_ = 0; n_ < 2; ++n_) asm volatile("" : "+v"(acc[a_][b_][m_][n_])); }
        E(acc, cur, wr, wc, fr, fq);
        if (!has_next) break;
#pragma unroll
        for (int a = 0; a < 2; ++a)
#pragma unroll
            for (int b = 0; b < 2; ++b)
#pragma unroll
                for (int m = 0; m < 4; ++m)
#pragma unroll
                    for (int n = 0; n < 2; ++n) { acc[a][b][m][n] = (f32x4){0.f, 0.f, 0.f, 0.f}; }
        cur = nxt; cA = nA; cB = nB; ++ui;
        if constexpr (GATHER) {
#pragma unroll
            for (int h = 0; h < 2; ++h)
#pragma unroll
                for (int i = 0; i < 2; ++i) vA[h][i] = nvA[h][i]; }
        if (wr == 1) PG8_BAR;
    }
    PG8_WAIT_V(0);
    PG8_BAR;
#undef PG8_AOFF
#undef PG8_SA
#undef PG8_SB
#undef PG8_STAGE
#undef PG8_LDA
#undef PG8_LDB
#undef PG8_STAGE_A
#undef PG8_LD8
#undef PG8_LO
#undef PG8_HI
#undef PG8_MMA
#undef PG8_WAIT_V
#undef PG8_WAIT_L
#undef PG8_BAR
#undef PG8_SCHED
}

__device__ __forceinline__ void st_bf4(bf16_t* p, f32x4 v) { u32x2 w; w.x = cvt_pk_bf16(v[0], v[1]); w.y = cvt_pk_bf16(v[2], v[3]); *(u32x2*)p = w; }
__device__ __forceinline__ void st_bf8(bf16_t* p, f32x4 v0, f32x4 v1) { u32x4 w; w.x = cvt_pk_bf16(v0[0], v0[1]); w.y = cvt_pk_bf16(v0[2], v0[3]); w.z = cvt_pk_bf16(v1[0], v1[1]); w.w = cvt_pk_bf16(v1[2], v1[3]); *(u32x4*)p = w; }

struct EpiInA {
    static constexpr bool PERM = true;
    bf16_t *Q, *Kn, *KT, *VT, *SG, *HU; const float* binp; const LAS float* rope;
    __device__ __forceinline__ void operator()(const f32x4 (&acc)[2][2][4][2], const Unit& u, int wr, int wc, int fr, int fq) const {
        const int pc = u.pc, rbase = u.pm * BM + wr * 64 + fr, cbase = pc * BM + wc * 32 + 8 * fq;
        f32x4 bv[2][2];
#pragma unroll
        for (int bj = 0; bj < 2; ++bj)
#pragma unroll
            for (int n = 0; n < 2; ++n) bv[bj][n] = *(const f32x4*)(binp + cbase + bj * HALF + 4 * n);
        const bool lat = u.pm < 128;
        const int bidx = lat ? (u.pm >> 4) : (u.pm - 128);
        if (pc < 4) {
            const bool isk = pc >= 2; const float ks = isk ? 0.08838834764831845f : 1.f;
            const int h0 = (pc & 1) * 2;
#pragma unroll
            for (int ai = 0; ai < 2; ++ai)
#pragma unroll
                for (int m = 0; m < 4; ++m) {
                    const int r = rbase + ai * HALF + m * 16, t = r & 4095;
                    const int tok = lat ? t : 4096 + ((r - T) & 255);
                    f32x4 cs = (f32x4){1.f, 1.f, 1.f, 1.f}, sn = (f32x4){0.f, 0.f, 0.f, 0.f};
                    if (lat) { const int pos = (wc >> 1) ? (t & 63) : (t >> 6); const LAS float* rp = rope + pos * 32 + 16 * (wc & 1) + 4 * fq; cs = *(const LAS f32x4*)rp; sn = *(const LAS f32x4*)(rp + 2048); }
#pragma unroll
                    for (int bj = 0; bj < 2; ++bj) {
                        const f32x4 x1 = acc[ai][bj][m][0] + bv[bj][0], x2 = acc[ai][bj][m][1] + bv[bj][1];
                        const f32x4 o1 = (x1 * cs - x2 * sn) * ks, o2 = (x1 * sn + x2 * cs) * ks;
                        const int col = (pc & 1) * BM + bj * HALF + wc * 32 + 8 * fq;
                        if (!isk) st_bf8(Q + (size_t)r * 512 + col, o1, o2);
                        else {
                            st_bf8(Kn + (size_t)r * 512 + col, o1, o2);
                            bf16_t* kt = KT + (((size_t)((bidx * 4 + h0 + bj) * 34 + (tok >> 7)) * 128 + (wc >> 1) * 64 + (fq & 1) * 32 + ((wc & 1) * 2 + (fq >> 1)) * 4)) * 128 + (tok & 127);
#pragma unroll
                            for (int e = 0; e < 4; ++e) { kt[e * 128] = (bf16_t)f2bf(o1[e]); kt[(16 + e) * 128] = (bf16_t)f2bf(o2[e]); }
                        }
                    }
                }
        } else if (pc < 8) {
            const int h = pc - 4;
#pragma unroll
            for (int ai = 0; ai < 2; ++ai)
#pragma unroll
                for (int m = 0; m < 4; ++m) {
                    const int r = rbase + ai * HALF + m * 16;
                    const int tok = lat ? (r & 4095) : 4096 + ((r - T) & 255);
#pragma unroll
                    for (int bj = 0; bj < 2; ++bj)
#pragma unroll
                        for (int n = 0; n < 2; ++n) {
                            const f32x4 v = acc[ai][bj][m][n] + bv[bj][n];
                            bf16_t* vt = VT + (((size_t)((bidx * 4 + h) * 34 + (tok >> 7)) * 256 + bj * HALF + wc * 32 + 8 * fq + 4 * n)) * 128 + (tok & 127);
#pragma unroll
                            for (int e = 0; e < 4; ++e) vt[e * 128] = (bf16_t)f2bf(v[e]);
                        }
                }
        } else {
            const bool isg = pc < 12;
            bf16_t* O = isg ? SG : HU; const int ldo = isg ? 1024 : 1536; const int c0 = (isg ? pc - 8 : pc - 12) * BM + wc * 32 + 8 * fq;
#pragma unroll
            for (int ai = 0; ai < 2; ++ai)
#pragma unroll
                for (int m = 0; m < 4; ++m) {
                    const int r = rbase + ai * HALF + m * 16;
#pragma unroll
                    for (int bj = 0; bj < 2; ++bj) {
                        f32x4 v0 = acc[ai][bj][m][0] + bv[bj][0], v1 = acc[ai][bj][m][1] + bv[bj][1];
                        if (isg) {
#pragma unroll
                            for (int e = 0; e < 4; ++e) { v0[e] = silu_f(v0[e]); v1[e] = silu_f(v1[e]); } }
                        st_bf8(O + (size_t)r * ldo + c0 + bj * HALF, v0, v1);
                    }
                }
        }
    }
};
struct EpiGate {
    static constexpr bool PERM = true;
    static constexpr float scale = 0.03125f;
    bf16_t* O; const float* bias; bf16_t* H;
    __device__ __forceinline__ void operator()(const f32x4 (&acc)[2][2][4][2], const Unit& u, int wr, int wc, int fr, int fq) const {
        const int rbase = u.pm * BM + wr * 64 + fr, col0 = u.pc * BM + wc * 32 + 8 * fq;
        bf16_t* Ob = u.pm >= 64 ? H - (size_t)16384 * 1024 : O;
        f32x4 bv[2][2];
#pragma unroll
        for (int bj = 0; bj < 2; ++bj)
#pragma unroll
            for (int n = 0; n < 2; ++n) bv[bj][n] = *(const f32x4*)(bias + col0 + bj * HALF + 4 * n);
        const float nscale = -1.4426950408889634f * scale; f32x4 nb[2][2];
#pragma unroll
        for (int bj = 0; bj < 2; ++bj)
#pragma unroll
            for (int n = 0; n < 2; ++n) nb[bj][n] = bv[bj][n] * -1.4426950408889634f;
#pragma unroll
        for (int ai = 0; ai < 2; ++ai)
#pragma unroll
            for (int m = 0; m < 4; ++m) { bf16_t* rowp = Ob + (size_t)(rbase + ai * HALF + m * 16) * 1024 + col0;
#pragma unroll
                for (int bj = 0; bj < 2; ++bj) { f32x4 v0 = acc[ai][bj][m][0] * nscale + nb[bj][0], v1 = acc[ai][bj][m][1] * nscale + nb[bj][1];
#pragma unroll
                    for (int e = 0; e < 4; ++e) { v0[e] = __builtin_amdgcn_rcpf(1.f + __builtin_amdgcn_exp2f(v0[e])); v1[e] = __builtin_amdgcn_rcpf(1.f + __builtin_amdgcn_exp2f(v1[e])); }
                    st_bf8(rowp + bj * HALF, v0, v1); } }
    }
};
template <int MODE, int SHIFT = 0> struct EpiMerge {
    static constexpr bool PERM = true;
    static constexpr float scale = 1.f / (float)(1 << SHIFT);
    bf16_t* O; const bf16_t* P; bf16_t* H;
    static constexpr size_t O8D = WS_KV - WS_SGH;
    template <int A0, int A1>
    __device__ __forceinline__ void batch(const f32x4 (&acc)[2][2][4][2], int rbase, int col0, bool hi) const {
        bf16_t* Ob = (MODE == 0 && hi) ? H - (size_t)16384 * 1024 : O; const bf16_t* Pb = hi ? H - (size_t)16384 * 1024 : P; unsigned char* O8 = (unsigned char*)const_cast<bf16_t*>(P) + O8D;
        u32x4 gw[A1 - A0][4][2], pw[MODE == 1 ? A1 - A0 : 1][4][2];
#pragma unroll
        for (int ai = A0; ai < A1; ++ai)
#pragma unroll
            for (int m = 0; m < 4; ++m)
#pragma unroll
                for (int bj = 0; bj < 2; ++bj) { const size_t off = (size_t)(rbase + ai * HALF + m * 16) * 1024 + col0 + bj * HALF;
                    gw[ai - A0][m][bj] = *(const u32x4*)(Ob + off); if (MODE == 1) pw[ai - A0][m][bj] = *(const u32x4*)(Pb + off); }
#pragma unroll
        for (int ai = A0; ai < A1; ++ai)
#pragma unroll
            for (int m = 0; m < 4; ++m)
#pragma unroll
                for (int bj = 0; bj < 2; ++bj) { const size_t off = (size_t)(rbase + ai * HALF + m * 16) * 1024 + col0 + bj * HALF;
                    const u32x4 g = gw[ai - A0][m][bj];
                    f32x4 v0 = acc[ai][bj][m][0] * scale, v1 = acc[ai][bj][m][1] * scale;
                    v0[0] *= bflo(g.x); v0[1] *= bfhi(g.x); v0[2] *= bflo(g.y); v0[3] *= bfhi(g.y);
                    v1[0] *= bflo(g.z); v1[1] *= bfhi(g.z); v1[2] *= bflo(g.w); v1[3] *= bfhi(g.w);
                    if (MODE == 1) { const u32x4 q = pw[ai - A0][m][bj];
                        v0[0] += bflo(q.x); v0[1] += bfhi(q.x); v0[2] += bflo(q.y); v0[3] += bfhi(q.y);
                        v1[0] += bflo(q.z); v1[1] += bfhi(q.z); v1[2] += bflo(q.w); v1[3] += bfhi(q.w); }
                    if (MODE == 1) { u32x2 w8; w8.x = pk_fp8x4(v0[0] * 32.f, v0[1] * 32.f, v0[2] * 32.f, v0[3] * 32.f); w8.y = pk_fp8x4(v1[0] * 32.f, v1[1] * 32.f, v1[2] * 32.f, v1[3] * 32.f); *(u32x2*)(O8 + off) = w8; }
                    else st_bf8(Ob + off, v0, v1); }
    }
    __device__ __forceinline__ void operator()(const f32x4 (&acc)[2][2][4][2], const Unit& u, int wr, int wc, int fr, int fq) const {
        const int rbase = u.pm * BM + wr * 64 + fr, col0 = u.pc * BM + wc * 32 + 8 * fq;
        const bool hi = u.pm >= 64;
        if (MODE == 0) batch<0, 2>(acc, rbase, col0, hi);
        else { batch<0, 1>(acc, rbase, col0, hi); batch<1, 2>(acc, rbase, col0, hi); }
    }
};
struct EpiX1 {
    static constexpr bool PERM = true;
    const float* x; const float* mod; bf16_t* out; float scale;
    __device__ __forceinline__ void operator()(const f32x4 (&acc)[2][2][4][2], const Unit& u, int wr, int wc, int fr, int fq) const {
        const int rbase = u.pm * BM + wr * 64 + fr, col0 = u.pc * BM + wc * 32 + 8 * fq;
        const float* gt = mod + (size_t)(u.pm >> 4) * 6144 + 2048 + col0;
        f32x4 gv[2][2];
#pragma unroll
        for (int bj = 0; bj < 2; ++bj)
#pragma unroll
            for (int n = 0; n < 2; ++n) gv[bj][n] = *(const f32x4*)(gt + bj * HALF + 4 * n) * scale;
#pragma unroll
        for (int ai = 0; ai < 2; ++ai) {
            f32x4 xv[4][2][2];
#pragma unroll
            for (int m = 0; m < 4; ++m)
#pragma unroll
                for (int bj = 0; bj < 2; ++bj)
#pragma unroll
                    for (int n = 0; n < 2; ++n) xv[m][bj][n] = *(const f32x4*)(x + (size_t)(rbase + ai * HALF + m * 16) * 1024 + col0 + bj * HALF + 4 * n);
#pragma unroll
            for (int m = 0; m < 4; ++m)
#pragma unroll
                for (int bj = 0; bj < 2; ++bj)
                    st_bf8(out + (size_t)(rbase + ai * HALF + m * 16) * 1024 + col0 + bj * HALF, xv[m][bj][0] + gv[bj][0] * acc[ai][bj][m][0], xv[m][bj][1] + gv[bj][1] * acc[ai][bj][m][1]);
        }
    }
};
struct EpiMoe1 {
    static constexpr bool PERM = true;
    unsigned char* HM;
    __device__ __forceinline__ void operator()(const f32x4 (&acc)[2][2][4][2], const Unit& u, int wr, int wc, int fr, int fq) const {
        const int rbase = u.pm * BM + wr * 64 + fr, col0 = u.pc * HALF + wc * 32 + 8 * fq;
#pragma unroll
        for (int ai = 0; ai < 2; ++ai)
#pragma unroll
            for (int m = 0; m < 4; ++m) {
                f32x4 v0, v1;
#pragma unroll
                for (int e = 0; e < 4; ++e) { v0[e] = silu_f(acc[ai][0][m][0][e] * 0.03125f) * (acc[ai][1][m][0][e] * 0.03125f); v1[e] = silu_f(acc[ai][0][m][1][e] * 0.03125f) * (acc[ai][1][m][1][e] * 0.03125f); }
                u32x2 w; w.x = pk_fp8x4(v0[0], v0[1], v0[2], v0[3]); w.y = pk_fp8x4(v1[0], v1[1], v1[2], v1[3]);
                *(u32x2*)(HM + (size_t)(rbase + ai * HALF + m * 16) * EH + col0) = w; }
    }
};
struct EpiBf {
    static constexpr bool PERM = true;
    bf16_t* O; int ldo; float scale;
    __device__ __forceinline__ void operator()(const f32x4 (&acc)[2][2][4][2], const Unit& u, int wr, int wc, int fr, int fq) const {
        const int rbase = u.pm * BM + wr * 64 + fr, col0 = u.pc * BM + wc * 32 + 8 * fq;
#pragma unroll
        for (int ai = 0; ai < 2; ++ai)
#pragma unroll
            for (int m = 0; m < 4; ++m)
#pragma unroll
                for (int bj = 0; bj < 2; ++bj) st_bf8(O + (size_t)(rbase + ai * HALF + m * 16) * ldo + col0 + bj * HALF, acc[ai][bj][m][0] * scale, acc[ai][bj][m][1] * scale);
    }
};
struct EpiF8 {
    static constexpr bool PERM = true;
    unsigned char* O; int ldo; float scale;
    __device__ __forceinline__ void operator()(const f32x4 (&acc)[2][2][4][2], const Unit& u, int wr, int wc, int fr, int fq) const {
        const int rbase = u.pm * BM + wr * 64 + fr, col0 = u.pc * BM + wc * 32 + 8 * fq;
#pragma unroll
        for (int ai = 0; ai < 2; ++ai)
#pragma unroll
            for (int m = 0; m < 4; ++m)
#pragma unroll
                for (int bj = 0; bj < 2; ++bj) { const f32x4 v0 = acc[ai][bj][m][0] * scale, v1 = acc[ai][bj][m][1] * scale; u32x2 w; w.x = pk_fp8x4(v0[0], v0[1], v0[2], v0[3]); w.y = pk_fp8x4(v1[0], v1[1], v1[2], v1[3]);
                    *(u32x2*)(O + (size_t)(rbase + ai * HALF + m * 16) * ldo + col0 + bj * HALF) = w; }
    }
};
}

namespace gt {
constexpr int STAGE_BYTES = 128 * 144 + 256 * 144;
struct NoHook { template <class A> __device__ __forceinline__ void operator()(int, A&) const {} };
struct NoTf { __device__ __forceinline__ u32x4 operator()(int, int, u32x4 v) const { return v; } };
template <int NT, int BKT, class AL, class BL, class Pre = NoHook, class Post = NoHook, class TfA = NoTf, class TfB = NoTf>
__device__ __forceinline__ void gemm_tile(f32x4 (&acc)[4][NT], const AL& al, const BL& bl, int nk, LAS unsigned char* st, int tid, const Pre& pre = Pre(), const Post& post = Post(), const TfA& tfa = TfA(), const TfB& tfb = TfB()) {
    constexpr int AST = (BKT + 8) * 2, PPR = BKT / 8, NA = 128 * PPR / 512, NB = 64 * NT * PPR / 512;
    const int lane = tid & 63, wid = tid >> 6, wr = wid >> 2, wc = wid & 3, fr = lane & 15, fq = lane >> 4;
    LAS unsigned char* sa = st; LAS unsigned char* sb = st + 128 * AST;
    u32x4 ra[NA], rb[NB];
#pragma unroll
    for (int i = 0; i < NA; ++i) { const int p = tid + i * 512; ra[i] = al(p / PPR, (p % PPR) * 8); }
#pragma unroll
    for (int i = 0; i < NB; ++i) { const int p = tid + i * 512; rb[i] = bl(p / PPR, (p % PPR) * 8); }
    for (int kt = 0; kt < nk; ++kt) {
        __syncthreads();
#pragma unroll
        for (int i = 0; i < NA; ++i) { const int p = tid + i * 512; *(LAS u32x4*)(sa + (p / PPR) * AST + (p % PPR) * 16) = tfa(p / PPR, kt * BKT + (p % PPR) * 8, ra[i]); }
#pragma unroll
        for (int i = 0; i < NB; ++i) { const int p = tid + i * 512; *(LAS u32x4*)(sb + (p / PPR) * AST + (p % PPR) * 16) = tfb(p / PPR, kt * BKT + (p % PPR) * 8, rb[i]); }
        __syncthreads();
        if (kt + 1 < nk) {
            int t2 = tid; asm volatile("" : "+v"(t2));
#pragma unroll
            for (int i = 0; i < NA; ++i) { const int p = t2 + i * 512; ra[i] = al(p / PPR, (kt + 1) * BKT + (p % PPR) * 8); }
#pragma unroll
            for (int i = 0; i < NB; ++i) { const int p = t2 + i * 512; rb[i] = bl(p / PPR, (kt + 1) * BKT + (p % PPR) * 8); }
        }
        pre(kt, acc);
#pragma unroll
        for (int kk = 0; kk < BKT / 32; ++kk) {
            bf16x8 a[4], b[NT];
#pragma unroll
            for (int m = 0; m < 4; ++m) a[m] = *(const LAS bf16x8*)(sa + (wr * 64 + m * 16 + fr) * AST + kk * 64 + fq * 16);
#pragma unroll
            for (int n = 0; n < NT; ++n) b[n] = *(const LAS bf16x8*)(sb + (wc * 16 * NT + n * 16 + fr) * AST + kk * 64 + fq * 16);
#pragma unroll
            for (int m = 0; m < 4; ++m)
#pragma unroll
                for (int n = 0; n < NT; ++n) acc[m][n] = __builtin_amdgcn_mfma_f32_16x16x32_bf16(a[m], b[n], acc[m][n], 0, 0, 0);
        }
        post(kt, acc);
    }
    __syncthreads();
}
template <int NT, int BKT>
__device__ __forceinline__ void compute_tile(f32x4 (&acc)[4][NT], LAS unsigned char* st, int tid) {
    constexpr int AST = (BKT + 8) * 2;
    const int lane = tid & 63, wid = tid >> 6, wr = wid >> 2, wc = wid & 3, fr = lane & 15, fq = lane >> 4;
    LAS unsigned char* sa = st; LAS unsigned char* sb = st + 128 * AST;
#pragma unroll
    for (int kk = 0; kk < BKT / 32; ++kk) {
        bf16x8 a[4], b[NT];
#pragma unroll
        for (int m = 0; m < 4; ++m) a[m] = *(const LAS bf16x8*)(sa + (wr * 64 + m * 16 + fr) * AST + kk * 64 + fq * 16);
#pragma unroll
        for (int n = 0; n < NT; ++n) b[n] = *(const LAS bf16x8*)(sb + (wc * 16 * NT + n * 16 + fr) * AST + kk * 64 + fq * 16);
#pragma unroll
        for (int m = 0; m < 4; ++m)
#pragma unroll
            for (int n = 0; n < NT; ++n) acc[m][n] = __builtin_amdgcn_mfma_f32_16x16x32_bf16(a[m], b[n], acc[m][n], 0, 0, 0);
    }
}
__device__ __forceinline__ void compute_tile_chain(f32x4 (&acc)[4][1], LAS unsigned char* st, int tid) {
    constexpr int AST = 272;
    const int lane = tid & 63, wid = tid >> 6, wr = wid >> 2, wc = wid & 3, fr = lane & 15, fq = lane >> 4;
    LAS unsigned char* sa = st + (wr * 64 + fr) * AST + fq * 16; LAS unsigned char* sb = st + 128 * AST + (wc * 16 + fr) * AST + fq * 16;
    bf16x8 a[4][4], b[4];
#pragma unroll
    for (int kk = 0; kk < 4; ++kk) {
#pragma unroll
        for (int m = 0; m < 4; ++m) a[kk][m] = *(const LAS bf16x8*)(sa + m * 16 * AST + kk * 64);
        b[kk] = *(const LAS bf16x8*)(sb + kk * 64); }
    __builtin_amdgcn_sched_barrier(0);
#pragma unroll
    for (int kk = 0; kk < 4; ++kk)
#pragma unroll
        for (int m = 0; m < 4; ++m) acc[m][0] = __builtin_amdgcn_mfma_f32_16x16x32_bf16(a[kk][m], b[kk], acc[m][0], 0, 0, 0);
    __builtin_amdgcn_sched_barrier(0);
}
struct LdRows {
    const bf16_t* base; int ld;
    __device__ __forceinline__ u32x4 operator()(int row, int k) const { return *(const u32x4*)(base + (size_t)row * ld + k); }
};
__device__ __forceinline__ u32x4 scale8(u32x4 v, float s0, float s1, float s2, float s3, float s4, float s5, float s6, float s7) {
    u32x4 o; o.x = pk2(bflo(v.x) * s0, bfhi(v.x) * s1); o.y = pk2(bflo(v.y) * s2, bfhi(v.y) * s3); o.z = pk2(bflo(v.z) * s4, bfhi(v.z) * s5); o.w = pk2(bflo(v.w) * s6, bfhi(v.w) * s7); return o;
}
}


#define XB_TMO      128
#define XB_XCNT(j)  (256  + 64 * (j))
#define XB_XSUB(j)  (1280 + 64 * (j))
#define XB_XGEN(j)  (2304 + 64 * (j))
#define XB_TOP      3328
#define XB_TOPGEN   3392
#define XCD_BAR_WORDS 3456
#define XB_SPIN_CAP (1u << 18)
__device__ __forceinline__ unsigned xb_ld(unsigned* p)              { return __hip_atomic_load(p, __ATOMIC_RELAXED, __HIP_MEMORY_SCOPE_AGENT); }
__device__ __forceinline__ unsigned xb_add(unsigned* p, unsigned v) { return __hip_atomic_fetch_add(p, v, __ATOMIC_RELAXED, __HIP_MEMORY_SCOPE_AGENT); }
__device__ __forceinline__ unsigned xb_xcc_id() { return (unsigned)__builtin_amdgcn_s_getreg((3 << 11) | 20) & 0xFu; }
#define XB_SPIN(cond, bar) do { unsigned _sp = 0; while (cond) { __builtin_amdgcn_s_sleep(1); \
    if ((++_sp & 255u) == 0u) { if (xb_ld(&(bar)[XB_TMO])) break; if (_sp > XB_SPIN_CAP) { atomicAdd(&(bar)[XB_TMO], 1u); break; } } } } while (0)
struct XcdBarrier { unsigned* bar; unsigned x; volatile LAS unsigned* st; };
__device__ __forceinline__ XcdBarrier xcd_barrier_post(unsigned* bar, volatile LAS unsigned* st) {
    XcdBarrier b; b.bar = bar; b.x = xb_xcc_id(); b.st = st;
    if (threadIdx.x == 0) (void)xb_add(&bar[XB_XCNT(b.x)], 1u);
    return b;
}
__device__ __forceinline__ void xcd_barrier_complete(unsigned* bar, unsigned x, unsigned& nloc, unsigned& nx) {
    const unsigned G = gridDim.x * gridDim.y * gridDim.z;
    unsigned sum, cnt, mine, sp = 0u;
    for (;;) {
        sum = 0u; cnt = 0u; mine = 0u;
#pragma unroll
        for (unsigned j = 0; j < 16; ++j) { const unsigned c = xb_ld(&bar[XB_XCNT(j)]); sum += c; cnt += (c > 0u) ? 1u : 0u; mine = (j == x) ? c : mine; }
        if (sum == G) break;
        __builtin_amdgcn_s_sleep(1);
        if ((++sp & 255u) == 0u) { if (xb_ld(&bar[XB_TMO])) break; if (sp > XB_SPIN_CAP) { atomicAdd(&bar[XB_TMO], 1u); break; } }
    }
    nloc = mine > 0u ? mine : 1u; nx = cnt > 0u ? cnt : 1u;
}
__device__ __forceinline__ void xcd_barrier(const XcdBarrier& b) {
    asm volatile("s_waitcnt vmcnt(0)" ::: "memory");
    __syncthreads();
    if (threadIdx.x == 0) {
        unsigned* bar = b.bar;
        __builtin_amdgcn_s_waitcnt(0);
        unsigned nloc = b.st[0], nx = b.st[1];
        if (nloc == 0u) { xcd_barrier_complete(bar, b.x, nloc, nx); b.st[0] = nloc; b.st[1] = nx; }
        const unsigned old = xb_add(&bar[XB_XSUB(b.x)], 1u);
        const unsigned gen = old / nloc;
        if (old + 1u == (gen + 1u) * nloc) {
            __builtin_amdgcn_fence(__ATOMIC_RELEASE, "agent");
            asm volatile("s_waitcnt vmcnt(0)" ::: "memory");
            const unsigned og = xb_add(&bar[XB_TOP], 1u);
            const unsigned tg = og / nx;
            if (og + 1u == (tg + 1u) * nx) xb_add(&bar[XB_TOPGEN], 1u);
            else XB_SPIN(xb_ld(&bar[XB_TOPGEN]) == tg, bar);
            __builtin_amdgcn_fence(__ATOMIC_ACQUIRE, "agent");
            xb_add(&bar[XB_XGEN(b.x)], 1u);
            asm volatile("s_waitcnt vmcnt(0)" ::: "memory");
        } else {
            XB_SPIN(xb_ld(&bar[XB_XGEN(b.x)]) == gen, bar);
            __builtin_amdgcn_fence(__ATOMIC_ACQUIRE, "agent");
            asm volatile("s_waitcnt vmcnt(0)" ::: "memory");
        }
    }
    __syncthreads();
}

struct Args { const float* in[31]; float* out; unsigned char* ws; };
enum { I_X = 0, I_C, I_CTX, I_CCTX, I_ADAW, I_ADAB, I_N1G, I_N2G, I_WIN, I_BIN, I_DECAY, I_RETWO, I_HCW, I_HCB, I_HW1, I_HB1, I_HFREQ, I_HW2, I_HB2, I_HW3, I_HSKIP, I_HYWO, I_WOUT,
       I_RGW, I_RGB, I_REW, I_REB, I_EW1, I_EW3, I_EW2, I_FNG };

template <class RowMap>
__device__ __forceinline__ void transpose_item(const float* W, int N, int k0, int n0, bf16_t* WT, int ldt, const RowMap& rm, LAS float* scr, int lane) {
    const int lr = lane >> 4, lc = (lane & 15) * 4;
    f32x4 vv[16];
#pragma unroll
    for (int i = 0; i < 16; ++i) vv[i] = *(const f32x4*)(W + (size_t)(k0 + 4 * i + lr) * N + n0 + lc);
#pragma unroll
    for (int i = 0; i < 16; ++i) { const int kk = 4 * i + lr; const f32x4 v = vv[i]; LAS float* s = scr + kk * 69 + lc; s[0] = v[0]; s[1] = v[1]; s[2] = v[2]; s[3] = v[3]; }
    asm volatile("s_waitcnt lgkmcnt(0)" ::: "memory");
    const int c = lane & 7;
#pragma unroll
    for (int j = 0; j < 8; ++j) { const int n = (lane >> 3) + 8 * j; const LAS float* s = scr + (8 * c) * 69 + n;
        u32x4 o; o.x = pk2(s[0 * 69], s[1 * 69]); o.y = pk2(s[2 * 69], s[3 * 69]); o.z = pk2(s[4 * 69], s[5 * 69]); o.w = pk2(s[6 * 69], s[7 * 69]);
        *(u32x4*)(WT + (size_t)rm(n0 + n) * ldt + k0 + 8 * c) = o; }
    asm volatile("s_waitcnt lgkmcnt(0)" ::: "memory");
}
using pg8::pk_fp8x4;
template <class RowMap>
__device__ __forceinline__ void transpose_item_f8(const float* W, int N, int k0, int n0, unsigned char* WT, int ldt, const RowMap& rm, float scale, LAS float* scr, int lane) {
    const int lr = lane >> 4, lc = (lane & 15) * 4;
    f32x4 vv[16];
#pragma unroll
    for (int i = 0; i < 16; ++i) vv[i] = *(const f32x4*)(W + (size_t)(k0 + 4 * i + lr) * N + n0 + lc);
#pragma unroll
    for (int i = 0; i < 16; ++i) { const int kk = 4 * i + lr; const f32x4 v = vv[i]; LAS float* s = scr + kk * 69 + lc; s[0] = v[0]; s[1] = v[1]; s[2] = v[2]; s[3] = v[3]; }
    asm volatile("s_waitcnt lgkmcnt(0)" ::: "memory");
    const int c = lane & 7;
#pragma unroll
    for (int j = 0; j < 8; ++j) { const int n = (lane >> 3) + 8 * j; const LAS float* s = scr + (8 * c) * 69 + n;
        u32x2 o; o.x = pk_fp8x4(s[0 * 69] * scale, s[1 * 69] * scale, s[2 * 69] * scale, s[3 * 69] * scale); o.y = pk_fp8x4(s[4 * 69] * scale, s[5 * 69] * scale, s[6 * 69] * scale, s[7 * 69] * scale);
        *(u32x2*)(WT + (size_t)rm(n0 + n) * ldt + k0 + 8 * c) = o; }
    asm volatile("s_waitcnt lgkmcnt(0)" ::: "memory");
}
struct RmId { __device__ __forceinline__ int operator()(int n) const { return n; } };
struct RmWin { __device__ __forceinline__ int operator()(int n) const { return win_destrow(n); } };
struct RmE13 { int add; __device__ __forceinline__ int operator()(int n) const { return 256 * (n >> 7) + (n & 127) + add; } };

__device__ __forceinline__ float lg2_decay(float logit) { return -log1pf(expf(-logit)) * 1.4426950408889634f; }

__device__ __forceinline__ void short_conv8(const bf16_t* HU, int row, int t, int ch, const float* cw, const float* cb, float (&o)[8]) {
    const f32x4 b0 = *(const f32x4*)(cb + ch), b1 = *(const f32x4*)(cb + ch + 4);
#pragma unroll
    for (int e = 0; e < 4; ++e) { o[e] = b0[e]; o[4 + e] = b1[e]; }
#pragma unroll
    for (int j = 0; j < 3; ++j) {
        const int tt = t + j - 1;
        if (tt >= 0 && tt < SEQ) {
            const u32x4 v = *(const u32x4*)(HU + (size_t)(row + j - 1) * 1536 + ch);
            const f32x4 w0 = *(const f32x4*)(cw + j * 1536 + ch), w1 = *(const f32x4*)(cw + j * 1536 + ch + 4);
            o[0] += bflo(v.x) * w0[0]; o[1] += bfhi(v.x) * w0[1]; o[2] += bflo(v.y) * w0[2]; o[3] += bfhi(v.y) * w0[3];
            o[4] += bflo(v.z) * w1[0]; o[5] += bfhi(v.z) * w1[1]; o[6] += bflo(v.w) * w1[2]; o[7] += bfhi(v.w) * w1[3];
        }
    }
}


__device__ __forceinline__ void short_conv8x8(const bf16_t* HU, int row0, int t0, int ch, const float* cw, const float* cb, float (&o)[8][8]) {
    u32x4 rw[10];
#pragma unroll
    for (int r = 0; r < 10; ++r) { const int tt = t0 + r - 1; rw[r] = (u32x4){0u, 0u, 0u, 0u}; if (tt >= 0 && tt < SEQ) rw[r] = *(const u32x4*)(HU + (size_t)(row0 + r - 1) * 1536 + ch); }
    float w[3][8], bb[8];
#pragma unroll
    for (int j = 0; j < 3; ++j) { const f32x4 w0 = *(const f32x4*)(cw + j * 1536 + ch), w1 = *(const f32x4*)(cw + j * 1536 + ch + 4);
#pragma unroll
        for (int e = 0; e < 4; ++e) { w[j][e] = w0[e]; w[j][4 + e] = w1[e]; } }
    { const f32x4 b0 = *(const f32x4*)(cb + ch), b1 = *(const f32x4*)(cb + ch + 4);
#pragma unroll
      for (int e = 0; e < 4; ++e) { bb[e] = b0[e]; bb[4 + e] = b1[e]; } }
#pragma unroll
    for (int t = 0; t < 8; ++t)
#pragma unroll
        for (int e = 0; e < 8; ++e) o[t][e] = bb[e];
#pragma unroll
    for (int r = 0; r < 10; ++r) {
        float u[8]; u[0] = bflo(rw[r].x); u[1] = bfhi(rw[r].x); u[2] = bflo(rw[r].y); u[3] = bfhi(rw[r].y); u[4] = bflo(rw[r].z); u[5] = bfhi(rw[r].z); u[6] = bflo(rw[r].w); u[7] = bfhi(rw[r].w);
#pragma unroll
        for (int j = 0; j < 3; ++j) { const int t = r - j;
            if (t >= 0 && t < 8) {
#pragma unroll
                for (int e = 0; e < 8; ++e) o[t][e] += u[e] * w[j][e]; } }
    }
}

typedef const __attribute__((address_space(4))) Args CArgs;
__device__ __forceinline__ CArgs* args_ptr() { CArgs* p = (CArgs*)__builtin_amdgcn_kernarg_segment_ptr(); asm volatile("" : "+s"(p)); return p; }
#define DECL_PTRS \
    CArgs& a = *args_ptr(); unsigned char* ws = a.ws; unsigned char* dob = (unsigned char*)a.out; \
    int tid = threadIdx.x; asm volatile("" : "+v"(tid)); const int lane = tid & 63, wave = tid >> 6, gw = bid * 8 + wave; (void)lane; (void)gw; \
    int* cnt = (int*)(ws + WS_CTL); \
    float* MOD = (float*)(ws + WS_MOD); float* ROPE = (float*)(ws + WS_ROPE); float* BINP = (float*)(ws + WS_BINP); float* FPART = (float*)(ws + WS_FPART); \
    int* TOKINFO = (int*)(ws + WS_TOKINFO); int* LISTS = (int*)(ws + WS_LISTS); \
    bf16_t* TR = (bf16_t*)(ws + WS_TR); \
    bf16_t* WT_IN = (bf16_t*)(ws + WS_WT_IN); bf16_t* WT_RETO = (bf16_t*)(ws + WS_WT_RETO); bf16_t* WT_HYO = (bf16_t*)(ws + WS_WT_HYO); bf16_t* WT_OUT = (bf16_t*)(ws + WS_WT_OUT); \
    bf16_t* Qb = (bf16_t*)(ws + WS_Q); bf16_t* Kb = (bf16_t*)(ws + WS_K); bf16_t* KT = (bf16_t*)(ws + WS_KT); bf16_t* VT = (bf16_t*)(ws + WS_VT); \
    float* FILT = (float*)(ws + WS_KV); \
    bf16_t* SGR = (bf16_t*)(ws + WS_SGR); bf16_t* SGH = (bf16_t*)(ws + WS_SGH); bf16_t* XB = (bf16_t*)(ws + WS_XB); \
    bf16_t* SG = (bf16_t*)(ws + WS_SG); bf16_t* HU = (bf16_t*)(ws + WS_HU); bf16_t* HM = (bf16_t*)(ws + WS_HU); \
    bf16_t* KV = (bf16_t*)(ws + WS_KV); bf16_t* WE13 = (bf16_t*)(ws + WS_WE13); bf16_t* WE2 = (bf16_t*)(ws + WS_WE2); \
    bf16_t* XN = (bf16_t*)(dob + DO_XN); bf16_t* ZT = (bf16_t*)(dob + DO_ZT); unsigned char* XN8 = dob + DO_XN8; unsigned char* RG8 = dob + DO_XN; (void)RG8; unsigned char* WTG8 = (unsigned char*)(ws + WS_WT_IN) + (size_t)NINA * 1024 * 2; (void)XN8; (void)WTG8; \
    bf16_t* X1 = (bf16_t*)(ws + WS_X1);     \
    (void)cnt; (void)MOD; (void)ROPE; (void)BINP; (void)FPART; (void)TOKINFO; (void)LISTS; (void)TR; (void)WT_IN; (void)WT_RETO; (void)WT_HYO; (void)WT_OUT; (void)Qb; (void)Kb; (void)KT; (void)VT; (void)FILT; \
    (void)SGR; (void)SGH; (void)XB; (void)SG; (void)HU; (void)HM; (void)KV; (void)WE13; (void)WE2; (void)XN; (void)ZT; (void)X1;

__global__ void __launch_bounds__(512, 2) fwd_kernel(Args a_) {
    extern __shared__ __attribute__((aligned(16))) unsigned char lds_raw[];
    LAS unsigned char* lds = (LAS unsigned char*)lds_raw;
    cg::grid_group grid = cg::this_grid();
    const int G = gridDim.x, bid = blockIdx.x, NGW = G * 8;
    volatile LAS unsigned* bst = (volatile LAS unsigned*)(lds + LDS_BYTES - 16);
    if (threadIdx.x == 0) { bst[0] = 0u; bst[1] = 0u; }
    __syncthreads();
    if (blockIdx.x == 0) { unsigned* bw = (unsigned*)(args_ptr()->ws + WS_CTL) + 1024; for (int i = threadIdx.x; i < XCD_BAR_WORDS; i += 512) bw[i] = 0u; if (threadIdx.x < 64) ((unsigned*)(args_ptr()->ws + WS_CTL))[threadIdx.x] = 0u; }
    grid.sync();
    const XcdBarrier xbar = xcd_barrier_post((unsigned*)(args_ptr()->ws + WS_CTL) + 1024, bst);
#define GRID_BAR() xcd_barrier(xbar)
    unsigned long long tprev_ = 0, spin_ = 0;
    if (PROBE_PHASE >= 0) tprev_ = __builtin_amdgcn_s_memrealtime();
#define STAMP(k) do { if (PROBE_PHASE >= 0 && blockIdx.x == 0 && threadIdx.x == 0) { const unsigned long long now_ = __builtin_amdgcn_s_memrealtime(); if ((k) == PROBE_PHASE) spin_ = now_ - tprev_; tprev_ = now_; } } while (0)

    { DECL_PTRS
    for (int it = bid; it < 193; it += G) {
        if (it < 192) {
            const int col0 = it * 32, kq = tid >> 5, cl = tid & 31;
            LAS float* sl = (LAS float*)(lds + 32768);
            float wv_[64];
#pragma unroll
            for (int kk = 0; kk < 64; ++kk) wv_[kk] = a.in[I_ADAW][(size_t)(kq * 64 + kk) * 6144 + col0 + cl];
            { float cv[18];
#pragma unroll
              for (int i = 0; i < 18; ++i) { const int r = i >> 1, k = (tid + 512 * i) & 1023; cv[i] = r < 8 ? a.in[I_C][r * 1024 + k] : a.in[I_CCTX][k]; }
#pragma unroll
              for (int i = 0; i < 18; ++i) { const int r = i >> 1, k = (tid + 512 * i) & 1023; sl[k * 12 + r] = silu_f(cv[i]); } }
            __syncthreads();
            float acc9[9];
#pragma unroll
            for (int r = 0; r < 9; ++r) acc9[r] = 0.f;
#pragma unroll
            for (int kk = 0; kk < 64; ++kk) { const int k = kq * 64 + kk; const float w = wv_[kk];
                const f32x4 s0 = *(const LAS f32x4*)(sl + k * 12), s1 = *(const LAS f32x4*)(sl + k * 12 + 4); const float s8 = sl[k * 12 + 8];
                acc9[0] += s0[0] * w; acc9[1] += s0[1] * w; acc9[2] += s0[2] * w; acc9[3] += s0[3] * w; acc9[4] += s1[0] * w; acc9[5] += s1[1] * w; acc9[6] += s1[2] * w; acc9[7] += s1[3] * w; acc9[8] += s8 * w; }
            LAS float* red = (LAS float*)lds;
#pragma unroll
            for (int r = 0; r < 9; ++r) red[(kq * 9 + r) * 32 + cl] = acc9[r];
            __syncthreads();
            if (tid < 288) { const int r = tid >> 5, c2 = tid & 31; float s = 0.f; for (int q = 0; q < 16; ++q) s += red[(q * 9 + r) * 32 + c2]; MOD[r * 6144 + col0 + c2] = s + a.in[I_ADAB][col0 + c2]; }
            asm volatile("s_waitcnt vmcnt(0)" ::: "memory");
            __syncthreads();
            if (it < 64 && tid == 0) {
                __builtin_amdgcn_fence(__ATOMIC_RELEASE, "agent");
                asm volatile("s_waitcnt vmcnt(0)" ::: "memory");
                (void)xb_add((unsigned*)cnt + 40, 1u);
            }
        } else {
            for (int idx = tid; idx < 2048; idx += 512) { const int pos = idx >> 5, i = idx & 31; const float inv = powf(10000.f, -(float)i / 32.f); const float ang = (float)pos * inv; ROPE[idx] = cosf(ang); ROPE[2048 + idx] = sinf(ang); }
            for (int n = tid; n < 6656; n += 512) BINP[win_destrow(n)] = a.in[I_BIN][n];
        }
    }
    for (int fi0 = bid + 63; fi0 < 256 + 63 + 256; fi0 += G) {
        const int fi = fi0 - 256; if (fi < 0 || fi >= 256) continue;
        {
            const int t0 = fi * 16;
            LAS float* feats = (LAS float*)lds; LAS float* hid1 = feats + 544; LAS float* hid2 = hid1 + 1024;
            for (int idx = tid; idx < 16 * 33; idx += 512) { const int row = idx / 33, f = idx % 33; const float t = (float)(t0 + row) * (1.f / 4096.f); float v;
                if (f == 0) v = t; else { const int mb = (f - 1) & 15; const float band = 1e-4f + (float)mb * ((15.f - 1e-4f) / 15.f); const float ph = (6.283185307179586f * t) * band; v = f <= 16 ? cosf(ph) : -sinf(ph); }
                feats[idx] = v; }
            __syncthreads();
            for (int idx = tid; idx < 1024; idx += 512) { const int row = idx >> 6, j = idx & 63; float s = a.in[I_HB1][j]; for (int f = 0; f < 33; ++f) s += feats[row * 33 + f] * a.in[I_HW1][f * 64 + j]; hid1[idx] = sinf(a.in[I_HFREQ][j] * s); }
            __syncthreads();
            for (int idx = tid; idx < 1024; idx += 512) { const int row = idx >> 6, j = idx & 63; float s = a.in[I_HB2][j]; for (int k = 0; k < 64; ++k) s += hid1[row * 64 + k] * a.in[I_HW2][k * 64 + j]; hid2[j * 16 + row] = sinf(a.in[I_HFREQ][j] * s); }
            __syncthreads();
            const float slow = 4.605170185988091f / 1.5f, fast = 4.605170185988091f / 0.3f;
            for (int col = tid; col < 1024; col += 512) {
                float ac[16];
#pragma unroll
                for (int r = 0; r < 16; ++r) ac[r] = 0.f;
#pragma unroll 4
                for (int k = 0; k < 64; ++k) { const float w = a.in[I_HW3][k * 1024 + col];
#pragma unroll
                    for (int r4 = 0; r4 < 4; ++r4) { const f32x4 hv = *(const LAS f32x4*)(hid2 + k * 16 + 4 * r4); ac[4 * r4] += hv[0] * w; ac[4 * r4 + 1] += hv[1] * w; ac[4 * r4 + 2] += hv[2] * w; ac[4 * r4 + 3] += hv[3] * w; } }
                const float delta = slow + (float)(col & 511) * ((fast - slow) / 511.f); float ps = 0.f;
#pragma unroll
                for (int r = 0; r < 16; ++r) { const float t = (float)(t0 + r) * (1.f / 4096.f); ac[r] *= expf(-t * delta); ps += fabsf(ac[r]); }
#pragma unroll
                for (int r = 0; r < 4; ++r) *(f32x4*)(FILT + (size_t)col * 4096 + t0 + 4 * r) = (f32x4){ac[4 * r], ac[4 * r + 1], ac[4 * r + 2], ac[4 * r + 3]};
                FPART[fi * 1024 + col] = ps;
            }
            __syncthreads();
        }
    }
    __syncthreads();
    {
        LAS float* scr = (LAS float*)(lds + wave * 17664);
        constexpr int I_IN = 16 * 104, I_RO = 16 * 16, I_HO = 8 * 16, I_OU = 16 * 16;
        for (int it = gw; it < I_IN + I_RO + I_HO + I_OU; it += NGW) {
            int r = it;
            if (r < I_IN) { const int nb = r % 104;
                if (nb < 72) transpose_item(a.in[I_WIN], 6656, 64 * (r / 104), 64 * nb, WT_IN, 1024, RmWin{}, scr, lane);
                else transpose_item_f8(a.in[I_WIN] + NINA, 6656, 64 * (r / 104), 64 * (nb - 72), WTG8, 1024, RmId{}, 32.f, scr, lane);
                continue; } r -= I_IN;
            if (r < I_RO) { transpose_item_f8(a.in[I_RETWO], 1024, 64 * (r / 16), 64 * (r % 16), (unsigned char*)WT_RETO, 1024, RmId{}, 32.f, scr, lane); continue; } r -= I_RO;
            if (r < I_HO) { transpose_item(a.in[I_HYWO], 1024, 64 * (r / 16), 64 * (r % 16), WT_HYO, 512, RmId{}, scr, lane); continue; } r -= I_HO;
            transpose_item_f8(a.in[I_WOUT], 1024, 64 * (r / 16), 64 * (r % 16), (unsigned char*)WT_OUT, 1024, RmId{}, 32.f, scr, lane);
        }
    }
    { unsigned* cw_ = (unsigned*)cnt + 40; unsigned* bar_ = (unsigned*)cnt + 1024;
      asm volatile("s_waitcnt vmcnt(0)" ::: "memory");
      __syncthreads();
      if (tid == 0) { XB_SPIN(xb_ld(cw_) < 64u, bar_); __builtin_amdgcn_fence(__ATOMIC_ACQUIRE, "agent"); asm volatile("s_waitcnt vmcnt(0)" ::: "memory"); }
      __syncthreads(); }
    }
    STAMP(0);

    { DECL_PTRS
    for (int m0 = gw; m0 < MT; m0 += 2 * NGW) {
        f32x4 v[2][4]; float s[2] = {0.f, 0.f};
#pragma unroll
        for (int q = 0; q < 2; ++q) { const int m = m0 + q * NGW; const bool ok = m < MT; const bool lat = m < T;
            const float* xr = !ok ? a.in[I_X] : lat ? a.in[I_X] + (size_t)m * D : a.in[I_CTX] + (size_t)(m - T) * D;
#pragma unroll
            for (int j = 0; j < 4; ++j) { v[q][j] = *(const f32x4*)(xr + 4 * lane + 256 * j); s[q] += (v[q][j][0] * v[q][j][0] + v[q][j][1] * v[q][j][1]) + (v[q][j][2] * v[q][j][2] + v[q][j][3] * v[q][j][3]); } }
#pragma unroll
        for (int q = 0; q < 2; ++q) { const int m = m0 + q * NGW; if (m >= MT) break; const bool lat = m < T;
            const float* md = MOD + (size_t)(lat ? (m >> 12) : 8) * 6144;
            const float rstd = rsqrtf(wave_sum(s[q]) * (1.f / D) + EPS);
#pragma unroll
            for (int j = 0; j < 4; ++j) { const int c0 = 4 * lane + 256 * j; const f32x4 g = *(const f32x4*)(a.in[I_N1G] + c0), sh = *(const f32x4*)(md + c0), sc = *(const f32x4*)(md + 1024 + c0);
                const f32x4 o = (v[q][j] * rstd * g) * (sc + 1.f) + sh; u32x2 w; w.x = pk2(o[0], o[1]); w.y = pk2(o[2], o[3]); *(u32x2*)(XN + (size_t)m * D + c0) = w;
                if (lat) *(unsigned*)(XN8 + (size_t)m * D + c0) = pk_fp8x4(o[0], o[1], o[2], o[3]); } }
    }
    }
    GRID_BAR();
    STAMP(1);

    { DECL_PTRS
    for (int c = bid; c < 512; c += G) {
        LAS float* red = (LAS float*)lds;
        float fa[16], fb[16];
#pragma unroll
        for (int it = 0; it < 16; ++it) { const int x = 4096 - (tid + 512 * it); fa[it] = 0.f; fb[it] = 0.f;
            if (x >= 0 && x < 4096) fa[it] = FILT[(size_t)c * 4096 + x];
            if (x <= 0 && x > -4096) fb[it] = FILT[(size_t)(512 + c) * 4096 - x]; }
        float p = 0.f; if (tid < 256) p = FPART[tid * 1024 + c]; else p = FPART[(tid - 256) * 1024 + 512 + c];
        p = wave_sum(p); if (lane == 0) red[wave] = p;
        __syncthreads();
        const float nf = 1.f / ((red[0] + red[1]) + (red[2] + red[3])), nb = 1.f / ((red[4] + red[5]) + (red[6] + red[7]));
#pragma unroll
        for (int it = 0; it < 16; ++it) TR[(size_t)c * 8192 + tid + 512 * it] = (bf16_t)f2bf(fa[it] * nf + fb[it] * nb);
        __syncthreads();
    }
    __syncthreads();
    {
        LAS float* ropel = (LAS float*)(lds + MISC_OFF);
        { const f32x4 r0 = *(const f32x4*)(ROPE + tid * 4), r1 = *(const f32x4*)(ROPE + (tid + 512) * 4); *(LAS f32x4*)(ropel + tid * 4) = r0; *(LAS f32x4*)(ropel + (tid + 512) * 4) = r1; }
        __syncthreads();
        pg8::Gemm g{XN, WT_IN, 1024, 1024, 1024}; pg8::InProjOrder S; S.init(G, bid);
        pg8::EpiInA E{Qb, Kb, KT, VT, SG, HU, BINP, ropel};
        pg8::gemm_phase(lds, g, S, E);
    }
    }
    GRID_BAR();
    STAMP(2);

    { DECL_PTRS
    for (int it = bid; it < 512; it += G) {
        const int b = it >> 6, tt = (it >> 3) & 7, cc = it & 7;
        LAS bf16_t* zt = (LAS bf16_t*)lds;
        { int tl = tid; asm volatile("" : "+v"(tl));
          const int tq = tl >> 3, cg = tl & 7, c0 = cc * 64 + cg * 8, t0 = tt * 512 + tq * 8, row0 = b * SEQ + t0;
          float x1[8][8], vv[8][8];
          short_conv8x8(HU, row0, t0, 512 + c0, a.in[I_HCW], a.in[I_HCB], x1);
          short_conv8x8(HU, row0, t0, 1024 + c0, a.in[I_HCW], a.in[I_HCB], vv);
#pragma unroll
          for (int e = 0; e < 8; ++e) { u32x4 w; w.x = pk2(x1[0][e] * vv[0][e], x1[1][e] * vv[1][e]); w.y = pk2(x1[2][e] * vv[2][e], x1[3][e] * vv[3][e]); w.z = pk2(x1[4][e] * vv[4][e], x1[5][e] * vv[5][e]); w.w = pk2(x1[6][e] * vv[6][e], x1[7][e] * vv[7][e]);
              *(LAS u32x4*)(zt + (cg * 8 + e) * 520 + tq * 8) = w; } }
        __syncthreads();
#pragma unroll
        for (int i = 0; i < 8; ++i) { const int ch = wave * 8 + i; *(u32x4*)(ZT + ((size_t)(cc * 64 + ch) * 8 + b) * SEQ + tt * 512 + lane * 8) = *(const LAS u32x4*)(zt + ch * 520 + lane * 8); }
        __syncthreads();
    }
    {
        LAS float* wtab = (LAS float*)(lds + 104448);
        for (int u0 = bid; u0 < 256; u0 += G) {
            int tl = tid; asm volatile("" : "+v"(tl));
            const int u = (G == 256) ? (((u0 & 7) + 8 * (u0 >> 6)) * 8 + ((u0 >> 3) & 7)) : u0;
            const int chain = u >> 2, dvq = u & 3, bh = chain >> 1, dir = chain & 1, h = bh & 3;
            const float lg = lg2_decay(a.in[I_DECAY][dir * 4 + h]); const float g128 = exp2f(128.f * lg);
            if (tl < 128) wtab[tl] = exp2f((float)(dir == 0 ? 127 - tl : tl) * lg);
            __syncthreads();
            struct LdK { const bf16_t* base; const LAS float* w; int dir;
                __device__ __forceinline__ u32x4 operator()(int row, int k) const { const int kt = k >> 7, j = k & 127;
                    const int ck = dir == 0 ? (kt == 0 ? 32 : kt == 1 ? 33 : kt - 2) : (kt == 0 ? 33 : kt == 1 ? 32 : 33 - kt);
                    return *(const u32x4*)(base + ((size_t)ck * 128 + row) * 128 + j); } };
            struct LdV { const bf16_t* base; int dir;
                __device__ __forceinline__ u32x4 operator()(int row, int k) const { const int kt = k >> 7, j = k & 127;
                    const int ck = dir == 0 ? (kt == 0 ? 32 : kt == 1 ? 33 : kt - 2) : (kt == 0 ? 33 : kt == 1 ? 32 : 33 - kt);
                    return *(const u32x4*)(base + ((size_t)ck * 256 + row) * 128 + j); } };
            struct Pre { float g;
                __device__ __forceinline__ void operator()(int, f32x4 (&acc)[4][1]) const {
#pragma unroll
                    for (int m = 0; m < 4; ++m) acc[m][0] = acc[m][0] * g; } };
            struct Post { unsigned char* out; int tl;
                __device__ __forceinline__ void operator()(int kt, f32x4 (&acc)[4][1]) const {
                    const int wr = tl >> 8, wc = (tl >> 6) & 3, fr = tl & 15, fq = (tl >> 4) & 3;
                    unsigned char* o = out + (size_t)kt * 32768 + (size_t)(wc * 16 + fr) * 128 + wr * 64 + 16 * fq;
                    u32x4 w; w.x = pk_fp8x4(acc[0][0][0] * 16.f, acc[0][0][1] * 16.f, acc[0][0][2] * 16.f, acc[0][0][3] * 16.f); w.y = pk_fp8x4(acc[1][0][0] * 16.f, acc[1][0][1] * 16.f, acc[1][0][2] * 16.f, acc[1][0][3] * 16.f);
                    w.z = pk_fp8x4(acc[2][0][0] * 16.f, acc[2][0][1] * 16.f, acc[2][0][2] * 16.f, acc[2][0][3] * 16.f); w.w = pk_fp8x4(acc[3][0][0] * 16.f, acc[3][0][1] * 16.f, acc[3][0][2] * 16.f, acc[3][0][3] * 16.f);
                    *(u32x4*)o = w; } };
            f32x4 acc[4][1];
#pragma unroll
            for (int m = 0; m < 4; ++m) acc[m][0] = (f32x4){0.f, 0.f, 0.f, 0.f};
            const LdK al{KT + (size_t)bh * 34 * 128 * 128, wtab, dir}; const LdV bl{VT + (size_t)bh * 34 * 256 * 128 + (size_t)dvq * 64 * 128, dir};
            const Pre pre{g128}; const Post post{(unsigned char*)KV + (size_t)chain * 33 * 32768 + (size_t)dvq * 64 * 128, tl};
            u32x4 rg[3][6];
#define CH_LOAD(slot, kt) do { int _t = tl; asm volatile("" : "+v"(_t)); _Pragma("unroll") for (int i = 0; i < 4; ++i) { const int pz = _t + 512 * i; rg[slot][i] = al(pz >> 4, (kt) * 128 + (pz & 15) * 8); } \
        _Pragma("unroll") for (int i = 0; i < 2; ++i) { const int pz = _t + 512 * i; rg[slot][4 + i] = bl(pz >> 4, (kt) * 128 + (pz & 15) * 8); } } while (0)
#define CH_PUT(slot, buf) do { \
        _Pragma("unroll") for (int i = 0; i < 4; ++i) { const int pz = tl + 512 * i; \
            *(LAS u32x4*)(lds + (buf) * 52224 + (pz >> 4) * 272 + (pz & 15) * 16) = gt::scale8(rg[slot][i], wq0[0], wq0[1], wq0[2], wq0[3], wq1[0], wq1[1], wq1[2], wq1[3]); } \
        _Pragma("unroll") for (int i = 0; i < 2; ++i) { const int pz = tl + 512 * i; *(LAS u32x4*)(lds + (buf) * 52224 + 128 * 272 + (pz >> 4) * 272 + (pz & 15) * 16) = rg[slot][4 + i]; } } while (0)
#define CH_STEP2(kt, nslot, buf) do { if ((kt) + 1 < 33) { CH_PUT(nslot, (buf) ^ 1); if ((kt) + 4 < 33) CH_LOAD(nslot, (kt) + 4); } \
        pre(kt, acc); gt::compute_tile_chain(acc, lds + (buf) * 52224, tl); post(kt, acc); __syncthreads(); } while (0)
            CH_LOAD(0, 0); CH_LOAD(1, 1); CH_LOAD(2, 2);
            const f32x4 wq0 = *(const LAS f32x4*)(wtab + (tl & 15) * 8), wq1 = *(const LAS f32x4*)(wtab + (tl & 15) * 8 + 4);
            CH_PUT(0, 0); CH_LOAD(0, 3);
            __syncthreads();
            for (int kt = 0; kt < 30; kt += 6) { CH_STEP2(kt, 1, 0); CH_STEP2(kt + 1, 2, 1); CH_STEP2(kt + 2, 0, 0); CH_STEP2(kt + 3, 1, 1); CH_STEP2(kt + 4, 2, 0); CH_STEP2(kt + 5, 0, 1); }
            CH_STEP2(30, 1, 0); CH_STEP2(31, 2, 1); CH_STEP2(32, 0, 0);
#undef CH_LOAD
#undef CH_STEP2
#undef CH_PUT
        }
    }
    }

    { DECL_PTRS
    {
        typedef float f32x16 __attribute__((ext_vector_type(16)));
        constexpr int CPB = 16448, ZOFF = 4 * CPB, ROWB = 10256, PADB = 992;
        for (int i = tid; i < (8 * ROWB) / 16; i += 512) *(LAS u32x4*)(lds + ZOFF + i * 16) = (u32x4){0u, 0u, 0u, 0u};
        __syncthreads();
        u32x4 zr[8], tv0[2], tv1[2];
#define CV_FETCH(cc) do { int _t = tid; asm volatile("" : "+v"(_t)); const bf16_t* _z = ZT + (size_t)(cc) * 8 * SEQ; const bf16_t* _tr = TR + (size_t)(cc) * 8192; \
        _Pragma("unroll") for (int i = 0; i < 8; ++i) { const int q = _t + 512 * i; zr[i] = *(const u32x4*)(_z + (size_t)(q >> 9) * SEQ + (q & 511) * 8); } \
        _Pragma("unroll") for (int i = 0; i < 2; ++i) { const int u = _t + 512 * i; tv0[i] = *(const u32x4*)(_tr + 8 * u); tv1[i] = (u32x4){0u, 0u, 0u, 0u}; if (u < 1023) tv1[i] = *(const u32x4*)(_tr + 8 * u + 8); } } while (0)
        if (bid < 512) { int _t = tid; asm volatile("" : "+v"(_t)); const bf16_t* _tr = TR + (size_t)bid * 8192;
#pragma unroll
            for (int i = 0; i < 2; ++i) { const int u = _t + 512 * i; tv0[i] = *(const u32x4*)(_tr + 8 * u); tv1[i] = (u32x4){0u, 0u, 0u, 0u}; if (u < 1023) tv1[i] = *(const u32x4*)(_tr + 8 * u + 8); } }
        GRID_BAR();
        STAMP(3);
        if (bid < 512) { int _t = tid; asm volatile("" : "+v"(_t)); const bf16_t* _z = ZT + (size_t)bid * 8 * SEQ;
#pragma unroll
            for (int i = 0; i < 8; ++i) { const int q = _t + 512 * i; zr[i] = *(const u32x4*)(_z + (size_t)(q >> 9) * SEQ + (q & 511) * 8); } }
        constexpr int NTASK = NE * 1536;
        int tk = __builtin_amdgcn_readfirstlane(gw); bool pend = false;
        float wv[16]; unsigned char* wdst = nullptr;
#define XT_ISSUE() do { if (tk < NTASK) { int _l = lane; asm volatile("" : "+v"(_l)); const int e = tk / 1536, r3 = tk - e * 1536, which = r3 >> 9, r = r3 & 511, n = _l & 15, kq = _l >> 4; \
            const float* src; \
            if (which < 2) { const int k0 = 64 * (r >> 5) + 16 * kq, nn_ = 16 * (r & 31) + n; src = (which ? a.in[I_EW3] : a.in[I_EW1]) + (size_t)e * 1024 * 512 + (size_t)k0 * 512 + nn_; \
                wdst = (unsigned char*)WE13 + (size_t)e * 1024 * 1024 + (size_t)(256 * (nn_ >> 7) + (nn_ & 127) + 128 * which) * 1024 + k0; \
                _Pragma("unroll") for (int j = 0; j < 16; ++j) wv[j] = __builtin_nontemporal_load(src + j * 512); } \
            else { const int k0 = 64 * (r >> 6) + 16 * kq, nn_ = 16 * (r & 63) + n; src = a.in[I_EW2] + (size_t)e * 512 * 1024 + (size_t)k0 * 1024 + nn_; \
                wdst = (unsigned char*)WE2 + (size_t)e * 1024 * 512 + (size_t)nn_ * 512 + k0; \
                _Pragma("unroll") for (int j = 0; j < 16; ++j) wv[j] = __builtin_nontemporal_load(src + j * 1024); } \
            pend = true; tk += NGW; } } while (0)
#define XT_RETIRE() do { if (pend) { u32x4 o_; o_.x = pk_fp8x4(wv[0] * 32.f, wv[1] * 32.f, wv[2] * 32.f, wv[3] * 32.f); o_.y = pk_fp8x4(wv[4] * 32.f, wv[5] * 32.f, wv[6] * 32.f, wv[7] * 32.f); \
            o_.z = pk_fp8x4(wv[8] * 32.f, wv[9] * 32.f, wv[10] * 32.f, wv[11] * 32.f); o_.w = pk_fp8x4(wv[12] * 32.f, wv[13] * 32.f, wv[14] * 32.f, wv[15] * 32.f); *(u32x4*)wdst = o_; pend = false; } } while (0)
        for (int c = bid; c < 512; c += G) {
            int tl = tid; asm volatile("" : "+v"(tl));
            const int w = tl >> 6, l = tl & 63, col = l & 31, hh = l >> 5, Rl = col >> 3, nn = col & 7;
            bf16_t* zc = ZT + (size_t)c * 8 * SEQ;
#pragma unroll
            for (int i = 0; i < 8; ++i) { const int q = tl + 512 * i, n = q >> 9, off = (q & 511) * 8; *(LAS u32x4*)(lds + ZOFF + n * ROWB + PADB + off * 2) = zr[i]; }
#pragma unroll
            for (int i = 0; i < 2; ++i) { const int u = tl + 512 * i; const u32x4 v0 = tv0[i], v1 = tv1[i];
                const unsigned W0 = v0.x, W1 = v0.y, W2 = v0.z, W3 = v0.w, W4 = v1.x, W5 = v1.y;
                *(LAS u32x4*)(lds + 0 * CPB + 16 * u) = v0;
                *(LAS u32x4*)(lds + 1 * CPB + 16 * u) = (u32x4){(W0 >> 16) | (W1 << 16), (W1 >> 16) | (W2 << 16), (W2 >> 16) | (W3 << 16), (W3 >> 16) | (W4 << 16)};
                *(LAS u32x4*)(lds + 2 * CPB + 16 * u) = (u32x4){W1, W2, W3, W4};
                *(LAS u32x4*)(lds + 3 * CPB + 16 * u) = (u32x4){(W1 >> 16) | (W2 << 16), (W2 >> 16) | (W3 << 16), (W3 >> 16) | (W4 << 16), (W4 >> 16) | (W5 << 16)}; }
            __syncthreads();
            if (c + G < 512) CV_FETCH(c + G);
            const int dlo = 32 * w - 255;
            const int e0 = 4096 - 16 * dlo - col + 8 * hh;
            int aaddr = (e0 & 3) * CPB + 2 * (e0 & ~3);
            int baddr = ZOFF + nn * ROWB + PADB + 2 * (512 * w + 64 * Rl + 8 * hh - 16 * dlo);
            f32x16 acc[4];
#pragma unroll
            for (int q = 0; q < 4; ++q)
#pragma unroll
                for (int i = 0; i < 16; ++i) acc[q][i] = 0.f;
            u32x2 alo = *(const LAS u32x2*)(lds + aaddr), ahi = *(const LAS u32x2*)(lds + aaddr + 8);
            u32x4 bq[4];
#pragma unroll
            for (int q = 0; q < 4; ++q) bq[q] = *(const LAS u32x4*)(lds + baddr + 512 * (q >> 1) + 64 * (q & 1));
            for (int seg = 0; seg < 15; ++seg) {
            XT_RETIRE(); XT_ISSUE();
#pragma unroll 1
            for (int it = 0; it < 19; ++it) {
                aaddr -= 32; baddr -= 32;
                const u32x2 nlo = *(const LAS u32x2*)(lds + aaddr), nhi = *(const LAS u32x2*)(lds + aaddr + 8);
                u32x4 nb[4];
#pragma unroll
                for (int q = 0; q < 4; ++q) nb[q] = *(const LAS u32x4*)(lds + baddr + 512 * (q >> 1) + 64 * (q & 1));
                const bf16x8 af = __builtin_bit_cast(bf16x8, (u32x4){alo.x, alo.y, ahi.x, ahi.y});
#pragma unroll
                for (int q = 0; q < 4; ++q) acc[q] = __builtin_amdgcn_mfma_f32_32x32x16_bf16(af, __builtin_bit_cast(bf16x8, bq[q]), acc[q], 0, 0, 0);
                alo = nlo; ahi = nhi;
#pragma unroll
                for (int q = 0; q < 4; ++q) bq[q] = nb[q];
            }
            }
            XT_RETIRE();
            {
                const bf16x8 af = __builtin_bit_cast(bf16x8, (u32x4){alo.x, alo.y, ahi.x, ahi.y});
#pragma unroll
                for (int q = 0; q < 4; ++q) acc[q] = __builtin_amdgcn_mfma_f32_32x32x16_bf16(af, __builtin_bit_cast(bf16x8, bq[q]), acc[q], 0, 0, 0);
            }
            const float skip = a.in[I_HSKIP][c];
#pragma unroll
            for (int q = 0; q < 4; ++q)
#pragma unroll
                for (int gq = 0; gq < 4; ++gq) {
                    const int t0 = 512 * w + 256 * (q >> 1) + 32 * (q & 1) + 64 * Rl + 8 * gq + 4 * hh;
                    const u32x2 zz = *(const LAS u32x2*)(lds + ZOFF + nn * ROWB + PADB + 2 * t0);
                    u32x2 o; o.x = pk2(acc[q][4 * gq] + skip * bflo(zz.x), acc[q][4 * gq + 1] + skip * bfhi(zz.x)); o.y = pk2(acc[q][4 * gq + 2] + skip * bflo(zz.y), acc[q][4 * gq + 3] + skip * bfhi(zz.y));
                    *(u32x2*)(zc + (size_t)nn * SEQ + t0) = o;
                }
            __syncthreads();
        }
        while (tk < NTASK) { XT_ISSUE(); XT_RETIRE(); }
    }
    asm volatile("s_waitcnt vmcnt(0)" ::: "memory");
    __syncthreads();
    if (tid == 0) { __builtin_amdgcn_fence(__ATOMIC_RELEASE, "agent"); asm volatile("s_waitcnt vmcnt(0)" ::: "memory"); (void)xb_add((unsigned*)cnt + 41, 1u); }
    }
    STAMP(4);

    { DECL_PTRS
    {
        LAS unsigned char* Pl = lds + 104448;
        LAS float* sfb = (LAS float*)(lds + 104448 + 128 * 272);
        LAS float* rsum = sfb + 256;
        LAS bf16_t* ot = (LAS bf16_t*)lds;
        for (int u = bid; u < 1024; u += G) {
            int tl = tid; asm volatile("" : "+v"(tl));
            const int wr = tl >> 8, wc = (tl >> 6) & 3, fr = tl & 15, fq = (tl >> 4) & 3;
            const int bh = u >> 5, c = u & 31, b = bh >> 2, h = bh & 3, row0 = b * SEQ + c * 128;
            const float lgf = lg2_decay(a.in[I_DECAY][h]), lgb = lg2_decay(a.in[I_DECAY][4 + h]);
            if (tl < 128) sfb[tl] = 0.0625f * exp2f((float)(tl + 1) * lgf); else if (tl < 256) sfb[tl] = 0.0625f * exp2f((float)(128 - (tl - 128)) * lgb);
            {
                f32x4 sacc[4][2];
#pragma unroll
                for (int m = 0; m < 4; ++m)
#pragma unroll
                    for (int n = 0; n < 2; ++n) sacc[m][n] = (f32x4){0.f, 0.f, 0.f, 0.f};
                gt::gemm_tile<2, 128>(sacc, gt::LdRows{Qb + (size_t)row0 * 512 + h * 128, 512}, gt::LdRows{Kb + (size_t)row0 * 512 + h * 128, 512}, 1, lds, tl);
#pragma unroll
                for (int m = 0; m < 4; ++m)
#pragma unroll
                    for (int n = 0; n < 2; ++n)
#pragma unroll
                        for (int j = 0; j < 4; ++j) { const int i = wr * 64 + m * 16 + 4 * fq + j, jj = wc * 32 + n * 16 + fr, df = i - jj;
                            const float dcy = __builtin_amdgcn_exp2f(df >= 0 ? (float)df * lgf : (float)(-df) * lgb);
                            *(LAS bf16_t*)(Pl + i * 272 + jj * 2) = (bf16_t)f2bf(sacc[m][n][j] * dcy); }
                asm volatile("" ::: "memory");
            }
            __syncthreads();
            struct LdA2 { LAS unsigned char* P; const bf16_t* q; const LAS float* sc;
                __device__ __forceinline__ u32x4 operator()(int row, int k) const {
                    if (k < 128) return *(const LAS u32x4*)(P + row * 272 + k * 2);
                    return *(const u32x4*)(q + (size_t)row * 512 + (k < 256 ? k - 128 : k - 256)); } };
            struct TfA2 { const LAS float* sc;
                __device__ __forceinline__ u32x4 operator()(int row, int k, u32x4 v) const { if (k < 128) return v; const float s = sc[k < 256 ? row : 128 + row]; return gt::scale8(v, s, s, s, s, s, s, s, s); } };
            struct LdB2 { const bf16_t* vt; const unsigned char* sf; const unsigned char* sb;
                __device__ __forceinline__ u32x4 operator()(int dv, int k) const {
                    if (k < 128) return *(const u32x4*)(vt + (size_t)dv * 128 + k);
                    const u32x2 t = k < 256 ? *(const u32x2*)(sf + (size_t)dv * 128 + (k - 128)) : *(const u32x2*)(sb + (size_t)dv * 128 + (k - 256));
                    u32x4 r; r.x = t.x; r.y = t.y; r.z = 0u; r.w = 0u; return r; } };
            struct TfB2 {
                __device__ __forceinline__ u32x4 operator()(int, int k, u32x4 v) const { if (k < 128) return v;
                    const auto f0 = __builtin_amdgcn_cvt_pk_f32_fp8(v.x, false), f1 = __builtin_amdgcn_cvt_pk_f32_fp8(v.x, true), f2 = __builtin_amdgcn_cvt_pk_f32_fp8(v.y, false), f3 = __builtin_amdgcn_cvt_pk_f32_fp8(v.y, true);
                    u32x4 o; o.x = pk2(f0[0], f0[1]); o.y = pk2(f1[0], f1[1]); o.z = pk2(f2[0], f2[1]); o.w = pk2(f3[0], f3[1]); return o; } };
            f32x4 acc[4][4];
#pragma unroll
            for (int m = 0; m < 4; ++m)
#pragma unroll
                for (int n = 0; n < 4; ++n) acc[m][n] = (f32x4){0.f, 0.f, 0.f, 0.f};
            const LdA2 al{Pl, Qb + (size_t)row0 * 512 + h * 128, sfb};
            const LdB2 bl{VT + ((size_t)bh * 34 + c) * 256 * 128, (const unsigned char*)KV + ((size_t)(bh * 2 + 0) * 33 + (c + 1)) * 32768, (const unsigned char*)KV + ((size_t)(bh * 2 + 1) * 33 + (32 - c)) * 32768};
            gt::gemm_tile<4, 128>(acc, al, bl, 3, lds, tl, gt::NoHook(), gt::NoHook(), TfA2{sfb}, TfB2());
            u32x4 gvv[8];
#pragma unroll
            for (int i = 0; i < 8; ++i) { const int pz = tl + 512 * i; gvv[i] = *(const u32x4*)(SG + (size_t)(row0 + (pz >> 5)) * 1024 + h * 256 + (pz & 31) * 8); }
#pragma unroll
            for (int m = 0; m < 4; ++m)
#pragma unroll
                for (int j = 0; j < 4; ++j) { float s = 0.f;
#pragma unroll
                    for (int n = 0; n < 4; ++n) s += acc[m][n][j] * acc[m][n][j];
                    s += __int_as_float(__builtin_amdgcn_update_dpp(0, __float_as_int(s), 0xB1, 0xf, 0xf, true)); s += __int_as_float(__builtin_amdgcn_update_dpp(0, __float_as_int(s), 0x4E, 0xf, 0xf, true));
                    s += __int_as_float(__builtin_amdgcn_update_dpp(0, __float_as_int(s), 0x124, 0xf, 0xf, true)); s += __int_as_float(__builtin_amdgcn_update_dpp(0, __float_as_int(s), 0x128, 0xf, 0xf, true));
                    if (fr == 0) rsum[(wr * 64 + m * 16 + 4 * fq + j) * 4 + wc] = s; }
            __syncthreads();
            f32x4 rsv[4][4];
#pragma unroll
            for (int m = 0; m < 4; ++m)
#pragma unroll
                for (int j = 0; j < 4; ++j) rsv[m][j] = *(const LAS f32x4*)(rsum + (wr * 64 + m * 16 + 4 * fq + j) * 4);
#pragma unroll
            for (int m = 0; m < 4; ++m)
#pragma unroll
                for (int j = 0; j < 4; ++j) { const int i = wr * 64 + m * 16 + 4 * fq + j; const f32x4 rs = rsv[m][j];
                    const float rstd = rsqrtf(((rs[0] + rs[1]) + (rs[2] + rs[3])) * (1.f / 256.f) + EPS);
#pragma unroll
                    for (int n = 0; n < 4; ++n) ot[i * 264 + wc * 64 + n * 16 + fr] = (bf16_t)f2bf(acc[m][n][j] * rstd); }
            __syncthreads();
#pragma unroll
            for (int i = 0; i < 8; ++i) { const int pz = tl + 512 * i, row = pz >> 5, c8 = pz & 31;
                const u32x4 gv = gvv[i], ov = *(const LAS u32x4*)(ot + row * 264 + c8 * 8);
                u32x2 o; o.x = pk_fp8x4(16.f * bflo(gv.x) * bflo(ov.x), 16.f * bfhi(gv.x) * bfhi(ov.x), 16.f * bflo(gv.y) * bflo(ov.y), 16.f * bfhi(gv.y) * bfhi(ov.y));
                o.y = pk_fp8x4(16.f * bflo(gv.z) * bflo(ov.z), 16.f * bfhi(gv.z) * bfhi(ov.z), 16.f * bflo(gv.w) * bflo(ov.w), 16.f * bfhi(gv.w) * bfhi(ov.w));
                *(u32x2*)(RG8 + (size_t)(row0 + row) * 1024 + h * 256 + c8 * 8) = o; }
            __syncthreads();
        }
    }
    { unsigned* cw_ = (unsigned*)cnt + 41; unsigned* bar_ = (unsigned*)cnt + 1024;
      __syncthreads();
      if (tid == 0) { XB_SPIN(xb_ld(cw_) < (unsigned)G, bar_); __builtin_amdgcn_fence(__ATOMIC_ACQUIRE, "agent"); asm volatile("s_waitcnt vmcnt(0)" ::: "memory"); }
      __syncthreads(); }
    for (int it = bid; it < 512; it += G) {
        const int b = it >> 6, tt = (it >> 3) & 7, cc = it & 7;
        LAS bf16_t* yt = (LAS bf16_t*)lds;
        u32x4 ytv[8];
#pragma unroll
        for (int i = 0; i < 8; ++i) { const int ch = wave * 8 + i; ytv[i] = *(const u32x4*)(ZT + ((size_t)(cc * 64 + ch) * 8 + b) * SEQ + tt * 512 + lane * 8); }
#pragma unroll
        for (int i = 0; i < 8; ++i) { const int ch = wave * 8 + i; *(LAS u32x4*)(yt + ch * 520 + lane * 8) = ytv[i]; }
        __syncthreads();
        { int tl = tid; asm volatile("" : "+v"(tl));
          const int tq = tl >> 3, cg = tl & 7, c0 = cc * 64 + cg * 8, t0 = tt * 512 + tq * 8, row0 = b * SEQ + t0;
          float x0[8][8];
          short_conv8x8(HU, row0, t0, c0, a.in[I_HCW], a.in[I_HCB], x0);
          u32x4 yv[8];
#pragma unroll
          for (int e = 0; e < 8; ++e) yv[e] = *(const LAS u32x4*)(yt + (cg * 8 + e) * 520 + tq * 8);
#pragma unroll
          for (int t = 0; t < 8; ++t) { float o[8];
#pragma unroll
              for (int e = 0; e < 8; ++e) { const unsigned wd = (t >> 1) == 0 ? yv[e].x : (t >> 1) == 1 ? yv[e].y : (t >> 1) == 2 ? yv[e].z : yv[e].w; o[e] = x0[t][e] * ((t & 1) ? bfhi(wd) : bflo(wd)); }
              u32x4 w; w.x = pk2(o[0], o[1]); w.y = pk2(o[2], o[3]); w.z = pk2(o[4], o[5]); w.w = pk2(o[6], o[7]);
              *(u32x4*)(HU + (size_t)(row0 + t) * 1536 + 512 + c0) = w; } }
        __syncthreads();
    }
    asm volatile("s_waitcnt vmcnt(0)" ::: "memory");
    __syncthreads();
    if (tid == 0) { __builtin_amdgcn_fence(__ATOMIC_RELEASE, "agent"); asm volatile("s_waitcnt vmcnt(0)" ::: "memory"); (void)xb_add((unsigned*)cnt + 46, 1u); }
    }
    STAMP(5);

    { DECL_PTRS
    bf16_t* SGHhi = (bf16_t*)(dob + 32 * MiB);
    {
        pg8::Gemm g{(const bf16_t*)XN8, (const bf16_t*)(WTG8 + (size_t)1024 * 1024), 512, 512, 512}; pg8::StaticOrder S; S.init(T, 1024, G, bid);
        pg8::EpiGate E{SGH, a.in[I_BIN] + NINA + 1024, SGHhi};
        pg8::gemm_phase<pg8::EpiGate, pg8::StaticOrder, false, true>(lds, g, S, E);
    }
    { unsigned* cw_ = (unsigned*)cnt + 46; unsigned* bar_ = (unsigned*)cnt + 1024;
      __syncthreads();
      if (tid == 0) { XB_SPIN(xb_ld(cw_) < (unsigned)G, bar_); __builtin_amdgcn_fence(__ATOMIC_ACQUIRE, "agent"); asm volatile("s_waitcnt vmcnt(0)" ::: "memory"); }
      __syncthreads(); }
    {
        pg8::Gemm g{HU + 512, WT_HYO, 512, 1536, 512}; pg8::StaticOrder S; S.init(T, 1024, G, bid);
        pg8::EpiMerge<0> E{SGH, nullptr, SGHhi};
        pg8::gemm_phase(lds, g, S, E);
    }
    {
        pg8::Gemm g{(const bf16_t*)XN8, (const bf16_t*)WTG8, 512, 512, 512}; pg8::StaticOrder S; S.init(T, 1024, G, bid);
        pg8::EpiGate E{SGR, a.in[I_BIN] + NINA, SGR + (size_t)16384 * 1024};
        pg8::gemm_phase<pg8::EpiGate, pg8::StaticOrder, false, true>(lds, g, S, E);
    }
    {
        pg8::Gemm g{(const bf16_t*)RG8, WT_RETO, 512, 512, 512}; pg8::StaticOrder S; S.init(T, 1024, G, bid);
        pg8::EpiMerge<1, 9> E{SGR, SGH, SGHhi};
        pg8::gemm_phase<pg8::EpiMerge<1, 9>, pg8::StaticOrder, false, true>(lds, g, S, E);
    }
    }
    GRID_BAR();
    STAMP(6);
    STAMP(7);
    STAMP(8);
    { DECL_PTRS
    {
        pg8::Gemm g{(const bf16_t*)KV  , WT_OUT  , 512, 512, 512}; pg8::StaticOrder S; S.init(T, 1024, G, bid);
        pg8::EpiX1 E{a.in[I_X], MOD, X1, 1.f / 1024.f};
        pg8::gemm_phase<pg8::EpiX1, pg8::StaticOrder, false, true>(lds, g, S, E);
    }
    }
    GRID_BAR();
    STAMP(9);

    { DECL_PTRS
    {
        LAS unsigned short* Wh = (LAS unsigned short*)lds; LAS unsigned short* Wo = Wh + 36 * 1032;
        { int tl = tid; asm volatile("" : "+v"(tl));
#pragma unroll 2
          for (int ps = 0; ps < 8; ++ps) { const int cc = tl & 31, k0 = ps * 128 + (tl >> 5) * 8; float w[8];
#pragma unroll
              for (int j = 0; j < 8; ++j) w[j] = a.in[I_REW][(size_t)(k0 + j) * 32 + cc];
              u32x4 H, L; H.x = pk2(w[0], w[1]); H.y = pk2(w[2], w[3]); H.z = pk2(w[4], w[5]); H.w = pk2(w[6], w[7]);
              L.x = pk2(w[0] - bflo(H.x), w[1] - bfhi(H.x)); L.y = pk2(w[2] - bflo(H.y), w[3] - bfhi(H.y)); L.z = pk2(w[4] - bflo(H.z), w[5] - bfhi(H.z)); L.w = pk2(w[6] - bflo(H.w), w[7] - bfhi(H.w));
              *(LAS u32x4*)(Wh + (4 + cc) * 1032 + k0) = H; *(LAS u32x4*)(Wo + (4 + cc) * 1032 + k0) = L; }
          { const int cc = tl & 3, k0 = (tl >> 2) * 8; float w[8];
#pragma unroll
            for (int j = 0; j < 8; ++j) w[j] = a.in[I_RGW][(size_t)(k0 + j) * 4 + cc];
            u32x4 H, L; H.x = pk2(w[0], w[1]); H.y = pk2(w[2], w[3]); H.z = pk2(w[4], w[5]); H.w = pk2(w[6], w[7]);
            L.x = pk2(w[0] - bflo(H.x), w[1] - bfhi(H.x)); L.y = pk2(w[2] - bflo(H.y), w[3] - bfhi(H.y)); L.z = pk2(w[4] - bflo(H.z), w[5] - bfhi(H.z)); L.w = pk2(w[6] - bflo(H.w), w[7] - bfhi(H.w));
            *(LAS u32x4*)(Wh + cc * 1032 + k0) = H; *(LAS u32x4*)(Wo + cc * 1032 + k0) = L; }
        }
        __syncthreads();
        unsigned char* H2 = (unsigned char*)SG;
        LAS float* Sw = (LAS float*)(lds + 151552 + wave * 1152);
        LAS int* lcnt = (LAS int*)(lds + 151552 + 9216);
        if (tid < NE) lcnt[tid] = 0;
        __syncthreads();
        for (int rb = gw; rb < T / 16; rb += NGW) {
            int ll = lane; asm volatile("" : "+v"(ll));
            const int r = ll & 15, kq = ll >> 4, row = rb * 16 + r, b = (rb * 16) >> 12;
            const float* md = MOD + (size_t)b * 6144; const bf16_t* xr = X1 + (size_t)row * D + 16 * kq;
            float s = 0.f;
#pragma unroll 8
            for (int i = 0; i < 16; ++i) { const u32x4 xa = *(const u32x4*)(xr + 64 * i), xb = *(const u32x4*)(xr + 64 * i + 8);
                s += (bflo(xa.x) * bflo(xa.x) + bfhi(xa.x) * bfhi(xa.x)) + (bflo(xa.y) * bflo(xa.y) + bfhi(xa.y) * bfhi(xa.y)) + (bflo(xa.z) * bflo(xa.z) + bfhi(xa.z) * bfhi(xa.z)) + (bflo(xa.w) * bflo(xa.w) + bfhi(xa.w) * bfhi(xa.w));
                s += (bflo(xb.x) * bflo(xb.x) + bfhi(xb.x) * bfhi(xb.x)) + (bflo(xb.y) * bflo(xb.y) + bfhi(xb.y) * bfhi(xb.y)) + (bflo(xb.z) * bflo(xb.z) + bfhi(xb.z) * bfhi(xb.z)) + (bflo(xb.w) * bflo(xb.w) + bfhi(xb.w) * bfhi(xb.w)); }
            s += __shfl_xor(s, 16); s += __shfl_xor(s, 32);
            const float rstd = rsqrtf(s * (1.f / D) + EPS);
            f32x4 lacc[3];
#pragma unroll
            for (int ct = 0; ct < 3; ++ct) lacc[ct] = (f32x4){0.f, 0.f, 0.f, 0.f};
            const int c0 = ll & 15, c2 = (32 + c0) < 36 ? 32 + c0 : 35;
#pragma unroll 1
            for (int i4 = 0; i4 < 4; ++i4) { u32x4 hwv[4];
#pragma unroll
            for (int ii = 0; ii < 4; ++ii) { const int i = 4 * i4 + ii;
                const int k0 = 64 * i + 16 * kq;
                const u32x4 xa = *(const u32x4*)(xr + 64 * i), xb = *(const u32x4*)(xr + 64 * i + 8);
                float xs[16] = {bflo(xa.x), bfhi(xa.x), bflo(xa.y), bfhi(xa.y), bflo(xa.z), bfhi(xa.z), bflo(xa.w), bfhi(xa.w), bflo(xb.x), bfhi(xb.x), bflo(xb.y), bfhi(xb.y), bflo(xb.z), bfhi(xb.z), bflo(xb.w), bfhi(xb.w)};
                float hv[16];
#pragma unroll
                for (int q = 0; q < 4; ++q) { const f32x4 gv = *(const f32x4*)(a.in[I_N2G] + k0 + 4 * q), sc = *(const f32x4*)(md + 4096 + k0 + 4 * q), sh = *(const f32x4*)(md + 3072 + k0 + 4 * q);
#pragma unroll
                    for (int e = 0; e < 4; ++e) hv[4 * q + e] = (xs[4 * q + e] * rstd * gv[e]) * (sc[e] + 1.f) + sh[e]; }
                hwv[ii].x = pk_fp8x4(hv[0], hv[1], hv[2], hv[3]); hwv[ii].y = pk_fp8x4(hv[4], hv[5], hv[6], hv[7]); hwv[ii].z = pk_fp8x4(hv[8], hv[9], hv[10], hv[11]); hwv[ii].w = pk_fp8x4(hv[12], hv[13], hv[14], hv[15]);
#pragma unroll
                for (int hh = 0; hh < 2; ++hh) {
                    u32x4 ah, ao;
                    ah.x = pk2(hv[8 * hh + 0], hv[8 * hh + 1]); ah.y = pk2(hv[8 * hh + 2], hv[8 * hh + 3]); ah.z = pk2(hv[8 * hh + 4], hv[8 * hh + 5]); ah.w = pk2(hv[8 * hh + 6], hv[8 * hh + 7]);
                    ao.x = pk2(hv[8 * hh + 0] - bflo(ah.x), hv[8 * hh + 1] - bfhi(ah.x)); ao.y = pk2(hv[8 * hh + 2] - bflo(ah.y), hv[8 * hh + 3] - bfhi(ah.y));
                    ao.z = pk2(hv[8 * hh + 4] - bflo(ah.z), hv[8 * hh + 5] - bfhi(ah.z)); ao.w = pk2(hv[8 * hh + 6] - bflo(ah.w), hv[8 * hh + 7] - bfhi(ah.w));
                    const bf16x8 Ah = __builtin_bit_cast(bf16x8, ah), Ao = __builtin_bit_cast(bf16x8, ao);
                    const int kb = k0 + 8 * hh;
                    const bf16x8 b0h = *(const LAS bf16x8*)(Wh + c0 * 1032 + kb), b1h = *(const LAS bf16x8*)(Wh + (16 + c0) * 1032 + kb), b2h = *(const LAS bf16x8*)(Wh + c2 * 1032 + kb);
                    const bf16x8 b0o = *(const LAS bf16x8*)(Wo + c0 * 1032 + kb), b1o = *(const LAS bf16x8*)(Wo + (16 + c0) * 1032 + kb), b2o = *(const LAS bf16x8*)(Wo + c2 * 1032 + kb);
                    lacc[0] = __builtin_amdgcn_mfma_f32_16x16x32_bf16(Ah, b0h, lacc[0], 0, 0, 0); lacc[1] = __builtin_amdgcn_mfma_f32_16x16x32_bf16(Ah, b1h, lacc[1], 0, 0, 0); lacc[2] = __builtin_amdgcn_mfma_f32_16x16x32_bf16(Ah, b2h, lacc[2], 0, 0, 0);
                    lacc[0] = __builtin_amdgcn_mfma_f32_16x16x32_bf16(Ao, b0h, lacc[0], 0, 0, 0); lacc[1] = __builtin_amdgcn_mfma_f32_16x16x32_bf16(Ao, b1h, lacc[1], 0, 0, 0); lacc[2] = __builtin_amdgcn_mfma_f32_16x16x32_bf16(Ao, b2h, lacc[2], 0, 0, 0);
                    lacc[0] = __builtin_amdgcn_mfma_f32_16x16x32_bf16(Ah, b0o, lacc[0], 0, 0, 0); lacc[1] = __builtin_amdgcn_mfma_f32_16x16x32_bf16(Ah, b1o, lacc[1], 0, 0, 0); lacc[2] = __builtin_amdgcn_mfma_f32_16x16x32_bf16(Ah, b2o, lacc[2], 0, 0, 0);
                }
            }
#pragma unroll
            for (int ii = 0; ii < 4; ++ii) *(u32x4*)(H2 + (size_t)row * D + 64 * (4 * i4 + ii) + 16 * kq) = hwv[ii];
            }
#pragma unroll
            for (int hf = 0; hf < 2; ++hf) {
                if ((kq >> 1) == hf) {
#pragma unroll
                    for (int j = 0; j < 4; ++j) { LAS float* sp = Sw + (4 * (kq & 1) + j) * 36 + c0; sp[0] = lacc[0][j]; sp[16] = lacc[1][j]; if (c0 < 4) sp[32] = lacc[2][j]; }
                }
                asm volatile("s_waitcnt lgkmcnt(0)" ::: "memory");
                if (ll < 8) {
                    const int rrow = rb * 16 + 8 * hf + ll;
                    float lg[36];
#pragma unroll
                    for (int q = 0; q < 9; ++q) { const f32x4 v = *(const LAS f32x4*)(Sw + ll * 36 + 4 * q); lg[4 * q] = v[0]; lg[4 * q + 1] = v[1]; lg[4 * q + 2] = v[2]; lg[4 * q + 3] = v[3]; }
                    float gl[4];
#pragma unroll
                    for (int j = 0; j < 4; ++j) gl[j] = lg[j] + a.in[I_RGB][j];
                    int gs = 0; float gm = gl[0];
#pragma unroll
                    for (int j = 1; j < 4; ++j) if (gl[j] > gm) { gm = gl[j]; gs = j; }
                    float den = 0.f;
#pragma unroll
                    for (int j = 0; j < 4; ++j) den += expf(gl[j] - gm);
                    const float pstar = 1.f / den;
                    float el[8];
#pragma unroll
                    for (int e = 0; e < 8; ++e) { const float v0 = lg[4 + e], v1 = lg[12 + e], v2 = lg[20 + e], v3 = lg[28 + e]; el[e] = (gs == 0 ? v0 : gs == 1 ? v1 : gs == 2 ? v2 : v3) + a.in[I_REB][gs * 8 + e]; }
                    int e0 = 0; float m0 = el[0];
#pragma unroll
                    for (int e = 1; e < 8; ++e) if (el[e] > m0) { m0 = el[e]; e0 = e; }
                            int e1 = e0 == 0 ? 1 : 0; float m1 = e0 == 0 ? el[1] : el[0];
#pragma unroll
                    for (int e = 1; e < 8; ++e) if (e != e0 && el[e] > m1) { m1 = el[e]; e1 = e; }
                    const float ex = expf(m1 - m0); const float w0 = pstar / (1.f + ex), w1 = pstar * ex / (1.f + ex);
                    const int E0 = gs * 8 + e0, E1 = gs * 8 + e1;
                    const int s0 = __hip_atomic_fetch_add(lcnt + E0, 1, __ATOMIC_RELAXED, __HIP_MEMORY_SCOPE_WORKGROUP), s1 = __hip_atomic_fetch_add(lcnt + E1, 1, __ATOMIC_RELAXED, __HIP_MEMORY_SCOPE_WORKGROUP);
                    int4 ti; ti.x = (E0 << 16) | s0; ti.y = (E1 << 16) | s1; ti.z = __float_as_int(w0); ti.w = __float_as_int(w1);
                    *(int4*)(TOKINFO + (size_t)rrow * 4) = ti;
                }
                asm volatile("s_waitcnt lgkmcnt(0)" ::: "memory");
            }
        }
        __syncthreads();
        LAS int* gbase = lcnt + 32;
        if (tid < NE) gbase[tid] = (int)__hip_atomic_fetch_add((unsigned*)cnt + tid, (unsigned)lcnt[tid], __ATOMIC_RELAXED, __HIP_MEMORY_SCOPE_AGENT);
        asm volatile("s_waitcnt vmcnt(0)" ::: "memory");
        __syncthreads();
        int* ROWTOK2 = LISTS + 262144;
        for (int rb = gw; rb < T / 16; rb += NGW) {
            if (lane < 16) { const int row = rb * 16 + lane;
                int4 ti = *(const int4*)(TOKINFO + (size_t)row * 4);
                const int e0 = ti.x >> 16, e1 = ti.y >> 16, s0 = gbase[e0] + (ti.x & 0xffff), s1 = gbase[e1] + (ti.y & 0xffff);
                ROWTOK2[e0 * 32768 + s0] = row; ROWTOK2[e1 * 32768 + s1] = row;
                ti.x = (e0 << 16) | s0; ti.y = (e1 << 16) | s1; *(int4*)(TOKINFO + (size_t)row * 4) = ti; }
        }
    }
    }
    GRID_BAR();
    STAMP(10);

    LAS int* tbase = (LAS int*)(lds + MISC_OFF);
    LAS int* texp = tbase + 64;
    int ntiles = 0;
    { DECL_PTRS
    {
        LAS int* total = texp + 320;
        if (tid < NE) total[tid] = (int)((const unsigned*)cnt)[tid];
        __syncthreads();
        if (tid < NE) { int acc = 0; for (int j = 0; j < tid; ++j) acc += (total[j] + 255) >> 8; tbase[tid] = acc; if (tid == NE - 1) tbase[NE] = acc + ((total[tid] + 255) >> 8); }
        __syncthreads();
        ntiles = tbase[NE];
        for (int t = tid; t < ntiles; t += 512) { int e = 0;
#pragma unroll 8
            for (int j = 1; j < NE; ++j) e += (tbase[j] <= t) ? 1 : 0;
            texp[t] = e; }
        __syncthreads();
        int* ROWTOK = LISTS; const int* ROWTOK2 = LISTS + 262144;
        {
#define RT_LD(j, R, K) int R = -1, K = 0; { const int l_ = (2 * (j) + (tid >> 8)) * G + bid;          \
              if (l_ < ntiles * 4) { const int full_ = (ntiles >> 3) * 32, pm_ = l_ < full_ ? (l_ >> 5) * 8 + (l_ & 7) : (ntiles & ~7) + ((l_ - full_) >> 2); \
                  const int e_ = texp[pm_], loc_ = pm_ * 256 + (tid & 255) - tbase[e_] * 256; R = pm_ * 256 + (tid & 255); if (loc_ < total[e_]) K = ROWTOK2[e_ * 32768 + loc_]; } }
          RT_LD(0, r0_, k0_) RT_LD(1, r1_, k1_) RT_LD(2, r2_, k2_) RT_LD(3, r3_, k3_)
#undef RT_LD
          if (r0_ >= 0) ROWTOK[r0_] = k0_; if (r1_ >= 0) ROWTOK[r1_] = k1_; if (r2_ >= 0) ROWTOK[r2_] = k2_; if (r3_ >= 0) ROWTOK[r3_] = k3_;
        }
        asm volatile("s_waitcnt vmcnt(0)" ::: "memory");
        __syncthreads();
    }
    }
    STAMP(11);

    { DECL_PTRS
    {
        pg8::Gemm g{SG  , WE13, 512, 512, 512}; pg8::MoeOrder S{ntiles, G, bid, texp};
        pg8::EpiMoe1 E{(unsigned char*)HM};
        pg8::gemm_phase<pg8::EpiMoe1, pg8::MoeOrder, true, true>(lds, g, S, E, LISTS);
    }
    }
    GRID_BAR();
    STAMP(12);
    { DECL_PTRS
    {
        pg8::Gemm g{HM  , WE2, 256, 256, 256}; pg8::MoeOrder S{ntiles, G, bid, texp};
        pg8::EpiF8 E{(unsigned char*)XB, 1024, 0.5f};
        pg8::gemm_phase<pg8::EpiF8, pg8::MoeOrder, false, true>(lds, g, S, E);
    }
    }
    GRID_BAR();
    STAMP(13);

    { DECL_PTRS
    {
        const unsigned char* YB = (const unsigned char*)XB;
        f32x4 fg[4];
#pragma unroll
        for (int j = 0; j < 4; ++j) fg[j] = *(const f32x4*)(a.in[I_FNG] + 4 * lane + 256 * j);
        int4 tn[2]; u32x2 xw[2][4], nxw[2][4]; int y0[2][4], y1[2][4], ny0[2][4], ny1[2][4]; f32x4 gvr[2][4], ngv[2][4]; float wq[2][2], nwq[2][2];
#define P8_TOK(r0) do { _Pragma("unroll") for (int q = 0; q < 2; ++q) { const int rn = (r0) + q * NGW; tn[q] = rn < T ? *(const int4*)(TOKINFO + (size_t)rn * 4) : (int4){0, 0, 0, 0}; } } while (0)
#define P8_DATA(XW, Y0, Y1, GV, WQ, r0) do { _Pragma("unroll") for (int q = 0; q < 2; ++q) { const int rr = (r0) + q * NGW; const int row = rr < T ? rr : 0; const float* gt2 = MOD + (size_t)(row >> 12) * 6144 + 5120; \
            WQ[q][0] = __int_as_float(tn[q].z) * 0.0625f; WQ[q][1] = __int_as_float(tn[q].w) * 0.0625f;     \
            const int yr0_ = tbase[tn[q].x >> 16] * 256 + (tn[q].x & 0xffff), yr1_ = tbase[tn[q].y >> 16] * 256 + (tn[q].y & 0xffff);     \
            _Pragma("unroll") for (int j = 0; j < 4; ++j) { const int c0 = 4 * lane + 256 * j; \
                XW[q][j] = *(const u32x2*)(X1 + (size_t)row * D + c0); Y0[q][j] = *(const int*)(YB + (size_t)yr0_ * D + c0); Y1[q][j] = *(const int*)(YB + (size_t)yr1_ * D + c0); GV[q][j] = *(const f32x4*)(gt2 + c0); } } } while (0)
        P8_TOK(gw);
        P8_DATA(xw, y0, y1, gvr, wq, gw);
        P8_TOK(gw + 2 * NGW);
        for (int row0 = gw; row0 < T; row0 += 2 * NGW) {
            P8_DATA(nxw, ny0, ny1, ngv, nwq, row0 + 2 * NGW);
            P8_TOK(row0 + 4 * NGW);
#pragma unroll
            for (int q = 0; q < 2; ++q) { const int row = row0 + q * NGW; if (row >= T) break;
                const float w0 = wq[q][0], w1 = wq[q][1];
                f32x4 v[4]; float s = 0.f;
#pragma unroll
                for (int j = 0; j < 4; ++j) {
                    const f32x4 xv = (f32x4){bflo(xw[q][j].x), bfhi(xw[q][j].x), bflo(xw[q][j].y), bfhi(xw[q][j].y)}, gv = gvr[q][j];
                    const int a0 = y0[q][j], a1 = y1[q][j];
                    f32x4 mo;
                    mo[0] = w0 * __builtin_amdgcn_cvt_f32_fp8(a0, 0) + w1 * __builtin_amdgcn_cvt_f32_fp8(a1, 0); mo[1] = w0 * __builtin_amdgcn_cvt_f32_fp8(a0, 1) + w1 * __builtin_amdgcn_cvt_f32_fp8(a1, 1);
                    mo[2] = w0 * __builtin_amdgcn_cvt_f32_fp8(a0, 2) + w1 * __builtin_amdgcn_cvt_f32_fp8(a1, 2); mo[3] = w0 * __builtin_amdgcn_cvt_f32_fp8(a0, 3) + w1 * __builtin_amdgcn_cvt_f32_fp8(a1, 3);
                    v[j] = xv + gv * mo; s += (v[j][0] * v[j][0] + v[j][1] * v[j][1]) + (v[j][2] * v[j][2] + v[j][3] * v[j][3]); }
                const float rstd = rsqrtf(wave_sum(s) * (1.f / D) + EPS);
#pragma unroll
                for (int j = 0; j < 4; ++j) { const int c0 = 4 * lane + 256 * j; *(f32x4*)(a.out + (size_t)row * D + c0) = v[j] * rstd * fg[j]; }
            }
#pragma unroll
            for (int q = 0; q < 2; ++q) { wq[q][0] = nwq[q][0]; wq[q][1] = nwq[q][1];
#pragma unroll
                for (int j = 0; j < 4; ++j) { xw[q][j] = nxw[q][j]; y0[q][j] = ny0[q][j]; y1[q][j] = ny1[q][j]; gvr[q][j] = ngv[q][j]; } }
        }
    }
    }
    STAMP(14);
    if (PROBE_PHASE >= 0 && blockIdx.x == 0 && threadIdx.x == 0) { const unsigned long long t0_ = __builtin_amdgcn_s_memrealtime(); while (__builtin_amdgcn_s_memrealtime() - t0_ < spin_) __builtin_amdgcn_s_sleep(8); }
}

extern "C" void kernel_launch(void* const* d_in, const int* in_sizes, int n_in, void* d_out, int out_size, void* d_ws, size_t ws_size, hipStream_t stream) {
    static int grid = 0;
    if (grid == 0) {
        if (n_in != 31 || out_size != T * D || ws_size < WS_END) { fprintf(stderr, "kernel_launch: unexpected shapes: n_in %d out %d ws %zu (need %zu)\n", n_in, out_size, ws_size, (size_t)WS_END); grid = -1; return; }
        int dev = 0, cus = 0, per_cu = 0;
        if (hipGetDevice(&dev) != hipSuccess || hipDeviceGetAttribute(&cus, hipDeviceAttributeMultiprocessorCount, dev) != hipSuccess) { grid = -1; return; }
        if (hipFuncSetAttribute((const void*)fwd_kernel, hipFuncAttributeMaxDynamicSharedMemorySize, LDS_BYTES) != hipSuccess) { fprintf(stderr, "kernel_launch: hipFuncSetAttribute failed\n"); grid = -1; return; }
        if (hipOccupancyMaxActiveBlocksPerMultiprocessor(&per_cu, (const void*)fwd_kernel, 512, LDS_BYTES) != hipSuccess || per_cu < 1) { fprintf(stderr, "kernel_launch: occupancy query says %d blocks per CU\n", per_cu); grid = -1; return; }
        grid = cus;
        fprintf(stderr, "kernel_launch: cus %d per_cu %d grid %d ws %zu\n", cus, per_cu, grid, ws_size);
    }
    if (grid < 0) return;
    Args a{};
    for (int i = 0; i < 31; ++i) a.in[i] = (const float*)d_in[i];
    a.out = (float*)d_out; a.ws = (unsigned char*)d_ws;
    void* args[] = {&a};
    const hipError_t e = hipLaunchCooperativeKernel((const void*)fwd_kernel, dim3(grid), dim3(512), args, LDS_BYTES, stream);
    if (e != hipSuccess) fprintf(stderr, "kernel_launch: cooperative launch failed: %s (grid %d)\n", hipGetErrorString(e), grid);
}
```
